# Optimizing an MI355X kernel written in HIP

```python
import jax, jax.numpy as jnp
from jax import lax
import numpy as np

D_MODEL = 1024
BATCH = 2
SEQ = 8192
DEPTH = 2

GRID_W = 64
MLSTM_HEADS = 4
MLSTM_HD = 128
MLSTM_W = MLSTM_HEADS * MLSTM_HD
MLSTM_CHUNK = 64
CONV_W = 5
ATTN_HEADS = 8
KV_HEADS = 2
ATTN_HD = 64
ATTN_W = ATTN_HEADS * ATTN_HD
KV_W = KV_HEADS * ATTN_HD
Q_BLOCK = 128
ROPE_BASE = 10000.0
N_GROUPS = 4
EXPERTS_PER_GROUP = 8
N_EXPERTS = N_GROUPS * EXPERTS_PER_GROUP
TOP_K = 2
EXPERT_HIDDEN = 512
NORM_EPS = 1e-6
SPLIT_SIZES = (MLSTM_W, MLSTM_W, MLSTM_W, MLSTM_W, 4 * MLSTM_HEADS, ATTN_W, KV_W, KV_W, D_MODEL, D_MODEL)
IN_W = sum(SPLIT_SIZES)

kernel_name = 'hybrid_mlstm_gqa_hmoe_encoder'


def rms_norm(x, g):
    xf = x.astype(jnp.float32)
    y = xf * lax.rsqrt(jnp.mean(xf * xf, axis=-1, keepdims=True) + NORM_EPS)
    return (y * g.astype(jnp.float32)).astype(x.dtype)


def rope_tables(seq):
    rows = seq // GRID_W
    row = jnp.repeat(jnp.arange(rows, dtype=jnp.float32), GRID_W)
    col = jnp.tile(jnp.arange(GRID_W, dtype=jnp.float32), rows)
    half = ATTN_HD // 2
    inv_freq = ROPE_BASE ** (-jnp.arange(0, half, 2, dtype=jnp.float32) / half)
    ang_r = row[:, None] * inv_freq
    ang_c = col[:, None] * inv_freq
    return (jnp.cos(ang_r), jnp.sin(ang_r), jnp.cos(ang_c), jnp.sin(ang_c))


def rotate(x, cos, sin):
    x1, x2 = jnp.split(x, 2, axis=-1)
    return jnp.concatenate([x1 * cos - x2 * sin, x2 * cos + x1 * sin], axis=-1)


def axial_rope(x, tables):
    cr, sr, cc, sc = [t[:, None, :] for t in tables]
    xr, xc = jnp.split(x, 2, axis=-1)
    return jnp.concatenate([rotate(xr, cr, sr), rotate(xc, cc, sc)], axis=-1)


def bidirectional_gqa(q, k, v, q_g, k_g, tables):
    B, S = q.shape[0], q.shape[1]
    G = ATTN_HEADS // KV_HEADS
    q = axial_rope(rms_norm(q, q_g).astype(jnp.float32), tables)
    k = axial_rope(rms_norm(k, k_g).astype(jnp.float32), tables)
    nb = S // Q_BLOCK
    qb = q.reshape(B, nb, Q_BLOCK, KV_HEADS, G, ATTN_HD).transpose(1, 0, 3, 4, 2, 5)
    kt = k.transpose(0, 2, 1, 3)
    vt = v.transpose(0, 2, 1, 3)
    scale = ATTN_HD ** -0.5

    def block(q_blk):
        s = jnp.einsum('bkgqd,bksd->bkgqs', q_blk, kt) * scale
        p = jax.nn.softmax(s.astype(jnp.float32), axis=-1)
        return jnp.einsum('bkgqs,bksd->bkgqd', p.astype(vt.dtype), vt)

    o = lax.map(block, qb)
    return o.transpose(1, 0, 4, 2, 3, 5).reshape(B, S, ATTN_W)


def mlstm_one_direction(q, k, v, log_i, log_f):
    B, H, S, dh = q.shape
    L = MLSTM_CHUNK
    nc = S // L
    q = q.reshape(B, H, nc, L, dh)
    k = k.reshape(B, H, nc, L, dh)
    v = v.reshape(B, H, nc, L, dh)
    li = log_i.reshape(B, H, nc, L)
    lf = log_f.reshape(B, H, nc, L)
    b = jnp.cumsum(lf, axis=-1)
    b_last = b[..., -1]
    a = b_last[..., None] - b + li
    a_max = jnp.max(a, axis=-1)
    w = jnp.exp(a - a_max[..., None])
    c_chunk = jnp.einsum('bhcl,bhcld,bhcle->bhcde', w, v, k)
    n_chunk = jnp.einsum('bhcl,bhcle->bhce', w, k)

    def step(carry, inp):
        c_st, n_st, m_st = carry
        c_in, n_in, bl, am = inp
        m_new = jnp.maximum(bl + m_st, am)
        decay = jnp.exp(bl + m_st - m_new)
        inject = jnp.exp(am - m_new)
        c_new = decay[..., None, None] * c_st + inject[..., None, None] * c_in
        n_new = decay[..., None] * n_st + inject[..., None] * n_in
        return (c_new, n_new, m_new), (c_st, n_st, m_st)

    init = (jnp.zeros((B, H, dh, dh), jnp.float32), jnp.zeros((B, H, dh), jnp.float32), jnp.zeros((B, H), jnp.float32))
    xs = (jnp.moveaxis(c_chunk, 2, 0), jnp.moveaxis(n_chunk, 2, 0), jnp.moveaxis(b_last, 2, 0), jnp.moveaxis(a_max, 2, 0))
    _, (c_prev, n_prev, m_prev) = lax.scan(step, init, xs)
    c_prev = jnp.moveaxis(c_prev, 0, 2)
    n_prev = jnp.moveaxis(n_prev, 0, 2)
    m_prev = jnp.moveaxis(m_prev, 0, 2)

    lower = jnp.tril(jnp.ones((L, L), dtype=bool))
    d = jnp.where(lower, b[..., :, None] - b[..., None, :] + li[..., None, :], -jnp.inf)
    m_inter = b + m_prev[..., None]
    m_out = jnp.maximum(m_inter, jnp.max(d, axis=-1))
    dw = jnp.exp(d - m_out[..., None])
    inter_w = jnp.exp(m_inter - m_out)
    s = jnp.einsum('bhcjd,bhcld->bhcjl', q, k) * dw
    num = jnp.einsum('bhcjl,bhcld->bhcjd', s, v) + inter_w[..., None] * jnp.einsum('bhcde,bhcje->bhcjd', c_prev, q)
    den = jnp.sum(s, axis=-1) + inter_w * jnp.einsum('bhce,bhcje->bhcj', n_prev, q)
    h = num / jnp.maximum(jnp.abs(den), jnp.exp(-m_out))[..., None]
    return h.reshape(B, H, S, dh)


def mlstm_mixer(q_pre, k_pre, v, o_pre, gates, conv_w, conv_b, norm_g):
    B, S = q_pre.shape[0], q_pre.shape[1]
    H, dh = MLSTM_HEADS, MLSTM_HD
    qk = jnp.concatenate([q_pre, k_pre], axis=-1)
    qk = lax.conv_general_dilated(qk, conv_w, window_strides=(1,), padding=[(CONV_W // 2, CONV_W // 2)],
                                  dimension_numbers=('NWC', 'WIO', 'NWC'), feature_group_count=2 * MLSTM_W) + conv_b
    qk = jax.nn.silu(qk)
    q, k = jnp.split(qk, 2, axis=-1)

    def heads(t):
        return t.reshape(B, S, H, dh).transpose(0, 2, 1, 3).astype(jnp.float32)

    q = heads(q) * (MLSTM_HD ** -0.5)
    k = heads(k)
    v = heads(v)
    g = gates.astype(jnp.float32).reshape(B, S, 4, H).transpose(2, 0, 3, 1)
    h_fwd = mlstm_one_direction(q, k, v, g[0], jax.nn.log_sigmoid(g[1]))

    def flip(t):
        return jnp.flip(t, axis=2)

    h_bwd = flip(mlstm_one_direction(flip(q), flip(k), flip(v), flip(g[2]), flip(jax.nn.log_sigmoid(g[3]))))
    h = (h_fwd + h_bwd).transpose(0, 2, 1, 3)
    h = rms_norm(h, norm_g.reshape(H, dh))
    return h.reshape(B, S, MLSTM_W).astype(o_pre.dtype) * jax.nn.sigmoid(o_pre)


def hierarchical_moe(h, w_rg, b_rg, w_re, b_re, w_gate, w_up, w_down):
    B, S, D = h.shape
    t = h.reshape(B * S, D)
    tf = t.astype(jnp.float32)
    p_group = jax.nn.softmax(tf @ w_rg.astype(jnp.float32) + b_rg.astype(jnp.float32), axis=-1)
    p_top, g_idx = lax.top_k(p_group, 1)
    e_logits = (tf @ w_re.astype(jnp.float32) + b_re.astype(jnp.float32)).reshape(-1, N_GROUPS, EXPERTS_PER_GROUP)
    e_logits = jnp.take_along_axis(e_logits, g_idx[:, :, None], axis=1)[:, 0]
    p_exp = jax.nn.softmax(e_logits, axis=-1)
    w_top, e_idx = lax.top_k(p_exp, TOP_K)
    w_top = w_top / jnp.sum(w_top, axis=-1, keepdims=True) * p_top
    expert_id = g_idx * EXPERTS_PER_GROUP + e_idx
    combine = jnp.sum(jax.nn.one_hot(expert_id, N_EXPERTS, dtype=jnp.float32) * w_top[..., None], axis=1).astype(t.dtype)
    out = jnp.zeros_like(t)
    for g in range(N_GROUPS):
        sl = slice(g * EXPERTS_PER_GROUP, (g + 1) * EXPERTS_PER_GROUP)
        a = jnp.einsum('td,edf->tef', t, w_gate[sl])
        u = jnp.einsum('td,edf->tef', t, w_up[sl])
        act = jax.nn.silu(a) * u * combine[:, sl, None]
        out = out + jnp.einsum('tef,efd->td', act, w_down[sl])
    return out.reshape(B, S, D)


def setup_inputs(seed: int = 0) -> dict:
    key = jax.random.key(seed)
    ks = iter(jax.random.split(key, 32))

    def normal(shape, scale):
        return scale * jax.random.normal(next(ks), shape, jnp.float32)

    D, H, F = D_MODEL, MLSTM_HEADS, EXPERT_HIDDEN
    x = normal((BATCH, SEQ, D), 1.0)
    c = normal((BATCH, D), 1.0)
    w_ada = normal((DEPTH, D, 6 * D), 0.5 * D ** -0.5)
    b_ada = normal((DEPTH, 6 * D), 0.02)
    norm1_g = 1.0 + normal((DEPTH, D), 0.02)
    w_in = normal((DEPTH, D, IN_W), D ** -0.5)
    b_in = normal((DEPTH, IN_W), 0.02)
    f_off = 4 * MLSTM_W
    f_bias = jnp.linspace(3.0, 6.0, H, dtype=jnp.float32)
    b_in = b_in.at[:, f_off + H:f_off + 2 * H].add(f_bias).at[:, f_off + 3 * H:f_off + 4 * H].add(f_bias)
    conv_w = normal((DEPTH, CONV_W, 1, 2 * MLSTM_W), CONV_W ** -0.5)
    conv_b = normal((DEPTH, 2 * MLSTM_W), 0.02)
    mlstm_norm_g = 1.0 + normal((DEPTH, MLSTM_W), 0.02)
    q_norm_g = 1.0 + normal((DEPTH, ATTN_HD), 0.02)
    k_norm_g = 1.0 + normal((DEPTH, ATTN_HD), 0.02)
    w_branch_m = normal((DEPTH, MLSTM_W, D), MLSTM_W ** -0.5)
    w_branch_a = normal((DEPTH, ATTN_W, D), ATTN_W ** -0.5)
    w_out = normal((DEPTH, D, D), D ** -0.5)
    norm2_g = 1.0 + normal((DEPTH, D), 0.02)
    w_router_group = normal((DEPTH, D, N_GROUPS), D ** -0.5)
    b_router_group = normal((DEPTH, N_GROUPS), 0.01)
    w_router_expert = normal((DEPTH, D, N_EXPERTS), D ** -0.5)
    b_router_expert = normal((DEPTH, N_EXPERTS), 0.01)
    w_gate = normal((DEPTH, N_EXPERTS, D, F), D ** -0.5)
    w_up = normal((DEPTH, N_EXPERTS, D, F), D ** -0.5)
    w_down = normal((DEPTH, N_EXPERTS, F, D), F ** -0.5)
    final_norm_g = 1.0 + normal((D,), 0.02)
    return {'x': x, 'c': c, 'w_ada': w_ada, 'b_ada': b_ada, 'norm1_g': norm1_g, 'w_in': w_in, 'b_in': b_in,
            'conv_w': conv_w, 'conv_b': conv_b, 'mlstm_norm_g': mlstm_norm_g, 'q_norm_g': q_norm_g,
            'k_norm_g': k_norm_g, 'w_branch_m': w_branch_m, 'w_branch_a': w_branch_a, 'w_out': w_out,
            'norm2_g': norm2_g, 'w_router_group': w_router_group, 'b_router_group': b_router_group,
            'w_router_expert': w_router_expert, 'b_router_expert': b_router_expert, 'w_gate': w_gate,
            'w_up': w_up, 'w_down': w_down, 'final_norm_g': final_norm_g}


def reference(x, c, w_ada, b_ada, norm1_g, w_in, b_in, conv_w, conv_b, mlstm_norm_g, q_norm_g, k_norm_g,
              w_branch_m, w_branch_a, w_out, norm2_g, w_router_group, b_router_group, w_router_expert,
              b_router_expert, w_gate, w_up, w_down, final_norm_g):
    B, S, D = x.shape
    tables = rope_tables(S)
    offsets = np.cumsum(SPLIT_SIZES)[:-1].tolist()
    cond = jax.nn.silu(c)
    for l in range(DEPTH):
        mod = cond @ w_ada[l] + b_ada[l]
        shift1, scale1, gate1, shift2, scale2, gate2 = [m[:, None, :] for m in jnp.split(mod, 6, axis=-1)]
        h = rms_norm(x, norm1_g[l]) * (1 + scale1) + shift1
        proj = h @ w_in[l] + b_in[l]
        mq, mk, mv, mo, mgates, aq, ak, av, gm, ga = jnp.split(proj, offsets, axis=-1)
        y_m = mlstm_mixer(mq, mk, mv, mo, mgates, conv_w[l], conv_b[l], mlstm_norm_g[l])
        y_a = bidirectional_gqa(aq.reshape(B, S, ATTN_HEADS, ATTN_HD), ak.reshape(B, S, KV_HEADS, ATTN_HD),
                                av.reshape(B, S, KV_HEADS, ATTN_HD), q_norm_g[l], k_norm_g[l], tables)
        merged = jax.nn.sigmoid(gm) * (y_m @ w_branch_m[l]) + jax.nn.sigmoid(ga) * (y_a.astype(x.dtype) @ w_branch_a[l])
        x = x + gate1 * (merged @ w_out[l])
        h2 = rms_norm(x, norm2_g[l]) * (1 + scale2) + shift2
        x = x + gate2 * hierarchical_moe(h2, w_router_group[l], b_router_group[l], w_router_expert[l],
                                         b_router_expert[l], w_gate[l], w_up[l], w_down[l])
    return rms_norm(x, final_norm_g)
```

```cpp
#ifdef EMU
#include "emu.h"
#define TID emu_tid()
#define BID emu_bid()
#define NBLK emu_nblk()
#define SYNC() emu_syncthreads()
#define DEV static inline
#define DEVM inline
#else
#include <hip/hip_runtime.h>
#include <cstdio>
#include <cstdint>
#define TID ((int)threadIdx.x)
#define BID ((int)blockIdx.x)
#define NBLK ((int)gridDim.x)
#define SYNC() __syncthreads()
#define DEV __device__ __forceinline__
#define DEVM __device__ __forceinline__
#endif

#ifndef CFG_SEQ
#define CFG_SEQ 8192
#endif
#ifndef CFG_BATCH
#define CFG_BATCH 2
#endif

typedef unsigned short bf16_t;
typedef short bf16x8 __attribute__((ext_vector_type(8)));
typedef float f32x4 __attribute__((ext_vector_type(4)));
typedef unsigned u32x4 __attribute__((ext_vector_type(4)));
typedef unsigned u32x2 __attribute__((ext_vector_type(2)));

constexpr int D = 1024, BATCH = CFG_BATCH, SEQ = CFG_SEQ, DEPTH = 2, T = BATCH * SEQ;
constexpr int GRID_W = 64;
constexpr int MH = 4, MHD = 128, MW = 512, ML = 64, NC = SEQ / ML, CONVW = 5;
constexpr int AH = 8, KVH = 2, AHD = 64, AW = 512, KVW = 128;
constexpr int NG = 4, EPG = 8, NE = 32, FF = 512;
constexpr float EPS = 1e-6f;
constexpr int IN_W = 4880, NP = 4992;
constexpr int C_MQ = 0, C_MK = 512, C_MV = 1024, C_MO = 1536, C_GATES = 2048, C_AQ = 2064, C_AK = 2576, C_AV = 2704, C_GM = 2832, C_GA = 3856;
constexpr int NTHREADS = 512;
constexpr int BHC = BATCH * MH * NC;
constexpr int ROWT_MAX = (2 * T) / 128 + NE;
constexpr int ACT_ROWS = ROWT_MAX * 128;

constexpr size_t al256(size_t x) { return (x + 255) & ~(size_t)255; }
constexpr size_t WS_CTL = 0, CTL_BYTES = 1 << 20;
constexpr size_t WS_MOD = WS_CTL + CTL_BYTES;
constexpr size_t WS_ROPE = WS_MOD + al256((size_t)DEPTH * BATCH * 6 * D * 4);
constexpr size_t WS_WIN = WS_ROPE + al256((size_t)(2 * (SEQ / GRID_W) * 16 + 2 * 64 * 16) * 4);
constexpr size_t WS_WBM = WS_WIN + (size_t)NP * D * 2;
constexpr size_t WS_WBA = WS_WBM + (size_t)D * MW * 2;
constexpr size_t WS_WOUT = WS_WBA + (size_t)D * AW * 2;
constexpr size_t WS_WGU = WS_WOUT + (size_t)D * D * 2;
constexpr size_t WS_WD = WS_WGU + (size_t)NE * 2 * FF * D * 2;
constexpr size_t WS_PROJ = WS_WD + (size_t)NE * D * FF * 2;
constexpr size_t WS_ACT = WS_PROJ;
constexpr size_t WS_Y = WS_ACT + al256((size_t)ACT_ROWS * FF * 2);
constexpr size_t PROJ_BYTES = (size_t)T * NP * 2;
static_assert(WS_Y + (size_t)2 * T * D * 2 <= WS_PROJ + PROJ_BYTES || T < 4096, "ACT + Y must fit into the PROJ overlay");
constexpr size_t OVL_BYTES = (WS_Y + (size_t)2 * T * D * 2 - WS_PROJ) > PROJ_BYTES ? (WS_Y + (size_t)2 * T * D * 2 - WS_PROJ) : PROJ_BYTES;
constexpr size_t WS_GATES = WS_PROJ + al256(OVL_BYTES);
constexpr size_t WS_QC = WS_GATES + (size_t)T * 16 * 4;
constexpr size_t WS_KC = WS_QC + (size_t)T * MW * 2;
constexpr size_t WS_MERGED = WS_QC;
constexpr size_t WS_AQN = WS_KC + (size_t)T * MW * 2;
constexpr size_t WS_AKN = WS_AQN + (size_t)T * AW * 2;
constexpr size_t WS_VT = WS_AKN + (size_t)T * KVW * 2;
constexpr size_t WS_CST = WS_VT + (size_t)T * KVW * 2;
constexpr size_t WS_H = WS_CST;
constexpr size_t CST_BYTES = (size_t)2 * BHC * 128 * 128 * 2;
static_assert((size_t)T * D * 2 <= CST_BYTES, "H fits in CST");
constexpr size_t WS_NST = WS_CST + CST_BYTES;
constexpr size_t WS_AMAX = WS_NST + (size_t)2 * BHC * 128 * 4;
constexpr size_t WS_BLAST = WS_AMAX + al256((size_t)2 * BHC * 4);
constexpr size_t WS_MPREV = WS_BLAST + al256((size_t)2 * BHC * 4);
constexpr size_t WS_YM = WS_MPREV + al256((size_t)2 * BHC * 4);
constexpr size_t WS_YA = WS_YM + (size_t)T * MW * 2;
constexpr size_t WS_LIST = WS_YA + (size_t)T * AW * 2;
constexpr size_t WS_WENT = WS_LIST + (size_t)NE * T * 4;
constexpr size_t WS_TOTAL = WS_WENT + (size_t)2 * T * 4;
constexpr int CW_CNT = 64;
constexpr int CW_BAR = 4096;

struct Params {
  const float *x, *c, *w_ada, *b_ada, *norm1_g, *w_in, *b_in, *conv_w, *conv_b, *mlstm_norm_g, *q_norm_g, *k_norm_g, *w_branch_m, *w_branch_a, *w_out, *norm2_g,
      *w_rg, *b_rg, *w_re, *b_re, *w_gate, *w_up, *w_down, *final_g;
  float* out; unsigned char* ws;
};

DEV float bf2f(bf16_t h) { return __builtin_bit_cast(float, (unsigned)h << 16); }
DEV bf16_t f2bf(float f) { unsigned u = __builtin_bit_cast(unsigned, f); return (bf16_t)((u + 0x7fffu + ((u >> 16) & 1u)) >> 16); }
DEV unsigned pk2(float lo, float hi) { return (unsigned)f2bf(lo) | ((unsigned)f2bf(hi) << 16); }
DEV float sigmoidf_(float x) { return 1.f / (1.f + expf(-x)); }
DEV float siluf_(float x) { return x / (1.f + expf(-x)); }
DEV float logsigmoidf_(float x) { return fminf(x, 0.f) - log1pf(expf(-fabsf(x))); }

#ifdef EMU
static inline f32x4 mfma16(bf16x8 a, bf16x8 b, f32x4 c) {
  struct In { bf16x8 a, b; f32x4 c; } in{a, b, c}; f32x4 out;
  emu_collective(&in, sizeof(In), &out, sizeof(out), [](char (*I)[64], char (*O)[32]) {
    float Dm[16][16];
    for (int r = 0; r < 16; ++r) for (int cc = 0; cc < 16; ++cc) { In* L = (In*)I[(r >> 2) * 16 + cc]; Dm[r][cc] = L->c[r & 3]; }
    for (int r = 0; r < 16; ++r) for (int cc = 0; cc < 16; ++cc) { float s = 0.f;
      for (int g = 0; g < 4; ++g) { In* LA = (In*)I[g * 16 + r]; In* LB = (In*)I[g * 16 + cc]; for (int j = 0; j < 8; ++j) s += bf2f((bf16_t)LA->a[j]) * bf2f((bf16_t)LB->b[j]); }
      Dm[r][cc] += s; }
    for (int l = 0; l < 64; ++l) { f32x4 o; for (int i = 0; i < 4; ++i) o[i] = Dm[(l >> 4) * 4 + i][l & 15]; memcpy(O[l], &o, 16); } });
  return out;
}
static inline f32x4 mfma4f32(float a, float b, f32x4 c) {
  struct In { float a, b; f32x4 c; } in{a, b, c}; f32x4 out;
  emu_collective(&in, sizeof(In), &out, sizeof(out), [](char (*I)[64], char (*O)[32]) {
    for (int l = 0; l < 64; ++l) { f32x4 o; for (int i = 0; i < 4; ++i) { const int r = (l >> 4) * 4 + i, cc = l & 15; float s = ((In*)I[l])->c[i];
      for (int k = 0; k < 4; ++k) s = fmaf(((In*)I[k * 16 + r])->a, ((In*)I[k * 16 + cc])->b, s); o[i] = s; } memcpy(O[l], &o, 16); } });
  return out;
}
static inline float shfl_xor_f(float v, int m) { float out; emu_collective(&v, 4, &out, 4, [m](char (*I)[64], char (*O)[32]) { for (int l = 0; l < 64; ++l) memcpy(O[l], I[l ^ m], 4); }); return out; }
static inline float shfl_f(float v, int src) { struct In { float v; int s; } in{v, src}; float out;
  emu_collective(&in, 8, &out, 4, [](char (*I)[64], char (*O)[32]) { for (int l = 0; l < 64; ++l) { In* me = (In*)I[l]; memcpy(O[l], I[me->s & 63], 4); } }); return out; }
static inline int atomic_add_i(int* p, int v) { return __atomic_fetch_add(p, v, __ATOMIC_RELAXED); }
#define LDS_PTR() emu_lds()
#else
DEV f32x4 mfma16(bf16x8 a, bf16x8 b, f32x4 c) { return __builtin_amdgcn_mfma_f32_16x16x32_bf16(a, b, c, 0, 0, 0); }
DEV f32x4 mfma4f32(float a, float b, f32x4 c) { return __builtin_amdgcn_mfma_f32_16x16x4f32(a, b, c, 0, 0, 0); }
DEV float shfl_xor_f(float v, int m) { return __shfl_xor(v, m, 64); }
DEV float shfl_f(float v, int src) { return __shfl(v, src, 64); }
DEV int atomic_add_i(int* p, int v) { return atomicAdd(p, v); }
extern __shared__ __attribute__((aligned(16))) char dyn_lds[];
#define LDS_PTR() (dyn_lds)
#endif
DEV float wave_sum(float v) { for (int m = 1; m < 64; m <<= 1) v += shfl_xor_f(v, m); return v; }
DEV float grp16_sum(float v) { for (int m = 1; m < 16; m <<= 1) v += shfl_xor_f(v, m); return v; }
DEV float grp16_max(float v) { for (int m = 1; m < 16; m <<= 1) v = fmaxf(v, shfl_xor_f(v, m)); return v; }
DEV bf16x8 ld8(const bf16_t* p) { return __builtin_bit_cast(bf16x8, *(const u32x4*)p); }

DEV void phase_mod_rope(const Params& p) {
  float* mod = (float*)(p.ws + WS_MOD);
  const int gtid = BID * NTHREADS + TID, gstride = NBLK * NTHREADS;
  for (int o = gtid; o < DEPTH * BATCH * 6 * D; o += gstride) {
    const int n = o % (6 * D), b = (o / (6 * D)) % BATCH, l = o / (6 * D * BATCH);
    const float* w = p.w_ada + (size_t)l * D * 6 * D + n; const float* cv = p.c + b * D;
    float s = p.b_ada[l * 6 * D + n];
    for (int k = 0; k < D; ++k) s += siluf_(cv[k]) * w[(size_t)k * 6 * D];
    mod[o] = s;
  }
  float* rope = (float*)(p.ws + WS_ROPE);
  constexpr int NR = SEQ / GRID_W;
  for (int o = gtid; o < (NR + 64) * 16; o += gstride) {
    const int i = o & 15, pos = o >> 4;
    const float inv = powf(10000.f, -(float)(2 * i) / 32.f);
    if (pos < NR) { const float a = (float)pos * inv; rope[pos * 16 + i] = cosf(a); rope[NR * 16 + pos * 16 + i] = sinf(a); }
    else { const int cpos = pos - NR; const float a = (float)cpos * inv; rope[2 * NR * 16 + cpos * 16 + i] = cosf(a); rope[2 * NR * 16 + 64 * 16 + cpos * 16 + i] = sinf(a); }
  }
}
DEV void transpose_item(char* lds, const float* src, int K, int N, bf16_t* dst, int mode, int item) {
  float* tile = (float*)lds;
  const int ntn = (N + 63) / 64, tk = item / ntn, tn = item % ntn, tid = TID;
  const int k0 = tk * 64, n0 = tn * 64;
  { const int kk = tid >> 3, c8 = (tid & 7) * 8;
    const float* s = src + (size_t)(k0 + kk) * N + n0 + c8;
    for (int j = 0; j < 8; ++j) tile[kk * 65 + c8 + j] = (n0 + c8 + j < N) ? s[j] : 0.f; }
  SYNC();
  { const int nn = tid >> 3, k8 = (tid & 7) * 8, n = n0 + nn;
    if (n < N) {
      int row = n; if (mode == 1) row = 32 * (n >> 4) + (n & 15); else if (mode == 2) row = 32 * (n >> 4) + 16 + (n & 15);
      u32x4 v; v.x = pk2(tile[(k8 + 0) * 65 + nn], tile[(k8 + 1) * 65 + nn]); v.y = pk2(tile[(k8 + 2) * 65 + nn], tile[(k8 + 3) * 65 + nn]);
      v.z = pk2(tile[(k8 + 4) * 65 + nn], tile[(k8 + 5) * 65 + nn]); v.w = pk2(tile[(k8 + 6) * 65 + nn], tile[(k8 + 7) * 65 + nn]);
      *(u32x4*)(dst + (size_t)row * K + k0 + k8) = v; } }
  SYNC();
}
DEV void phase_convert(const Params& p, int l) {
  char* lds = LDS_PTR();
  constexpr int I_IN = (D / 64) * ((IN_W + 63) / 64), I_BM = (MW / 64) * (D / 64), I_BA = (AW / 64) * (D / 64), I_OUT = (D / 64) * (D / 64);
  constexpr int I_G = (D / 64) * (FF / 64), I_D = (FF / 64) * (D / 64);
  constexpr int B1 = I_IN, B2 = B1 + I_BM, B3 = B2 + I_BA, B4 = B3 + I_OUT, B5 = B4 + NE * I_G, B6 = B5 + NE * I_G, B7 = B6 + NE * I_D;
  for (int it = BID; it < B7; it += NBLK) {
    if (it < B1) transpose_item(lds, p.w_in + (size_t)l * D * IN_W, D, IN_W, (bf16_t*)(p.ws + WS_WIN), 0, it);
    else if (it < B2) transpose_item(lds, p.w_branch_m + (size_t)l * MW * D, MW, D, (bf16_t*)(p.ws + WS_WBM), 0, it - B1);
    else if (it < B3) transpose_item(lds, p.w_branch_a + (size_t)l * AW * D, AW, D, (bf16_t*)(p.ws + WS_WBA), 0, it - B2);
    else if (it < B4) transpose_item(lds, p.w_out + (size_t)l * D * D, D, D, (bf16_t*)(p.ws + WS_WOUT), 0, it - B3);
    else if (it < B5) { const int e = (it - B4) / I_G, r = (it - B4) % I_G; transpose_item(lds, p.w_gate + ((size_t)l * NE + e) * D * FF, D, FF, (bf16_t*)(p.ws + WS_WGU) + (size_t)e * 2 * FF * D, 1, r); }
    else if (it < B6) { const int e = (it - B5) / I_G, r = (it - B5) % I_G; transpose_item(lds, p.w_up + ((size_t)l * NE + e) * D * FF, D, FF, (bf16_t*)(p.ws + WS_WGU) + (size_t)e * 2 * FF * D, 2, r); }
    else { const int e = (it - B6) / I_D, r = (it - B6) % I_D; transpose_item(lds, p.w_down + ((size_t)l * NE + e) * FF * D, FF, D, (bf16_t*)(p.ws + WS_WD) + (size_t)e * D * FF, 0, r); }
  }
}

DEV void phase_norm(const Params& p, int l, int mode, int which) {
  const int lane = TID & 63, wv = TID >> 6, nwv = NTHREADS / 64;
  const float* mod = (const float*)(p.ws + WS_MOD);
  bf16_t* H = (bf16_t*)(p.ws + WS_H);
  const bf16_t* Y = (const bf16_t*)(p.ws + WS_Y);
  for (int t = BID * nwv + wv; t < T; t += NBLK * nwv) {
    const int b = t / SEQ;
    f32x4 v[4]; float ss = 0.f;
    for (int i = 0; i < 4; ++i) {
      const int c4 = lane + 64 * i;
      if (mode == 0) v[i] = ((const f32x4*)(p.x + (size_t)t * D))[c4];
      else {
        v[i] = ((const f32x4*)(p.out + (size_t)t * D))[c4];
        if (mode == 1) {
          const f32x4 g2 = ((const f32x4*)(mod + ((size_t)(l - 1) * BATCH + b) * 6 * D + 5 * D))[c4];
          const u32x2 y0 = ((const u32x2*)(Y + (size_t)(2 * t) * D))[c4], y1 = ((const u32x2*)(Y + (size_t)(2 * t + 1) * D))[c4];
          v[i][0] += g2[0] * (bf2f((bf16_t)(y0.x & 0xffff)) + bf2f((bf16_t)(y1.x & 0xffff)));
          v[i][1] += g2[1] * (bf2f((bf16_t)(y0.x >> 16)) + bf2f((bf16_t)(y1.x >> 16)));
          v[i][2] += g2[2] * (bf2f((bf16_t)(y0.y & 0xffff)) + bf2f((bf16_t)(y1.y & 0xffff)));
          v[i][3] += g2[3] * (bf2f((bf16_t)(y0.y >> 16)) + bf2f((bf16_t)(y1.y >> 16)));
        }
      }
      ss += v[i][0] * v[i][0] + v[i][1] * v[i][1] + v[i][2] * v[i][2] + v[i][3] * v[i][3];
    }
    ss = wave_sum(ss);
    const float rs = 1.f / sqrtf(ss * (1.f / D) + EPS);
    if (which == 2) {
      for (int i = 0; i < 4; ++i) { const int c4 = lane + 64 * i; const f32x4 g = ((const f32x4*)p.final_g)[c4];
        f32x4 o; for (int j = 0; j < 4; ++j) o[j] = v[i][j] * rs * g[j]; ((f32x4*)(p.out + (size_t)t * D))[c4] = o; }
      continue;
    }
    if (mode != 2) for (int i = 0; i < 4; ++i) ((f32x4*)(p.out + (size_t)t * D))[lane + 64 * i] = v[i];
    const float* mb = mod + ((size_t)l * BATCH + b) * 6 * D + (which == 0 ? 0 : 3 * D);
    const float* gw = (which == 0 ? p.norm1_g : p.norm2_g) + (size_t)l * D;
    f32x4 hv[4];
    for (int i = 0; i < 4; ++i) { const int c4 = lane + 64 * i;
      const f32x4 g = ((const f32x4*)gw)[c4], sh = ((const f32x4*)mb)[c4], sc = ((const f32x4*)(mb + D))[c4];
      for (int j = 0; j < 4; ++j) hv[i][j] = (v[i][j] * rs * g[j]) * (1.f + sc[j]) + sh[j];
      u32x2 o; o.x = pk2(hv[i][0], hv[i][1]); o.y = pk2(hv[i][2], hv[i][3]); ((u32x2*)(H + (size_t)t * D))[c4] = o; }
  }
}
constexpr int HSP = 1028;
DEV void phase_norm2_router(const Params& p, int l) {
  char* lds = LDS_PTR();
  float* HS = (float*)lds;
  float* PART = HS + 16 * HSP;
  const int tid = TID, lane = tid & 63, w = tid >> 6;
  const float* mod = (const float*)(p.ws + WS_MOD);
  bf16_t* H = (bf16_t*)(p.ws + WS_H);
  const float* wrg = p.w_rg + (size_t)l * D * NG; const float* wre = p.w_re + (size_t)l * D * NE;
  const float* gw = p.norm2_g + (size_t)l * D;
  for (int tb = BID * 16; tb < T; tb += NBLK * 16) {
    SYNC();
    for (int q = 0; q < 2; ++q) {
      const int tl = 2 * w + q, t = tb + tl, b = t / SEQ;
      f32x4 v[4]; float ss = 0.f;
      for (int i = 0; i < 4; ++i) { v[i] = ((const f32x4*)(p.out + (size_t)t * D))[lane + 64 * i]; ss += v[i][0] * v[i][0] + v[i][1] * v[i][1] + v[i][2] * v[i][2] + v[i][3] * v[i][3]; }
      ss = wave_sum(ss);
      const float rs = 1.f / sqrtf(ss * (1.f / D) + EPS);
      const float* mb = mod + ((size_t)l * BATCH + b) * 6 * D + 3 * D;
      for (int i = 0; i < 4; ++i) { const int c4 = lane + 64 * i;
        const f32x4 g = ((const f32x4*)gw)[c4], sh = ((const f32x4*)mb)[c4], sc = ((const f32x4*)(mb + D))[c4];
        f32x4 hv; for (int j = 0; j < 4; ++j) hv[j] = (v[i][j] * rs * g[j]) * (1.f + sc[j]) + sh[j];
        u32x2 o; o.x = pk2(hv[0], hv[1]); o.y = pk2(hv[2], hv[3]); ((u32x2*)(H + (size_t)t * D))[c4] = o;
        *(f32x4*)(HS + tl * HSP + 4 * c4) = hv; }
    }
    SYNC();
    f32x4 acc[3]; for (int nt = 0; nt < 3; ++nt) acc[nt] = (f32x4){0.f, 0.f, 0.f, 0.f};
#pragma unroll 4
    for (int kk = 0; kk < 32; ++kk) {
      const int d = 128 * w + 4 * kk + (lane >> 4);
      const float a = HS[(lane & 15) * HSP + d];
      const int o0 = lane & 15;
      const float b0 = (o0 < NG) ? wrg[(size_t)d * NG + o0] : wre[(size_t)d * NE + o0 - NG];
      const float b1 = wre[(size_t)d * NE + 16 + o0 - NG];
      const float b2 = (o0 < NG) ? wre[(size_t)d * NE + 32 + o0 - NG] : 0.f;
      acc[0] = mfma4f32(a, b0, acc[0]); acc[1] = mfma4f32(a, b1, acc[1]); acc[2] = mfma4f32(a, b2, acc[2]);
    }
    for (int nt = 0; nt < 3; ++nt) for (int i = 0; i < 4; ++i) PART[(w * 16 + (lane >> 4) * 4 + i) * 48 + nt * 16 + (lane & 15)] = acc[nt][i];
    SYNC();
    if (tid < 16) {
      const int t = tb + tid;
      float lg[NG];
      int g = 0; float gmx = -3.0e38f;
#pragma unroll
      for (int o = 0; o < NG; ++o) { float s = p.b_rg[l * NG + o];
#pragma unroll 1
        for (int ww = 0; ww < 8; ++ww) s += PART[(ww * 16 + tid) * 48 + o]; lg[o] = s; if (s > gmx) { gmx = s; g = o; } }
      float gsum = 0.f; for (int o = 0; o < NG; ++o) gsum += expf(lg[o] - gmx);
      const float ptop = 1.f / gsum;
      int e0 = 0, e1 = 0; float m0 = -3.0e38f, m1 = -3.0e38f;
#pragma unroll 1
      for (int j = 0; j < EPG; ++j) { float s = p.b_re[l * NE + g * EPG + j];
#pragma unroll 1
        for (int ww = 0; ww < 8; ++ww) s += PART[(ww * 16 + tid) * 48 + NG + g * EPG + j];
        if (s > m0) { m1 = m0; e1 = e0; m0 = s; e0 = j; } else if (s > m1) { m1 = s; e1 = j; } }
      const float x1 = expf(m1 - m0), w0 = ptop / (1.f + x1), w1 = ptop * x1 / (1.f + x1);
      int* cnt = (int*)(p.ws + WS_CTL) + CW_CNT + l * NE; int* list = (int*)(p.ws + WS_LIST); float* went = (float*)(p.ws + WS_WENT);
      const int ea = g * EPG + e0, eb = g * EPG + e1;
      const int pa = atomic_add_i(cnt + ea, 1); list[(size_t)ea * T + pa] = 2 * t; went[2 * t] = w0;
      const int pb = atomic_add_i(cnt + eb, 1); list[(size_t)eb * T + pb] = 2 * t + 1; went[2 * t + 1] = w1;
    }
  }
}

constexpr int GP = 72;
struct RowPlain { const bf16_t* base; size_t ld; DEVM const bf16_t* operator()(int r) const { return base + (size_t)r * ld; } };
template <class RowA>
DEV void gemm_kloop(char* lds, const RowA& rowA, const bf16_t* Bt, size_t ldb, int K, f32x4 (&acc)[4][2]) {
  bf16_t* As = (bf16_t*)lds; bf16_t* Bs = As + 128 * GP;
  const int tid = TID, lane = tid & 63, w = tid >> 6, wm = w >> 2, wn = w & 3;
  const int r0 = tid >> 3, pc = (tid & 7) * 8;
  const bf16_t* a0 = rowA(r0) + pc; const bf16_t* a1 = rowA(r0 + 64) + pc;
  const bf16_t* b0 = Bt + (size_t)r0 * ldb + pc; const bf16_t* b1 = Bt + (size_t)(r0 + 64) * ldb + pc;
  u32x4 ra0 = *(const u32x4*)a0, ra1 = *(const u32x4*)a1, rb0 = *(const u32x4*)b0, rb1 = *(const u32x4*)b1;
  const int nk = K / 64;
  for (int kt = 0; kt < nk; ++kt) {
    SYNC();
    *(u32x4*)(As + r0 * GP + pc) = ra0; *(u32x4*)(As + (r0 + 64) * GP + pc) = ra1;
    *(u32x4*)(Bs + r0 * GP + pc) = rb0; *(u32x4*)(Bs + (r0 + 64) * GP + pc) = rb1;
    SYNC();
    if (kt + 1 < nk) { const int ko = (kt + 1) * 64; ra0 = *(const u32x4*)(a0 + ko); ra1 = *(const u32x4*)(a1 + ko); rb0 = *(const u32x4*)(b0 + ko); rb1 = *(const u32x4*)(b1 + ko); }
#pragma unroll
    for (int ks = 0; ks < 2; ++ks) {
      const int kof = ks * 32 + (lane >> 4) * 8;
      bf16x8 af[4], bfr[2];
#pragma unroll
      for (int mt = 0; mt < 4; ++mt) af[mt] = ld8(As + (wm * 64 + mt * 16 + (lane & 15)) * GP + kof);
#pragma unroll
      for (int nt = 0; nt < 2; ++nt) bfr[nt] = ld8(Bs + (wn * 32 + nt * 16 + (lane & 15)) * GP + kof);
#pragma unroll
      for (int mt = 0; mt < 4; ++mt)
#pragma unroll
        for (int nt = 0; nt < 2; ++nt) acc[mt][nt] = mfma16(af[mt], bfr[nt], acc[mt][nt]);
    }
  }
}
DEV void zero_acc(f32x4 (&acc)[4][2]) { for (int i = 0; i < 4; ++i) for (int j = 0; j < 2; ++j) acc[i][j] = (f32x4){0.f, 0.f, 0.f, 0.f}; }

DEV void phase_gemm_in(const Params& p, int l) {
  char* lds = LDS_PTR();
  const bf16_t* H = (const bf16_t*)(p.ws + WS_H); const bf16_t* W = (const bf16_t*)(p.ws + WS_WIN);
  bf16_t* PROJ = (bf16_t*)(p.ws + WS_PROJ); float* GATES = (float*)(p.ws + WS_GATES);
  const float* bias = p.b_in + (size_t)l * IN_W;
  constexpr int nM = T / 128, nN = NP / 128;
  const int lane = TID & 63, w = TID >> 6, wm = w >> 2, wn = w & 3;
  for (int u = BID; u < nM * nN; u += NBLK) {
    const int pm = u % nM, pn = u / nM;
    f32x4 acc[4][2]; zero_acc(acc);
    RowPlain ra{H + (size_t)pm * 128 * D, (size_t)D};
    gemm_kloop(lds, ra, W + (size_t)pn * 128 * D, D, D, acc);
    for (int nt = 0; nt < 2; ++nt) {
      const int col = pn * 128 + wn * 32 + nt * 16 + (lane & 15);
      if (col >= IN_W) continue;
      const float bv = bias[col];
      for (int mt = 0; mt < 4; ++mt) for (int i = 0; i < 4; ++i) {
        const int row = pm * 128 + wm * 64 + mt * 16 + (lane >> 4) * 4 + i; const float v = acc[mt][nt][i] + bv;
        PROJ[(size_t)row * NP + col] = f2bf(v);
        if (col >= C_GATES && col < C_GATES + 16) GATES[(size_t)row * 16 + (col - C_GATES)] = v;
      }
    }
  }
}
DEV void phase_gemm_merge(const Params& p) {
  char* lds = LDS_PTR();
  const bf16_t* YM = (const bf16_t*)(p.ws + WS_YM); const bf16_t* YA = (const bf16_t*)(p.ws + WS_YA);
  const bf16_t* WM = (const bf16_t*)(p.ws + WS_WBM); const bf16_t* WA = (const bf16_t*)(p.ws + WS_WBA);
  const bf16_t* PROJ = (const bf16_t*)(p.ws + WS_PROJ); bf16_t* MG = (bf16_t*)(p.ws + WS_MERGED);
  constexpr int nM = T / 128, nN = D / 128;
  const int lane = TID & 63, w = TID >> 6, wm = w >> 2, wn = w & 3;
  for (int u = BID; u < nM * nN; u += NBLK) {
    const int pm = u / nN, pn = u % nN;
    f32x4 acc1[4][2], acc2[4][2]; zero_acc(acc1); zero_acc(acc2);
    RowPlain r1{YM + (size_t)pm * 128 * MW, (size_t)MW}; gemm_kloop(lds, r1, WM + (size_t)pn * 128 * MW, MW, MW, acc1);
    RowPlain r2{YA + (size_t)pm * 128 * AW, (size_t)AW}; gemm_kloop(lds, r2, WA + (size_t)pn * 128 * AW, AW, AW, acc2);
    for (int nt = 0; nt < 2; ++nt) { const int col = pn * 128 + wn * 32 + nt * 16 + (lane & 15);
      for (int mt = 0; mt < 4; ++mt) for (int i = 0; i < 4; ++i) {
        const int row = pm * 128 + wm * 64 + mt * 16 + (lane >> 4) * 4 + i;
        const float gm = bf2f(PROJ[(size_t)row * NP + C_GM + col]), ga = bf2f(PROJ[(size_t)row * NP + C_GA + col]);
        MG[(size_t)row * D + col] = f2bf(sigmoidf_(gm) * acc1[mt][nt][i] + sigmoidf_(ga) * acc2[mt][nt][i]); } }
  }
}
DEV void phase_gemm_out(const Params& p, int l) {
  char* lds = LDS_PTR();
  const bf16_t* MG = (const bf16_t*)(p.ws + WS_MERGED); const bf16_t* W = (const bf16_t*)(p.ws + WS_WOUT);
  const float* mod = (const float*)(p.ws + WS_MOD);
  constexpr int nM = T / 128, nN = D / 128;
  const int lane = TID & 63, w = TID >> 6, wm = w >> 2, wn = w & 3;
  for (int u = BID; u < nM * nN; u += NBLK) {
    const int pm = u / nN, pn = u % nN;
    f32x4 acc[4][2]; zero_acc(acc);
    RowPlain ra{MG + (size_t)pm * 128 * D, (size_t)D}; gemm_kloop(lds, ra, W + (size_t)pn * 128 * D, D, D, acc);
    const int b = (pm * 128) / SEQ;
    for (int nt = 0; nt < 2; ++nt) { const int col = pn * 128 + wn * 32 + nt * 16 + (lane & 15);
      const float g1 = mod[((size_t)l * BATCH + b) * 6 * D + 2 * D + col];
      for (int mt = 0; mt < 4; ++mt) for (int i = 0; i < 4; ++i) {
        const int row = pm * 128 + wm * 64 + mt * 16 + (lane >> 4) * 4 + i;
        p.out[(size_t)row * D + col] += g1 * acc[mt][nt][i]; } }
  }
}
struct RowGather { const bf16_t* base; const int* list; int nvalid; DEVM const bf16_t* operator()(int r) const { const int ent = (r < nvalid) ? list[r] : list[0]; return base + (size_t)(ent >> 1) * D; } };
DEV void moe_tiles(const Params& p, int l, int* s_pref) {
  if (TID == 0) { const int* cnt = (const int*)(p.ws + WS_CTL) + CW_CNT + l * NE; int a = 0; for (int e = 0; e < NE; ++e) { s_pref[e] = a; a += (cnt[e] + 127) / 128; } s_pref[NE] = a; }
  SYNC();
}
DEV void phase_moe_up(const Params& p, int l) {
  char* lds = LDS_PTR(); int* s_pref = (int*)(lds + 2 * 128 * GP * 2);
  moe_tiles(p, l, s_pref);
  const bf16_t* H = (const bf16_t*)(p.ws + WS_H); const bf16_t* W = (const bf16_t*)(p.ws + WS_WGU); bf16_t* ACT = (bf16_t*)(p.ws + WS_ACT);
  const int* cnt = (const int*)(p.ws + WS_CTL) + CW_CNT + l * NE; const int* list = (const int*)(p.ws + WS_LIST); const float* went = (const float*)(p.ws + WS_WENT);
  const int ntile = s_pref[NE];
  const int lane = TID & 63, w = TID >> 6, wm = w >> 2, wn = w & 3;
  for (int u = BID; u < ntile * 8; u += NBLK) {
    const int rt = u >> 3, ct = u & 7;
    int e = 0; while (s_pref[e + 1] <= rt) ++e;
    const int lt = rt - s_pref[e], nvalid = cnt[e] - lt * 128;
    const int* elist = list + (size_t)e * T + lt * 128;
    f32x4 acc[4][2]; zero_acc(acc);
    RowGather ra{H, elist, nvalid};
    gemm_kloop(lds, ra, W + ((size_t)e * 2 * FF + ct * 128) * D, D, D, acc);
    const int f = (ct * 4 + wn) * 16 + (lane & 15);
    for (int mt = 0; mt < 4; ++mt) for (int i = 0; i < 4; ++i) {
      const int r = wm * 64 + mt * 16 + (lane >> 4) * 4 + i;
      if (r < nvalid) { const float wt = went[elist[r]]; const float a = acc[mt][0][i], uu = acc[mt][1][i];
        ACT[((size_t)rt * 128 + r) * FF + f] = f2bf(siluf_(a) * uu * wt); } }
  }
}
DEV void phase_moe_down(const Params& p, int l) {
  char* lds = LDS_PTR(); int* s_pref = (int*)(lds + 2 * 128 * GP * 2);
  moe_tiles(p, l, s_pref);
  const bf16_t* ACT = (const bf16_t*)(p.ws + WS_ACT); const bf16_t* W = (const bf16_t*)(p.ws + WS_WD); bf16_t* Y = (bf16_t*)(p.ws + WS_Y);
  const int* cnt = (const int*)(p.ws + WS_CTL) + CW_CNT + l * NE; const int* list = (const int*)(p.ws + WS_LIST);
  const int ntile = s_pref[NE];
  const int lane = TID & 63, w = TID >> 6, wm = w >> 2, wn = w & 3;
  for (int u = BID; u < ntile * 8; u += NBLK) {
    const int rt = u >> 3, ct = u & 7;
    int e = 0; while (s_pref[e + 1] <= rt) ++e;
    const int lt = rt - s_pref[e], nvalid = cnt[e] - lt * 128;
    const int* elist = list + (size_t)e * T + lt * 128;
    f32x4 acc[4][2]; zero_acc(acc);
    RowPlain ra{ACT + (size_t)rt * 128 * FF, (size_t)FF};
    gemm_kloop(lds, ra, W + ((size_t)e * D + ct * 128) * FF, FF, FF, acc);
    for (int nt = 0; nt < 2; ++nt) { const int col = ct * 128 + wn * 32 + nt * 16 + (lane & 15);
      for (int mt = 0; mt < 4; ++mt) for (int i = 0; i < 4; ++i) {
        const int r = wm * 64 + mt * 16 + (lane >> 4) * 4 + i;
        if (r < nvalid) Y[(size_t)elist[r] * D + col] = f2bf(acc[mt][nt][i]); } }
  }
}

DEV void phase_prep(const Params& p, int l) {
  const bf16_t* PROJ = (const bf16_t*)(p.ws + WS_PROJ);
  bf16_t* QC = (bf16_t*)(p.ws + WS_QC); bf16_t* KC = (bf16_t*)(p.ws + WS_KC);
  const int gtid = BID * NTHREADS + TID, gstride = NBLK * NTHREADS;
  const float* cw = p.conv_w + (size_t)l * CONVW * 2 * MW; const float* cb = p.conv_b + (size_t)l * 2 * MW;
  for (int it = gtid; it < T * 128; it += gstride) {
    const int t = it >> 7, c8 = (it & 127) * 8, s = t % SEQ;
    float a[8]; for (int j = 0; j < 8; ++j) a[j] = cb[c8 + j];
    for (int wi = 0; wi < CONVW; ++wi) { const int ss = s + wi - 2; if (ss < 0 || ss >= SEQ) continue;
      const bf16x8 v = ld8(PROJ + (size_t)(t + wi - 2) * NP + c8);
      for (int j = 0; j < 8; ++j) a[j] += bf2f((bf16_t)v[j]) * cw[wi * 2 * MW + c8 + j]; }
    const float sc = (c8 < MW) ? 0.08838834764831845f : 1.f;
    u32x4 o; o.x = pk2(siluf_(a[0]) * sc, siluf_(a[1]) * sc); o.y = pk2(siluf_(a[2]) * sc, siluf_(a[3]) * sc); o.z = pk2(siluf_(a[4]) * sc, siluf_(a[5]) * sc); o.w = pk2(siluf_(a[6]) * sc, siluf_(a[7]) * sc);
    if (c8 < MW) *(u32x4*)(QC + (size_t)t * MW + c8) = o; else *(u32x4*)(KC + (size_t)t * MW + c8 - MW) = o;
  }
  bf16_t* AQN = (bf16_t*)(p.ws + WS_AQN); bf16_t* AKN = (bf16_t*)(p.ws + WS_AKN); bf16_t* VT = (bf16_t*)(p.ws + WS_VT);
  const float* rope = (const float*)(p.ws + WS_ROPE); constexpr int NR = SEQ / GRID_W;
  for (int it = gtid; it < T * 10; it += gstride) {
    const int hh = it / T, t = it % T, b = t / SEQ, s = t % SEQ;
    const bool isq = hh < AH;
    const bf16_t* src = PROJ + (size_t)t * NP + (isq ? C_AQ + hh * 64 : C_AK + (hh - AH) * 64);
    const float* g = (isq ? p.q_norm_g : p.k_norm_g) + (size_t)l * AHD;
    float v[64]; float ss = 0.f;
    for (int j8 = 0; j8 < 8; ++j8) { const bf16x8 x8 = ld8(src + j8 * 8); for (int j = 0; j < 8; ++j) { const float f = bf2f((bf16_t)x8[j]); v[j8 * 8 + j] = f; ss += f * f; } }
    const float rs = 1.f / sqrtf(ss * (1.f / 64.f) + EPS);
    for (int j = 0; j < 64; ++j) v[j] = v[j] * rs * g[j];
    const int row = s / GRID_W, col = s % GRID_W;
    const float* cr = rope + row * 16; const float* sr = rope + NR * 16 + row * 16; const float* cc = rope + 2 * NR * 16 + col * 16; const float* sc_ = rope + 2 * NR * 16 + 64 * 16 + col * 16;
    float o[64];
    for (int i = 0; i < 16; ++i) {
      o[i] = v[i] * cr[i] - v[16 + i] * sr[i]; o[16 + i] = v[16 + i] * cr[i] + v[i] * sr[i];
      o[32 + i] = v[32 + i] * cc[i] - v[48 + i] * sc_[i]; o[48 + i] = v[48 + i] * cc[i] + v[32 + i] * sc_[i]; }
    const float qs = isq ? 0.125f : 1.f;
    bf16_t* dst = isq ? AQN + (size_t)t * AW + hh * 64 : AKN + (size_t)t * KVW + (hh - AH) * 64;
    for (int j8 = 0; j8 < 8; ++j8) { u32x4 w4; w4.x = pk2(o[j8 * 8] * qs, o[j8 * 8 + 1] * qs); w4.y = pk2(o[j8 * 8 + 2] * qs, o[j8 * 8 + 3] * qs); w4.z = pk2(o[j8 * 8 + 4] * qs, o[j8 * 8 + 5] * qs); w4.w = pk2(o[j8 * 8 + 6] * qs, o[j8 * 8 + 7] * qs);
      *(u32x4*)(dst + j8 * 8) = w4; }
    if (!isq) { const int kv = hh - AH; const bf16_t* vs = PROJ + (size_t)t * NP + C_AV + kv * 64;
      for (int d = 0; d < 64; ++d) VT[((size_t)(b * KVH + kv) * 64 + d) * SEQ + s] = vs[d]; }
  }
}

DEV void phase_attn(const Params& p) {
  char* lds = LDS_PTR();
  bf16_t* Ks = (bf16_t*)lds; bf16_t* Vs = Ks + 64 * GP; bf16_t* Ps = Vs + 64 * GP;
  const bf16_t* AQN = (const bf16_t*)(p.ws + WS_AQN); const bf16_t* AKN = (const bf16_t*)(p.ws + WS_AKN); const bf16_t* VT = (const bf16_t*)(p.ws + WS_VT);
  bf16_t* YA = (bf16_t*)(p.ws + WS_YA);
  const int tid = TID, lane = tid & 63, w = tid >> 6;
  constexpr int NQB = SEQ / 128, NU = BATCH * AH * NQB;
  bf16_t* Pw = Ps + w * 16 * GP;
  for (int u = BID; u < NU; u += NBLK) {
    const int qb = u % NQB, h = (u / NQB) % AH, b = u / (NQB * AH), kv = h / (AH / KVH);
    const int r0 = qb * 128 + w * 16;
    bf16x8 qa[2];
    for (int ks = 0; ks < 2; ++ks) qa[ks] = ld8(AQN + (size_t)(b * SEQ + r0 + (lane & 15)) * AW + h * 64 + ks * 32 + (lane >> 4) * 8);
    f32x4 o[4]; for (int i = 0; i < 4; ++i) o[i] = (f32x4){0.f, 0.f, 0.f, 0.f};
    float mrow[4], lrow[4]; for (int i = 0; i < 4; ++i) { mrow[i] = -3.0e38f; lrow[i] = 0.f; }
    for (int kt = 0; kt < SEQ / 64; ++kt) {
      SYNC();
      { const int r = tid >> 3, pc = (tid & 7) * 8;
        *(u32x4*)(Ks + r * GP + pc) = *(const u32x4*)(AKN + (size_t)(b * SEQ + kt * 64 + r) * KVW + kv * 64 + pc);
        *(u32x4*)(Vs + r * GP + pc) = *(const u32x4*)(VT + ((size_t)(b * KVH + kv) * 64 + r) * SEQ + kt * 64 + pc); }
      SYNC();
      f32x4 s[4];
      for (int nt = 0; nt < 4; ++nt) { s[nt] = (f32x4){0.f, 0.f, 0.f, 0.f};
        for (int ks = 0; ks < 2; ++ks) s[nt] = mfma16(qa[ks], ld8(Ks + (nt * 16 + (lane & 15)) * GP + ks * 32 + (lane >> 4) * 8), s[nt]); }
      for (int i = 0; i < 4; ++i) {
        float mx = fmaxf(fmaxf(s[0][i], s[1][i]), fmaxf(s[2][i], s[3][i])); mx = grp16_max(mx);
        const float mnew = fmaxf(mrow[i], mx), alpha = expf(mrow[i] - mnew); mrow[i] = mnew;
        float rsum = 0.f;
        for (int nt = 0; nt < 4; ++nt) { const float pv = expf(s[nt][i] - mnew); rsum += pv; Pw[((lane >> 4) * 4 + i) * GP + nt * 16 + (lane & 15)] = f2bf(pv); }
        lrow[i] = lrow[i] * alpha + rsum;
        for (int nd = 0; nd < 4; ++nd) o[nd][i] *= alpha;
      }
      SYNC();
      for (int ks = 0; ks < 2; ++ks) { const bf16x8 pa = ld8(Pw + (lane & 15) * GP + ks * 32 + (lane >> 4) * 8);
        for (int nd = 0; nd < 4; ++nd) o[nd] = mfma16(pa, ld8(Vs + (nd * 16 + (lane & 15)) * GP + ks * 32 + (lane >> 4) * 8), o[nd]); }
    }
    for (int i = 0; i < 4; ++i) { const float lt = grp16_sum(lrow[i]), inv = 1.f / lt; const int row = b * SEQ + r0 + (lane >> 4) * 4 + i;
      for (int nd = 0; nd < 4; ++nd) YA[(size_t)row * AW + h * 64 + nd * 16 + (lane & 15)] = f2bf(o[nd][i] * inv); }
  }
}

DEV void phase_mlstm_a(const Params& p) {
  char* lds = LDS_PTR();
  bf16_t* VW = (bf16_t*)lds;
  bf16_t* KT = VW + 2 * 128 * GP;
  float* sc = (float*)(KT + 128 * GP);
  float* s_lf = sc; float* s_a = sc + 128; float* s_w = sc + 256;
  const bf16_t* PROJ = (const bf16_t*)(p.ws + WS_PROJ); const bf16_t* KC = (const bf16_t*)(p.ws + WS_KC); const float* GATES = (const float*)(p.ws + WS_GATES);
  bf16_t* CST = (bf16_t*)(p.ws + WS_CST); float* NST = (float*)(p.ws + WS_NST); float* AMAX = (float*)(p.ws + WS_AMAX); float* BLAST = (float*)(p.ws + WS_BLAST);
  const int tid = TID, lane = tid & 63, w = tid >> 6;
  for (int u = BID; u < BHC; u += NBLK) {
    const int c = u % NC, h = (u / NC) % MH, b = u / (NC * MH);
    const int t0 = b * SEQ + c * ML;
    SYNC();
    if (tid < 128) { const int dir = tid >> 6, l = tid & 63; s_lf[dir * 64 + l] = logsigmoidf_(GATES[(size_t)(t0 + l) * 16 + (dir ? 12 : 4) + h]); }
    SYNC();
    if (tid < 128) { const int dir = tid >> 6, l = tid & 63; const float li = GATES[(size_t)(t0 + l) * 16 + (dir ? 8 : 0) + h];
      float a = li;
      if (dir == 0) { for (int q = l + 1; q < 64; ++q) a += s_lf[q]; } else { for (int q = 0; q < l; ++q) a += s_lf[64 + q]; }
      s_a[dir * 64 + l] = a; }
    SYNC();
    if (tid < 128) { const int dir = tid >> 6, l = tid & 63; float mx = -3.0e38f, tot = 0.f;
      for (int q = 0; q < 64; ++q) { mx = fmaxf(mx, s_a[dir * 64 + q]); tot += s_lf[dir * 64 + q]; }
      s_w[dir * 64 + l] = expf(s_a[dir * 64 + l] - mx);
      if (l == 0) { AMAX[dir * BHC + u] = mx; BLAST[dir * BHC + u] = tot; } }
    SYNC();
    for (int it = tid; it < 1024; it += NTHREADS) { const int l = it >> 4, d8 = (it & 15) * 8;
      const bf16x8 v8 = ld8(PROJ + (size_t)(t0 + l) * NP + C_MV + h * 128 + d8); const bf16x8 k8 = ld8(KC + (size_t)(t0 + l) * MW + h * 128 + d8);
      const float wf = s_w[l], wb = s_w[64 + l];
      for (int j = 0; j < 8; ++j) { const float vf = bf2f((bf16_t)v8[j]); VW[(d8 + j) * GP + l] = f2bf(vf * wf); VW[(128 + d8 + j) * GP + l] = f2bf(vf * wb); KT[(d8 + j) * GP + l] = (bf16_t)k8[j]; } }
    SYNC();
    { const int dir = w >> 2, m2 = w & 3;
      for (int mi = 0; mi < 2; ++mi) { const int mt = m2 * 2 + mi;
        bf16x8 af[2]; for (int ks = 0; ks < 2; ++ks) af[ks] = ld8(VW + (dir * 128 + mt * 16 + (lane & 15)) * GP + ks * 32 + (lane >> 4) * 8);
        for (int nt = 0; nt < 8; ++nt) { f32x4 acc = (f32x4){0.f, 0.f, 0.f, 0.f};
          for (int ks = 0; ks < 2; ++ks) acc = mfma16(af[ks], ld8(KT + (nt * 16 + (lane & 15)) * GP + ks * 32 + (lane >> 4) * 8), acc);
          bf16_t* dst = CST + ((size_t)(dir * BHC + u) * 128 + mt * 16 + (lane >> 4) * 4) * 128 + nt * 16 + (lane & 15);
          for (int i = 0; i < 4; ++i) dst[i * 128] = f2bf(acc[i]); } } }
    if (tid < 256) { const int dir = tid >> 7, e = tid & 127; float s = 0.f; for (int l = 0; l < 64; ++l) s += s_w[dir * 64 + l] * bf2f(KT[e * GP + l]); NST[(size_t)(dir * BHC + u) * 128 + e] = s; }
  }
}
DEV void phase_mlstm_scan(const Params& p) {
  bf16_t* CST = (bf16_t*)(p.ws + WS_CST); float* NST = (float*)(p.ws + WS_NST);
  const float* AMAX = (const float*)(p.ws + WS_AMAX); const float* BLAST = (const float*)(p.ws + WS_BLAST); float* MPREV = (float*)(p.ws + WS_MPREV);
  const int gtid = BID * NTHREADS + TID, gstride = NBLK * NTHREADS;
  constexpr int PER = 8192 + 64;
  for (int it = gtid; it < 2 * BATCH * MH * PER; it += gstride) {
    const int pi = it % PER, dbh = it / PER, dir = dbh / (BATCH * MH), bh = dbh % (BATCH * MH);
    float s0 = 0.f, s1 = 0.f, m = 0.f;
    for (int cc = 0; cc < NC; ++cc) {
      const int c = dir ? NC - 1 - cc : cc; const int u = bh * NC + c;
      const float bl = BLAST[dir * BHC + u], am = AMAX[dir * BHC + u];
      const float mn = fmaxf(bl + m, am), dec = expf(bl + m - mn), inj = expf(am - mn);
      if (pi < 8192) { unsigned* ptr = (unsigned*)(CST + (size_t)(dir * BHC + u) * 16384) + pi; const unsigned in = *ptr;
        *ptr = pk2(s0, s1); s0 = dec * s0 + inj * bf2f((bf16_t)(in & 0xffff)); s1 = dec * s1 + inj * bf2f((bf16_t)(in >> 16)); }
      else { float* ptr = NST + (size_t)(dir * BHC + u) * 128 + 2 * (pi - 8192); const float i0 = ptr[0], i1 = ptr[1];
        ptr[0] = s0; ptr[1] = s1; s0 = dec * s0 + inj * i0; s1 = dec * s1 + inj * i1; }
      if (pi == 0) MPREV[dir * BHC + u] = m;
      m = mn;
    }
  }
}
constexpr int QP = 136;
constexpr int C_HALF_BYTES = (64 * QP * 2) * 2 + 128 * GP * 2 + 4 * 16 * GP * 2 + (4 * 64 + 2 * 128 + 4) * 4;
DEV void phase_mlstm_c(const Params& p, int l) {
  char* lds = LDS_PTR();
  const int tid = TID, lane = tid & 63, w = tid >> 6, half = w >> 2, wv = w & 3, htid = tid & 255;
  char* hb = lds + half * ((C_HALF_BYTES + 255) & ~255);
  bf16_t* Qs = (bf16_t*)hb; bf16_t* Ks = Qs + 64 * QP; bf16_t* VTs = Ks + 64 * QP; bf16_t* Ps = VTs + 128 * GP;
  float* s_b = (float*)(Ps + 4 * 16 * GP);
  float* s_li = s_b + 128;
  float* s_n = s_li + 128;
  float* s_m = s_n + 256;
  bf16_t* Pw = Ps + wv * 16 * GP;
  const bf16_t* PROJ = (const bf16_t*)(p.ws + WS_PROJ); const bf16_t* QC = (const bf16_t*)(p.ws + WS_QC); const bf16_t* KC = (const bf16_t*)(p.ws + WS_KC);
  const float* GATES = (const float*)(p.ws + WS_GATES); const bf16_t* CST = (const bf16_t*)(p.ws + WS_CST); const float* NST = (const float*)(p.ws + WS_NST);
  const float* MPREV = (const float*)(p.ws + WS_MPREV); bf16_t* YM = (bf16_t*)(p.ws + WS_YM);
  const float* ng = p.mlstm_norm_g + (size_t)l * MW;
  for (int u0 = BID * 2; u0 < BHC; u0 += NBLK * 2) {
    const int u = u0 + half;
    const int c = u % NC, h = (u / NC) % MH, b = u / (NC * MH);
    const int t0 = b * SEQ + c * ML;
    SYNC();
    for (int it = htid; it < 1024; it += 256) { const int r = it >> 4, d8 = (it & 15) * 8;
      *(u32x4*)(Qs + r * QP + d8) = *(const u32x4*)(QC + (size_t)(t0 + r) * MW + h * 128 + d8);
      *(u32x4*)(Ks + r * QP + d8) = *(const u32x4*)(KC + (size_t)(t0 + r) * MW + h * 128 + d8);
      const bf16x8 v8 = ld8(PROJ + (size_t)(t0 + r) * NP + C_MV + h * 128 + d8);
      for (int j = 0; j < 8; ++j) VTs[(d8 + j) * GP + r] = (bf16_t)v8[j]; }
    if (htid < 128) { const int dir = htid >> 6, q = htid & 63; s_li[dir * 64 + q] = GATES[(size_t)(t0 + q) * 16 + (dir ? 8 : 0) + h];
      s_b[dir * 64 + q] = logsigmoidf_(GATES[(size_t)(t0 + q) * 16 + (dir ? 12 : 4) + h]); }
    s_n[htid] = NST[(size_t)((htid >> 7) * BHC + u) * 128 + (htid & 127)];
    if (htid < 2) s_m[htid] = MPREV[htid * BHC + u];
    SYNC();
    float cum = 0.f;
    if (htid < 128) { const int dir = htid >> 6, q = htid & 63;
      if (dir == 0) { for (int z = 0; z <= q; ++z) cum += s_b[z]; } else { for (int z = q; z < 64; ++z) cum += s_b[64 + z]; } }
    SYNC();
    if (htid < 128) s_b[htid] = cum;
    SYNC();
    const int j0 = wv * 16;
    bf16x8 qa[4]; for (int ks = 0; ks < 4; ++ks) qa[ks] = ld8(Qs + (j0 + (lane & 15)) * QP + ks * 32 + (lane >> 4) * 8);
    f32x4 S[4];
    for (int nt = 0; nt < 4; ++nt) { S[nt] = (f32x4){0.f, 0.f, 0.f, 0.f};
      for (int ks = 0; ks < 4; ++ks) S[nt] = mfma16(qa[ks], ld8(Ks + (nt * 16 + (lane & 15)) * QP + ks * 32 + (lane >> 4) * 8), S[nt]); }
    float qn[2];
    for (int dir = 0; dir < 2; ++dir) { float a = 0.f; const int e0 = (lane >> 4) * 32;
      for (int e = 0; e < 32; ++e) a += bf2f(Qs[(j0 + (lane & 15)) * QP + e0 + e]) * s_n[dir * 128 + e0 + e];
      a += shfl_xor_f(a, 16); a += shfl_xor_f(a, 32); qn[dir] = a; }
    f32x4 hs[8]; for (int nd = 0; nd < 8; ++nd) hs[nd] = (f32x4){0.f, 0.f, 0.f, 0.f};
    for (int dir = 0; dir < 2; ++dir) {
      const float* bb = s_b + dir * 64; const float* li = s_li + dir * 64; const float mp = s_m[dir];
      float iw[4], dinv[4];
      for (int i = 0; i < 4; ++i) {
        const int j = j0 + (lane >> 4) * 4 + i; const float bj = bb[j];
        float dv[4], mx = -3.0e38f;
        for (int nt = 0; nt < 4; ++nt) { const int lk = nt * 16 + (lane & 15); const bool ok = dir ? (lk >= j) : (lk <= j);
          dv[nt] = ok ? (bj - bb[lk] + li[lk]) : -3.0e38f; mx = fmaxf(mx, dv[nt]); }
        mx = grp16_max(mx);
        const float mi = bj + mp, mo = fmaxf(mi, mx);
        float rsum = 0.f;
        for (int nt = 0; nt < 4; ++nt) { const float sv = (dv[nt] > -1.0e38f) ? S[nt][i] * expf(dv[nt] - mo) : 0.f; rsum += sv; Pw[((lane >> 4) * 4 + i) * GP + nt * 16 + (lane & 15)] = f2bf(sv); }
        rsum = grp16_sum(rsum);
        iw[i] = expf(mi - mo);
        const float qnj = shfl_f(qn[dir], (lane >> 4) * 4 + i);
        const float den = rsum + iw[i] * qnj;
        dinv[i] = 1.f / fmaxf(fabsf(den), expf(-mo));
      }
      SYNC();
      f32x4 a1[8], a2[8];
      for (int nd = 0; nd < 8; ++nd) { a1[nd] = (f32x4){0.f, 0.f, 0.f, 0.f}; a2[nd] = (f32x4){0.f, 0.f, 0.f, 0.f}; }
      for (int ks = 0; ks < 2; ++ks) { const bf16x8 pa = ld8(Pw + (lane & 15) * GP + ks * 32 + (lane >> 4) * 8);
        for (int nd = 0; nd < 8; ++nd) a1[nd] = mfma16(pa, ld8(VTs + (nd * 16 + (lane & 15)) * GP + ks * 32 + (lane >> 4) * 8), a1[nd]); }
      const bf16_t* Cp = CST + (size_t)(dir * BHC + u) * 16384;
      for (int ks = 0; ks < 4; ++ks) for (int nd = 0; nd < 8; ++nd) a2[nd] = mfma16(qa[ks], ld8(Cp + (size_t)(nd * 16 + (lane & 15)) * 128 + ks * 32 + (lane >> 4) * 8), a2[nd]);
      for (int nd = 0; nd < 8; ++nd) for (int i = 0; i < 4; ++i) hs[nd][i] += (a1[nd][i] + iw[i] * a2[nd][i]) * dinv[i];
      SYNC();
    }
    for (int i = 0; i < 4; ++i) { float ss = 0.f; for (int nd = 0; nd < 8; ++nd) ss += hs[nd][i] * hs[nd][i];
      ss = grp16_sum(ss); const float rs = 1.f / sqrtf(ss * (1.f / 128.f) + EPS);
      const int t = t0 + j0 + (lane >> 4) * 4 + i;
      for (int nd = 0; nd < 8; ++nd) { const int d = nd * 16 + (lane & 15); const float og = bf2f(PROJ[(size_t)t * NP + C_MO + h * 128 + d]);
        YM[(size_t)t * MW + h * 128 + d] = f2bf(hs[nd][i] * rs * ng[h * 128 + d] * sigmoidf_(og)); } }
  }
}

constexpr int LDS_BYTES = 131072;
#ifndef EMU
#define KDEF(name, body) __global__ void __launch_bounds__(NTHREADS, 2) name(Params p, int l) { body; }
#else
#define KDEF(name, body) static void name(Params p, int l) { body; }
#endif
KDEF(k_mod_rope, (void)l; phase_mod_rope(p))
KDEF(k_convert, phase_convert(p, l))
KDEF(k_norm1_first, phase_norm(p, l, 0, 0))
KDEF(k_norm1_next, phase_norm(p, l, 1, 0))
KDEF(k_norm2, phase_norm2_router(p, l))
KDEF(k_final, phase_norm(p, l, 1, 2))
KDEF(k_gemm_in, phase_gemm_in(p, l))
KDEF(k_prep, phase_prep(p, l))
KDEF(k_mlstm_a, (void)l; phase_mlstm_a(p))
KDEF(k_mlstm_scan, (void)l; phase_mlstm_scan(p))
KDEF(k_attn, (void)l; phase_attn(p))
KDEF(k_mlstm_c, phase_mlstm_c(p, l))
KDEF(k_merge, (void)l; phase_gemm_merge(p))
KDEF(k_out, phase_gemm_out(p, l))
KDEF(k_moe_up, phase_moe_up(p, l))
KDEF(k_moe_down, phase_moe_down(p, l))

#ifdef EMU
#define LAUNCH(k, grid, l) emu_launch(grid, NTHREADS, LDS_BYTES, [=]() { k(prm, l); }, false)
static int emu_grid_size = 8;
static int emu_stop_after = 1000;
#else
#define LAUNCH(k, grid, l) k<<<grid, NTHREADS, LDS_BYTES, stream>>>(prm, l)
#endif

extern "C" void kernel_launch(void* const* d_in, const int* in_sizes, int n_in, void* d_out, int out_size, void* d_ws, size_t ws_size, hipStream_t stream) {
  (void)in_sizes; (void)n_in; (void)out_size;
  if (ws_size < WS_TOTAL) { fprintf(stderr, "workspace too small: %zu < %zu\n", ws_size, (size_t)WS_TOTAL); return; }
  Params prm{};
  const float** f = (const float**)&prm;
  for (int i = 0; i < 24; ++i) f[i] = (const float*)d_in[i];
  prm.out = (float*)d_out; prm.ws = (unsigned char*)d_ws;
#ifdef EMU
  const int grid = emu_grid_size; memset(d_ws, 0, CTL_BYTES); int step = 0;
#define STEP() if (++step > emu_stop_after) return
#else
  const int grid = 256;
  static bool attr_done = false;
  if (!attr_done) { attr_done = true;
    const void* ks[] = {(const void*)k_mod_rope, (const void*)k_convert, (const void*)k_norm1_first, (const void*)k_norm1_next, (const void*)k_norm2, (const void*)k_final, (const void*)k_gemm_in, (const void*)k_prep,
                        (const void*)k_mlstm_a, (const void*)k_mlstm_scan, (const void*)k_attn, (const void*)k_mlstm_c, (const void*)k_merge, (const void*)k_out, (const void*)k_moe_up, (const void*)k_moe_down};
    for (const void* k : ks) hipFuncSetAttribute(k, hipFuncAttributeMaxDynamicSharedMemorySize, LDS_BYTES); }
  hipMemsetAsync(d_ws, 0, CTL_BYTES, stream);
#define STEP()
#endif
  LAUNCH(k_mod_rope, grid, 0); STEP();
  for (int l = 0; l < DEPTH; ++l) {
    LAUNCH(k_convert, grid, l); STEP();
    if (l == 0) LAUNCH(k_norm1_first, grid, l); else LAUNCH(k_norm1_next, grid, l);
    STEP();
    LAUNCH(k_gemm_in, grid, l); STEP();
    LAUNCH(k_prep, grid, l); STEP();
    LAUNCH(k_mlstm_a, grid, l); STEP();
    LAUNCH(k_mlstm_scan, grid, l); STEP();
    LAUNCH(k_attn, grid, l); STEP();
    LAUNCH(k_mlstm_c, grid, l); STEP();
    LAUNCH(k_merge, grid, l); STEP();
    LAUNCH(k_out, grid, l); STEP();
    LAUNCH(k_norm2, grid, l); STEP();
    LAUNCH(k_moe_up, grid, l); STEP();
    LAUNCH(k_moe_down, grid, l); STEP();
  }
  LAUNCH(k_final, grid, DEPTH); STEP();
}
```

```cpp
#ifdef EMU
#include "emu.h"
#define TID emu_tid()
#define BID emu_bid()
#define NBLK emu_nblk()
#define SYNC() emu_syncthreads()
#define DEV static inline
#define DEVM inline
#else
#include <hip/hip_runtime.h>
#include <cstdio>
#include <cstdint>
__device__ __forceinline__ int tid_opaque() { int t = (int)threadIdx.x; asm volatile("" : "+v"(t)); return t; }
#define TID tid_opaque()
#define BID ((int)blockIdx.x)
#define NBLK ((int)gridDim.x)
#define SYNC() __syncthreads()
#define DEV __device__ __forceinline__
#define DEVM __device__ __forceinline__
#endif

#ifndef CFG_SEQ
#define CFG_SEQ 8192
#endif
#ifndef CFG_BATCH
#define CFG_BATCH 2
#endif

#ifndef PHMASK
#define PHMASK 0xFFFFFFFFu
#endif
#define UNR _Pragma("unroll")
typedef unsigned short bf16_t;
typedef short bf16x8 __attribute__((ext_vector_type(8)));
typedef float f32x4 __attribute__((ext_vector_type(4)));
typedef unsigned u32x4 __attribute__((ext_vector_type(4)));
typedef unsigned u32x2 __attribute__((ext_vector_type(2)));

constexpr int D = 1024, BATCH = CFG_BATCH, SEQ = CFG_SEQ, DEPTH = 2, T = BATCH * SEQ;
constexpr int GRID_W = 64;
constexpr int MH = 4, MHD = 128, MW = 512, ML = 64, NC = SEQ / ML, CONVW = 5;
constexpr int AH = 8, KVH = 2, AHD = 64, AW = 512, KVW = 128;
constexpr int NG = 4, EPG = 8, NE = 32, FF = 512;
constexpr float EPS = 1e-6f;
constexpr int IN_W = 4880, NP = 4992;
constexpr int C_MQ = 0, C_MK = 512, C_MV = 1024, C_MO = 1536, C_GATES = 2048, C_AQ = 2064, C_AK = 2576, C_AV = 2704, C_GM = 2832, C_GA = 3856;
constexpr int NTHREADS = 512;
constexpr int BHC = BATCH * MH * NC;
constexpr int ROWT_MAX = (2 * T) / 128 + NE;
constexpr int ACT_ROWS = ROWT_MAX * 128;

constexpr size_t al256(size_t x) { return (x + 255) & ~(size_t)255; }
constexpr size_t WS_CTL = 0, CTL_BYTES = 1 << 20;
constexpr size_t WS_MOD = WS_CTL + CTL_BYTES;
constexpr size_t WS_ROPE = WS_MOD + al256((size_t)DEPTH * BATCH * 6 * D * 4);
constexpr size_t WS_WIN = WS_ROPE + al256((size_t)(2 * (SEQ / GRID_W) * 16 + 2 * 64 * 16) * 4);
constexpr size_t WS_WBM = WS_WIN + (size_t)NP * D * 2;
constexpr size_t WS_WBA = WS_WBM + (size_t)D * MW * 2;
constexpr size_t WS_WOUT = WS_WBA + (size_t)D * AW * 2;
constexpr size_t WS_WGU = WS_WOUT + (size_t)D * D * 2;
constexpr size_t WS_WD = WS_WGU + (size_t)NE * 2 * FF * D * 2;
constexpr size_t WS_PROJ = WS_WD + (size_t)NE * D * FF * 2;
constexpr size_t WS_ACT = WS_PROJ;
constexpr size_t WS_Y = WS_ACT + al256((size_t)ACT_ROWS * FF * 2);
constexpr size_t PROJ_BYTES = (size_t)T * NP * 2;
static_assert(WS_Y + (size_t)2 * T * D * 2 <= WS_PROJ + PROJ_BYTES || T < 4096, "ACT + Y must fit into the PROJ overlay");
constexpr size_t OVL_BYTES = (WS_Y + (size_t)2 * T * D * 2 - WS_PROJ) > PROJ_BYTES ? (WS_Y + (size_t)2 * T * D * 2 - WS_PROJ) : PROJ_BYTES;
constexpr size_t WS_GATES = WS_PROJ + al256(OVL_BYTES);
constexpr size_t WS_QC = WS_GATES + (size_t)T * 16 * 4;
constexpr size_t WS_KC = WS_QC + (size_t)T * MW * 2;
constexpr size_t WS_MERGED = WS_QC;
constexpr size_t WS_AQN = WS_KC + (size_t)T * MW * 2;
constexpr size_t WS_AKN = WS_AQN + (size_t)T * AW * 2;
constexpr size_t WS_VT = WS_AKN + (size_t)T * KVW * 2;
constexpr size_t WS_CST = WS_VT + (size_t)T * KVW * 2;
constexpr size_t WS_H = WS_CST;
constexpr size_t CST_BYTES = (size_t)2 * BHC * 128 * 128 * 2;
static_assert((size_t)T * D * 2 <= CST_BYTES, "H fits in CST");
constexpr size_t WS_NST = WS_CST + CST_BYTES;
constexpr size_t WS_AMAX = WS_NST + (size_t)2 * BHC * 128 * 4;
constexpr size_t WS_BLAST = WS_AMAX + al256((size_t)2 * BHC * 4);
constexpr size_t WS_MPREV = WS_BLAST + al256((size_t)2 * BHC * 4);
constexpr size_t WS_YM = WS_MPREV + al256((size_t)2 * BHC * 4);
constexpr size_t WS_YA = WS_YM + (size_t)T * MW * 2;
constexpr size_t WS_LIST = WS_YA + (size_t)T * AW * 2;
constexpr size_t WS_WENT = WS_LIST + (size_t)NE * T * 4;
constexpr size_t WS_TOTAL = WS_WENT + (size_t)2 * T * 4;
constexpr int CW_CNT = 64;
constexpr int CW_BAR = 4096;

struct Params {
  const float *x, *c, *w_ada, *b_ada, *norm1_g, *w_in, *b_in, *conv_w, *conv_b, *mlstm_norm_g, *q_norm_g, *k_norm_g, *w_branch_m, *w_branch_a, *w_out, *norm2_g,
      *w_rg, *b_rg, *w_re, *b_re, *w_gate, *w_up, *w_down, *final_g;
  float* out; unsigned char* ws;
};

DEV float bf2f(bf16_t h) { return __builtin_bit_cast(float, (unsigned)h << 16); }
DEV bf16_t f2bf(float f) { unsigned u = __builtin_bit_cast(unsigned, f); return (bf16_t)((u + 0x7fffu + ((u >> 16) & 1u)) >> 16); }
DEV unsigned pk2(float lo, float hi) { return (unsigned)f2bf(lo) | ((unsigned)f2bf(hi) << 16); }
DEV float sigmoidf_(float x) { return 1.f / (1.f + expf(-x)); }
DEV float siluf_(float x) { return x / (1.f + expf(-x)); }
DEV float logsigmoidf_(float x) { return fminf(x, 0.f) - log1pf(expf(-fabsf(x))); }

#ifdef EMU
static inline f32x4 mfma16(bf16x8 a, bf16x8 b, f32x4 c) {
  struct In { bf16x8 a, b; f32x4 c; } in{a, b, c}; f32x4 out;
  emu_collective(&in, sizeof(In), &out, sizeof(out), [](char (*I)[64], char (*O)[32]) {
    float Dm[16][16];
    for (int r = 0; r < 16; ++r) for (int cc = 0; cc < 16; ++cc) { In* L = (In*)I[(r >> 2) * 16 + cc]; Dm[r][cc] = L->c[r & 3]; }
    for (int r = 0; r < 16; ++r) for (int cc = 0; cc < 16; ++cc) { float s = 0.f;
      for (int g = 0; g < 4; ++g) { In* LA = (In*)I[g * 16 + r]; In* LB = (In*)I[g * 16 + cc]; for (int j = 0; j < 8; ++j) s += bf2f((bf16_t)LA->a[j]) * bf2f((bf16_t)LB->b[j]); }
      Dm[r][cc] += s; }
    for (int l = 0; l < 64; ++l) { f32x4 o; for (int i = 0; i < 4; ++i) o[i] = Dm[(l >> 4) * 4 + i][l & 15]; memcpy(O[l], &o, 16); } });
  return out;
}
static inline f32x4 mfma4f32(float a, float b, f32x4 c) {
  struct In { float a, b; f32x4 c; } in{a, b, c}; f32x4 out;
  emu_collective(&in, sizeof(In), &out, sizeof(out), [](char (*I)[64], char (*O)[32]) {
    for (int l = 0; l < 64; ++l) { f32x4 o; UNR for (int i = 0; i < 4; ++i) { const int r = (l >> 4) * 4 + i, cc = l & 15; float s = ((In*)I[l])->c[i];
      for (int k = 0; k < 4; ++k) s = fmaf(((In*)I[k * 16 + r])->a, ((In*)I[k * 16 + cc])->b, s); o[i] = s; } memcpy(O[l], &o, 16); } });
  return out;
}
static inline float shfl_xor_f(float v, int m) { float out; emu_collective(&v, 4, &out, 4, [m](char (*I)[64], char (*O)[32]) { for (int l = 0; l < 64; ++l) memcpy(O[l], I[l ^ m], 4); }); return out; }
static inline float shfl_f(float v, int src) { struct In { float v; int s; } in{v, src}; float out;
  emu_collective(&in, 8, &out, 4, [](char (*I)[64], char (*O)[32]) { for (int l = 0; l < 64; ++l) { In* me = (In*)I[l]; memcpy(O[l], I[me->s & 63], 4); } }); return out; }
static inline int atomic_add_i(int* p, int v) { return __atomic_fetch_add(p, v, __ATOMIC_RELAXED); }
#define LDS_PTR() emu_lds()
#else
DEV f32x4 mfma16(bf16x8 a, bf16x8 b, f32x4 c) { return __builtin_amdgcn_mfma_f32_16x16x32_bf16(a, b, c, 0, 0, 0); }
DEV f32x4 mfma4f32(float a, float b, f32x4 c) { return __builtin_amdgcn_mfma_f32_16x16x4f32(a, b, c, 0, 0, 0); }
DEV float shfl_xor_f(float v, int m) {
  const int iv = __builtin_bit_cast(int, v);
  switch (m) {
    case 1: return __builtin_bit_cast(float, __builtin_amdgcn_ds_swizzle(iv, (1 << 10) | 0x1f));
    case 2: return __builtin_bit_cast(float, __builtin_amdgcn_ds_swizzle(iv, (2 << 10) | 0x1f));
    case 4: return __builtin_bit_cast(float, __builtin_amdgcn_ds_swizzle(iv, (4 << 10) | 0x1f));
    case 8: return __builtin_bit_cast(float, __builtin_amdgcn_ds_swizzle(iv, (8 << 10) | 0x1f));
    case 16: return __builtin_bit_cast(float, __builtin_amdgcn_ds_swizzle(iv, (16 << 10) | 0x1f));
    default: { const int lane = TID & 63; return __builtin_bit_cast(float, __builtin_amdgcn_ds_bpermute(((lane ^ m) & 63) << 2, iv)); }
  }
}
DEV float shfl_f(float v, int src) { return __builtin_bit_cast(float, __builtin_amdgcn_ds_bpermute((src & 63) << 2, __builtin_bit_cast(int, v))); }
DEV int atomic_add_i(int* p, int v) { return atomicAdd(p, v); }
extern __shared__ __attribute__((aligned(16))) char dyn_lds[];
#define LDS_PTR() (dyn_lds)
#endif
DEV float grp16_sum(float v) { v += shfl_xor_f(v, 1); v += shfl_xor_f(v, 2); v += shfl_xor_f(v, 4); v += shfl_xor_f(v, 8); return v; }
DEV float grp16_max(float v) { v = fmaxf(v, shfl_xor_f(v, 1)); v = fmaxf(v, shfl_xor_f(v, 2)); v = fmaxf(v, shfl_xor_f(v, 4)); v = fmaxf(v, shfl_xor_f(v, 8)); return v; }
DEV float wave_sum(float v) { v = grp16_sum(v); v += shfl_xor_f(v, 16); v += shfl_xor_f(v, 32); return v; }
DEV bf16x8 ld8(const bf16_t* p) { return __builtin_bit_cast(bf16x8, *(const u32x4*)p); }

DEV void phase_mod_rope(const Params& p) {
  float* mod = (float*)(p.ws + WS_MOD);
  const int gtid = BID * NTHREADS + TID, gstride = NBLK * NTHREADS;
  for (int o = gtid; o < DEPTH * BATCH * 6 * D; o += gstride) {
    const int n = o % (6 * D), b = (o / (6 * D)) % BATCH, l = o / (6 * D * BATCH);
    const float* w = p.w_ada + (size_t)l * D * 6 * D + n; const float* cv = p.c + b * D;
    float s = p.b_ada[l * 6 * D + n];
    for (int k = 0; k < D; ++k) s += siluf_(cv[k]) * w[(size_t)k * 6 * D];
    mod[o] = s;
  }
  float* rope = (float*)(p.ws + WS_ROPE);
  constexpr int NR = SEQ / GRID_W;
  for (int o = gtid; o < (NR + 64) * 16; o += gstride) {
    const int i = o & 15, pos = o >> 4;
    const float inv = powf(10000.f, -(float)(2 * i) / 32.f);
    if (pos < NR) { const float a = (float)pos * inv; rope[pos * 16 + i] = cosf(a); rope[NR * 16 + pos * 16 + i] = sinf(a); }
    else { const int cpos = pos - NR; const float a = (float)cpos * inv; rope[2 * NR * 16 + cpos * 16 + i] = cosf(a); rope[2 * NR * 16 + 64 * 16 + cpos * 16 + i] = sinf(a); }
  }
}
DEV void transpose_item(char* lds, const float* src, int K, int N, bf16_t* dst, int mode, int item) {
  float* tile = (float*)lds;
  const int ntn = (N + 63) / 64, tk = item / ntn, tn = item % ntn, tid = TID;
  const int k0 = tk * 64, n0 = tn * 64;
  { const int kk = tid >> 3, c8 = (tid & 7) * 8;
    const float* s = src + (size_t)(k0 + kk) * N + n0 + c8;
    UNR for (int j = 0; j < 8; ++j) tile[kk * 65 + c8 + j] = (n0 + c8 + j < N) ? s[j] : 0.f; }
  SYNC();
  { const int nn = tid >> 3, k8 = (tid & 7) * 8, n = n0 + nn;
    if (n < N) {
      int row = n; if (mode == 1) row = 32 * (n >> 4) + (n & 15); else if (mode == 2) row = 32 * (n >> 4) + 16 + (n & 15);
      u32x4 v; v.x = pk2(tile[(k8 + 0) * 65 + nn], tile[(k8 + 1) * 65 + nn]); v.y = pk2(tile[(k8 + 2) * 65 + nn], tile[(k8 + 3) * 65 + nn]);
      v.z = pk2(tile[(k8 + 4) * 65 + nn], tile[(k8 + 5) * 65 + nn]); v.w = pk2(tile[(k8 + 6) * 65 + nn], tile[(k8 + 7) * 65 + nn]);
      *(u32x4*)(dst + (size_t)row * K + k0 + k8) = v; } }
  SYNC();
}
DEV void phase_convert(const Params& p, int l) {
  char* lds = LDS_PTR();
  constexpr int I_IN = (D / 64) * ((IN_W + 63) / 64), I_BM = (MW / 64) * (D / 64), I_BA = (AW / 64) * (D / 64), I_OUT = (D / 64) * (D / 64);
  constexpr int I_G = (D / 64) * (FF / 64), I_D = (FF / 64) * (D / 64);
  constexpr int B1 = I_IN, B2 = B1 + I_BM, B3 = B2 + I_BA, B4 = B3 + I_OUT, B5 = B4 + NE * I_G, B6 = B5 + NE * I_G, B7 = B6 + NE * I_D;
  for (int it = BID; it < B7; it += NBLK) {
    if (it < B1) transpose_item(lds, p.w_in + (size_t)l * D * IN_W, D, IN_W, (bf16_t*)(p.ws + WS_WIN), 0, it);
    else if (it < B2) transpose_item(lds, p.w_branch_m + (size_t)l * MW * D, MW, D, (bf16_t*)(p.ws + WS_WBM), 0, it - B1);
    else if (it < B3) transpose_item(lds, p.w_branch_a + (size_t)l * AW * D, AW, D, (bf16_t*)(p.ws + WS_WBA), 0, it - B2);
    else if (it < B4) transpose_item(lds, p.w_out + (size_t)l * D * D, D, D, (bf16_t*)(p.ws + WS_WOUT), 0, it - B3);
    else if (it < B5) { const int e = (it - B4) / I_G, r = (it - B4) % I_G; transpose_item(lds, p.w_gate + ((size_t)l * NE + e) * D * FF, D, FF, (bf16_t*)(p.ws + WS_WGU) + (size_t)e * 2 * FF * D, 1, r); }
    else if (it < B6) { const int e = (it - B5) / I_G, r = (it - B5) % I_G; transpose_item(lds, p.w_up + ((size_t)l * NE + e) * D * FF, D, FF, (bf16_t*)(p.ws + WS_WGU) + (size_t)e * 2 * FF * D, 2, r); }
    else { const int e = (it - B6) / I_D, r = (it - B6) % I_D; transpose_item(lds, p.w_down + ((size_t)l * NE + e) * FF * D, FF, D, (bf16_t*)(p.ws + WS_WD) + (size_t)e * D * FF, 0, r); }
  }
}

DEV void phase_norm(const Params& p, int l, int mode, int which) {
  const int lane = TID & 63, wv = TID >> 6, nwv = NTHREADS / 64;
  const float* mod = (const float*)(p.ws + WS_MOD);
  bf16_t* H = (bf16_t*)(p.ws + WS_H);
  const bf16_t* Y = (const bf16_t*)(p.ws + WS_Y);
  for (int t = BID * nwv + wv; t < T; t += NBLK * nwv) {
    const int b = t / SEQ;
    f32x4 v[4]; float ss = 0.f;
    UNR for (int i = 0; i < 4; ++i) {
      const int c4 = lane + 64 * i;
      if (mode == 0) v[i] = ((const f32x4*)(p.x + (size_t)t * D))[c4];
      else {
        v[i] = ((const f32x4*)(p.out + (size_t)t * D))[c4];
        if (mode == 1) {
          const f32x4 g2 = ((const f32x4*)(mod + ((size_t)(l - 1) * BATCH + b) * 6 * D + 5 * D))[c4];
          const u32x2 y0 = ((const u32x2*)(Y + (size_t)(2 * t) * D))[c4], y1 = ((const u32x2*)(Y + (size_t)(2 * t + 1) * D))[c4];
          v[i][0] += g2[0] * (bf2f((bf16_t)(y0.x & 0xffff)) + bf2f((bf16_t)(y1.x & 0xffff)));
          v[i][1] += g2[1] * (bf2f((bf16_t)(y0.x >> 16)) + bf2f((bf16_t)(y1.x >> 16)));
          v[i][2] += g2[2] * (bf2f((bf16_t)(y0.y & 0xffff)) + bf2f((bf16_t)(y1.y & 0xffff)));
          v[i][3] += g2[3] * (bf2f((bf16_t)(y0.y >> 16)) + bf2f((bf16_t)(y1.y >> 16)));
        }
      }
      ss += v[i][0] * v[i][0] + v[i][1] * v[i][1] + v[i][2] * v[i][2] + v[i][3] * v[i][3];
    }
    ss = wave_sum(ss);
    const float rs = 1.f / sqrtf(ss * (1.f / D) + EPS);
    if (which == 2) {
      UNR for (int i = 0; i < 4; ++i) { const int c4 = lane + 64 * i; const f32x4 g = ((const f32x4*)p.final_g)[c4];
        f32x4 o; UNR for (int j = 0; j < 4; ++j) o[j] = v[i][j] * rs * g[j]; ((f32x4*)(p.out + (size_t)t * D))[c4] = o; }
      continue;
    }
    if (mode != 2) UNR for (int i = 0; i < 4; ++i) ((f32x4*)(p.out + (size_t)t * D))[lane + 64 * i] = v[i];
    const float* mb = mod + ((size_t)l * BATCH + b) * 6 * D + (which == 0 ? 0 : 3 * D);
    const float* gw = (which == 0 ? p.norm1_g : p.norm2_g) + (size_t)l * D;
    f32x4 hv[4];
    UNR for (int i = 0; i < 4; ++i) { const int c4 = lane + 64 * i;
      const f32x4 g = ((const f32x4*)gw)[c4], sh = ((const f32x4*)mb)[c4], sc = ((const f32x4*)(mb + D))[c4];
      UNR for (int j = 0; j < 4; ++j) hv[i][j] = (v[i][j] * rs * g[j]) * (1.f + sc[j]) + sh[j];
      u32x2 o; o.x = pk2(hv[i][0], hv[i][1]); o.y = pk2(hv[i][2], hv[i][3]); ((u32x2*)(H + (size_t)t * D))[c4] = o; }
  }
}
constexpr int HSP = 1028;
DEV void phase_norm2_router(const Params& p, int l) {
  char* lds = LDS_PTR();
  float* HS = (float*)lds;
  float* PART = HS + 16 * HSP;
  const int tid = TID, lane = tid & 63, w = tid >> 6;
  const float* mod = (const float*)(p.ws + WS_MOD);
  bf16_t* H = (bf16_t*)(p.ws + WS_H);
  const float* wrg = p.w_rg + (size_t)l * D * NG; const float* wre = p.w_re + (size_t)l * D * NE;
  const float* gw = p.norm2_g + (size_t)l * D;
  for (int tb = BID * 16; tb < T; tb += NBLK * 16) {
    SYNC();
    UNR for (int q = 0; q < 2; ++q) {
      const int tl = 2 * w + q, t = tb + tl, b = t / SEQ;
      f32x4 v[4]; float ss = 0.f;
      UNR for (int i = 0; i < 4; ++i) { v[i] = ((const f32x4*)(p.out + (size_t)t * D))[lane + 64 * i]; ss += v[i][0] * v[i][0] + v[i][1] * v[i][1] + v[i][2] * v[i][2] + v[i][3] * v[i][3]; }
      ss = wave_sum(ss);
      const float rs = 1.f / sqrtf(ss * (1.f / D) + EPS);
      const float* mb = mod + ((size_t)l * BATCH + b) * 6 * D + 3 * D;
      UNR for (int i = 0; i < 4; ++i) { const int c4 = lane + 64 * i;
        const f32x4 g = ((const f32x4*)gw)[c4], sh = ((const f32x4*)mb)[c4], sc = ((const f32x4*)(mb + D))[c4];
        f32x4 hv; UNR for (int j = 0; j < 4; ++j) hv[j] = (v[i][j] * rs * g[j]) * (1.f + sc[j]) + sh[j];
        u32x2 o; o.x = pk2(hv[0], hv[1]); o.y = pk2(hv[2], hv[3]); ((u32x2*)(H + (size_t)t * D))[c4] = o;
        *(f32x4*)(HS + tl * HSP + 4 * c4) = hv; }
    }
    SYNC();
    f32x4 acc[3]; UNR for (int nt = 0; nt < 3; ++nt) acc[nt] = (f32x4){0.f, 0.f, 0.f, 0.f};
#pragma unroll 4
    for (int kk = 0; kk < 32; ++kk) {
      const int d = 128 * w + 4 * kk + (lane >> 4);
      const float a = HS[(lane & 15) * HSP + d];
      const int o0 = lane & 15;
      const float b0 = (o0 < NG) ? wrg[(size_t)d * NG + o0] : wre[(size_t)d * NE + o0 - NG];
      const float b1 = wre[(size_t)d * NE + 16 + o0 - NG];
      const float b2 = (o0 < NG) ? wre[(size_t)d * NE + 32 + o0 - NG] : 0.f;
      acc[0] = mfma4f32(a, b0, acc[0]); acc[1] = mfma4f32(a, b1, acc[1]); acc[2] = mfma4f32(a, b2, acc[2]);
    }
    UNR for (int nt = 0; nt < 3; ++nt) UNR for (int i = 0; i < 4; ++i) PART[(w * 16 + (lane >> 4) * 4 + i) * 48 + nt * 16 + (lane & 15)] = acc[nt][i];
    SYNC();
    if (tid < 16) {
      const int t = tb + tid;
      float lg[NG];
      int g = 0; float gmx = -3.0e38f;
#pragma unroll
      for (int o = 0; o < NG; ++o) { float s = p.b_rg[l * NG + o];
#pragma unroll 1
        for (int ww = 0; ww < 8; ++ww) s += PART[(ww * 16 + tid) * 48 + o]; lg[o] = s; if (s > gmx) { gmx = s; g = o; } }
      float gsum = 0.f; UNR for (int o = 0; o < NG; ++o) gsum += expf(lg[o] - gmx);
      const float ptop = 1.f / gsum;
      int e0 = 0, e1 = 0; float m0 = -3.0e38f, m1 = -3.0e38f;
#pragma unroll 1
      for (int j = 0; j < EPG; ++j) { float s = p.b_re[l * NE + g * EPG + j];
#pragma unroll 1
        for (int ww = 0; ww < 8; ++ww) s += PART[(ww * 16 + tid) * 48 + NG + g * EPG + j];
        if (s > m0) { m1 = m0; e1 = e0; m0 = s; e0 = j; } else if (s > m1) { m1 = s; e1 = j; } }
      const float x1 = expf(m1 - m0), w0 = ptop / (1.f + x1), w1 = ptop * x1 / (1.f + x1);
      int* cnt = (int*)(p.ws + WS_CTL) + CW_CNT + l * NE; int* list = (int*)(p.ws + WS_LIST); float* went = (float*)(p.ws + WS_WENT);
      const int ea = g * EPG + e0, eb = g * EPG + e1;
      const int pa = atomic_add_i(cnt + ea, 1); list[(size_t)ea * T + pa] = 2 * t; went[2 * t] = w0;
      const int pb = atomic_add_i(cnt + eb, 1); list[(size_t)eb * T + pb] = 2 * t + 1; went[2 * t + 1] = w1;
    }
  }
}

constexpr int GP = 72;
struct RowPlain { const bf16_t* base; size_t ld; DEVM const bf16_t* operator()(int r) const { return base + (size_t)r * ld; } };
template <class RowA>
DEV void gemm_kloop(char* lds, const RowA& rowA, const bf16_t* Bt, size_t ldb, int K, f32x4 (&acc)[4][2]) {
  bf16_t* As = (bf16_t*)lds; bf16_t* Bs = As + 128 * GP;
  const int tid = TID, lane = tid & 63, w = tid >> 6, wm = w >> 2, wn = w & 3;
  const int r0 = tid >> 3, pc = (tid & 7) * 8;
  const bf16_t* a0 = rowA(r0) + pc; const bf16_t* a1 = rowA(r0 + 64) + pc;
  const bf16_t* b0 = Bt + (size_t)r0 * ldb + pc; const bf16_t* b1 = Bt + (size_t)(r0 + 64) * ldb + pc;
  u32x4 ra0 = *(const u32x4*)a0, ra1 = *(const u32x4*)a1, rb0 = *(const u32x4*)b0, rb1 = *(const u32x4*)b1;
  const int nk = K / 64;
  for (int kt = 0; kt < nk; ++kt) {
    SYNC();
    *(u32x4*)(As + r0 * GP + pc) = ra0; *(u32x4*)(As + (r0 + 64) * GP + pc) = ra1;
    *(u32x4*)(Bs + r0 * GP + pc) = rb0; *(u32x4*)(Bs + (r0 + 64) * GP + pc) = rb1;
    SYNC();
    if (kt + 1 < nk) { const int ko = (kt + 1) * 64; ra0 = *(const u32x4*)(a0 + ko); ra1 = *(const u32x4*)(a1 + ko); rb0 = *(const u32x4*)(b0 + ko); rb1 = *(const u32x4*)(b1 + ko); }
#pragma unroll
    for (int ks = 0; ks < 2; ++ks) {
      const int kof = ks * 32 + (lane >> 4) * 8;
      bf16x8 af[4], bfr[2];
#pragma unroll
      for (int mt = 0; mt < 4; ++mt) af[mt] = ld8(As + (wm * 64 + mt * 16 + (lane & 15)) * GP + kof);
#pragma unroll
      for (int nt = 0; nt < 2; ++nt) bfr[nt] = ld8(Bs + (wn * 32 + nt * 16 + (lane & 15)) * GP + kof);
#pragma unroll
      for (int mt = 0; mt < 4; ++mt)
#pragma unroll
        for (int nt = 0; nt < 2; ++nt) acc[mt][nt] = mfma16(af[mt], bfr[nt], acc[mt][nt]);
    }
  }
}
DEV void zero_acc(f32x4 (&acc)[4][2]) { UNR for (int i = 0; i < 4; ++i) UNR for (int j = 0; j < 2; ++j) acc[i][j] = (f32x4){0.f, 0.f, 0.f, 0.f}; }

DEV void phase_gemm_in(const Params& p, int l) {
  char* lds = LDS_PTR();
  const bf16_t* H = (const bf16_t*)(p.ws + WS_H); const bf16_t* W = (const bf16_t*)(p.ws + WS_WIN);
  bf16_t* PROJ = (bf16_t*)(p.ws + WS_PROJ); float* GATES = (float*)(p.ws + WS_GATES);
  const float* bias = p.b_in + (size_t)l * IN_W;
  constexpr int nM = T / 128, nN = NP / 128;
  for (int u = BID; u < nM * nN; u += NBLK) {
    const int pm = u % nM, pn = u / nM;
    f32x4 acc[4][2]; zero_acc(acc);
    RowPlain ra{H + (size_t)pm * 128 * D, (size_t)D};
    gemm_kloop(lds, ra, W + (size_t)pn * 128 * D, D, D, acc);
    const int etid = TID, lane = etid & 63, w = etid >> 6, wm = w >> 2, wn = w & 3;
    UNR for (int nt = 0; nt < 2; ++nt) {
      const int col = pn * 128 + wn * 32 + nt * 16 + (lane & 15);
      if (col >= IN_W) continue;
      const float bv = bias[col];
      UNR for (int mt = 0; mt < 4; ++mt) UNR for (int i = 0; i < 4; ++i) {
        const int row = pm * 128 + wm * 64 + mt * 16 + (lane >> 4) * 4 + i; const float v = acc[mt][nt][i] + bv;
        PROJ[(size_t)row * NP + col] = f2bf(v);
        if (col >= C_GATES && col < C_GATES + 16) GATES[(size_t)row * 16 + (col - C_GATES)] = v;
      }
    }
  }
}
DEV void phase_gemm_merge(const Params& p) {
  char* lds = LDS_PTR();
  const bf16_t* YM = (const bf16_t*)(p.ws + WS_YM); const bf16_t* YA = (const bf16_t*)(p.ws + WS_YA);
  const bf16_t* WM = (const bf16_t*)(p.ws + WS_WBM); const bf16_t* WA = (const bf16_t*)(p.ws + WS_WBA);
  const bf16_t* PROJ = (const bf16_t*)(p.ws + WS_PROJ); bf16_t* MG = (bf16_t*)(p.ws + WS_MERGED);
  constexpr int nM = T / 128, nN = D / 128;
  for (int u = BID; u < nM * nN; u += NBLK) {
    const int pm = u / nN, pn = u % nN;
    f32x4 acc[4][2]; zero_acc(acc);
    RowPlain r1{YM + (size_t)pm * 128 * MW, (size_t)MW}; gemm_kloop(lds, r1, WM + (size_t)pn * 128 * MW, MW, MW, acc);
    float* park = (float*)(lds + 40960);
    { const int ptid = TID; UNR for (int mt = 0; mt < 4; ++mt) UNR for (int nt = 0; nt < 2; ++nt) UNR for (int i = 0; i < 4; ++i) park[((mt * 2 + nt) * 4 + i) * NTHREADS + ptid] = acc[mt][nt][i]; }
    zero_acc(acc);
    RowPlain r2{YA + (size_t)pm * 128 * AW, (size_t)AW}; gemm_kloop(lds, r2, WA + (size_t)pn * 128 * AW, AW, AW, acc);
    const int etid = TID, lane = etid & 63, w = etid >> 6, wm = w >> 2, wn = w & 3;
    UNR for (int nt = 0; nt < 2; ++nt) { const int col = pn * 128 + wn * 32 + nt * 16 + (lane & 15);
      UNR for (int mt = 0; mt < 4; ++mt) UNR for (int i = 0; i < 4; ++i) {
        const int row = pm * 128 + wm * 64 + mt * 16 + (lane >> 4) * 4 + i;
        const float gm = bf2f(PROJ[(size_t)row * NP + C_GM + col]), ga = bf2f(PROJ[(size_t)row * NP + C_GA + col]);
        MG[(size_t)row * D + col] = f2bf(sigmoidf_(gm) * park[((mt * 2 + nt) * 4 + i) * NTHREADS + etid] + sigmoidf_(ga) * acc[mt][nt][i]); } }
  }
}
DEV void phase_gemm_out(const Params& p, int l) {
  char* lds = LDS_PTR();
  const bf16_t* MG = (const bf16_t*)(p.ws + WS_MERGED); const bf16_t* W = (const bf16_t*)(p.ws + WS_WOUT);
  const float* mod = (const float*)(p.ws + WS_MOD);
  constexpr int nM = T / 128, nN = D / 128;
  for (int u = BID; u < nM * nN; u += NBLK) {
    const int pm = u / nN, pn = u % nN;
    f32x4 acc[4][2]; zero_acc(acc);
    RowPlain ra{MG + (size_t)pm * 128 * D, (size_t)D}; gemm_kloop(lds, ra, W + (size_t)pn * 128 * D, D, D, acc);
    const int etid = TID, lane = etid & 63, w = etid >> 6, wm = w >> 2, wn = w & 3;
    const int b = (pm * 128) / SEQ;
    UNR for (int nt = 0; nt < 2; ++nt) { const int col = pn * 128 + wn * 32 + nt * 16 + (lane & 15);
      const float g1 = mod[((size_t)l * BATCH + b) * 6 * D + 2 * D + col];
      UNR for (int mt = 0; mt < 4; ++mt) UNR for (int i = 0; i < 4; ++i) {
        const int row = pm * 128 + wm * 64 + mt * 16 + (lane >> 4) * 4 + i;
        p.out[(size_t)row * D + col] += g1 * acc[mt][nt][i]; } }
  }
}
struct RowGather { const bf16_t* base; const int* list; int nvalid; DEVM const bf16_t* operator()(int r) const { const int ent = (r < nvalid) ? list[r] : list[0]; return base + (size_t)(ent >> 1) * D; } };
DEV void moe_tiles(const Params& p, int l, int* s_pref) {
  if (TID == 0) { const int* cnt = (const int*)(p.ws + WS_CTL) + CW_CNT + l * NE; int a = 0; for (int e = 0; e < NE; ++e) { s_pref[e] = a; a += (cnt[e] + 127) / 128; } s_pref[NE] = a; }
  SYNC();
}
DEV void phase_moe_up(const Params& p, int l) {
  char* lds = LDS_PTR(); int* s_pref = (int*)(lds + 2 * 128 * GP * 2);
  moe_tiles(p, l, s_pref);
  const bf16_t* H = (const bf16_t*)(p.ws + WS_H); const bf16_t* W = (const bf16_t*)(p.ws + WS_WGU); bf16_t* ACT = (bf16_t*)(p.ws + WS_ACT);
  const int* cnt = (const int*)(p.ws + WS_CTL) + CW_CNT + l * NE; const int* list = (const int*)(p.ws + WS_LIST); const float* went = (const float*)(p.ws + WS_WENT);
  const int ntile = s_pref[NE];
  for (int u = BID; u < ntile * 8; u += NBLK) {
    const int rt = u >> 3, ct = u & 7;
    int e = 0; while (s_pref[e + 1] <= rt) ++e;
    const int lt = rt - s_pref[e], nvalid = cnt[e] - lt * 128;
    const int* elist = list + (size_t)e * T + lt * 128;
    f32x4 acc[4][2]; zero_acc(acc);
    RowGather ra{H, elist, nvalid};
    gemm_kloop(lds, ra, W + ((size_t)e * 2 * FF + ct * 128) * D, D, D, acc);
    const int etid = TID, lane = etid & 63, w = etid >> 6, wm = w >> 2, wn = w & 3;
    const int f = (ct * 4 + wn) * 16 + (lane & 15);
    UNR for (int mt = 0; mt < 4; ++mt) UNR for (int i = 0; i < 4; ++i) {
      const int r = wm * 64 + mt * 16 + (lane >> 4) * 4 + i;
      if (r < nvalid) { const float wt = went[elist[r]]; const float a = acc[mt][0][i], uu = acc[mt][1][i];
        ACT[((size_t)rt * 128 + r) * FF + f] = f2bf(siluf_(a) * uu * wt); } }
  }
}
DEV void phase_moe_down(const Params& p, int l) {
  char* lds = LDS_PTR(); int* s_pref = (int*)(lds + 2 * 128 * GP * 2);
  moe_tiles(p, l, s_pref);
  const bf16_t* ACT = (const bf16_t*)(p.ws + WS_ACT); const bf16_t* W = (const bf16_t*)(p.ws + WS_WD); bf16_t* Y = (bf16_t*)(p.ws + WS_Y);
  const int* cnt = (const int*)(p.ws + WS_CTL) + CW_CNT + l * NE; const int* list = (const int*)(p.ws + WS_LIST);
  const int ntile = s_pref[NE];
  for (int u = BID; u < ntile * 8; u += NBLK) {
    const int rt = u >> 3, ct = u & 7;
    int e = 0; while (s_pref[e + 1] <= rt) ++e;
    const int lt = rt - s_pref[e], nvalid = cnt[e] - lt * 128;
    const int* elist = list + (size_t)e * T + lt * 128;
    f32x4 acc[4][2]; zero_acc(acc);
    RowPlain ra{ACT + (size_t)rt * 128 * FF, (size_t)FF};
    gemm_kloop(lds, ra, W + ((size_t)e * D + ct * 128) * FF, FF, FF, acc);
    const int etid = TID, lane = etid & 63, w = etid >> 6, wm = w >> 2, wn = w & 3;
    UNR for (int nt = 0; nt < 2; ++nt) { const int col = ct * 128 + wn * 32 + nt * 16 + (lane & 15);
      UNR for (int mt = 0; mt < 4; ++mt) UNR for (int i = 0; i < 4; ++i) {
        const int r = wm * 64 + mt * 16 + (lane >> 4) * 4 + i;
        if (r < nvalid) Y[(size_t)elist[r] * D + col] = f2bf(acc[mt][nt][i]); } }
  }
}

DEV void phase_prep(const Params& p, int l) {
  const bf16_t* PROJ = (const bf16_t*)(p.ws + WS_PROJ);
  bf16_t* QC = (bf16_t*)(p.ws + WS_QC); bf16_t* KC = (bf16_t*)(p.ws + WS_KC);
  const int gtid = BID * NTHREADS + TID, gstride = NBLK * NTHREADS;
  const float* cw = p.conv_w + (size_t)l * CONVW * 2 * MW; const float* cb = p.conv_b + (size_t)l * 2 * MW;
  for (int it = gtid; it < T * 128; it += gstride) {
    const int t = it >> 7, c8 = (it & 127) * 8, s = t % SEQ;
    float a[8]; UNR for (int j = 0; j < 8; ++j) a[j] = cb[c8 + j];
    UNR for (int wi = 0; wi < CONVW; ++wi) { const int ss = s + wi - 2; if (ss < 0 || ss >= SEQ) continue;
      const bf16x8 v = ld8(PROJ + (size_t)(t + wi - 2) * NP + c8);
      UNR for (int j = 0; j < 8; ++j) a[j] += bf2f((bf16_t)v[j]) * cw[wi * 2 * MW + c8 + j]; }
    const float sc = (c8 < MW) ? 0.08838834764831845f : 1.f;
    u32x4 o; o.x = pk2(siluf_(a[0]) * sc, siluf_(a[1]) * sc); o.y = pk2(siluf_(a[2]) * sc, siluf_(a[3]) * sc); o.z = pk2(siluf_(a[4]) * sc, siluf_(a[5]) * sc); o.w = pk2(siluf_(a[6]) * sc, siluf_(a[7]) * sc);
    if (c8 < MW) *(u32x4*)(QC + (size_t)t * MW + c8) = o; else *(u32x4*)(KC + (size_t)t * MW + c8 - MW) = o;
  }
  bf16_t* AQN = (bf16_t*)(p.ws + WS_AQN); bf16_t* AKN = (bf16_t*)(p.ws + WS_AKN); bf16_t* VT = (bf16_t*)(p.ws + WS_VT);
  const float* rope = (const float*)(p.ws + WS_ROPE); constexpr int NR = SEQ / GRID_W;
  for (int it0 = BID * NTHREADS; it0 < T * 10 * 8; it0 += gstride) {
    const int it = it0 + TID, j = it & 7, th = it >> 3, hh = th / T, t = th % T, s = t % SEQ;
    const bool isq = hh < AH;
    const bf16_t* src = PROJ + (size_t)t * NP + (isq ? C_AQ + hh * 64 : C_AK + (hh - AH) * 64) + j * 8;
    const float* g = (isq ? p.q_norm_g : p.k_norm_g) + (size_t)l * AHD + j * 8;
    const bf16x8 x8 = ld8(src);
    float v[8], pr[8]; float ss = 0.f;
#pragma unroll
    for (int k = 0; k < 8; ++k) { v[k] = bf2f((bf16_t)x8[k]); ss += v[k] * v[k]; }
    ss += shfl_xor_f(ss, 1); ss += shfl_xor_f(ss, 2); ss += shfl_xor_f(ss, 4);
    const float rs = 1.f / sqrtf(ss * (1.f / 64.f) + EPS);
#pragma unroll
    for (int k = 0; k < 8; ++k) v[k] = v[k] * rs * g[k];
#pragma unroll
    for (int k = 0; k < 8; ++k) pr[k] = shfl_xor_f(v[k], 2);
    const int pos = (j < 4) ? s / GRID_W : s % GRID_W;
    const float* ct = rope + (j < 4 ? 0 : 2 * NR * 16) + pos * 16 + (j & 1) * 8;
    const float* st = ct + (j < 4 ? NR * 16 : 64 * 16);
    const float sgn = (j & 2) ? 1.f : -1.f, qs = isq ? 0.125f : 1.f;
    float o[8];
#pragma unroll
    for (int k = 0; k < 8; ++k) o[k] = (v[k] * ct[k] + sgn * pr[k] * st[k]) * qs;
    u32x4 w4; w4.x = pk2(o[0], o[1]); w4.y = pk2(o[2], o[3]); w4.z = pk2(o[4], o[5]); w4.w = pk2(o[6], o[7]);
    bf16_t* dst = isq ? AQN + (size_t)t * AW + hh * 64 + j * 8 : AKN + (size_t)t * KVW + (hh - AH) * 64 + j * 8;
    *(u32x4*)dst = w4;
  }
  for (int it = gtid; it < T * KVH * 8; it += gstride) {
    const int s = it % SEQ, d8 = (it / SEQ) & 7, bk = it / (SEQ * 8), b = bk / KVH, kv = bk % KVH;
    const bf16x8 v8 = ld8(PROJ + (size_t)(b * SEQ + s) * NP + C_AV + kv * 64 + d8 * 8);
#pragma unroll
    for (int k = 0; k < 8; ++k) VT[((size_t)bk * 64 + d8 * 8 + k) * SEQ + s] = (bf16_t)v8[k];
  }
}

DEV void phase_attn(const Params& p) {
  char* lds = LDS_PTR();
  bf16_t* Ks = (bf16_t*)lds; bf16_t* Vs = Ks + 64 * GP; bf16_t* Ps = Vs + 64 * GP;
  const bf16_t* AQN = (const bf16_t*)(p.ws + WS_AQN); const bf16_t* AKN = (const bf16_t*)(p.ws + WS_AKN); const bf16_t* VT = (const bf16_t*)(p.ws + WS_VT);
  bf16_t* YA = (bf16_t*)(p.ws + WS_YA);
  const int tid = TID, lane = tid & 63, w = tid >> 6;
  constexpr int NQB = SEQ / 128, NU = BATCH * AH * NQB;
  bf16_t* Pw = Ps + w * 16 * GP;
  for (int u = BID; u < NU; u += NBLK) {
    const int qb = u % NQB, h = (u / NQB) % AH, b = u / (NQB * AH), kv = h / (AH / KVH);
    const int r0 = qb * 128 + w * 16;
    bf16x8 qa[2];
    UNR for (int ks = 0; ks < 2; ++ks) qa[ks] = ld8(AQN + (size_t)(b * SEQ + r0 + (lane & 15)) * AW + h * 64 + ks * 32 + (lane >> 4) * 8);
    f32x4 o[4]; UNR for (int i = 0; i < 4; ++i) o[i] = (f32x4){0.f, 0.f, 0.f, 0.f};
    float mrow[4], lrow[4]; UNR for (int i = 0; i < 4; ++i) { mrow[i] = -3.0e38f; lrow[i] = 0.f; }
    for (int kt = 0; kt < SEQ / 64; ++kt) {
      SYNC();
      { const int r = tid >> 3, pc = (tid & 7) * 8;
        *(u32x4*)(Ks + r * GP + pc) = *(const u32x4*)(AKN + (size_t)(b * SEQ + kt * 64 + r) * KVW + kv * 64 + pc);
        *(u32x4*)(Vs + r * GP + pc) = *(const u32x4*)(VT + ((size_t)(b * KVH + kv) * 64 + r) * SEQ + kt * 64 + pc); }
      SYNC();
      f32x4 s[4];
      UNR for (int nt = 0; nt < 4; ++nt) { s[nt] = (f32x4){0.f, 0.f, 0.f, 0.f};
        UNR for (int ks = 0; ks < 2; ++ks) s[nt] = mfma16(qa[ks], ld8(Ks + (nt * 16 + (lane & 15)) * GP + ks * 32 + (lane >> 4) * 8), s[nt]); }
      UNR for (int i = 0; i < 4; ++i) {
        float mx = fmaxf(fmaxf(s[0][i], s[1][i]), fmaxf(s[2][i], s[3][i])); mx = grp16_max(mx);
        const float mnew = fmaxf(mrow[i], mx), alpha = expf(mrow[i] - mnew); mrow[i] = mnew;
        float rsum = 0.f;
        UNR for (int nt = 0; nt < 4; ++nt) { const float pv = expf(s[nt][i] - mnew); rsum += pv; Pw[((lane >> 4) * 4 + i) * GP + nt * 16 + (lane & 15)] = f2bf(pv); }
        lrow[i] = lrow[i] * alpha + rsum;
        UNR for (int nd = 0; nd < 4; ++nd) o[nd][i] *= alpha;
      }
      SYNC();
      UNR for (int ks = 0; ks < 2; ++ks) { const bf16x8 pa = ld8(Pw + (lane & 15) * GP + ks * 32 + (lane >> 4) * 8);
        UNR for (int nd = 0; nd < 4; ++nd) o[nd] = mfma16(pa, ld8(Vs + (nd * 16 + (lane & 15)) * GP + ks * 32 + (lane >> 4) * 8), o[nd]); }
    }
    UNR for (int i = 0; i < 4; ++i) { const float lt = grp16_sum(lrow[i]), inv = 1.f / lt; const int row = b * SEQ + r0 + (lane >> 4) * 4 + i;
      UNR for (int nd = 0; nd < 4; ++nd) YA[(size_t)row * AW + h * 64 + nd * 16 + (lane & 15)] = f2bf(o[nd][i] * inv); }
  }
}

DEV void phase_mlstm_a(const Params& p) {
  char* lds = LDS_PTR();
  bf16_t* VW = (bf16_t*)lds;
  bf16_t* KT = VW + 2 * 128 * GP;
  float* sc = (float*)(KT + 128 * GP);
  float* s_lf = sc; float* s_a = sc + 128; float* s_w = sc + 256;
  const bf16_t* PROJ = (const bf16_t*)(p.ws + WS_PROJ); const bf16_t* KC = (const bf16_t*)(p.ws + WS_KC); const float* GATES = (const float*)(p.ws + WS_GATES);
  bf16_t* CST = (bf16_t*)(p.ws + WS_CST); float* NST = (float*)(p.ws + WS_NST); float* AMAX = (float*)(p.ws + WS_AMAX); float* BLAST = (float*)(p.ws + WS_BLAST);
  const int tid = TID, lane = tid & 63, w = tid >> 6;
  for (int u = BID; u < BHC; u += NBLK) {
    const int c = u % NC, h = (u / NC) % MH, b = u / (NC * MH);
    const int t0 = b * SEQ + c * ML;
    SYNC();
    if (tid < 128) { const int dir = tid >> 6, l = tid & 63; s_lf[dir * 64 + l] = logsigmoidf_(GATES[(size_t)(t0 + l) * 16 + (dir ? 12 : 4) + h]); }
    SYNC();
    if (tid < 128) { const int dir = tid >> 6, l = tid & 63; const float li = GATES[(size_t)(t0 + l) * 16 + (dir ? 8 : 0) + h];
      float a = li;
      if (dir == 0) { for (int q = l + 1; q < 64; ++q) a += s_lf[q]; } else { for (int q = 0; q < l; ++q) a += s_lf[64 + q]; }
      s_a[dir * 64 + l] = a; }
    SYNC();
    if (tid < 128) { const int dir = tid >> 6, l = tid & 63; float mx = -3.0e38f, tot = 0.f;
      for (int q = 0; q < 64; ++q) { mx = fmaxf(mx, s_a[dir * 64 + q]); tot += s_lf[dir * 64 + q]; }
      s_w[dir * 64 + l] = expf(s_a[dir * 64 + l] - mx);
      if (l == 0) { AMAX[dir * BHC + u] = mx; BLAST[dir * BHC + u] = tot; } }
    SYNC();
    for (int it = tid; it < 1024; it += NTHREADS) { const int l = it >> 4, d8 = (it & 15) * 8;
      const bf16x8 v8 = ld8(PROJ + (size_t)(t0 + l) * NP + C_MV + h * 128 + d8); const bf16x8 k8 = ld8(KC + (size_t)(t0 + l) * MW + h * 128 + d8);
      const float wf = s_w[l], wb = s_w[64 + l];
      UNR for (int j = 0; j < 8; ++j) { const float vf = bf2f((bf16_t)v8[j]); VW[(d8 + j) * GP + l] = f2bf(vf * wf); VW[(128 + d8 + j) * GP + l] = f2bf(vf * wb); KT[(d8 + j) * GP + l] = (bf16_t)k8[j]; } }
    SYNC();
    { const int dir = w >> 2, m2 = w & 3;
      UNR for (int mi = 0; mi < 2; ++mi) { const int mt = m2 * 2 + mi;
        bf16x8 af[2]; UNR for (int ks = 0; ks < 2; ++ks) af[ks] = ld8(VW + (dir * 128 + mt * 16 + (lane & 15)) * GP + ks * 32 + (lane >> 4) * 8);
        UNR for (int nt = 0; nt < 8; ++nt) { f32x4 acc = (f32x4){0.f, 0.f, 0.f, 0.f};
          UNR for (int ks = 0; ks < 2; ++ks) acc = mfma16(af[ks], ld8(KT + (nt * 16 + (lane & 15)) * GP + ks * 32 + (lane >> 4) * 8), acc);
          bf16_t* dst = CST + ((size_t)(dir * BHC + u) * 128 + mt * 16 + (lane >> 4) * 4) * 128 + nt * 16 + (lane & 15);
          UNR for (int i = 0; i < 4; ++i) dst[i * 128] = f2bf(acc[i]); } } }
    if (tid < 256) { const int dir = tid >> 7, e = tid & 127; float s = 0.f; for (int l = 0; l < 64; ++l) s += s_w[dir * 64 + l] * bf2f(KT[e * GP + l]); NST[(size_t)(dir * BHC + u) * 128 + e] = s; }
  }
}
DEV void phase_mlstm_scan(const Params& p) {
  bf16_t* CST = (bf16_t*)(p.ws + WS_CST); float* NST = (float*)(p.ws + WS_NST);
  const float* AMAX = (const float*)(p.ws + WS_AMAX); const float* BLAST = (const float*)(p.ws + WS_BLAST); float* MPREV = (float*)(p.ws + WS_MPREV);
  const int gtid = BID * NTHREADS + TID, gstride = NBLK * NTHREADS;
  constexpr int PER = 8192 + 64;
  for (int it = gtid; it < 2 * BATCH * MH * PER; it += gstride) {
    const int pi = it % PER, dbh = it / PER, dir = dbh / (BATCH * MH), bh = dbh % (BATCH * MH);
    float s0 = 0.f, s1 = 0.f, m = 0.f;
    for (int cc = 0; cc < NC; ++cc) {
      const int c = dir ? NC - 1 - cc : cc; const int u = bh * NC + c;
      const float bl = BLAST[dir * BHC + u], am = AMAX[dir * BHC + u];
      const float mn = fmaxf(bl + m, am), dec = expf(bl + m - mn), inj = expf(am - mn);
      if (pi < 8192) { unsigned* ptr = (unsigned*)(CST + (size_t)(dir * BHC + u) * 16384) + pi; const unsigned in = *ptr;
        *ptr = pk2(s0, s1); s0 = dec * s0 + inj * bf2f((bf16_t)(in & 0xffff)); s1 = dec * s1 + inj * bf2f((bf16_t)(in >> 16)); }
      else { float* ptr = NST + (size_t)(dir * BHC + u) * 128 + 2 * (pi - 8192); const float i0 = ptr[0], i1 = ptr[1];
        ptr[0] = s0; ptr[1] = s1; s0 = dec * s0 + inj * i0; s1 = dec * s1 + inj * i1; }
      if (pi == 0) MPREV[dir * BHC + u] = m;
      m = mn;
    }
  }
}
constexpr int QP = 136;
constexpr int C_HALF_BYTES = (64 * QP * 2) * 2 + 128 * GP * 2 + 4 * 16 * GP * 2 + (4 * 64 + 2 * 128 + 4) * 4;
DEV void phase_mlstm_c(const Params& p, int l) {
  char* lds = LDS_PTR();
  const int tid = TID, lane = tid & 63, w = tid >> 6, half = w >> 2, wv = w & 3, htid = tid & 255;
  char* hb = lds + half * ((C_HALF_BYTES + 255) & ~255);
  bf16_t* Qs = (bf16_t*)hb; bf16_t* Ks = Qs + 64 * QP; bf16_t* VTs = Ks + 64 * QP; bf16_t* Ps = VTs + 128 * GP;
  float* s_b = (float*)(Ps + 4 * 16 * GP);
  float* s_li = s_b + 128;
  float* s_n = s_li + 128;
  float* s_m = s_n + 256;
  bf16_t* Pw = Ps + wv * 16 * GP;
  const bf16_t* PROJ = (const bf16_t*)(p.ws + WS_PROJ); const bf16_t* QC = (const bf16_t*)(p.ws + WS_QC); const bf16_t* KC = (const bf16_t*)(p.ws + WS_KC);
  const float* GATES = (const float*)(p.ws + WS_GATES); const bf16_t* CST = (const bf16_t*)(p.ws + WS_CST); const float* NST = (const float*)(p.ws + WS_NST);
  const float* MPREV = (const float*)(p.ws + WS_MPREV); bf16_t* YM = (bf16_t*)(p.ws + WS_YM);
  const float* ng = p.mlstm_norm_g + (size_t)l * MW;
  for (int u0 = BID * 2; u0 < BHC; u0 += NBLK * 2) {
    const int u = u0 + half;
    const int c = u % NC, h = (u / NC) % MH, b = u / (NC * MH);
    const int t0 = b * SEQ + c * ML;
    SYNC();
    for (int it = htid; it < 1024; it += 256) { const int r = it >> 4, d8 = (it & 15) * 8;
      *(u32x4*)(Qs + r * QP + d8) = *(const u32x4*)(QC + (size_t)(t0 + r) * MW + h * 128 + d8);
      *(u32x4*)(Ks + r * QP + d8) = *(const u32x4*)(KC + (size_t)(t0 + r) * MW + h * 128 + d8);
      const bf16x8 v8 = ld8(PROJ + (size_t)(t0 + r) * NP + C_MV + h * 128 + d8);
      UNR for (int j = 0; j < 8; ++j) VTs[(d8 + j) * GP + r] = (bf16_t)v8[j]; }
    if (htid < 128) { const int dir = htid >> 6, q = htid & 63; s_li[dir * 64 + q] = GATES[(size_t)(t0 + q) * 16 + (dir ? 8 : 0) + h];
      s_b[dir * 64 + q] = logsigmoidf_(GATES[(size_t)(t0 + q) * 16 + (dir ? 12 : 4) + h]); }
    s_n[htid] = NST[(size_t)((htid >> 7) * BHC + u) * 128 + (htid & 127)];
    if (htid < 2) s_m[htid] = MPREV[htid * BHC + u];
    SYNC();
    float cum = 0.f;
    if (htid < 128) { const int dir = htid >> 6, q = htid & 63;
      if (dir == 0) { for (int z = 0; z <= q; ++z) cum += s_b[z]; } else { for (int z = q; z < 64; ++z) cum += s_b[64 + z]; } }
    SYNC();
    if (htid < 128) s_b[htid] = cum;
    SYNC();
    const int j0 = wv * 16;
    bf16x8 qa[4]; UNR for (int ks = 0; ks < 4; ++ks) qa[ks] = ld8(Qs + (j0 + (lane & 15)) * QP + ks * 32 + (lane >> 4) * 8);
    f32x4 S[4];
    UNR for (int nt = 0; nt < 4; ++nt) { S[nt] = (f32x4){0.f, 0.f, 0.f, 0.f};
      UNR for (int ks = 0; ks < 4; ++ks) S[nt] = mfma16(qa[ks], ld8(Ks + (nt * 16 + (lane & 15)) * QP + ks * 32 + (lane >> 4) * 8), S[nt]); }
    f32x4 hs[8]; UNR for (int nd = 0; nd < 8; ++nd) hs[nd] = (f32x4){0.f, 0.f, 0.f, 0.f};
#pragma unroll 1
    for (int dir = 0; dir < 2; ++dir) {
      float qn = 0.f; { const int e0 = (lane >> 4) * 32;
        for (int e = 0; e < 32; ++e) qn += bf2f(Qs[(j0 + (lane & 15)) * QP + e0 + e]) * s_n[dir * 128 + e0 + e];
        qn += shfl_xor_f(qn, 16); qn += shfl_xor_f(qn, 32); }
      const float* bb = s_b + dir * 64; const float* li = s_li + dir * 64; const float mp = s_m[dir];
      float fsc[4];
      UNR for (int i = 0; i < 4; ++i) {
        const int j = j0 + (lane >> 4) * 4 + i; const float bj = bb[j];
        float dv[4], sv[4], mx = -3.0e38f;
        UNR for (int nt = 0; nt < 4; ++nt) { const int lk = nt * 16 + (lane & 15); const bool ok = dir ? (lk >= j) : (lk <= j);
          dv[nt] = ok ? (bj - bb[lk] + li[lk]) : -3.0e38f; mx = fmaxf(mx, dv[nt]); }
        mx = grp16_max(mx);
        const float mi = bj + mp, mo = fmaxf(mi, mx);
        float rsum = 0.f;
        UNR for (int nt = 0; nt < 4; ++nt) { sv[nt] = (dv[nt] > -1.0e38f) ? S[nt][i] * expf(dv[nt] - mo) : 0.f; rsum += sv[nt]; }
        rsum = grp16_sum(rsum);
        const float iw = expf(mi - mo);
        const float qnj = shfl_f(qn, (lane >> 4) * 4 + i);
        const float den = rsum + iw * qnj;
        const float dinv = 1.f / fmaxf(fabsf(den), expf(-mo));
        UNR for (int nt = 0; nt < 4; ++nt) Pw[((lane >> 4) * 4 + i) * GP + nt * 16 + (lane & 15)] = f2bf(sv[nt] * dinv);
        fsc[i] = iw * dinv;
      }
      float fa = 0.f;
      UNR for (int i = 0; i < 4; ++i) { const float tv = shfl_f(fsc[i], ((lane & 15) >> 2) * 16); fa = ((lane & 3) == i) ? tv : fa; }
      SYNC();
      UNR for (int ks = 0; ks < 2; ++ks) { const bf16x8 pa = ld8(Pw + (lane & 15) * GP + ks * 32 + (lane >> 4) * 8);
        UNR for (int nd = 0; nd < 8; ++nd) hs[nd] = mfma16(pa, ld8(VTs + (nd * 16 + (lane & 15)) * GP + ks * 32 + (lane >> 4) * 8), hs[nd]); }
      const bf16_t* Cp = CST + (size_t)(dir * BHC + u) * 16384;
      UNR for (int ks = 0; ks < 4; ++ks) {
        bf16x8 qs; UNR for (int e = 0; e < 8; ++e) qs[e] = (short)f2bf(bf2f((bf16_t)qa[ks][e]) * fa);
        UNR for (int nd = 0; nd < 8; ++nd) hs[nd] = mfma16(qs, ld8(Cp + (size_t)(nd * 16 + (lane & 15)) * 128 + ks * 32 + (lane >> 4) * 8), hs[nd]); }
      SYNC();
    }
    UNR for (int i = 0; i < 4; ++i) { float ss = 0.f; UNR for (int nd = 0; nd < 8; ++nd) ss += hs[nd][i] * hs[nd][i];
      ss = grp16_sum(ss); const float rs = 1.f / sqrtf(ss * (1.f / 128.f) + EPS);
      const int t = t0 + j0 + (lane >> 4) * 4 + i;
      UNR for (int nd = 0; nd < 8; ++nd) { const int d = nd * 16 + (lane & 15); const float og = bf2f(PROJ[(size_t)t * NP + C_MO + h * 128 + d]);
        YM[(size_t)t * MW + h * 128 + d] = f2bf(hs[nd][i] * rs * ng[h * 128 + d] * sigmoidf_(og)); } }
  }
}

constexpr int LDS_PHASE_BYTES = 131072;
constexpr int LDS_BYTES = LDS_PHASE_BYTES + 256;
#ifndef EMU
#define XB_TMO      128
#define XB_XCNT(j)  (256  + 64 * (j))
#define XB_XSUB(j)  (1280 + 64 * (j))
#define XB_XGEN(j)  (2304 + 64 * (j))
#define XB_TOP      3328
#define XB_TOPGEN   3392
#define XCD_BAR_WORDS 3456
#define XB_SPIN_CAP (1u << 18)
#define LAS __attribute__((address_space(3)))
__device__ __forceinline__ unsigned xb_ld(unsigned* p)              { return __hip_atomic_load(p, __ATOMIC_RELAXED, __HIP_MEMORY_SCOPE_AGENT); }
__device__ __forceinline__ unsigned xb_add(unsigned* p, unsigned v) { return __hip_atomic_fetch_add(p, v, __ATOMIC_RELAXED, __HIP_MEMORY_SCOPE_AGENT); }
__device__ __forceinline__ unsigned xb_xcc_id() { return (unsigned)__builtin_amdgcn_s_getreg((3 << 11) | 20) & 0xFu; }
#define XB_SPIN(cond, bar) do { unsigned _sp = 0; while (cond) { __builtin_amdgcn_s_sleep(1); \
    if ((++_sp & 255u) == 0u) { if (xb_ld(&(bar)[XB_TMO])) break; if (_sp > XB_SPIN_CAP) { atomicAdd(&(bar)[XB_TMO], 1u); break; } } } } while (0)
struct XcdBarrier { unsigned* bar; unsigned x; volatile LAS unsigned* st; };
__device__ __forceinline__ XcdBarrier xcd_barrier_post(unsigned* bar, volatile LAS unsigned* st) {
    XcdBarrier b; b.bar = bar; b.x = xb_xcc_id(); b.st = st;
    if (threadIdx.x == 0) (void)xb_add(&bar[XB_XCNT(b.x)], 1u);
    return b;
}
__device__ __forceinline__ void xcd_barrier_complete(unsigned* bar, unsigned x, unsigned& nloc, unsigned& nx) {
    const unsigned G = gridDim.x * gridDim.y * gridDim.z;
    unsigned sum, cnt, mine, sp = 0u;
    for (;;) {
        sum = 0u; cnt = 0u; mine = 0u;
#pragma unroll
        for (unsigned j = 0; j < 16; ++j) { const unsigned c = xb_ld(&bar[XB_XCNT(j)]); sum += c; cnt += (c > 0u) ? 1u : 0u; mine = (j == x) ? c : mine; }
        if (sum == G) break;
        __builtin_amdgcn_s_sleep(1);
        if ((++sp & 255u) == 0u) { if (xb_ld(&bar[XB_TMO])) break; if (sp > XB_SPIN_CAP) { atomicAdd(&bar[XB_TMO], 1u); break; } }
    }
    nloc = mine > 0u ? mine : 1u; nx = cnt > 0u ? cnt : 1u;
}
__device__ __forceinline__ void xcd_barrier(const XcdBarrier& b) {
    asm volatile("s_waitcnt vmcnt(0)" ::: "memory");
    __syncthreads();
    if (threadIdx.x == 0) {
        unsigned* bar = b.bar;
        __builtin_amdgcn_s_waitcnt(0);
        unsigned nloc = b.st[0], nx = b.st[1];
        if (nloc == 0u) { xcd_barrier_complete(bar, b.x, nloc, nx); b.st[0] = nloc; b.st[1] = nx; }
        const unsigned old = xb_add(&bar[XB_XSUB(b.x)], 1u);
        const unsigned gen = old / nloc;
        if (old + 1u == (gen + 1u) * nloc) {
            __builtin_amdgcn_fence(__ATOMIC_RELEASE, "agent");
            asm volatile("s_waitcnt vmcnt(0)" ::: "memory");
            const unsigned og = xb_add(&bar[XB_TOP], 1u);
            const unsigned tg = og / nx;
            if (og + 1u == (tg + 1u) * nx) xb_add(&bar[XB_TOPGEN], 1u);
            else XB_SPIN(xb_ld(&bar[XB_TOPGEN]) == tg, bar);
            __builtin_amdgcn_fence(__ATOMIC_ACQUIRE, "agent");
            xb_add(&bar[XB_XGEN(b.x)], 1u);
            asm volatile("s_waitcnt vmcnt(0)" ::: "memory");
        } else {
            XB_SPIN(xb_ld(&bar[XB_XGEN(b.x)]) == gen, bar);
            __builtin_amdgcn_fence(__ATOMIC_ACQUIRE, "agent");
            asm volatile("s_waitcnt vmcnt(0)" ::: "memory");
        }
    }
    __syncthreads();
}
__device__ __forceinline__ Params fresh(const Params& p) { Params q = p; unsigned long long w = (unsigned long long)q.ws; asm volatile("" : "+s"(w)); q.ws = (unsigned char*)w; return q; }
#define GRID_BAR() do { XcdBarrier xb_ = xbar; unsigned long long bw_ = (unsigned long long)xb_.bar; asm volatile("" : "+s"(bw_)); xb_.bar = (unsigned*)bw_; xcd_barrier(xb_); } while (0)
__global__ void __launch_bounds__(NTHREADS, 2) k_fwd(Params p) {
  {
    volatile LAS unsigned* st = (volatile LAS unsigned*)(LAS char*)(dyn_lds + LDS_PHASE_BYTES);
    if (threadIdx.x == 0) { st[0] = 0u; st[1] = 0u; st[2] = 0u; st[3] = 0u; }
    __syncthreads();
  }
  const XcdBarrier xbar = xcd_barrier_post((unsigned*)(p.ws + WS_CTL) + CW_BAR, (volatile LAS unsigned*)(LAS char*)(dyn_lds + LDS_PHASE_BYTES));
#else
#define GRID_BAR() emu_gridsync()
static inline Params fresh(const Params& p) { return p; }
static void k_fwd(Params p) {
#endif
  if (PHMASK & (1u << 0)) { phase_mod_rope(fresh(p)); }
  for (int l = 0; l < DEPTH; ++l) {
    if (PHMASK & (1u << 1)) { phase_convert(fresh(p), l); }
    GRID_BAR();
    if (PHMASK & (1u << 2)) { if (l == 0) phase_norm(fresh(p), l, 0, 0); else phase_norm(fresh(p), l, 1, 0); }
    GRID_BAR();
    if (PHMASK & (1u << 3)) { phase_gemm_in(fresh(p), l); }
    GRID_BAR();
    if (PHMASK & (1u << 4)) { phase_prep(fresh(p), l); }
    GRID_BAR();
    if (PHMASK & (1u << 5)) { phase_mlstm_a(fresh(p)); }
    GRID_BAR();
    if (PHMASK & (1u << 6)) { phase_mlstm_scan(fresh(p)); }
    if (PHMASK & (1u << 7)) { phase_attn(fresh(p)); }
    GRID_BAR();
    if (PHMASK & (1u << 8)) { phase_mlstm_c(fresh(p), l); }
    GRID_BAR();
    if (PHMASK & (1u << 9)) { phase_gemm_merge(fresh(p)); }
    GRID_BAR();
    if (PHMASK & (1u << 10)) { phase_gemm_out(fresh(p), l); }
    GRID_BAR();
    if (PHMASK & (1u << 11)) { phase_norm2_router(fresh(p), l); }
    GRID_BAR();
    if (PHMASK & (1u << 12)) { phase_moe_up(fresh(p), l); }
    GRID_BAR();
    if (PHMASK & (1u << 13)) { phase_moe_down(fresh(p), l); }
    GRID_BAR();
  }
  if (PHMASK & (1u << 14)) { phase_norm(fresh(p), DEPTH, 1, 2); }
}

#ifdef EMU
static int emu_grid_size = 8;
static int emu_stop_after = 1000;
#endif
extern "C" void kernel_launch(void* const* d_in, const int* in_sizes, int n_in, void* d_out, int out_size, void* d_ws, size_t ws_size, hipStream_t stream) {
  (void)in_sizes; (void)n_in; (void)out_size;
  if (ws_size < WS_TOTAL) { fprintf(stderr, "workspace too small: %zu < %zu\n", ws_size, (size_t)WS_TOTAL); return; }
  Params prm{};
  const float** f = (const float**)&prm;
  for (int i = 0; i < 24; ++i) f[i] = (const float*)d_in[i];
  prm.out = (float*)d_out; prm.ws = (unsigned char*)d_ws;
#ifdef EMU
  memset(d_ws, 0, CTL_BYTES);
  emu_launch(emu_grid_size, NTHREADS, LDS_BYTES, [=]() { k_fwd(prm); }, true);
#else
  static int grid = 0;
  if (!grid) {
    int dev = 0, cus = 0, per_cu = 0;
    (void)hipGetDevice(&dev);
    (void)hipDeviceGetAttribute(&cus, hipDeviceAttributeMultiprocessorCount, dev);
    (void)hipFuncSetAttribute((const void*)k_fwd, hipFuncAttributeMaxDynamicSharedMemorySize, LDS_BYTES);
    (void)hipOccupancyMaxActiveBlocksPerMultiprocessor(&per_cu, k_fwd, NTHREADS, LDS_BYTES);
    grid = cus * (per_cu < 1 ? per_cu : 1);
    if (grid <= 0) { fprintf(stderr, "occupancy query says the kernel does not fit (cus %d per_cu %d)\n", cus, per_cu); grid = 0; return; }
  }
  (void)hipMemsetAsync(d_ws, 0, CTL_BYTES, stream);
  k_fwd<<<grid, NTHREADS, LDS_BYTES, stream>>>(prm);
#endif
}
```

```cpp
#ifdef EMU
#include "emu.h"
#define TID emu_tid()
#define BID emu_bid()
#define NBLK emu_nblk()
#define SYNC() emu_syncthreads()
#define DEV static inline
#define DEVM inline
#else
#include <hip/hip_runtime.h>
#include <cstdio>
#include <cstdint>
__device__ __forceinline__ int tid_opaque() { int t = (int)threadIdx.x; asm volatile("" : "+v"(t)); return t; }
#define TID tid_opaque()
#define BID ((int)blockIdx.x)
#define NBLK ((int)gridDim.x)
#define SYNC() __syncthreads()
#define DEV __device__ __forceinline__
#define DEVM __device__ __forceinline__
#endif

#ifndef CFG_SEQ
#define CFG_SEQ 8192
#endif
#ifndef CFG_BATCH
#define CFG_BATCH 2
#endif

#ifndef PHMASK
#define PHMASK 0xFFFFFFFFu
#endif
#define UNR _Pragma("unroll")
typedef unsigned short bf16_t;
typedef short bf16x8 __attribute__((ext_vector_type(8)));
typedef float f32x4 __attribute__((ext_vector_type(4)));
typedef unsigned u32x4 __attribute__((ext_vector_type(4)));
typedef unsigned u32x2 __attribute__((ext_vector_type(2)));

constexpr int D = 1024, BATCH = CFG_BATCH, SEQ = CFG_SEQ, DEPTH = 2, T = BATCH * SEQ;
constexpr int GRID_W = 64;
constexpr int MH = 4, MHD = 128, MW = 512, ML = 64, NC = SEQ / ML, CONVW = 5;
constexpr int AH = 8, KVH = 2, AHD = 64, AW = 512, KVW = 128;
constexpr int NG = 4, EPG = 8, NE = 32, FF = 512;
constexpr float EPS = 1e-6f;
constexpr int IN_W = 4880, NP = 4992;
constexpr int C_MQ = 0, C_MK = 512, C_MV = 1024, C_MO = 1536, C_GATES = 2048, C_AQ = 2064, C_AK = 2576, C_AV = 2704, C_GM = 2832, C_GA = 3856;
constexpr int NTHREADS = 512;
constexpr int BHC = BATCH * MH * NC;
constexpr int ROWT_MAX = (2 * T) / 128 + NE;
constexpr int ACT_ROWS = ROWT_MAX * 128;

constexpr size_t al256(size_t x) { return (x + 255) & ~(size_t)255; }
constexpr size_t WS_CTL = 0, CTL_BYTES = 1 << 20;
constexpr size_t WS_MOD = WS_CTL + CTL_BYTES;
constexpr size_t WS_ROPE = WS_MOD + al256((size_t)DEPTH * BATCH * 6 * D * 4);
constexpr size_t WS_WIN = WS_ROPE + al256((size_t)(2 * (SEQ / GRID_W) * 16 + 2 * 64 * 16) * 4);
constexpr size_t WS_WBM = WS_WIN + (size_t)NP * D * 2;
constexpr size_t WS_WBA = WS_WBM + (size_t)D * MW * 2;
constexpr size_t WS_WOUT = WS_WBA + (size_t)D * AW * 2;
constexpr size_t WS_WGU = WS_WOUT + (size_t)D * D * 2;
constexpr size_t WS_WD = WS_WGU + (size_t)NE * 2 * FF * D * 2;
constexpr size_t WS_PROJ = WS_WD + (size_t)NE * D * FF * 2;
constexpr size_t WS_ACT = WS_PROJ;
constexpr size_t WS_Y = WS_ACT + al256((size_t)ACT_ROWS * FF * 2);
constexpr size_t PROJ_BYTES = (size_t)T * NP * 2;
static_assert(WS_Y + (size_t)2 * T * D * 2 <= WS_PROJ + PROJ_BYTES || T < 4096, "ACT + Y must fit into the PROJ overlay");
constexpr size_t OVL_BYTES = (WS_Y + (size_t)2 * T * D * 2 - WS_PROJ) > PROJ_BYTES ? (WS_Y + (size_t)2 * T * D * 2 - WS_PROJ) : PROJ_BYTES;
constexpr size_t WS_GATES = WS_PROJ + al256(OVL_BYTES);
constexpr size_t WS_QC = WS_GATES + (size_t)T * 16 * 4;
constexpr size_t WS_KC = WS_QC + (size_t)T * MW * 2;
constexpr size_t WS_MERGED = WS_QC;
constexpr size_t WS_AQN = WS_KC + (size_t)T * MW * 2;
constexpr size_t WS_AKN = WS_AQN + (size_t)T * AW * 2;
constexpr size_t WS_VT = WS_AKN + (size_t)T * KVW * 2;
constexpr size_t WS_CST = WS_VT + (size_t)T * KVW * 2;
constexpr size_t WS_H = WS_CST;
constexpr size_t CST_BYTES = (size_t)2 * BHC * 128 * 128 * 2;
static_assert((size_t)T * D * 2 <= CST_BYTES, "H fits in CST");
constexpr size_t WS_NST = WS_CST + CST_BYTES;
constexpr size_t WS_AMAX = WS_NST + (size_t)2 * BHC * 128 * 4;
constexpr size_t WS_BLAST = WS_AMAX + al256((size_t)2 * BHC * 4);
constexpr size_t WS_MPREV = WS_BLAST + al256((size_t)2 * BHC * 4);
constexpr size_t WS_YM = WS_MPREV + al256((size_t)2 * BHC * 4);
constexpr size_t WS_YA = WS_YM + (size_t)T * MW * 2;
constexpr size_t WS_LIST = WS_YA + (size_t)T * AW * 2;
constexpr size_t WS_WENT = WS_LIST + (size_t)NE * T * 4;
constexpr size_t WS_TOTAL = WS_WENT + (size_t)2 * T * 4;
constexpr int CW_CNT = 64;
constexpr int CW_BAR = 4096;

struct Params {
  const float *x, *c, *w_ada, *b_ada, *norm1_g, *w_in, *b_in, *conv_w, *conv_b, *mlstm_norm_g, *q_norm_g, *k_norm_g, *w_branch_m, *w_branch_a, *w_out, *norm2_g,
      *w_rg, *b_rg, *w_re, *b_re, *w_gate, *w_up, *w_down, *final_g;
  float* out; unsigned char* ws;
};

DEV float bf2f(bf16_t h) { return __builtin_bit_cast(float, (unsigned)h << 16); }
DEV bf16_t f2bf(float f) { unsigned u = __builtin_bit_cast(unsigned, f); return (bf16_t)((u + 0x7fffu + ((u >> 16) & 1u)) >> 16); }
DEV unsigned pk2(float lo, float hi) { return (unsigned)f2bf(lo) | ((unsigned)f2bf(hi) << 16); }
DEV float sigmoidf_(float x) { return 1.f / (1.f + expf(-x)); }
DEV float siluf_(float x) { return x / (1.f + expf(-x)); }
DEV float logsigmoidf_(float x) { return fminf(x, 0.f) - log1pf(expf(-fabsf(x))); }

#ifdef EMU
static inline f32x4 mfma16(bf16x8 a, bf16x8 b, f32x4 c) {
  struct In { bf16x8 a, b; f32x4 c; } in{a, b, c}; f32x4 out;
  emu_collective(&in, sizeof(In), &out, sizeof(out), [](char (*I)[64], char (*O)[32]) {
    float Dm[16][16];
    for (int r = 0; r < 16; ++r) for (int cc = 0; cc < 16; ++cc) { In* L = (In*)I[(r >> 2) * 16 + cc]; Dm[r][cc] = L->c[r & 3]; }
    for (int r = 0; r < 16; ++r) for (int cc = 0; cc < 16; ++cc) { float s = 0.f;
      for (int g = 0; g < 4; ++g) { In* LA = (In*)I[g * 16 + r]; In* LB = (In*)I[g * 16 + cc]; for (int j = 0; j < 8; ++j) s += bf2f((bf16_t)LA->a[j]) * bf2f((bf16_t)LB->b[j]); }
      Dm[r][cc] += s; }
    for (int l = 0; l < 64; ++l) { f32x4 o; for (int i = 0; i < 4; ++i) o[i] = Dm[(l >> 4) * 4 + i][l & 15]; memcpy(O[l], &o, 16); } });
  return out;
}
static inline f32x4 mfma4f32(float a, float b, f32x4 c) {
  struct In { float a, b; f32x4 c; } in{a, b, c}; f32x4 out;
  emu_collective(&in, sizeof(In), &out, sizeof(out), [](char (*I)[64], char (*O)[32]) {
    for (int l = 0; l < 64; ++l) { f32x4 o; UNR for (int i = 0; i < 4; ++i) { const int r = (l >> 4) * 4 + i, cc = l & 15; float s = ((In*)I[l])->c[i];
      for (int k = 0; k < 4; ++k) s = fmaf(((In*)I[k * 16 + r])->a, ((In*)I[k * 16 + cc])->b, s); o[i] = s; } memcpy(O[l], &o, 16); } });
  return out;
}
static inline float shfl_xor_f(float v, int m) { float out; emu_collective(&v, 4, &out, 4, [m](char (*I)[64], char (*O)[32]) { for (int l = 0; l < 64; ++l) memcpy(O[l], I[l ^ m], 4); }); return out; }
static inline float shfl_f(float v, int src) { struct In { float v; int s; } in{v, src}; float out;
  emu_collective(&in, 8, &out, 4, [](char (*I)[64], char (*O)[32]) { for (int l = 0; l < 64; ++l) { In* me = (In*)I[l]; memcpy(O[l], I[me->s & 63], 4); } }); return out; }
static inline int atomic_add_i(int* p, int v) { return __atomic_fetch_add(p, v, __ATOMIC_RELAXED); }
#define LDS_PTR() emu_lds()
#else
DEV f32x4 mfma16(bf16x8 a, bf16x8 b, f32x4 c) { return __builtin_amdgcn_mfma_f32_16x16x32_bf16(a, b, c, 0, 0, 0); }
DEV f32x4 mfma4f32(float a, float b, f32x4 c) { return __builtin_amdgcn_mfma_f32_16x16x4f32(a, b, c, 0, 0, 0); }
DEV float shfl_xor_f(float v, int m) {
  const int iv = __builtin_bit_cast(int, v);
  switch (m) {
    case 1: return __builtin_bit_cast(float, __builtin_amdgcn_ds_swizzle(iv, (1 << 10) | 0x1f));
    case 2: return __builtin_bit_cast(float, __builtin_amdgcn_ds_swizzle(iv, (2 << 10) | 0x1f));
    case 4: return __builtin_bit_cast(float, __builtin_amdgcn_ds_swizzle(iv, (4 << 10) | 0x1f));
    case 8: return __builtin_bit_cast(float, __builtin_amdgcn_ds_swizzle(iv, (8 << 10) | 0x1f));
    case 16: return __builtin_bit_cast(float, __builtin_amdgcn_ds_swizzle(iv, (16 << 10) | 0x1f));
    default: { const int lane = TID & 63; return __builtin_bit_cast(float, __builtin_amdgcn_ds_bpermute(((lane ^ m) & 63) << 2, iv)); }
  }
}
DEV float shfl_f(float v, int src) { return __builtin_bit_cast(float, __builtin_amdgcn_ds_bpermute((src & 63) << 2, __builtin_bit_cast(int, v))); }
DEV int atomic_add_i(int* p, int v) { return atomicAdd(p, v); }
extern __shared__ __attribute__((aligned(16))) char dyn_lds[];
#define LDS_PTR() (dyn_lds)
#endif
DEV float grp16_sum(float v) { v += shfl_xor_f(v, 1); v += shfl_xor_f(v, 2); v += shfl_xor_f(v, 4); v += shfl_xor_f(v, 8); return v; }
DEV float grp16_max(float v) { v = fmaxf(v, shfl_xor_f(v, 1)); v = fmaxf(v, shfl_xor_f(v, 2)); v = fmaxf(v, shfl_xor_f(v, 4)); v = fmaxf(v, shfl_xor_f(v, 8)); return v; }
DEV float wave_sum(float v) { v = grp16_sum(v); v += shfl_xor_f(v, 16); v += shfl_xor_f(v, 32); return v; }
DEV bf16x8 ld8(const bf16_t* p) { return __builtin_bit_cast(bf16x8, *(const u32x4*)p); }

DEV void phase_mod_rope(const Params& p) {
  float* mod = (float*)(p.ws + WS_MOD);
  const int gtid = BID * NTHREADS + TID, gstride = NBLK * NTHREADS;
  for (int o = gtid; o < DEPTH * BATCH * 6 * D; o += gstride) {
    const int n = o % (6 * D), b = (o / (6 * D)) % BATCH, l = o / (6 * D * BATCH);
    const float* w = p.w_ada + (size_t)l * D * 6 * D + n; const float* cv = p.c + b * D;
    float s = p.b_ada[l * 6 * D + n];
    for (int k = 0; k < D; ++k) s += siluf_(cv[k]) * w[(size_t)k * 6 * D];
    mod[o] = s;
  }
  float* rope = (float*)(p.ws + WS_ROPE);
  constexpr int NR = SEQ / GRID_W;
  for (int o = gtid; o < (NR + 64) * 16; o += gstride) {
    const int i = o & 15, pos = o >> 4;
    const float inv = powf(10000.f, -(float)(2 * i) / 32.f);
    if (pos < NR) { const float a = (float)pos * inv; rope[pos * 16 + i] = cosf(a); rope[NR * 16 + pos * 16 + i] = sinf(a); }
    else { const int cpos = pos - NR; const float a = (float)cpos * inv; rope[2 * NR * 16 + cpos * 16 + i] = cosf(a); rope[2 * NR * 16 + 64 * 16 + cpos * 16 + i] = sinf(a); }
  }
}
DEV void transpose_item(char* lds, const float* src, int K, int N, bf16_t* dst, int mode, int item) {
  float* tile = (float*)lds;
  const int ntn = (N + 63) / 64, tk = item / ntn, tn = item % ntn, tid = TID;
  const int k0 = tk * 64, n0 = tn * 64;
  { const int kk = tid >> 3, c8 = (tid & 7) * 8;
    const float* s = src + (size_t)(k0 + kk) * N + n0 + c8;
    UNR for (int j = 0; j < 8; ++j) tile[kk * 65 + c8 + j] = (n0 + c8 + j < N) ? s[j] : 0.f; }
  SYNC();
  { const int nn = tid >> 3, k8 = (tid & 7) * 8, n = n0 + nn;
    if (n < N) {
      int row = n; if (mode == 1) row = 32 * (n >> 4) + (n & 15); else if (mode == 2) row = 32 * (n >> 4) + 16 + (n & 15);
      u32x4 v; v.x = pk2(tile[(k8 + 0) * 65 + nn], tile[(k8 + 1) * 65 + nn]); v.y = pk2(tile[(k8 + 2) * 65 + nn], tile[(k8 + 3) * 65 + nn]);
      v.z = pk2(tile[(k8 + 4) * 65 + nn], tile[(k8 + 5) * 65 + nn]); v.w = pk2(tile[(k8 + 6) * 65 + nn], tile[(k8 + 7) * 65 + nn]);
      *(u32x4*)(dst + (size_t)row * K + k0 + k8) = v; } }
  SYNC();
}
DEV void phase_convert(const Params& p, int l) {
  char* lds = LDS_PTR();
  constexpr int I_IN = (D / 64) * ((IN_W + 63) / 64), I_BM = (MW / 64) * (D / 64), I_BA = (AW / 64) * (D / 64), I_OUT = (D / 64) * (D / 64);
  constexpr int I_G = (D / 64) * (FF / 64), I_D = (FF / 64) * (D / 64);
  constexpr int B1 = I_IN, B2 = B1 + I_BM, B3 = B2 + I_BA, B4 = B3 + I_OUT, B5 = B4 + NE * I_G, B6 = B5 + NE * I_G, B7 = B6 + NE * I_D;
  for (int it = BID; it < B7; it += NBLK) {
    if (it < B1) transpose_item(lds, p.w_in + (size_t)l * D * IN_W, D, IN_W, (bf16_t*)(p.ws + WS_WIN), 0, it);
    else if (it < B2) transpose_item(lds, p.w_branch_m + (size_t)l * MW * D, MW, D, (bf16_t*)(p.ws + WS_WBM), 0, it - B1);
    else if (it < B3) transpose_item(lds, p.w_branch_a + (size_t)l * AW * D, AW, D, (bf16_t*)(p.ws + WS_WBA), 0, it - B2);
    else if (it < B4) transpose_item(lds, p.w_out + (size_t)l * D * D, D, D, (bf16_t*)(p.ws + WS_WOUT), 0, it - B3);
    else if (it < B5) { const int e = (it - B4) / I_G, r = (it - B4) % I_G; transpose_item(lds, p.w_gate + ((size_t)l * NE + e) * D * FF, D, FF, (bf16_t*)(p.ws + WS_WGU) + (size_t)e * 2 * FF * D, 1, r); }
    else if (it < B6) { const int e = (it - B5) / I_G, r = (it - B5) % I_G; transpose_item(lds, p.w_up + ((size_t)l * NE + e) * D * FF, D, FF, (bf16_t*)(p.ws + WS_WGU) + (size_t)e * 2 * FF * D, 2, r); }
    else { const int e = (it - B6) / I_D, r = (it - B6) % I_D; transpose_item(lds, p.w_down + ((size_t)l * NE + e) * FF * D, FF, D, (bf16_t*)(p.ws + WS_WD) + (size_t)e * D * FF, 0, r); }
  }
}

DEV void phase_norm(const Params& p, int l, int mode, int which) {
  const int lane = TID & 63, wv = TID >> 6, nwv = NTHREADS / 64;
  const float* mod = (const float*)(p.ws + WS_MOD);
  bf16_t* H = (bf16_t*)(p.ws + WS_H);
  const bf16_t* Y = (const bf16_t*)(p.ws + WS_Y);
  for (int t = BID * nwv + wv; t < T; t += NBLK * nwv) {
    const int b = t / SEQ;
    f32x4 v[4]; float ss = 0.f;
    UNR for (int i = 0; i < 4; ++i) {
      const int c4 = lane + 64 * i;
      if (mode == 0) v[i] = ((const f32x4*)(p.x + (size_t)t * D))[c4];
      else {
        v[i] = ((const f32x4*)(p.out + (size_t)t * D))[c4];
        if (mode == 1) {
          const f32x4 g2 = ((const f32x4*)(mod + ((size_t)(l - 1) * BATCH + b) * 6 * D + 5 * D))[c4];
          const u32x2 y0 = ((const u32x2*)(Y + (size_t)(2 * t) * D))[c4], y1 = ((const u32x2*)(Y + (size_t)(2 * t + 1) * D))[c4];
          v[i][0] += g2[0] * (bf2f((bf16_t)(y0.x & 0xffff)) + bf2f((bf16_t)(y1.x & 0xffff)));
          v[i][1] += g2[1] * (bf2f((bf16_t)(y0.x >> 16)) + bf2f((bf16_t)(y1.x >> 16)));
          v[i][2] += g2[2] * (bf2f((bf16_t)(y0.y & 0xffff)) + bf2f((bf16_t)(y1.y & 0xffff)));
          v[i][3] += g2[3] * (bf2f((bf16_t)(y0.y >> 16)) + bf2f((bf16_t)(y1.y >> 16)));
        }
      }
      ss += v[i][0] * v[i][0] + v[i][1] * v[i][1] + v[i][2] * v[i][2] + v[i][3] * v[i][3];
    }
    ss = wave_sum(ss);
    const float rs = 1.f / sqrtf(ss * (1.f / D) + EPS);
    if (which == 2) {
      UNR for (int i = 0; i < 4; ++i) { const int c4 = lane + 64 * i; const f32x4 g = ((const f32x4*)p.final_g)[c4];
        f32x4 o; UNR for (int j = 0; j < 4; ++j) o[j] = v[i][j] * rs * g[j]; ((f32x4*)(p.out + (size_t)t * D))[c4] = o; }
      continue;
    }
    if (mode != 2) UNR for (int i = 0; i < 4; ++i) ((f32x4*)(p.out + (size_t)t * D))[lane + 64 * i] = v[i];
    const float* mb = mod + ((size_t)l * BATCH + b) * 6 * D + (which == 0 ? 0 : 3 * D);
    const float* gw = (which == 0 ? p.norm1_g : p.norm2_g) + (size_t)l * D;
    f32x4 hv[4];
    UNR for (int i = 0; i < 4; ++i) { const int c4 = lane + 64 * i;
      const f32x4 g = ((const f32x4*)gw)[c4], sh = ((const f32x4*)mb)[c4], sc = ((const f32x4*)(mb + D))[c4];
      UNR for (int j = 0; j < 4; ++j) hv[i][j] = (v[i][j] * rs * g[j]) * (1.f + sc[j]) + sh[j];
      u32x2 o; o.x = pk2(hv[i][0], hv[i][1]); o.y = pk2(hv[i][2], hv[i][3]); ((u32x2*)(H + (size_t)t * D))[c4] = o; }
  }
}
constexpr int HSP = 1028;
DEV void phase_norm2_router(const Params& p, int l) {
  char* lds = LDS_PTR();
  float* HS = (float*)lds;
  float* PART = HS + 16 * HSP;
  const int tid = TID, lane = tid & 63, w = tid >> 6;
  const float* mod = (const float*)(p.ws + WS_MOD);
  bf16_t* H = (bf16_t*)(p.ws + WS_H);
  const float* wrg = p.w_rg + (size_t)l * D * NG; const float* wre = p.w_re + (size_t)l * D * NE;
  const float* gw = p.norm2_g + (size_t)l * D;
  for (int tb = BID * 16; tb < T; tb += NBLK * 16) {
    SYNC();
    UNR for (int q = 0; q < 2; ++q) {
      const int tl = 2 * w + q, t = tb + tl, b = t / SEQ;
      f32x4 v[4]; float ss = 0.f;
      UNR for (int i = 0; i < 4; ++i) { v[i] = ((const f32x4*)(p.out + (size_t)t * D))[lane + 64 * i]; ss += v[i][0] * v[i][0] + v[i][1] * v[i][1] + v[i][2] * v[i][2] + v[i][3] * v[i][3]; }
      ss = wave_sum(ss);
      const float rs = 1.f / sqrtf(ss * (1.f / D) + EPS);
      const float* mb = mod + ((size_t)l * BATCH + b) * 6 * D + 3 * D;
      UNR for (int i = 0; i < 4; ++i) { const int c4 = lane + 64 * i;
        const f32x4 g = ((const f32x4*)gw)[c4], sh = ((const f32x4*)mb)[c4], sc = ((const f32x4*)(mb + D))[c4];
        f32x4 hv; UNR for (int j = 0; j < 4; ++j) hv[j] = (v[i][j] * rs * g[j]) * (1.f + sc[j]) + sh[j];
        u32x2 o; o.x = pk2(hv[0], hv[1]); o.y = pk2(hv[2], hv[3]); ((u32x2*)(H + (size_t)t * D))[c4] = o;
        *(f32x4*)(HS + tl * HSP + 4 * c4) = hv; }
    }
    SYNC();
    f32x4 acc[3]; UNR for (int nt = 0; nt < 3; ++nt) acc[nt] = (f32x4){0.f, 0.f, 0.f, 0.f};
#pragma unroll 4
    for (int kk = 0; kk < 32; ++kk) {
      const int d = 128 * w + 4 * kk + (lane >> 4);
      const float a = HS[(lane & 15) * HSP + d];
      const int o0 = lane & 15;
      const float b0 = (o0 < NG) ? wrg[(size_t)d * NG + o0] : wre[(size_t)d * NE + o0 - NG];
      const float b1 = wre[(size_t)d * NE + 16 + o0 - NG];
      const float b2 = (o0 < NG) ? wre[(size_t)d * NE + 32 + o0 - NG] : 0.f;
      acc[0] = mfma4f32(a, b0, acc[0]); acc[1] = mfma4f32(a, b1, acc[1]); acc[2] = mfma4f32(a, b2, acc[2]);
    }
    UNR for (int nt = 0; nt < 3; ++nt) UNR for (int i = 0; i < 4; ++i) PART[(w * 16 + (lane >> 4) * 4 + i) * 48 + nt * 16 + (lane & 15)] = acc[nt][i];
    SYNC();
    if (tid < 16) {
      const int t = tb + tid;
      float lg[NG];
      int g = 0; float gmx = -3.0e38f;
#pragma unroll
      for (int o = 0; o < NG; ++o) { float s = p.b_rg[l * NG + o];
#pragma unroll 1
        for (int ww = 0; ww < 8; ++ww) s += PART[(ww * 16 + tid) * 48 + o]; lg[o] = s; if (s > gmx) { gmx = s; g = o; } }
      float gsum = 0.f; UNR for (int o = 0; o < NG; ++o) gsum += expf(lg[o] - gmx);
      const float ptop = 1.f / gsum;
      int e0 = 0, e1 = 0; float m0 = -3.0e38f, m1 = -3.0e38f;
#pragma unroll 1
      for (int j = 0; j < EPG; ++j) { float s = p.b_re[l * NE + g * EPG + j];
#pragma unroll 1
        for (int ww = 0; ww < 8; ++ww) s += PART[(ww * 16 + tid) * 48 + NG + g * EPG + j];
        if (s > m0) { m1 = m0; e1 = e0; m0 = s; e0 = j; } else if (s > m1) { m1 = s; e1 = j; } }
      const float x1 = expf(m1 - m0), w0 = ptop / (1.f + x1), w1 = ptop * x1 / (1.f + x1);
      int* cnt = (int*)(p.ws + WS_CTL) + CW_CNT + l * NE; int* list = (int*)(p.ws + WS_LIST); float* went = (float*)(p.ws + WS_WENT);
      const int ea = g * EPG + e0, eb = g * EPG + e1;
      const int pa = atomic_add_i(cnt + ea, 1); list[(size_t)ea * T + pa] = 2 * t; went[2 * t] = w0;
      const int pb = atomic_add_i(cnt + eb, 1); list[(size_t)eb * T + pb] = 2 * t + 1; went[2 * t + 1] = w1;
    }
  }
}

constexpr int GP = 72;
struct RowPlain { const bf16_t* base; size_t ld; DEVM const bf16_t* operator()(int r) const { return base + (size_t)r * ld; } };
template <class RowA>
DEV void gemm_kloop(char* lds, const RowA& rowA, const bf16_t* Bt, size_t ldb, int K, f32x4 (&acc)[4][2]) {
  bf16_t* As = (bf16_t*)lds; bf16_t* Bs = As + 128 * GP;
  const int tid = TID, lane = tid & 63, w = tid >> 6, wm = w >> 2, wn = w & 3;
  const int r0 = tid >> 3, pc = (tid & 7) * 8;
  const bf16_t* a0 = rowA(r0) + pc; const bf16_t* a1 = rowA(r0 + 64) + pc;
  const bf16_t* b0 = Bt + (size_t)r0 * ldb + pc; const bf16_t* b1 = Bt + (size_t)(r0 + 64) * ldb + pc;
  u32x4 ra0 = *(const u32x4*)a0, ra1 = *(const u32x4*)a1, rb0 = *(const u32x4*)b0, rb1 = *(const u32x4*)b1;
  const int nk = K / 64;
  for (int kt = 0; kt < nk; ++kt) {
    SYNC();
    *(u32x4*)(As + r0 * GP + pc) = ra0; *(u32x4*)(As + (r0 + 64) * GP + pc) = ra1;
    *(u32x4*)(Bs + r0 * GP + pc) = rb0; *(u32x4*)(Bs + (r0 + 64) * GP + pc) = rb1;
    SYNC();
    if (kt + 1 < nk) { const int ko = (kt + 1) * 64; ra0 = *(const u32x4*)(a0 + ko); ra1 = *(const u32x4*)(a1 + ko); rb0 = *(const u32x4*)(b0 + ko); rb1 = *(const u32x4*)(b1 + ko); }
#pragma unroll
    for (int ks = 0; ks < 2; ++ks) {
      const int kof = ks * 32 + (lane >> 4) * 8;
      bf16x8 af[4], bfr[2];
#pragma unroll
      for (int mt = 0; mt < 4; ++mt) af[mt] = ld8(As + (wm * 64 + mt * 16 + (lane & 15)) * GP + kof);
#pragma unroll
      for (int nt = 0; nt < 2; ++nt) bfr[nt] = ld8(Bs + (wn * 32 + nt * 16 + (lane & 15)) * GP + kof);
#pragma unroll
      for (int mt = 0; mt < 4; ++mt)
#pragma unroll
        for (int nt = 0; nt < 2; ++nt) acc[mt][nt] = mfma16(af[mt], bfr[nt], acc[mt][nt]);
    }
  }
}
DEV void zero_acc(f32x4 (&acc)[4][2]) { UNR for (int i = 0; i < 4; ++i) UNR for (int j = 0; j < 2; ++j) acc[i][j] = (f32x4){0.f, 0.f, 0.f, 0.f}; }

DEV void phase_gemm_in(const Params& p, int l) {
  char* lds = LDS_PTR();
  const bf16_t* H = (const bf16_t*)(p.ws + WS_H); const bf16_t* W = (const bf16_t*)(p.ws + WS_WIN);
  bf16_t* PROJ = (bf16_t*)(p.ws + WS_PROJ); float* GATES = (float*)(p.ws + WS_GATES);
  const float* bias = p.b_in + (size_t)l * IN_W;
  constexpr int nM = T / 128, nN = NP / 128;
  for (int u = BID; u < nM * nN; u += NBLK) {
    const int pm = u % nM, pn = u / nM;
    f32x4 acc[4][2]; zero_acc(acc);
    RowPlain ra{H + (size_t)pm * 128 * D, (size_t)D};
    gemm_kloop(lds, ra, W + (size_t)pn * 128 * D, D, D, acc);
    const int etid = TID, lane = etid & 63, w = etid >> 6, wm = w >> 2, wn = w & 3;
    UNR for (int nt = 0; nt < 2; ++nt) {
      const int col = pn * 128 + wn * 32 + nt * 16 + (lane & 15);
      if (col >= IN_W) continue;
      const float bv = bias[col];
      UNR for (int mt = 0; mt < 4; ++mt) UNR for (int i = 0; i < 4; ++i) {
        const int row = pm * 128 + wm * 64 + mt * 16 + (lane >> 4) * 4 + i; const float v = acc[mt][nt][i] + bv;
        PROJ[(size_t)row * NP + col] = f2bf(v);
        if (col >= C_GATES && col < C_GATES + 16) GATES[(size_t)row * 16 + (col - C_GATES)] = v;
      }
    }
  }
}
DEV void phase_gemm_merge(const Params& p) {
  char* lds = LDS_PTR();
  const bf16_t* YM = (const bf16_t*)(p.ws + WS_YM); const bf16_t* YA = (const bf16_t*)(p.ws + WS_YA);
  const bf16_t* WM = (const bf16_t*)(p.ws + WS_WBM); const bf16_t* WA = (const bf16_t*)(p.ws + WS_WBA);
  const bf16_t* PROJ = (const bf16_t*)(p.ws + WS_PROJ); bf16_t* MG = (bf16_t*)(p.ws + WS_MERGED);
  constexpr int nM = T / 128, nN = D / 128;
  for (int u = BID; u < nM * nN; u += NBLK) {
    const int pm = u / nN, pn = u % nN;
    f32x4 acc[4][2]; zero_acc(acc);
    RowPlain r1{YM + (size_t)pm * 128 * MW, (size_t)MW}; gemm_kloop(lds, r1, WM + (size_t)pn * 128 * MW, MW, MW, acc);
    float* park = (float*)(lds + 40960);
    { const int ptid = TID; UNR for (int mt = 0; mt < 4; ++mt) UNR for (int nt = 0; nt < 2; ++nt) UNR for (int i = 0; i < 4; ++i) park[((mt * 2 + nt) * 4 + i) * NTHREADS + ptid] = acc[mt][nt][i]; }
    zero_acc(acc);
    RowPlain r2{YA + (size_t)pm * 128 * AW, (size_t)AW}; gemm_kloop(lds, r2, WA + (size_t)pn * 128 * AW, AW, AW, acc);
    const int etid = TID, lane = etid & 63, w = etid >> 6, wm = w >> 2, wn = w & 3;
    UNR for (int nt = 0; nt < 2; ++nt) { const int col = pn * 128 + wn * 32 + nt * 16 + (lane & 15);
      UNR for (int mt = 0; mt < 4; ++mt) UNR for (int i = 0; i < 4; ++i) {
        const int row = pm * 128 + wm * 64 + mt * 16 + (lane >> 4) * 4 + i;
        const float gm = bf2f(PROJ[(size_t)row * NP + C_GM + col]), ga = bf2f(PROJ[(size_t)row * NP + C_GA + col]);
        MG[(size_t)row * D + col] = f2bf(sigmoidf_(gm) * park[((mt * 2 + nt) * 4 + i) * NTHREADS + etid] + sigmoidf_(ga) * acc[mt][nt][i]); } }
  }
}
DEV void phase_gemm_out(const Params& p, int l) {
  char* lds = LDS_PTR();
  const bf16_t* MG = (const bf16_t*)(p.ws + WS_MERGED); const bf16_t* W = (const bf16_t*)(p.ws + WS_WOUT);
  const float* mod = (const float*)(p.ws + WS_MOD);
  constexpr int nM = T / 128, nN = D / 128;
  for (int u = BID; u < nM * nN; u += NBLK) {
    const int pm = u / nN, pn = u % nN;
    f32x4 acc[4][2]; zero_acc(acc);
    RowPlain ra{MG + (size_t)pm * 128 * D, (size_t)D}; gemm_kloop(lds, ra, W + (size_t)pn * 128 * D, D, D, acc);
    const int etid = TID, lane = etid & 63, w = etid >> 6, wm = w >> 2, wn = w & 3;
    const int b = (pm * 128) / SEQ;
    UNR for (int nt = 0; nt < 2; ++nt) { const int col = pn * 128 + wn * 32 + nt * 16 + (lane & 15);
      const float g1 = mod[((size_t)l * BATCH + b) * 6 * D + 2 * D + col];
      UNR for (int mt = 0; mt < 4; ++mt) UNR for (int i = 0; i < 4; ++i) {
        const int row = pm * 128 + wm * 64 + mt * 16 + (lane >> 4) * 4 + i;
        p.out[(size_t)row * D + col] += g1 * acc[mt][nt][i]; } }
  }
}
struct RowGather { const bf16_t* base; const int* list; int nvalid; DEVM const bf16_t* operator()(int r) const { const int ent = (r < nvalid) ? list[r] : list[0]; return base + (size_t)(ent >> 1) * D; } };
DEV void moe_tiles(const Params& p, int l, int* s_pref) {
  if (TID == 0) { const int* cnt = (const int*)(p.ws + WS_CTL) + CW_CNT + l * NE; int a = 0; for (int e = 0; e < NE; ++e) { s_pref[e] = a; a += (cnt[e] + 127) / 128; } s_pref[NE] = a; }
  SYNC();
}
DEV void phase_moe_up(const Params& p, int l) {
  char* lds = LDS_PTR(); int* s_pref = (int*)(lds + 2 * 128 * GP * 2);
  moe_tiles(p, l, s_pref);
  const bf16_t* H = (const bf16_t*)(p.ws + WS_H); const bf16_t* W = (const bf16_t*)(p.ws + WS_WGU); bf16_t* ACT = (bf16_t*)(p.ws + WS_ACT);
  const int* cnt = (const int*)(p.ws + WS_CTL) + CW_CNT + l * NE; const int* list = (const int*)(p.ws + WS_LIST); const float* went = (const float*)(p.ws + WS_WENT);
  const int ntile = s_pref[NE];
  for (int u = BID; u < ntile * 8; u += NBLK) {
    const int rt = u >> 3, ct = u & 7;
    int e = 0; while (s_pref[e + 1] <= rt) ++e;
    const int lt = rt - s_pref[e], nvalid = cnt[e] - lt * 128;
    const int* elist = list + (size_t)e * T + lt * 128;
    f32x4 acc[4][2]; zero_acc(acc);
    RowGather ra{H, elist, nvalid};
    gemm_kloop(lds, ra, W + ((size_t)e * 2 * FF + ct * 128) * D, D, D, acc);
    const int etid = TID, lane = etid & 63, w = etid >> 6, wm = w >> 2, wn = w & 3;
    const int f = (ct * 4 + wn) * 16 + (lane & 15);
    UNR for (int mt = 0; mt < 4; ++mt) UNR for (int i = 0; i < 4; ++i) {
      const int r = wm * 64 + mt * 16 + (lane >> 4) * 4 + i;
      if (r < nvalid) { const float wt = went[elist[r]]; const float a = acc[mt][0][i], uu = acc[mt][1][i];
        ACT[((size_t)rt * 128 + r) * FF + f] = f2bf(siluf_(a) * uu * wt); } }
  }
}
DEV void phase_moe_down(const Params& p, int l) {
  char* lds = LDS_PTR(); int* s_pref = (int*)(lds + 2 * 128 * GP * 2);
  moe_tiles(p, l, s_pref);
  const bf16_t* ACT = (const bf16_t*)(p.ws + WS_ACT); const bf16_t* W = (const bf16_t*)(p.ws + WS_WD); bf16_t* Y = (bf16_t*)(p.ws + WS_Y);
  const int* cnt = (const int*)(p.ws + WS_CTL) + CW_CNT + l * NE; const int* list = (const int*)(p.ws + WS_LIST);
  const int ntile = s_pref[NE];
  for (int u = BID; u < ntile * 8; u += NBLK) {
    const int rt = u >> 3, ct = u & 7;
    int e = 0; while (s_pref[e + 1] <= rt) ++e;
    const int lt = rt - s_pref[e], nvalid = cnt[e] - lt * 128;
    const int* elist = list + (size_t)e * T + lt * 128;
    f32x4 acc[4][2]; zero_acc(acc);
    RowPlain ra{ACT + (size_t)rt * 128 * FF, (size_t)FF};
    gemm_kloop(lds, ra, W + ((size_t)e * D + ct * 128) * FF, FF, FF, acc);
    const int etid = TID, lane = etid & 63, w = etid >> 6, wm = w >> 2, wn = w & 3;
    UNR for (int nt = 0; nt < 2; ++nt) { const int col = ct * 128 + wn * 32 + nt * 16 + (lane & 15);
      UNR for (int mt = 0; mt < 4; ++mt) UNR for (int i = 0; i < 4; ++i) {
        const int r = wm * 64 + mt * 16 + (lane >> 4) * 4 + i;
        if (r < nvalid) Y[(size_t)elist[r] * D + col] = f2bf(acc[mt][nt][i]); } }
  }
}

DEV void phase_prep(const Params& p, int l) {
  const bf16_t* PROJ = (const bf16_t*)(p.ws + WS_PROJ);
  bf16_t* QC = (bf16_t*)(p.ws + WS_QC); bf16_t* KC = (bf16_t*)(p.ws + WS_KC);
  const int gtid = BID * NTHREADS + TID, gstride = NBLK * NTHREADS;
  const float* cw = p.conv_w + (size_t)l * CONVW * 2 * MW; const float* cb = p.conv_b + (size_t)l * 2 * MW;
  for (int it = gtid; it < T * 128; it += gstride) {
    const int t = it >> 7, c8 = (it & 127) * 8, s = t % SEQ;
    float a[8]; UNR for (int j = 0; j < 8; ++j) a[j] = cb[c8 + j];
    UNR for (int wi = 0; wi < CONVW; ++wi) { const int ss = s + wi - 2; if (ss < 0 || ss >= SEQ) continue;
      const bf16x8 v = ld8(PROJ + (size_t)(t + wi - 2) * NP + c8);
      UNR for (int j = 0; j < 8; ++j) a[j] += bf2f((bf16_t)v[j]) * cw[wi * 2 * MW + c8 + j]; }
    const float sc = (c8 < MW) ? 0.08838834764831845f : 1.f;
    u32x4 o; o.x = pk2(siluf_(a[0]) * sc, siluf_(a[1]) * sc); o.y = pk2(siluf_(a[2]) * sc, siluf_(a[3]) * sc); o.z = pk2(siluf_(a[4]) * sc, siluf_(a[5]) * sc); o.w = pk2(siluf_(a[6]) * sc, siluf_(a[7]) * sc);
    if (c8 < MW) *(u32x4*)(QC + (size_t)t * MW + c8) = o; else *(u32x4*)(KC + (size_t)t * MW + c8 - MW) = o;
  }
  bf16_t* AQN = (bf16_t*)(p.ws + WS_AQN); bf16_t* AKN = (bf16_t*)(p.ws + WS_AKN); bf16_t* VT = (bf16_t*)(p.ws + WS_VT);
  const float* rope = (const float*)(p.ws + WS_ROPE); constexpr int NR = SEQ / GRID_W;
  for (int it0 = BID * NTHREADS; it0 < T * 10 * 8; it0 += gstride) {
    const int it = it0 + TID, j = it & 7, th = it >> 3, hh = th / T, t = th % T, s = t % SEQ;
    const bool isq = hh < AH;
    const bf16_t* src = PROJ + (size_t)t * NP + (isq ? C_AQ + hh * 64 : C_AK + (hh - AH) * 64) + j * 8;
    const float* g = (isq ? p.q_norm_g : p.k_norm_g) + (size_t)l * AHD + j * 8;
    const bf16x8 x8 = ld8(src);
    float v[8], pr[8]; float ss = 0.f;
#pragma unroll
    for (int k = 0; k < 8; ++k) { v[k] = bf2f((bf16_t)x8[k]); ss += v[k] * v[k]; }
    ss += shfl_xor_f(ss, 1); ss += shfl_xor_f(ss, 2); ss += shfl_xor_f(ss, 4);
    const float rs = 1.f / sqrtf(ss * (1.f / 64.f) + EPS);
#pragma unroll
    for (int k = 0; k < 8; ++k) v[k] = v[k] * rs * g[k];
#pragma unroll
    for (int k = 0; k < 8; ++k) pr[k] = shfl_xor_f(v[k], 2);
    const int pos = (j < 4) ? s / GRID_W : s % GRID_W;
    const float* ct = rope + (j < 4 ? 0 : 2 * NR * 16) + pos * 16 + (j & 1) * 8;
    const float* st = ct + (j < 4 ? NR * 16 : 64 * 16);
    const float sgn = (j & 2) ? 1.f : -1.f, qs = isq ? 0.125f * 1.4426950408889634f : 1.f;
    float o[8];
#pragma unroll
    for (int k = 0; k < 8; ++k) o[k] = (v[k] * ct[k] + sgn * pr[k] * st[k]) * qs;
    u32x4 w4; w4.x = pk2(o[0], o[1]); w4.y = pk2(o[2], o[3]); w4.z = pk2(o[4], o[5]); w4.w = pk2(o[6], o[7]);
    bf16_t* dst = isq ? AQN + (size_t)t * AW + hh * 64 + j * 8 : AKN + (size_t)t * KVW + (hh - AH) * 64 + j * 8;
    *(u32x4*)dst = w4;
  }
#ifdef EMU
  for (int it = gtid; it < T * KVH * 8; it += gstride) {
    const int s = it % SEQ, d8 = (it / SEQ) & 7, bk = it / (SEQ * 8), b = bk / KVH, kv = bk % KVH;
    const bf16x8 v8 = ld8(PROJ + (size_t)(b * SEQ + s) * NP + C_AV + kv * 64 + d8 * 8);
#pragma unroll
    for (int k = 0; k < 8; ++k) VT[((size_t)bk * 64 + d8 * 8 + k) * SEQ + s] = (bf16_t)v8[k];
  }
#else
  (void)VT;
#endif
}

#ifdef EMU
DEV void phase_attn(const Params& p) {
  char* lds = LDS_PTR();
  bf16_t* Ks = (bf16_t*)lds; bf16_t* Vs = Ks + 64 * GP; bf16_t* Ps = Vs + 64 * GP;
  const bf16_t* AQN = (const bf16_t*)(p.ws + WS_AQN); const bf16_t* AKN = (const bf16_t*)(p.ws + WS_AKN); const bf16_t* VT = (const bf16_t*)(p.ws + WS_VT);
  bf16_t* YA = (bf16_t*)(p.ws + WS_YA);
  const int tid = TID, lane = tid & 63, w = tid >> 6;
  constexpr int NQB = SEQ / 128, NU = BATCH * AH * NQB;
  bf16_t* Pw = Ps + w * 16 * GP;
  for (int u = BID; u < NU; u += NBLK) {
    const int qb = u % NQB, h = (u / NQB) % AH, b = u / (NQB * AH), kv = h / (AH / KVH);
    const int r0 = qb * 128 + w * 16;
    bf16x8 qa[2];
    UNR for (int ks = 0; ks < 2; ++ks) qa[ks] = ld8(AQN + (size_t)(b * SEQ + r0 + (lane & 15)) * AW + h * 64 + ks * 32 + (lane >> 4) * 8);
    f32x4 o[4]; UNR for (int i = 0; i < 4; ++i) o[i] = (f32x4){0.f, 0.f, 0.f, 0.f};
    float mrow[4], lrow[4]; UNR for (int i = 0; i < 4; ++i) { mrow[i] = -3.0e38f; lrow[i] = 0.f; }
    for (int kt = 0; kt < SEQ / 64; ++kt) {
      SYNC();
      { const int r = tid >> 3, pc = (tid & 7) * 8;
        *(u32x4*)(Ks + r * GP + pc) = *(const u32x4*)(AKN + (size_t)(b * SEQ + kt * 64 + r) * KVW + kv * 64 + pc);
        *(u32x4*)(Vs + r * GP + pc) = *(const u32x4*)(VT + ((size_t)(b * KVH + kv) * 64 + r) * SEQ + kt * 64 + pc); }
      SYNC();
      f32x4 s[4];
      UNR for (int nt = 0; nt < 4; ++nt) { s[nt] = (f32x4){0.f, 0.f, 0.f, 0.f};
        UNR for (int ks = 0; ks < 2; ++ks) s[nt] = mfma16(qa[ks], ld8(Ks + (nt * 16 + (lane & 15)) * GP + ks * 32 + (lane >> 4) * 8), s[nt]); }
      UNR for (int i = 0; i < 4; ++i) {
        float mx = fmaxf(fmaxf(s[0][i], s[1][i]), fmaxf(s[2][i], s[3][i])); mx = grp16_max(mx);
        const float mnew = fmaxf(mrow[i], mx), alpha = exp2f(mrow[i] - mnew); mrow[i] = mnew;
        float rsum = 0.f;
        UNR for (int nt = 0; nt < 4; ++nt) { const float pv = exp2f(s[nt][i] - mnew); rsum += pv; Pw[((lane >> 4) * 4 + i) * GP + nt * 16 + (lane & 15)] = f2bf(pv); }
        lrow[i] = lrow[i] * alpha + rsum;
        UNR for (int nd = 0; nd < 4; ++nd) o[nd][i] *= alpha;
      }
      SYNC();
      UNR for (int ks = 0; ks < 2; ++ks) { const bf16x8 pa = ld8(Pw + (lane & 15) * GP + ks * 32 + (lane >> 4) * 8);
        UNR for (int nd = 0; nd < 4; ++nd) o[nd] = mfma16(pa, ld8(Vs + (nd * 16 + (lane & 15)) * GP + ks * 32 + (lane >> 4) * 8), o[nd]); }
    }
    UNR for (int i = 0; i < 4; ++i) { const float lt = grp16_sum(lrow[i]), inv = 1.f / lt; const int row = b * SEQ + r0 + (lane >> 4) * 4 + i;
      UNR for (int nd = 0; nd < 4; ++nd) YA[(size_t)row * AW + h * 64 + nd * 16 + (lane & 15)] = f2bf(o[nd][i] * inv); }
  }
}

#else
namespace attn_body {
using bf16=unsigned short;
using bf16x8=__attribute__((ext_vector_type(8)))short;
using s16x4=__attribute__((ext_vector_type(4)))short;
using f32x16=__attribute__((ext_vector_type(16)))float;
using u32x4=__attribute__((ext_vector_type(4)))unsigned;
constexpr int SEQ=::SEQ,D=64;
constexpr int NW=8,QBLK=32,QB=QBLK*NW,KVBLK=64,NQB=SEQ/QB;
constexpr int ATTN_UNIT_ROWS=QB;
__device__ __forceinline__ int crow(int r,int hi){return (r&3)+8*(r>>2)+4*hi;}
#define SBAR() __builtin_amdgcn_sched_barrier(0)
constexpr int NSLOT=3, SLOTB=8192;
constexpr int LDS_K=0, LDS_V=NSLOT*SLOTB, LDS_WS=2*NSLOT*SLOTB, LDS_OST=LDS_WS+NW*64*4, LDS_BYTES=LDS_OST+NW*4096;
constexpr float C2=0.125f*1.4426950408889634f;
__device__ __forceinline__ void glds16(const void*gsrc,unsigned lds_dst){unsigned keep;
  asm volatile("s_mov_b32 %0, m0\n\ts_mov_b32 m0, %2\n\ts_nop 0\n\tglobal_load_lds_dwordx4 %1, off\n\ts_mov_b32 m0, %0":"=&s"(keep):"v"(gsrc),"s"(lds_dst):"memory");}
__device__ __forceinline__ float max3f(float a,float b,float c){float r;asm("v_max3_f32 %0, %1, %2, %3":"=v"(r):"v"(a),"v"(b),"v"(c));return r;}
__device__ __forceinline__ float max2f(float a,float b){float r;asm("v_max_f32_e32 %0, %1, %2":"=v"(r):"v"(a),"v"(b));return r;}
__device__ __forceinline__ float fadd_s(float a,float b){float r;asm("v_add_f32_e32 %0, %1, %2":"=v"(r):"v"(a),"v"(b));return r;}
__device__ __forceinline__ float fsub_s(float a,float b){float r;asm("v_sub_f32_e32 %0, %1, %2":"=v"(r):"v"(a),"v"(b));return r;}
typedef float f32x2_t __attribute__((ext_vector_type(2))); typedef __bf16 bf16x2_t __attribute__((ext_vector_type(2)));
__device__ __forceinline__ unsigned cvtpk_s(float lo,float hi){f32x2_t v={lo,hi};bf16x2_t b=__builtin_convertvector(v,bf16x2_t);return __builtin_bit_cast(unsigned,b);}
#define WAIT_BAR(N) asm volatile("s_waitcnt vmcnt(" #N ") lgkmcnt(0)\n\ts_barrier":::"memory")

__device__ __forceinline__ void qkt(f32x16&p0,f32x16&p1,const char*Kslot,const bf16x8*qr,const f32x16&negm,int r32,int hi){
  const char*kb=Kslot+hi*1024+r32*16;
  #pragma unroll
  for(int d0=0;d0<4;++d0){
    const bf16x8 b0=*reinterpret_cast<const bf16x8*>(kb+d0*2048);
    const bf16x8 b1=*reinterpret_cast<const bf16x8*>(kb+d0*2048+512);
    if(d0==0){p0=__builtin_amdgcn_mfma_f32_32x32x16_bf16(b0,qr[0],negm,0,0,0);p1=__builtin_amdgcn_mfma_f32_32x32x16_bf16(b1,qr[0],negm,0,0,0);}
    else{p0=__builtin_amdgcn_mfma_f32_32x32x16_bf16(b0,qr[d0],p0,0,0,0);p1=__builtin_amdgcn_mfma_f32_32x32x16_bf16(b1,qr[d0],p1,0,0,0);}}
}
typedef __attribute__((address_space(3))) const char* lds_cptr;
typedef short v4i16_t __attribute__((ext_vector_type(4)));
__device__ __forceinline__ void kload8(bf16x8*kf,lds_cptr kp){
  kf[0]=*(const __attribute__((address_space(3))) bf16x8*)(kp);      kf[1]=*(const __attribute__((address_space(3))) bf16x8*)(kp+512);
  kf[2]=*(const __attribute__((address_space(3))) bf16x8*)(kp+2048); kf[3]=*(const __attribute__((address_space(3))) bf16x8*)(kp+2560);
  kf[4]=*(const __attribute__((address_space(3))) bf16x8*)(kp+4096); kf[5]=*(const __attribute__((address_space(3))) bf16x8*)(kp+4608);
  kf[6]=*(const __attribute__((address_space(3))) bf16x8*)(kp+6144); kf[7]=*(const __attribute__((address_space(3))) bf16x8*)(kp+6656);
}
__device__ __forceinline__ void kload2(bf16x8*kf,lds_cptr kp,int j){ kf[2*j]=*(const __attribute__((address_space(3))) bf16x8*)(kp+j*2048); kf[2*j+1]=*(const __attribute__((address_space(3))) bf16x8*)(kp+j*2048+512); }
__device__ __forceinline__ s16x4 vtr(lds_cptr p){ return __builtin_bit_cast(s16x4,__builtin_amdgcn_ds_read_tr16_b64_v4i16((__attribute__((address_space(3))) v4i16_t*)p)); }
__device__ __forceinline__ float rowmax(const f32x16&p0,const f32x16&p1){
  float a=max3f(p0[0],p0[1],p1[0]),b=max3f(p0[2],p0[3],p1[1]);a=max3f(a,p1[2],p1[3]);
  #pragma unroll
  for(int r=4;r<16;r+=4){a=max3f(a,p0[r],p0[r+1]);b=max3f(b,p0[r+2],p0[r+3]);a=max3f(a,p1[r],p1[r+1]);b=max3f(b,p1[r+2],p1[r+3]);}
  const float m=max2f(a,b);
  auto rr=__builtin_amdgcn_permlane32_swap(__float_as_uint(m),__float_as_uint(m),false,false);
  return max2f(__uint_as_float(rr[0]),__uint_as_float(rr[1]));
}
__device__ __forceinline__ void pv(f32x16*o,int vb,bf16x8 pa0,bf16x8 pa1,bf16x8 pa2,bf16x8 pa3){
  #pragma unroll
  for(int d0=0;d0<2;++d0){s16x4 lo[4],hi[4];
    #pragma unroll
    for(int ks=0;ks<4;++ks){
      asm volatile("ds_read_b64_tr_b16 %0,%1 offset:%c2":"=&v"(lo[ks]):"v"(vb),"i"(d0*4096+ks*1024):"memory");
      asm volatile("ds_read_b64_tr_b16 %0,%1 offset:%c2":"=&v"(hi[ks]):"v"(vb),"i"(d0*4096+ks*1024+512):"memory");}
    asm volatile("s_waitcnt lgkmcnt(0)":::"memory");SBAR();
    #define PK(k) (bf16x8){lo[k][0],lo[k][1],lo[k][2],lo[k][3],hi[k][0],hi[k][1],hi[k][2],hi[k][3]}
    o[d0]=__builtin_amdgcn_mfma_f32_32x32x16_bf16(pa0,PK(0),o[d0],0,0,0);
    o[d0]=__builtin_amdgcn_mfma_f32_32x32x16_bf16(pa1,PK(1),o[d0],0,0,0);
    o[d0]=__builtin_amdgcn_mfma_f32_32x32x16_bf16(pa2,PK(2),o[d0],0,0,0);
    o[d0]=__builtin_amdgcn_mfma_f32_32x32x16_bf16(pa3,PK(3),o[d0],0,0,0);
    #undef PK
  }
}

#ifndef ATTN_STORE16
#define ATTN_STORE16(p,v) (*(u32x4*)(p)=(v))
#endif
template<int THRL,int QP,int KP,int VP> __device__ __forceinline__ void attn_unit(long rowbase,int qb,const bf16*Q,const bf16*__restrict__ K,const bf16*__restrict__ V,bf16*O,char*shm){
  const int tid=threadIdx.x,lane=tid&63,r32=lane&31,hi=lane>>5; const int wid=__builtin_amdgcn_readfirstlane(tid>>6);
  const int q0=qb*QB;
  const bf16*Qw=Q+(rowbase+q0+wid*QBLK)*QP;
  const bf16*Kh=K+rowbase*KP,*Vh=V+rowbase*VP;
  const unsigned lds0=(unsigned)(uintptr_t)shm;
  float*wsf=(float*)(shm+LDS_WS)+wid*64;
  const bf16*ksrc=Kh+(long)lane*KP+wid*8;
  const bf16*vsrc=Vh+(long)(16*(wid&3)+(lane>>2))*VP+(wid>>2)*32+(lane&3)*8;
  const unsigned kdst=lds0+LDS_K+wid*1024, vdst=lds0+LDS_V+wid*1024;
  #define DMA_K(t,slot) glds16(ksrc+(long)(t)*KVBLK*KP,(unsigned)__builtin_amdgcn_readfirstlane(kdst+(slot)))
  #define DMA_V(t,slot) glds16(vsrc+(long)(t)*KVBLK*VP,(unsigned)__builtin_amdgcn_readfirstlane(vdst+(slot)))
  const int vb0=(int)(lds0+LDS_V)+((lane>>4)&1)*32+(lane&3)*8+(4*hi+((lane&15)>>2))*64;
  const char*Kbase=shm+LDS_K; bf16x8 kf[8];
  const lds_cptr shm3=(lds_cptr)shm; const lds_cptr kp0=shm3+LDS_K+hi*1024+r32*16; const lds_cptr vp0=shm3+LDS_V+((lane>>4)&1)*32+(lane&3)*8+(4*hi+((lane&15)>>2))*64;
  int NT=SEQ/KVBLK; asm volatile("":"+s"(NT));
  DMA_K(0,0);DMA_V(0,0);DMA_K(1,SLOTB);
  bf16x8 qr[4];
  #pragma unroll
  for(int d0=0;d0<4;++d0)qr[d0]=*reinterpret_cast<const bf16x8*>(&Qw[(long)r32*QP+d0*16+hi*8]);
  float mhat=0.f,l_reg=0.f;f32x16 o[2];o[0]=f32x16{};o[1]=f32x16{};f32x16 negm=f32x16{};asm volatile("":"+v"(negm));
  #define CMASK(P0,P1,t) do{}while(0)
  bool resc=false;
  #define START(P0,P1) do{ const float rm=rowmax(P0,P1); resc=false; \
    { const float dl=rm; mhat=fadd_s(mhat,dl); \
      _Pragma("unroll") for(int r=0;r<16;++r){P0[r]=fsub_s(P0[r],dl);P1[r]=fsub_s(P1[r],dl);} \
      _Pragma("unroll") for(int r=0;r<16;++r)negm[r]=-mhat; asm volatile("":"+v"(negm)); } \
    _Pragma("unroll") for(int r=0;r<16;++r)P0[r]=__builtin_amdgcn_exp2f(P0[r]); }while(0)
  #define RESC() do{ if(resc){ asm volatile("s_waitcnt lgkmcnt(0)":::"memory"); \
      _Pragma("unroll") for(int d_=0;d_<2;++d_) _Pragma("unroll") for(int r=0;r<16;++r)o[d_][r]*=wsf[crow(r,hi)]; } }while(0)
  f32x16 pA0,pA1,pB0,pB1;
  int sl_prev=0,sl_cur=0,sl_next=SLOTB;
  #define ROT() do{sl_prev=sl_cur;sl_cur=sl_next;sl_next=(sl_next==(NSLOT-1)*SLOTB)?0:sl_next+SLOTB;}while(0)
  DMA_K(2,2*SLOTB);
  WAIT_BAR(3);
  qkt(pA0,pA1,Kbase,qr,negm,r32,hi);asm volatile("s_nop 15\n\ts_nop 7":"+v"(pA0),"+v"(pA1));CMASK(pA0,pA1,0);
  START(pA0,pA1);
  _Pragma("unroll") for(int r=0;r<16;++r)pA1[r]=__builtin_amdgcn_exp2f(pA1[r]);
  WAIT_BAR(0);
  DMA_K(3,0);DMA_V(1,SLOTB);
  ROT();
  kload8(kf,kp0+sl_cur);
  WAIT_BAR(2);
  s16x4 vlo[8],vhi[8]; u32x4 pw0,pw1,pw2,pw3;
  #define PKW(P,B) cvtpk_s(P[B],P[B+1])
  #define PAF(k) __builtin_bit_cast(bf16x8,pw##k)
  #define VFR(i) (bf16x8){vlo[i][0],vlo[i][1],vlo[i][2],vlo[i][3],vhi[i][0],vhi[i][1],vhi[i][2],vhi[i][3]}
  #define PIN(x) asm volatile("":"+v"(x))
  #define MX3(a,b,c) __builtin_fmaxf(__builtin_fmaxf((a),(b)),(c))
  #define GAPA(MF,A0,A1,A2,A3,W0,W1,PW) do{ MF; sacc+=A0; sacc+=A1; sacc+=A2; sacc+=A3; PIN(sacc); W0; W1; PIN(PW); SBAR(); }while(0)
  #define EX(v) __builtin_amdgcn_exp2f(v)
  #define GAPB(MF,X,B) do{ MF; X[B]=EX(X[B]); X[B+1]=EX(X[B+1]); X[B+2]=EX(X[B+2]); X[B+3]=EX(X[B+3]); PIN(X); SBAR(); }while(0)
  #define VRD(i) do{ vlo[i]=vtr(vp_+(((i)>>2)*4096+((i)&3)*1024)); vhi[i]=vtr(vp_+(((i)>>2)*4096+((i)&3)*1024+512)); }while(0)
  #define KRD(G,j) do{ if(G){ kload2(kf,kp0+sl_next,j); SBAR(); } }while(0)
  #define STEP(C0,C1,P0,P1,t,GK,GV,GL) do{ SBAR(); \
    const lds_cptr vp_=vp0+sl_prev; \
    VRD(0); SBAR(); float sacc=(P0[0]+P0[1]); \
    GAPA(C0=__builtin_amdgcn_mfma_f32_32x32x16_bf16(kf[0],qr[0],negm,0,0,0), P0[2],P0[3],P0[4],P0[5],     pw0[0]=PKW(P0,0), pw0[1]=PKW(P0,2), pw0); \
    VRD(4); SBAR(); GAPA(C1=__builtin_amdgcn_mfma_f32_32x32x16_bf16(kf[1],qr[0],negm,0,0,0), P0[6],P0[7],P0[8],P0[9],     pw0[2]=PKW(P0,4), pw0[3]=PKW(P0,6), pw0); \
    VRD(1); SBAR(); GAPA(C0=__builtin_amdgcn_mfma_f32_32x32x16_bf16(kf[2],qr[1],C0,0,0,0),   P0[10],P0[11],P0[12],P0[13], pw1[0]=PKW(P0,8), pw1[1]=PKW(P0,10), pw1); \
    VRD(5); SBAR(); GAPA(C1=__builtin_amdgcn_mfma_f32_32x32x16_bf16(kf[3],qr[1],C1,0,0,0),   P0[14],P0[15],P1[0],P1[1],   pw1[2]=PKW(P0,12),pw1[3]=PKW(P0,14), pw1); \
    VRD(2); SBAR(); GAPA(C0=__builtin_amdgcn_mfma_f32_32x32x16_bf16(kf[4],qr[2],C0,0,0,0),   P1[2],P1[3],P1[4],P1[5],     pw2[0]=PKW(P1,0), pw2[1]=PKW(P1,2), pw2); \
    VRD(6); SBAR(); GAPA(C1=__builtin_amdgcn_mfma_f32_32x32x16_bf16(kf[5],qr[2],C1,0,0,0),   P1[6],P1[7],P1[8],P1[9],     pw2[2]=PKW(P1,4), pw2[3]=PKW(P1,6), pw2); \
    VRD(3); SBAR(); GAPA(C0=__builtin_amdgcn_mfma_f32_32x32x16_bf16(kf[6],qr[3],C0,0,0,0),   P1[10],P1[11],P1[12],P1[13], pw3[0]=PKW(P1,8), pw3[1]=PKW(P1,10), pw3); \
    VRD(7); SBAR(); GAPA(C1=__builtin_amdgcn_mfma_f32_32x32x16_bf16(kf[7],qr[3],C1,0,0,0),   P1[14],P1[15],0.f,0.f,       pw3[2]=PKW(P1,12),pw3[3]=PKW(P1,14), pw3); \
    l_reg+=sacc; \
    if(GK){DMA_K((t)+3,sl_cur);} if(GV){DMA_V((t)+1,sl_next);} \
    CMASK(C0,C1,t); \
    { float a=MX3(C0[0],C0[1],C1[0]),b=MX3(C0[2],C0[3],C1[1]); a=MX3(a,C1[2],C1[3]); \
      _Pragma("unroll") for(int r=4;r<16;r+=4){a=MX3(a,C0[r],C0[r+1]);b=MX3(b,C0[r+2],C0[r+3]);a=MX3(a,C1[r],C1[r+1]);b=MX3(b,C1[r+2],C1[r+3]);} \
      float rm=__builtin_fmaxf(a,b); { auto rr=__builtin_amdgcn_permlane32_swap(__float_as_uint(rm),__float_as_uint(rm),false,false); rm=__builtin_fmaxf(__uint_as_float(rr[0]),__uint_as_float(rr[1])); } \
      resc=false; \
      if(__builtin_expect(__any(rm>(float)THRL),0)){ const float dl=__builtin_fmaxf(rm,0.f); mhat+=dl; \
        _Pragma("unroll") for(int r=0;r<16;++r){C0[r]-=dl;C1[r]-=dl;} \
        _Pragma("unroll") for(int r=0;r<16;++r)negm[r]=-mhat; asm volatile("":"+v"(negm)); \
        const float f=__builtin_amdgcn_exp2f(-dl); l_reg*=f; if(hi==0)wsf[r32]=f; resc=true; } } \
    SBAR(); \
    GAPB(o[0]=__builtin_amdgcn_mfma_f32_32x32x16_bf16(PAF(0),VFR(0),o[0],0,0,0), C0,0); \
    GAPB(o[1]=__builtin_amdgcn_mfma_f32_32x32x16_bf16(PAF(0),VFR(4),o[1],0,0,0), C0,4); \
    KRD(GL,0); GAPB(o[0]=__builtin_amdgcn_mfma_f32_32x32x16_bf16(PAF(1),VFR(1),o[0],0,0,0), C0,8); \
    KRD(GL,1); GAPB(o[1]=__builtin_amdgcn_mfma_f32_32x32x16_bf16(PAF(1),VFR(5),o[1],0,0,0), C0,12); \
    KRD(GL,2); GAPB(o[0]=__builtin_amdgcn_mfma_f32_32x32x16_bf16(PAF(2),VFR(2),o[0],0,0,0), C1,0); \
    KRD(GL,3); GAPB(o[1]=__builtin_amdgcn_mfma_f32_32x32x16_bf16(PAF(2),VFR(6),o[1],0,0,0), C1,4); \
    GAPB(o[0]=__builtin_amdgcn_mfma_f32_32x32x16_bf16(PAF(3),VFR(3),o[0],0,0,0), C1,8); \
    GAPB(o[1]=__builtin_amdgcn_mfma_f32_32x32x16_bf16(PAF(3),VFR(7),o[1],0,0,0), C1,12); \
    }while(0)
  int t=1;
  for(;t+5<NT;t+=2){
    STEP(pB0,pB1,pA0,pA1,t,true,true,true);     WAIT_BAR(2); RESC(); ROT();
    STEP(pA0,pA1,pB0,pB1,t+1,true,true,true);   WAIT_BAR(2); RESC(); ROT();
  }
  #define ENDW(tt) do{ if((tt)+3<NT){WAIT_BAR(2);} else if((tt)+2<NT){WAIT_BAR(1);} else {WAIT_BAR(0);} }while(0)
  for(;t+1<NT;t+=2){
    STEP(pB0,pB1,pA0,pA1,t,(t+3<NT),(t+1<NT),(t+1<NT));       ENDW(t);   RESC(); ROT();
    STEP(pA0,pA1,pB0,pB1,t+1,(t+4<NT),(t+2<NT),(t+2<NT));     ENDW(t+1); RESC(); ROT();
  }
  STEP(pB0,pB1,pA0,pA1,NT-1,false,false,false); RESC();
  { float sacc=pB0[0]+pB0[1]; _Pragma("unroll") for(int r=2;r<16;++r)sacc+=pB0[r]; _Pragma("unroll") for(int r=0;r<16;++r)sacc+=pB1[r]; l_reg+=sacc;
    pw0=(u32x4){PKW(pB0,0),PKW(pB0,2),PKW(pB0,4),PKW(pB0,6)};pw1=(u32x4){PKW(pB0,8),PKW(pB0,10),PKW(pB0,12),PKW(pB0,14)};pw2=(u32x4){PKW(pB1,0),PKW(pB1,2),PKW(pB1,4),PKW(pB1,6)};pw3=(u32x4){PKW(pB1,8),PKW(pB1,10),PKW(pB1,12),PKW(pB1,14)};
    SBAR(); pv(o,vb0+sl_cur,PAF(0),PAF(1),PAF(2),PAF(3)); }
  #undef PKW
  #undef PAF
  #undef VFR
  #undef PIN
  #undef MX3
  #undef GAPA
  #undef GAPB
  #undef EX
  #undef VRD
  #undef KRD
  #undef STEP
  #undef ENDW
  {auto rr=__builtin_amdgcn_permlane32_swap(__float_as_uint(l_reg),__float_as_uint(l_reg),false,false);l_reg=__uint_as_float(rr[0])+__uint_as_float(rr[1]);}
  if(hi==0)wsf[32+r32]=l_reg;asm volatile("s_waitcnt lgkmcnt(0)":::"memory");
  float rli[16];
  #pragma unroll
  for(int r=0;r<16;++r)rli[r]=__builtin_amdgcn_rcpf(wsf[32+crow(r,hi)]);
  bf16*Ow=O+(rowbase+q0+wid*QBLK)*QP;
  { bf16*stg=(bf16*)(shm+LDS_OST)+wid*2048;
    #pragma unroll
    for(int r=0;r<16;++r){const int orow=crow(r,hi);
      #pragma unroll
      for(int d0=0;d0<2;++d0)stg[orow*64+d0*32+r32]=f2bf(o[d0][r]*rli[r]);}
    asm volatile("s_waitcnt lgkmcnt(0)":::"memory");
    #pragma unroll
    for(int i=0;i<4;++i){const int row=i*8+(lane>>3),ch=lane&7; const u32x4 v=*(const u32x4*)(stg+row*64+ch*8); ATTN_STORE16(Ow+(long)row*QP+ch*8,v);} }
  asm volatile("s_waitcnt lgkmcnt(0)\n\ts_barrier":::"memory");
  #undef DMA_K
  #undef DMA_V
  #undef CMASK
  #undef START
  #undef RESC
  #undef ROT
}
#undef SBAR
#undef WAIT_BAR
}

DEV void phase_attn(const Params& p) {
  char* lds = LDS_PTR();
  const bf16_t* AQN = (const bf16_t*)(p.ws + WS_AQN); const bf16_t* AKN = (const bf16_t*)(p.ws + WS_AKN); const bf16_t* PROJ = (const bf16_t*)(p.ws + WS_PROJ);
  bf16_t* YA = (bf16_t*)(p.ws + WS_YA);
  constexpr int NQB = SEQ / 256, NU = BATCH * AH * NQB;
  for (int u = BID; u < NU; u += NBLK) {
    const int qb = u % NQB, h = (u / NQB) % AH, b = u / (NQB * AH), kv = h / (AH / KVH);
    attn_body::attn_unit<8, AW, KVW, NP>((long)b * SEQ, qb, AQN + h * 64, AKN + kv * 64, PROJ + C_AV + kv * 64, YA + h * 64, lds);
  }
}
#endif
DEV void phase_mlstm_a(const Params& p) {
  char* lds = LDS_PTR();
  bf16_t* VW = (bf16_t*)lds;
  bf16_t* KT = VW + 2 * 128 * GP;
  float* sc = (float*)(KT + 128 * GP);
  float* s_lf = sc; float* s_a = sc + 128; float* s_w = sc + 256;
  const bf16_t* PROJ = (const bf16_t*)(p.ws + WS_PROJ); const bf16_t* KC = (const bf16_t*)(p.ws + WS_KC); const float* GATES = (const float*)(p.ws + WS_GATES);
  bf16_t* CST = (bf16_t*)(p.ws + WS_CST); float* NST = (float*)(p.ws + WS_NST); float* AMAX = (float*)(p.ws + WS_AMAX); float* BLAST = (float*)(p.ws + WS_BLAST);
  const int tid = TID, lane = tid & 63, w = tid >> 6;
  for (int u = BID; u < BHC; u += NBLK) {
    const int c = u % NC, h = (u / NC) % MH, b = u / (NC * MH);
    const int t0 = b * SEQ + c * ML;
    SYNC();
    if (tid < 128) { const int dir = tid >> 6, l = tid & 63; s_lf[dir * 64 + l] = logsigmoidf_(GATES[(size_t)(t0 + l) * 16 + (dir ? 12 : 4) + h]); }
    SYNC();
    if (tid < 128) { const int dir = tid >> 6, l = tid & 63; const float li = GATES[(size_t)(t0 + l) * 16 + (dir ? 8 : 0) + h];
      float a = li;
      if (dir == 0) { for (int q = l + 1; q < 64; ++q) a += s_lf[q]; } else { for (int q = 0; q < l; ++q) a += s_lf[64 + q]; }
      s_a[dir * 64 + l] = a; }
    SYNC();
    if (tid < 128) { const int dir = tid >> 6, l = tid & 63; float mx = -3.0e38f, tot = 0.f;
      for (int q = 0; q < 64; ++q) { mx = fmaxf(mx, s_a[dir * 64 + q]); tot += s_lf[dir * 64 + q]; }
      s_w[dir * 64 + l] = expf(s_a[dir * 64 + l] - mx);
      if (l == 0) { AMAX[dir * BHC + u] = mx; BLAST[dir * BHC + u] = tot; } }
    SYNC();
    for (int it = tid; it < 1024; it += NTHREADS) { const int l = it >> 4, d8 = (it & 15) * 8;
      const bf16x8 v8 = ld8(PROJ + (size_t)(t0 + l) * NP + C_MV + h * 128 + d8); const bf16x8 k8 = ld8(KC + (size_t)(t0 + l) * MW + h * 128 + d8);
      const float wf = s_w[l], wb = s_w[64 + l];
      UNR for (int j = 0; j < 8; ++j) { const float vf = bf2f((bf16_t)v8[j]); VW[(d8 + j) * GP + l] = f2bf(vf * wf); VW[(128 + d8 + j) * GP + l] = f2bf(vf * wb); KT[(d8 + j) * GP + l] = (bf16_t)k8[j]; } }
    SYNC();
    { const int dir = w >> 2, m2 = w & 3;
      UNR for (int mi = 0; mi < 2; ++mi) { const int mt = m2 * 2 + mi;
        bf16x8 af[2]; UNR for (int ks = 0; ks < 2; ++ks) af[ks] = ld8(VW + (dir * 128 + mt * 16 + (lane & 15)) * GP + ks * 32 + (lane >> 4) * 8);
        UNR for (int nt = 0; nt < 8; ++nt) { f32x4 acc = (f32x4){0.f, 0.f, 0.f, 0.f};
          UNR for (int ks = 0; ks < 2; ++ks) acc = mfma16(af[ks], ld8(KT + (nt * 16 + (lane & 15)) * GP + ks * 32 + (lane >> 4) * 8), acc);
          bf16_t* dst = CST + ((size_t)(dir * BHC + u) * 128 + mt * 16 + (lane >> 4) * 4) * 128 + nt * 16 + (lane & 15);
          UNR for (int i = 0; i < 4; ++i) dst[i * 128] = f2bf(acc[i]); } } }
    if (tid < 256) { const int dir = tid >> 7, e = tid & 127; float s = 0.f; for (int l = 0; l < 64; ++l) s += s_w[dir * 64 + l] * bf2f(KT[e * GP + l]); NST[(size_t)(dir * BHC + u) * 128 + e] = s; }
  }
}
DEV void phase_mlstm_scan(const Params& p) {
  bf16_t* CST = (bf16_t*)(p.ws + WS_CST); float* NST = (float*)(p.ws + WS_NST);
  const float* AMAX = (const float*)(p.ws + WS_AMAX); const float* BLAST = (const float*)(p.ws + WS_BLAST); float* MPREV = (float*)(p.ws + WS_MPREV);
  const int gtid = BID * NTHREADS + TID, gstride = NBLK * NTHREADS;
  constexpr int PER = 8192 + 64;
  for (int it = gtid; it < 2 * BATCH * MH * PER; it += gstride) {
    const int pi = it % PER, dbh = it / PER, dir = dbh / (BATCH * MH), bh = dbh % (BATCH * MH);
    float s0 = 0.f, s1 = 0.f, m = 0.f;
    for (int cc = 0; cc < NC; ++cc) {
      const int c = dir ? NC - 1 - cc : cc; const int u = bh * NC + c;
      const float bl = BLAST[dir * BHC + u], am = AMAX[dir * BHC + u];
      const float mn = fmaxf(bl + m, am), dec = expf(bl + m - mn), inj = expf(am - mn);
      if (pi < 8192) { unsigned* ptr = (unsigned*)(CST + (size_t)(dir * BHC + u) * 16384) + pi; const unsigned in = *ptr;
        *ptr = pk2(s0, s1); s0 = dec * s0 + inj * bf2f((bf16_t)(in & 0xffff)); s1 = dec * s1 + inj * bf2f((bf16_t)(in >> 16)); }
      else { float* ptr = NST + (size_t)(dir * BHC + u) * 128 + 2 * (pi - 8192); const float i0 = ptr[0], i1 = ptr[1];
        ptr[0] = s0; ptr[1] = s1; s0 = dec * s0 + inj * i0; s1 = dec * s1 + inj * i1; }
      if (pi == 0) MPREV[dir * BHC + u] = m;
      m = mn;
    }
  }
}
constexpr int QP = 136;
constexpr int C_HALF_BYTES = (64 * QP * 2) * 2 + 128 * GP * 2 + 4 * 16 * GP * 2 + (4 * 64 + 2 * 128 + 4) * 4;
DEV void phase_mlstm_c(const Params& p, int l) {
  char* lds = LDS_PTR();
  const int tid = TID, lane = tid & 63, w = tid >> 6, half = w >> 2, wv = w & 3, htid = tid & 255;
  char* hb = lds + half * ((C_HALF_BYTES + 255) & ~255);
  bf16_t* Qs = (bf16_t*)hb; bf16_t* Ks = Qs + 64 * QP; bf16_t* VTs = Ks + 64 * QP; bf16_t* Ps = VTs + 128 * GP;
  float* s_b = (float*)(Ps + 4 * 16 * GP);
  float* s_li = s_b + 128;
  float* s_n = s_li + 128;
  float* s_m = s_n + 256;
  bf16_t* Pw = Ps + wv * 16 * GP;
  const bf16_t* PROJ = (const bf16_t*)(p.ws + WS_PROJ); const bf16_t* QC = (const bf16_t*)(p.ws + WS_QC); const bf16_t* KC = (const bf16_t*)(p.ws + WS_KC);
  const float* GATES = (const float*)(p.ws + WS_GATES); const bf16_t* CST = (const bf16_t*)(p.ws + WS_CST); const float* NST = (const float*)(p.ws + WS_NST);
  const float* MPREV = (const float*)(p.ws + WS_MPREV); bf16_t* YM = (bf16_t*)(p.ws + WS_YM);
  const float* ng = p.mlstm_norm_g + (size_t)l * MW;
  for (int u0 = BID * 2; u0 < BHC; u0 += NBLK * 2) {
    const int u = u0 + half;
    const int c = u % NC, h = (u / NC) % MH, b = u / (NC * MH);
    const int t0 = b * SEQ + c * ML;
    SYNC();
    for (int it = htid; it < 1024; it += 256) { const int r = it >> 4, d8 = (it & 15) * 8;
      *(u32x4*)(Qs + r * QP + d8) = *(const u32x4*)(QC + (size_t)(t0 + r) * MW + h * 128 + d8);
      *(u32x4*)(Ks + r * QP + d8) = *(const u32x4*)(KC + (size_t)(t0 + r) * MW + h * 128 + d8);
      const bf16x8 v8 = ld8(PROJ + (size_t)(t0 + r) * NP + C_MV + h * 128 + d8);
      UNR for (int j = 0; j < 8; ++j) VTs[(d8 + j) * GP + r] = (bf16_t)v8[j]; }
    if (htid < 128) { const int dir = htid >> 6, q = htid & 63; s_li[dir * 64 + q] = GATES[(size_t)(t0 + q) * 16 + (dir ? 8 : 0) + h];
      s_b[dir * 64 + q] = logsigmoidf_(GATES[(size_t)(t0 + q) * 16 + (dir ? 12 : 4) + h]); }
    s_n[htid] = NST[(size_t)((htid >> 7) * BHC + u) * 128 + (htid & 127)];
    if (htid < 2) s_m[htid] = MPREV[htid * BHC + u];
    SYNC();
    float cum = 0.f;
    if (htid < 128) { const int dir = htid >> 6, q = htid & 63;
      if (dir == 0) { for (int z = 0; z <= q; ++z) cum += s_b[z]; } else { for (int z = q; z < 64; ++z) cum += s_b[64 + z]; } }
    SYNC();
    if (htid < 128) s_b[htid] = cum;
    SYNC();
    const int j0 = wv * 16;
    bf16x8 qa[4]; UNR for (int ks = 0; ks < 4; ++ks) qa[ks] = ld8(Qs + (j0 + (lane & 15)) * QP + ks * 32 + (lane >> 4) * 8);
    f32x4 S[4];
    UNR for (int nt = 0; nt < 4; ++nt) { S[nt] = (f32x4){0.f, 0.f, 0.f, 0.f};
      UNR for (int ks = 0; ks < 4; ++ks) S[nt] = mfma16(qa[ks], ld8(Ks + (nt * 16 + (lane & 15)) * QP + ks * 32 + (lane >> 4) * 8), S[nt]); }
    f32x4 hs[8]; UNR for (int nd = 0; nd < 8; ++nd) hs[nd] = (f32x4){0.f, 0.f, 0.f, 0.f};
#pragma unroll 1
    for (int dir = 0; dir < 2; ++dir) {
      float qn = 0.f; { const int e0 = (lane >> 4) * 32;
        for (int e = 0; e < 32; ++e) qn += bf2f(Qs[(j0 + (lane & 15)) * QP + e0 + e]) * s_n[dir * 128 + e0 + e];
        qn += shfl_xor_f(qn, 16); qn += shfl_xor_f(qn, 32); }
      const float* bb = s_b + dir * 64; const float* li = s_li + dir * 64; const float mp = s_m[dir];
      float fsc[4];
      UNR for (int i = 0; i < 4; ++i) {
        const int j = j0 + (lane >> 4) * 4 + i; const float bj = bb[j];
        float dv[4], sv[4], mx = -3.0e38f;
        UNR for (int nt = 0; nt < 4; ++nt) { const int lk = nt * 16 + (lane & 15); const bool ok = dir ? (lk >= j) : (lk <= j);
          dv[nt] = ok ? (bj - bb[lk] + li[lk]) : -3.0e38f; mx = fmaxf(mx, dv[nt]); }
        mx = grp16_max(mx);
        const float mi = bj + mp, mo = fmaxf(mi, mx);
        float rsum = 0.f;
        UNR for (int nt = 0; nt < 4; ++nt) { sv[nt] = (dv[nt] > -1.0e38f) ? S[nt][i] * expf(dv[nt] - mo) : 0.f; rsum += sv[nt]; }
        rsum = grp16_sum(rsum);
        const float iw = expf(mi - mo);
        const float qnj = shfl_f(qn, (lane >> 4) * 4 + i);
        const float den = rsum + iw * qnj;
        const float dinv = 1.f / fmaxf(fabsf(den), expf(-mo));
        UNR for (int nt = 0; nt < 4; ++nt) Pw[((lane >> 4) * 4 + i) * GP + nt * 16 + (lane & 15)] = f2bf(sv[nt] * dinv);
        fsc[i] = iw * dinv;
      }
      float fa = 0.f;
      UNR for (int i = 0; i < 4; ++i) { const float tv = shfl_f(fsc[i], ((lane & 15) >> 2) * 16); fa = ((lane & 3) == i) ? tv : fa; }
      SYNC();
      UNR for (int ks = 0; ks < 2; ++ks) { const bf16x8 pa = ld8(Pw + (lane & 15) * GP + ks * 32 + (lane >> 4) * 8);
        UNR for (int nd = 0; nd < 8; ++nd) hs[nd] = mfma16(pa, ld8(VTs + (nd * 16 + (lane & 15)) * GP + ks * 32 + (lane >> 4) * 8), hs[nd]); }
      const bf16_t* Cp = CST + (size_t)(dir * BHC + u) * 16384;
      UNR for (int ks = 0; ks < 4; ++ks) {
        bf16x8 qs; UNR for (int e = 0; e < 8; ++e) qs[e] = (short)f2bf(bf2f((bf16_t)qa[ks][e]) * fa);
        UNR for (int nd = 0; nd < 8; ++nd) hs[nd] = mfma16(qs, ld8(Cp + (size_t)(nd * 16 + (lane & 15)) * 128 + ks * 32 + (lane >> 4) * 8), hs[nd]); }
      SYNC();
    }
    UNR for (int i = 0; i < 4; ++i) { float ss = 0.f; UNR for (int nd = 0; nd < 8; ++nd) ss += hs[nd][i] * hs[nd][i];
      ss = grp16_sum(ss); const float rs = 1.f / sqrtf(ss * (1.f / 128.f) + EPS);
      const int t = t0 + j0 + (lane >> 4) * 4 + i;
      UNR for (int nd = 0; nd < 8; ++nd) { const int d = nd * 16 + (lane & 15); const float og = bf2f(PROJ[(size_t)t * NP + C_MO + h * 128 + d]);
        YM[(size_t)t * MW + h * 128 + d] = f2bf(hs[nd][i] * rs * ng[h * 128 + d] * sigmoidf_(og)); } }
  }
}

constexpr int LDS_PHASE_BYTES = 131072;
constexpr int LDS_BYTES = LDS_PHASE_BYTES + 256;
#ifndef EMU
#define XB_TMO      128
#define XB_XCNT(j)  (256  + 64 * (j))
#define XB_XSUB(j)  (1280 + 64 * (j))
#define XB_XGEN(j)  (2304 + 64 * (j))
#define XB_TOP      3328
#define XB_TOPGEN   3392
#define XCD_BAR_WORDS 3456
#define XB_SPIN_CAP (1u << 18)
#define LAS __attribute__((address_space(3)))
__device__ __forceinline__ unsigned xb_ld(unsigned* p)              { return __hip_atomic_load(p, __ATOMIC_RELAXED, __HIP_MEMORY_SCOPE_AGENT); }
__device__ __forceinline__ unsigned xb_add(unsigned* p, unsigned v) { return __hip_atomic_fetch_add(p, v, __ATOMIC_RELAXED, __HIP_MEMORY_SCOPE_AGENT); }
__device__ __forceinline__ unsigned xb_xcc_id() { return (unsigned)__builtin_amdgcn_s_getreg((3 << 11) | 20) & 0xFu; }
#define XB_SPIN(cond, bar) do { unsigned _sp = 0; while (cond) { __builtin_amdgcn_s_sleep(1); \
    if ((++_sp & 255u) == 0u) { if (xb_ld(&(bar)[XB_TMO])) break; if (_sp > XB_SPIN_CAP) { atomicAdd(&(bar)[XB_TMO], 1u); break; } } } } while (0)
struct XcdBarrier { unsigned* bar; unsigned x; volatile LAS unsigned* st; };
__device__ __forceinline__ XcdBarrier xcd_barrier_post(unsigned* bar, volatile LAS unsigned* st) {
    XcdBarrier b; b.bar = bar; b.x = xb_xcc_id(); b.st = st;
    if (threadIdx.x == 0) (void)xb_add(&bar[XB_XCNT(b.x)], 1u);
    return b;
}
__device__ __forceinline__ void xcd_barrier_complete(unsigned* bar, unsigned x, unsigned& nloc, unsigned& nx) {
    const unsigned G = gridDim.x * gridDim.y * gridDim.z;
    unsigned sum, cnt, mine, sp = 0u;
    for (;;) {
        sum = 0u; cnt = 0u; mine = 0u;
#pragma unroll
        for (unsigned j = 0; j < 16; ++j) { const unsigned c = xb_ld(&bar[XB_XCNT(j)]); sum += c; cnt += (c > 0u) ? 1u : 0u; mine = (j == x) ? c : mine; }
        if (sum == G) break;
        __builtin_amdgcn_s_sleep(1);
        if ((++sp & 255u) == 0u) { if (xb_ld(&bar[XB_TMO])) break; if (sp > XB_SPIN_CAP) { atomicAdd(&bar[XB_TMO], 1u); break; } }
    }
    nloc = mine > 0u ? mine : 1u; nx = cnt > 0u ? cnt : 1u;
}
__device__ __forceinline__ void xcd_barrier(const XcdBarrier& b) {
    asm volatile("s_waitcnt vmcnt(0)" ::: "memory");
    __syncthreads();
    if (threadIdx.x == 0) {
        unsigned* bar = b.bar;
        __builtin_amdgcn_s_waitcnt(0);
        unsigned nloc = b.st[0], nx = b.st[1];
        if (nloc == 0u) { xcd_barrier_complete(bar, b.x, nloc, nx); b.st[0] = nloc; b.st[1] = nx; }
        const unsigned old = xb_add(&bar[XB_XSUB(b.x)], 1u);
        const unsigned gen = old / nloc;
        if (old + 1u == (gen + 1u) * nloc) {
            __builtin_amdgcn_fence(__ATOMIC_RELEASE, "agent");
            asm volatile("s_waitcnt vmcnt(0)" ::: "memory");
            const unsigned og = xb_add(&bar[XB_TOP], 1u);
            const unsigned tg = og / nx;
            if (og + 1u == (tg + 1u) * nx) xb_add(&bar[XB_TOPGEN], 1u);
            else XB_SPIN(xb_ld(&bar[XB_TOPGEN]) == tg, bar);
            __builtin_amdgcn_fence(__ATOMIC_ACQUIRE, "agent");
            xb_add(&bar[XB_XGEN(b.x)], 1u);
            asm volatile("s_waitcnt vmcnt(0)" ::: "memory");
        } else {
            XB_SPIN(xb_ld(&bar[XB_XGEN(b.x)]) == gen, bar);
            __builtin_amdgcn_fence(__ATOMIC_ACQUIRE, "agent");
            asm volatile("s_waitcnt vmcnt(0)" ::: "memory");
        }
    }
    __syncthreads();
}
__device__ __forceinline__ Params fresh(const Params& p) { Params q = p; unsigned long long w = (unsigned long long)q.ws; asm volatile("" : "+s"(w)); q.ws = (unsigned char*)w; return q; }
#define GRID_BAR() do { XcdBarrier xb_ = xbar; unsigned long long bw_ = (unsigned long long)xb_.bar; asm volatile("" : "+s"(bw_)); xb_.bar = (unsigned*)bw_; xcd_barrier(xb_); } while (0)
__global__ void __launch_bounds__(NTHREADS, 2) k_fwd(Params p) {
  {
    volatile LAS unsigned* st = (volatile LAS unsigned*)(LAS char*)(dyn_lds + LDS_PHASE_BYTES);
    if (threadIdx.x == 0) { st[0] = 0u; st[1] = 0u; st[2] = 0u; st[3] = 0u; }
    __syncthreads();
  }
  const XcdBarrier xbar = xcd_barrier_post((unsigned*)(p.ws + WS_CTL) + CW_BAR, (volatile LAS unsigned*)(LAS char*)(dyn_lds + LDS_PHASE_BYTES));
#else
#define GRID_BAR() emu_gridsync()
static inline Params fresh(const Params& p) { return p; }
static void k_fwd(Params p) {
#endif
  if (PHMASK & (1u << 0)) { phase_mod_rope(fresh(p)); }
  for (int l = 0; l < DEPTH; ++l) {
    if (PHMASK & (1u << 1)) { phase_convert(fresh(p), l); }
    GRID_BAR();
    if (PHMASK & (1u << 2)) { if (l == 0) phase_norm(fresh(p), l, 0, 0); else phase_norm(fresh(p), l, 1, 0); }
    GRID_BAR();
    if (PHMASK & (1u << 3)) { phase_gemm_in(fresh(p), l); }
    GRID_BAR();
    if (PHMASK & (1u << 4)) { phase_prep(fresh(p), l); }
    GRID_BAR();
    if (PHMASK & (1u << 5)) { phase_mlstm_a(fresh(p)); }
    GRID_BAR();
    if (PHMASK & (1u << 6)) { phase_mlstm_scan(fresh(p)); }
    if (PHMASK & (1u << 7)) { phase_attn(fresh(p)); }
    GRID_BAR();
    if (PHMASK & (1u << 8)) { phase_mlstm_c(fresh(p), l); }
    GRID_BAR();
    if (PHMASK & (1u << 9)) { phase_gemm_merge(fresh(p)); }
    GRID_BAR();
    if (PHMASK & (1u << 10)) { phase_gemm_out(fresh(p), l); }
    GRID_BAR();
    if (PHMASK & (1u << 11)) { phase_norm2_router(fresh(p), l); }
    GRID_BAR();
    if (PHMASK & (1u << 12)) { phase_moe_up(fresh(p), l); }
    GRID_BAR();
    if (PHMASK & (1u << 13)) { phase_moe_down(fresh(p), l); }
    GRID_BAR();
  }
  if (PHMASK & (1u << 14)) { phase_norm(fresh(p), DEPTH, 1, 2); }
}

#ifdef EMU
static int emu_grid_size = 8;
static int emu_stop_after = 1000;
#endif
extern "C" void kernel_launch(void* const* d_in, const int* in_sizes, int n_in, void* d_out, int out_size, void* d_ws, size_t ws_size, hipStream_t stream) {
  (void)in_sizes; (void)n_in; (void)out_size;
  if (ws_size < WS_TOTAL) { fprintf(stderr, "workspace too small: %zu < %zu\n", ws_size, (size_t)WS_TOTAL); return; }
  Params prm{};
  const float** f = (const float**)&prm;
  for (int i = 0; i < 24; ++i) f[i] = (const float*)d_in[i];
  prm.out = (float*)d_out; prm.ws = (unsigned char*)d_ws;
#ifdef EMU
  memset(d_ws, 0, CTL_BYTES);
  emu_launch(emu_grid_size, NTHREADS, LDS_BYTES, [=]() { k_fwd(prm); }, true);
#else
  static int grid = 0;
  if (!grid) {
    int dev = 0, cus = 0, per_cu = 0;
    (void)hipGetDevice(&dev);
    (void)hipDeviceGetAttribute(&cus, hipDeviceAttributeMultiprocessorCount, dev);
    (void)hipFuncSetAttribute((const void*)k_fwd, hipFuncAttributeMaxDynamicSharedMemorySize, LDS_BYTES);
    (void)hipOccupancyMaxActiveBlocksPerMultiprocessor(&per_cu, k_fwd, NTHREADS, LDS_BYTES);
    grid = cus * (per_cu < 1 ? per_cu : 1);
    if (grid <= 0) { fprintf(stderr, "occupancy query says the kernel does not fit (cus %d per_cu %d)\n", cus, per_cu); grid = 0; return; }
  }
  (void)hipMemsetAsync(d_ws, 0, CTL_BYTES, stream);
  k_fwd<<<grid, NTHREADS, LDS_BYTES, stream>>>(prm);
#endif
}
```

```cpp
#ifdef EMU
#include "emu.h"
#define TID emu_tid()
#define BID emu_bid()
#define NBLK emu_nblk()
#define SYNC() emu_syncthreads()
#define DEV static inline
#define DEVM inline
#else
#include <hip/hip_runtime.h>
#include <cstdio>
#include <cstdint>
__device__ __forceinline__ int tid_opaque() { int t = (int)threadIdx.x; asm volatile("" : "+v"(t)); return t; }
#define TID tid_opaque()
#define BID ((int)blockIdx.x)
#define NBLK ((int)gridDim.x)
#define SYNC() __syncthreads()
#define DEV __device__ __forceinline__
#define DEVM __device__ __forceinline__
#endif

#ifndef CFG_SEQ
#define CFG_SEQ 8192
#endif
#ifndef CFG_BATCH
#define CFG_BATCH 2
#endif

#ifndef PHMASK
#define PHMASK 0xFFFFFFFFu
#endif
#define UNR _Pragma("unroll")
typedef unsigned short bf16_t;
typedef short bf16x8 __attribute__((ext_vector_type(8)));
typedef float f32x4 __attribute__((ext_vector_type(4)));
typedef unsigned u32x4 __attribute__((ext_vector_type(4)));
typedef unsigned u32x2 __attribute__((ext_vector_type(2)));

constexpr int D = 1024, BATCH = CFG_BATCH, SEQ = CFG_SEQ, DEPTH = 2, T = BATCH * SEQ;
constexpr int GRID_W = 64;
constexpr int MH = 4, MHD = 128, MW = 512, ML = 64, NC = SEQ / ML, CONVW = 5;
constexpr int AH = 8, KVH = 2, AHD = 64, AW = 512, KVW = 128;
constexpr int NG = 4, EPG = 8, NE = 32, FF = 512;
constexpr float EPS = 1e-6f;
constexpr int IN_W = 4880, NP = 5120;
constexpr int C_MQ = 0, C_MK = 512, C_MV = 1024, C_MO = 1536, C_GATES = 2048, C_AQ = 2064, C_AK = 2576, C_AV = 2704, C_GM = 2832, C_GA = 3856;
constexpr int NTHREADS = 512;
constexpr int BHC = BATCH * MH * NC;
constexpr int ROWT_MAX = (2 * T) / 256 + NE;
constexpr int SLOT_ROWS = ROWT_MAX * 256;

constexpr size_t al256(size_t x) { return (x + 255) & ~(size_t)255; }
constexpr size_t WS_CTL = 0, CTL_BYTES = 1 << 20;
constexpr size_t WS_MOD = WS_CTL + CTL_BYTES;
constexpr size_t WS_ROPE = WS_MOD + al256((size_t)DEPTH * BATCH * 6 * D * 4);
constexpr size_t WS_WIN = WS_ROPE + al256((size_t)(2 * (SEQ / GRID_W) * 16 + 2 * 64 * 16) * 4);
constexpr size_t WS_WBM = WS_WIN + (size_t)NP * D * 2;
constexpr size_t WS_WBA = WS_WBM + (size_t)D * MW * 2;
constexpr size_t WS_WOUT = WS_WBA + (size_t)D * AW * 2;
constexpr size_t WS_WGU = WS_WOUT + (size_t)D * D * 2;
constexpr size_t WS_WD = WS_WGU + (size_t)NE * 2 * FF * D * 2;
constexpr size_t WS_PROJ = WS_WD + (size_t)NE * D * FF * 2;
constexpr size_t WS_ACT = WS_PROJ;
constexpr size_t WS_Y = WS_ACT + al256((size_t)SLOT_ROWS * FF * 2);
constexpr size_t PROJ_BYTES = (size_t)T * NP * 2;
constexpr size_t OVL_BYTES = (WS_Y + (size_t)2 * T * D * 2 - WS_PROJ) > PROJ_BYTES ? (WS_Y + (size_t)2 * T * D * 2 - WS_PROJ) : PROJ_BYTES;
constexpr size_t WS_GATES = WS_PROJ + al256(OVL_BYTES);
constexpr size_t WS_QC = WS_GATES + (size_t)T * 16 * 4;
constexpr size_t WS_KC = WS_QC + (size_t)T * MW * 2;
constexpr size_t WS_MERGED = WS_QC;
constexpr size_t WS_AQN = WS_KC + (size_t)T * MW * 2;
constexpr size_t WS_AKN = WS_AQN + (size_t)T * AW * 2;
constexpr size_t WS_VT = WS_AKN + (size_t)T * KVW * 2;
constexpr size_t WS_YM = WS_VT + (size_t)T * KVW * 2;
constexpr size_t WS_YA = WS_YM + (size_t)T * MW * 2;
constexpr size_t QCYA_BYTES = WS_YA + (size_t)T * AW * 2 - WS_QC;
constexpr size_t HS_BYTES = (size_t)SLOT_ROWS * D * 2;
constexpr size_t WS_HS = WS_QC;
constexpr size_t WS_CST = WS_QC + al256(HS_BYTES > QCYA_BYTES ? HS_BYTES : QCYA_BYTES);
constexpr size_t WS_H = WS_CST;
constexpr size_t WS_TMP = WS_CST;
constexpr size_t CST_BYTES = (size_t)2 * BHC * 128 * 128 * 2;
static_assert((size_t)T * D * 4 <= CST_BYTES, "H and TMP fit in CST");
constexpr size_t WS_NST = WS_CST + CST_BYTES;
constexpr size_t WS_AMAX = WS_NST + (size_t)2 * BHC * 128 * 4;
constexpr size_t WS_BLAST = WS_AMAX + al256((size_t)2 * BHC * 4);
constexpr size_t WS_MPREV = WS_BLAST + al256((size_t)2 * BHC * 4);
constexpr size_t WS_ENT_E = WS_MPREV + al256((size_t)2 * BHC * 4);
constexpr size_t WS_ENT_POS = WS_ENT_E + (size_t)2 * T * 4;
constexpr size_t WS_WENT = WS_ENT_POS + (size_t)2 * T * 4;
constexpr size_t WS_SLOT_ENT = WS_WENT + (size_t)2 * T * 4;
constexpr size_t WS_SLOT_W = WS_SLOT_ENT + (size_t)SLOT_ROWS * 4;
constexpr size_t WS_TOTAL = WS_SLOT_W + (size_t)SLOT_ROWS * 4;
constexpr int CW_CNT = 64;
constexpr int CW_BAR = 4096;

struct Params {
  const float *x, *c, *w_ada, *b_ada, *norm1_g, *w_in, *b_in, *conv_w, *conv_b, *mlstm_norm_g, *q_norm_g, *k_norm_g, *w_branch_m, *w_branch_a, *w_out, *norm2_g,
      *w_rg, *b_rg, *w_re, *b_re, *w_gate, *w_up, *w_down, *final_g;
  float* out; unsigned char* ws;
};

DEV float bf2f(bf16_t h) { return __builtin_bit_cast(float, (unsigned)h << 16); }
DEV bf16_t f2bf(float f) { unsigned u = __builtin_bit_cast(unsigned, f); return (bf16_t)((u + 0x7fffu + ((u >> 16) & 1u)) >> 16); }
DEV unsigned pk2(float lo, float hi) { return (unsigned)f2bf(lo) | ((unsigned)f2bf(hi) << 16); }
DEV float sigmoidf_(float x) { return 1.f / (1.f + expf(-x)); }
DEV float siluf_(float x) { return x / (1.f + expf(-x)); }
DEV float logsigmoidf_(float x) { return fminf(x, 0.f) - log1pf(expf(-fabsf(x))); }

#ifdef EMU
static inline f32x4 mfma16(bf16x8 a, bf16x8 b, f32x4 c) {
  struct In { bf16x8 a, b; f32x4 c; } in{a, b, c}; f32x4 out;
  emu_collective(&in, sizeof(In), &out, sizeof(out), [](char (*I)[64], char (*O)[32]) {
    float Dm[16][16];
    for (int r = 0; r < 16; ++r) for (int cc = 0; cc < 16; ++cc) { In* L = (In*)I[(r >> 2) * 16 + cc]; Dm[r][cc] = L->c[r & 3]; }
    for (int r = 0; r < 16; ++r) for (int cc = 0; cc < 16; ++cc) { float s = 0.f;
      for (int g = 0; g < 4; ++g) { In* LA = (In*)I[g * 16 + r]; In* LB = (In*)I[g * 16 + cc]; for (int j = 0; j < 8; ++j) s += bf2f((bf16_t)LA->a[j]) * bf2f((bf16_t)LB->b[j]); }
      Dm[r][cc] += s; }
    for (int l = 0; l < 64; ++l) { f32x4 o; for (int i = 0; i < 4; ++i) o[i] = Dm[(l >> 4) * 4 + i][l & 15]; memcpy(O[l], &o, 16); } });
  return out;
}
static inline f32x4 mfma4f32(float a, float b, f32x4 c) {
  struct In { float a, b; f32x4 c; } in{a, b, c}; f32x4 out;
  emu_collective(&in, sizeof(In), &out, sizeof(out), [](char (*I)[64], char (*O)[32]) {
    for (int l = 0; l < 64; ++l) { f32x4 o; UNR for (int i = 0; i < 4; ++i) { const int r = (l >> 4) * 4 + i, cc = l & 15; float s = ((In*)I[l])->c[i];
      for (int k = 0; k < 4; ++k) s = fmaf(((In*)I[k * 16 + r])->a, ((In*)I[k * 16 + cc])->b, s); o[i] = s; } memcpy(O[l], &o, 16); } });
  return out;
}
static inline float shfl_xor_f(float v, int m) { float out; emu_collective(&v, 4, &out, 4, [m](char (*I)[64], char (*O)[32]) { for (int l = 0; l < 64; ++l) memcpy(O[l], I[l ^ m], 4); }); return out; }
static inline float shfl_f(float v, int src) { struct In { float v; int s; } in{v, src}; float out;
  emu_collective(&in, 8, &out, 4, [](char (*I)[64], char (*O)[32]) { for (int l = 0; l < 64; ++l) { In* me = (In*)I[l]; memcpy(O[l], I[me->s & 63], 4); } }); return out; }
static inline int atomic_add_i(int* p, int v) { return __atomic_fetch_add(p, v, __ATOMIC_RELAXED); }
#define LDS_PTR() emu_lds()
#else
DEV f32x4 mfma16(bf16x8 a, bf16x8 b, f32x4 c) { return __builtin_amdgcn_mfma_f32_16x16x32_bf16(a, b, c, 0, 0, 0); }
DEV f32x4 mfma4f32(float a, float b, f32x4 c) { return __builtin_amdgcn_mfma_f32_16x16x4f32(a, b, c, 0, 0, 0); }
DEV float shfl_xor_f(float v, int m) {
  const int iv = __builtin_bit_cast(int, v);
  switch (m) {
    case 1: return __builtin_bit_cast(float, __builtin_amdgcn_ds_swizzle(iv, (1 << 10) | 0x1f));
    case 2: return __builtin_bit_cast(float, __builtin_amdgcn_ds_swizzle(iv, (2 << 10) | 0x1f));
    case 4: return __builtin_bit_cast(float, __builtin_amdgcn_ds_swizzle(iv, (4 << 10) | 0x1f));
    case 8: return __builtin_bit_cast(float, __builtin_amdgcn_ds_swizzle(iv, (8 << 10) | 0x1f));
    case 16: return __builtin_bit_cast(float, __builtin_amdgcn_ds_swizzle(iv, (16 << 10) | 0x1f));
    default: { const int lane = TID & 63; return __builtin_bit_cast(float, __builtin_amdgcn_ds_bpermute(((lane ^ m) & 63) << 2, iv)); }
  }
}
DEV float shfl_f(float v, int src) { return __builtin_bit_cast(float, __builtin_amdgcn_ds_bpermute((src & 63) << 2, __builtin_bit_cast(int, v))); }
DEV int atomic_add_i(int* p, int v) { return atomicAdd(p, v); }
extern __shared__ __attribute__((aligned(16))) char dyn_lds[];
#define LDS_PTR() (dyn_lds)
#endif
DEV float grp16_sum(float v) { v += shfl_xor_f(v, 1); v += shfl_xor_f(v, 2); v += shfl_xor_f(v, 4); v += shfl_xor_f(v, 8); return v; }
DEV float grp16_max(float v) { v = fmaxf(v, shfl_xor_f(v, 1)); v = fmaxf(v, shfl_xor_f(v, 2)); v = fmaxf(v, shfl_xor_f(v, 4)); v = fmaxf(v, shfl_xor_f(v, 8)); return v; }
DEV float wave_sum(float v) { v = grp16_sum(v); v += shfl_xor_f(v, 16); v += shfl_xor_f(v, 32); return v; }
DEV bf16x8 ld8(const bf16_t* p) { return __builtin_bit_cast(bf16x8, *(const u32x4*)p); }

DEV void phase_mod_rope(const Params& p) {
  float* mod = (float*)(p.ws + WS_MOD);
  const int gtid = BID * NTHREADS + TID, gstride = NBLK * NTHREADS;
  for (int o = gtid; o < DEPTH * BATCH * 6 * D; o += gstride) {
    const int n = o % (6 * D), b = (o / (6 * D)) % BATCH, l = o / (6 * D * BATCH);
    const float* w = p.w_ada + (size_t)l * D * 6 * D + n; const float* cv = p.c + b * D;
    float s = p.b_ada[l * 6 * D + n];
    for (int k = 0; k < D; ++k) s += siluf_(cv[k]) * w[(size_t)k * 6 * D];
    mod[o] = s;
  }
  float* rope = (float*)(p.ws + WS_ROPE);
  constexpr int NR = SEQ / GRID_W;
  for (int o = gtid; o < (NR + 64) * 16; o += gstride) {
    const int i = o & 15, pos = o >> 4;
    const float inv = powf(10000.f, -(float)(2 * i) / 32.f);
    if (pos < NR) { const float a = (float)pos * inv; rope[pos * 16 + i] = cosf(a); rope[NR * 16 + pos * 16 + i] = sinf(a); }
    else { const int cpos = pos - NR; const float a = (float)cpos * inv; rope[2 * NR * 16 + cpos * 16 + i] = cosf(a); rope[2 * NR * 16 + 64 * 16 + cpos * 16 + i] = sinf(a); }
  }
}
DEV void transpose_item(char* lds, const float* src, int K, int N, bf16_t* dst, int mode, int item) {
  float* tile = (float*)lds;
  const int ntn = (N + 63) / 64, tk = item / ntn, tn = item % ntn, tid = TID;
  const int k0 = tk * 64, n0 = tn * 64;
  { const int kk = tid >> 3, c8 = (tid & 7) * 8;
    const float* s = src + (size_t)(k0 + kk) * N + n0 + c8;
    UNR for (int j = 0; j < 8; ++j) tile[kk * 65 + c8 + j] = (n0 + c8 + j < N) ? s[j] : 0.f; }
  SYNC();
  { const int nn = tid >> 3, k8 = (tid & 7) * 8, n = n0 + nn;
    if (n < N) {
      int row = n; if (mode == 1) row = 32 * (n >> 4) + (n & 15); else if (mode == 2) row = 32 * (n >> 4) + 16 + (n & 15);
      u32x4 v; v.x = pk2(tile[(k8 + 0) * 65 + nn], tile[(k8 + 1) * 65 + nn]); v.y = pk2(tile[(k8 + 2) * 65 + nn], tile[(k8 + 3) * 65 + nn]);
      v.z = pk2(tile[(k8 + 4) * 65 + nn], tile[(k8 + 5) * 65 + nn]); v.w = pk2(tile[(k8 + 6) * 65 + nn], tile[(k8 + 7) * 65 + nn]);
      *(u32x4*)(dst + (size_t)row * K + k0 + k8) = v; } }
  SYNC();
}
DEV void phase_convert(const Params& p, int l) {
  char* lds = LDS_PTR();
  constexpr int I_IN = (D / 64) * ((IN_W + 63) / 64), I_BM = (MW / 64) * (D / 64), I_BA = (AW / 64) * (D / 64), I_OUT = (D / 64) * (D / 64);
  constexpr int I_G = (D / 64) * (FF / 64), I_D = (FF / 64) * (D / 64);
  constexpr int B1 = I_IN, B2 = B1 + I_BM, B3 = B2 + I_BA, B4 = B3 + I_OUT, B5 = B4 + NE * I_G, B6 = B5 + NE * I_G, B7 = B6 + NE * I_D;
  for (int it = BID; it < B7; it += NBLK) {
    if (it < B1) transpose_item(lds, p.w_in + (size_t)l * D * IN_W, D, IN_W, (bf16_t*)(p.ws + WS_WIN), 0, it);
    else if (it < B2) transpose_item(lds, p.w_branch_m + (size_t)l * MW * D, MW, D, (bf16_t*)(p.ws + WS_WBM), 0, it - B1);
    else if (it < B3) transpose_item(lds, p.w_branch_a + (size_t)l * AW * D, AW, D, (bf16_t*)(p.ws + WS_WBA), 0, it - B2);
    else if (it < B4) transpose_item(lds, p.w_out + (size_t)l * D * D, D, D, (bf16_t*)(p.ws + WS_WOUT), 0, it - B3);
    else if (it < B5) { const int e = (it - B4) / I_G, r = (it - B4) % I_G; transpose_item(lds, p.w_gate + ((size_t)l * NE + e) * D * FF, D, FF, (bf16_t*)(p.ws + WS_WGU) + (size_t)e * 2 * FF * D, 1, r); }
    else if (it < B6) { const int e = (it - B5) / I_G, r = (it - B5) % I_G; transpose_item(lds, p.w_up + ((size_t)l * NE + e) * D * FF, D, FF, (bf16_t*)(p.ws + WS_WGU) + (size_t)e * 2 * FF * D, 2, r); }
    else { const int e = (it - B6) / I_D, r = (it - B6) % I_D; transpose_item(lds, p.w_down + ((size_t)l * NE + e) * FF * D, FF, D, (bf16_t*)(p.ws + WS_WD) + (size_t)e * D * FF, 0, r); }
  }
}

DEV void phase_norm(const Params& p, int l, int mode, int which) {
  const int lane = TID & 63, wv = TID >> 6, nwv = NTHREADS / 64;
  const float* mod = (const float*)(p.ws + WS_MOD);
  bf16_t* H = (bf16_t*)(p.ws + WS_H);
  const bf16_t* Y = (const bf16_t*)(p.ws + WS_Y);
  for (int t = BID * nwv + wv; t < T; t += NBLK * nwv) {
    const int b = t / SEQ;
    f32x4 v[4]; float ss = 0.f;
    UNR for (int i = 0; i < 4; ++i) {
      const int c4 = lane + 64 * i;
      if (mode == 0) v[i] = ((const f32x4*)(p.x + (size_t)t * D))[c4];
      else {
        v[i] = ((const f32x4*)(p.out + (size_t)t * D))[c4];
        if (mode == 1) {
          const f32x4 g2 = ((const f32x4*)(mod + ((size_t)(l - 1) * BATCH + b) * 6 * D + 5 * D))[c4];
          const u32x2 y0 = ((const u32x2*)(Y + (size_t)(2 * t) * D))[c4], y1 = ((const u32x2*)(Y + (size_t)(2 * t + 1) * D))[c4];
          v[i][0] += g2[0] * (bf2f((bf16_t)(y0.x & 0xffff)) + bf2f((bf16_t)(y1.x & 0xffff)));
          v[i][1] += g2[1] * (bf2f((bf16_t)(y0.x >> 16)) + bf2f((bf16_t)(y1.x >> 16)));
          v[i][2] += g2[2] * (bf2f((bf16_t)(y0.y & 0xffff)) + bf2f((bf16_t)(y1.y & 0xffff)));
          v[i][3] += g2[3] * (bf2f((bf16_t)(y0.y >> 16)) + bf2f((bf16_t)(y1.y >> 16)));
        }
      }
      ss += v[i][0] * v[i][0] + v[i][1] * v[i][1] + v[i][2] * v[i][2] + v[i][3] * v[i][3];
    }
    ss = wave_sum(ss);
    const float rs = 1.f / sqrtf(ss * (1.f / D) + EPS);
    if (which == 2) {
      UNR for (int i = 0; i < 4; ++i) { const int c4 = lane + 64 * i; const f32x4 g = ((const f32x4*)p.final_g)[c4];
        f32x4 o; UNR for (int j = 0; j < 4; ++j) o[j] = v[i][j] * rs * g[j]; ((f32x4*)(p.out + (size_t)t * D))[c4] = o; }
      continue;
    }
    if (mode != 2) UNR for (int i = 0; i < 4; ++i) ((f32x4*)(p.out + (size_t)t * D))[lane + 64 * i] = v[i];
    const float* mb = mod + ((size_t)l * BATCH + b) * 6 * D + (which == 0 ? 0 : 3 * D);
    const float* gw = (which == 0 ? p.norm1_g : p.norm2_g) + (size_t)l * D;
    f32x4 hv[4];
    UNR for (int i = 0; i < 4; ++i) { const int c4 = lane + 64 * i;
      const f32x4 g = ((const f32x4*)gw)[c4], sh = ((const f32x4*)mb)[c4], sc = ((const f32x4*)(mb + D))[c4];
      UNR for (int j = 0; j < 4; ++j) hv[i][j] = (v[i][j] * rs * g[j]) * (1.f + sc[j]) + sh[j];
      u32x2 o; o.x = pk2(hv[i][0], hv[i][1]); o.y = pk2(hv[i][2], hv[i][3]); ((u32x2*)(H + (size_t)t * D))[c4] = o; }
  }
}
constexpr int HSP = 1028;
DEV void phase_norm2_router(const Params& p, int l) {
  char* lds = LDS_PTR();
  float* HS = (float*)lds;
  float* PART = HS + 16 * HSP;
  const int tid = TID, lane = tid & 63, w = tid >> 6;
  const float* mod = (const float*)(p.ws + WS_MOD);
  bf16_t* H = (bf16_t*)(p.ws + WS_H);
  const float* wrg = p.w_rg + (size_t)l * D * NG; const float* wre = p.w_re + (size_t)l * D * NE;
  const float* gw = p.norm2_g + (size_t)l * D;
  for (int tb = BID * 16; tb < T; tb += NBLK * 16) {
    SYNC();
    UNR for (int q = 0; q < 2; ++q) {
      const int tl = 2 * w + q, t = tb + tl, b = t / SEQ;
      f32x4 v[4]; float ss = 0.f;
      UNR for (int i = 0; i < 4; ++i) { v[i] = ((const f32x4*)(p.out + (size_t)t * D))[lane + 64 * i]; ss += v[i][0] * v[i][0] + v[i][1] * v[i][1] + v[i][2] * v[i][2] + v[i][3] * v[i][3]; }
      ss = wave_sum(ss);
      const float rs = 1.f / sqrtf(ss * (1.f / D) + EPS);
      const float* mb = mod + ((size_t)l * BATCH + b) * 6 * D + 3 * D;
      UNR for (int i = 0; i < 4; ++i) { const int c4 = lane + 64 * i;
        const f32x4 g = ((const f32x4*)gw)[c4], sh = ((const f32x4*)mb)[c4], sc = ((const f32x4*)(mb + D))[c4];
        f32x4 hv; UNR for (int j = 0; j < 4; ++j) hv[j] = (v[i][j] * rs * g[j]) * (1.f + sc[j]) + sh[j];
        u32x2 o; o.x = pk2(hv[0], hv[1]); o.y = pk2(hv[2], hv[3]); ((u32x2*)(H + (size_t)t * D))[c4] = o;
        *(f32x4*)(HS + tl * HSP + 4 * c4) = hv; }
    }
    SYNC();
    f32x4 acc[3]; UNR for (int nt = 0; nt < 3; ++nt) acc[nt] = (f32x4){0.f, 0.f, 0.f, 0.f};
#pragma unroll 4
    for (int kk = 0; kk < 32; ++kk) {
      const int d = 128 * w + 4 * kk + (lane >> 4);
      const float a = HS[(lane & 15) * HSP + d];
      const int o0 = lane & 15;
      const float b0 = (o0 < NG) ? wrg[(size_t)d * NG + o0] : wre[(size_t)d * NE + o0 - NG];
      const float b1 = wre[(size_t)d * NE + 16 + o0 - NG];
      const float b2 = (o0 < NG) ? wre[(size_t)d * NE + 32 + o0 - NG] : 0.f;
      acc[0] = mfma4f32(a, b0, acc[0]); acc[1] = mfma4f32(a, b1, acc[1]); acc[2] = mfma4f32(a, b2, acc[2]);
    }
    UNR for (int nt = 0; nt < 3; ++nt) UNR for (int i = 0; i < 4; ++i) PART[(w * 16 + (lane >> 4) * 4 + i) * 48 + nt * 16 + (lane & 15)] = acc[nt][i];
    SYNC();
    if (tid < 16) {
      const int t = tb + tid;
      float lg[NG];
      int g = 0; float gmx = -3.0e38f;
#pragma unroll
      for (int o = 0; o < NG; ++o) { float s = p.b_rg[l * NG + o];
#pragma unroll 1
        for (int ww = 0; ww < 8; ++ww) s += PART[(ww * 16 + tid) * 48 + o]; lg[o] = s; if (s > gmx) { gmx = s; g = o; } }
      float gsum = 0.f; UNR for (int o = 0; o < NG; ++o) gsum += expf(lg[o] - gmx);
      const float ptop = 1.f / gsum;
      int e0 = 0, e1 = 0; float m0 = -3.0e38f, m1 = -3.0e38f;
#pragma unroll 1
      for (int j = 0; j < EPG; ++j) { float s = p.b_re[l * NE + g * EPG + j];
#pragma unroll 1
        for (int ww = 0; ww < 8; ++ww) s += PART[(ww * 16 + tid) * 48 + NG + g * EPG + j];
        if (s > m0) { m1 = m0; e1 = e0; m0 = s; e0 = j; } else if (s > m1) { m1 = s; e1 = j; } }
      const float x1 = expf(m1 - m0), w0 = ptop / (1.f + x1), w1 = ptop * x1 / (1.f + x1);
      int* cnt = (int*)(p.ws + WS_CTL) + CW_CNT + l * NE; int* ent_e = (int*)(p.ws + WS_ENT_E); int* ent_pos = (int*)(p.ws + WS_ENT_POS); float* went = (float*)(p.ws + WS_WENT);
      const int ea = g * EPG + e0, eb = g * EPG + e1;
      ent_e[2 * t] = ea; ent_pos[2 * t] = atomic_add_i(cnt + ea, 1); went[2 * t] = w0;
      ent_e[2 * t + 1] = eb; ent_pos[2 * t + 1] = atomic_add_i(cnt + eb, 1); went[2 * t + 1] = w1;
    }
  }
}

constexpr int GP = 72;
constexpr int LDS_PHASE_BYTES = 131072;
constexpr int LDS_BYTES = LDS_PHASE_BYTES + 256;
DEV void moe_tiles(const Params& p, int l, int* s_pref) {
  SYNC();
  if (TID == 0) { const int* cnt = (const int*)(p.ws + WS_CTL) + CW_CNT + l * NE; int a = 0; for (int e = 0; e < NE; ++e) { s_pref[e] = a; a += (cnt[e] + 255) / 256; } s_pref[NE] = a; }
  SYNC();
}
DEV void phase_moe_gather(const Params& p, int l) {
  int* s_pref = (int*)(LDS_PTR() + LDS_PHASE_BYTES + 64);
  moe_tiles(p, l, s_pref);
  const int* cnt = (const int*)(p.ws + WS_CTL) + CW_CNT + l * NE; const int* ent_e = (const int*)(p.ws + WS_ENT_E); const int* ent_pos = (const int*)(p.ws + WS_ENT_POS);
  const float* went = (const float*)(p.ws + WS_WENT); int* slot_ent = (int*)(p.ws + WS_SLOT_ENT); float* slot_w = (float*)(p.ws + WS_SLOT_W);
  const bf16_t* H = (const bf16_t*)(p.ws + WS_H); bf16_t* HS = (bf16_t*)(p.ws + WS_HS);
  const int tid = TID, lane = tid & 63, wv = tid >> 6;
  for (int i = BID * 8 + wv; i < 2 * T; i += NBLK * 8) {
    const int slot = s_pref[ent_e[i]] * 256 + ent_pos[i];
    const u32x4* src = (const u32x4*)(H + (size_t)(i >> 1) * D); u32x4* dst = (u32x4*)(HS + (size_t)slot * D);
    dst[lane] = src[lane]; dst[lane + 64] = src[lane + 64];
    if (lane == 0) { slot_ent[slot] = i; slot_w[slot] = went[i]; }
  }
  for (int e = BID; e < NE; e += NBLK) { const int s0 = s_pref[e] * 256 + cnt[e], s1 = s_pref[e + 1] * 256; for (int q = s0 + tid; q < s1; q += NTHREADS) slot_ent[q] = -1; }
}
#ifdef EMU
struct RowPlain { const bf16_t* base; size_t ld; DEVM const bf16_t* operator()(int r) const { return base + (size_t)r * ld; } };
template <class RowA>
DEV void gemm_kloop(char* lds, const RowA& rowA, const bf16_t* Bt, size_t ldb, int K, f32x4 (&acc)[4][2]) {
  bf16_t* As = (bf16_t*)lds; bf16_t* Bs = As + 128 * GP;
  const int tid = TID, lane = tid & 63, w = tid >> 6, wm = w >> 2, wn = w & 3;
  const int r0 = tid >> 3, pc = (tid & 7) * 8;
  const bf16_t* a0 = rowA(r0) + pc; const bf16_t* a1 = rowA(r0 + 64) + pc;
  const bf16_t* b0 = Bt + (size_t)r0 * ldb + pc; const bf16_t* b1 = Bt + (size_t)(r0 + 64) * ldb + pc;
  u32x4 ra0 = *(const u32x4*)a0, ra1 = *(const u32x4*)a1, rb0 = *(const u32x4*)b0, rb1 = *(const u32x4*)b1;
  const int nk = K / 64;
  for (int kt = 0; kt < nk; ++kt) {
    SYNC();
    *(u32x4*)(As + r0 * GP + pc) = ra0; *(u32x4*)(As + (r0 + 64) * GP + pc) = ra1;
    *(u32x4*)(Bs + r0 * GP + pc) = rb0; *(u32x4*)(Bs + (r0 + 64) * GP + pc) = rb1;
    SYNC();
    if (kt + 1 < nk) { const int ko = (kt + 1) * 64; ra0 = *(const u32x4*)(a0 + ko); ra1 = *(const u32x4*)(a1 + ko); rb0 = *(const u32x4*)(b0 + ko); rb1 = *(const u32x4*)(b1 + ko); }
#pragma unroll
    for (int ks = 0; ks < 2; ++ks) {
      const int kof = ks * 32 + (lane >> 4) * 8;
      bf16x8 af[4], bfr[2];
#pragma unroll
      for (int mt = 0; mt < 4; ++mt) af[mt] = ld8(As + (wm * 64 + mt * 16 + (lane & 15)) * GP + kof);
#pragma unroll
      for (int nt = 0; nt < 2; ++nt) bfr[nt] = ld8(Bs + (wn * 32 + nt * 16 + (lane & 15)) * GP + kof);
#pragma unroll
      for (int mt = 0; mt < 4; ++mt)
#pragma unroll
        for (int nt = 0; nt < 2; ++nt) acc[mt][nt] = mfma16(af[mt], bfr[nt], acc[mt][nt]);
    }
  }
}
DEV void zero_acc(f32x4 (&acc)[4][2]) { UNR for (int i = 0; i < 4; ++i) UNR for (int j = 0; j < 2; ++j) acc[i][j] = (f32x4){0.f, 0.f, 0.f, 0.f}; }

DEV void phase_gemm_in(const Params& p, int l) {
  char* lds = LDS_PTR();
  const bf16_t* H = (const bf16_t*)(p.ws + WS_H); const bf16_t* W = (const bf16_t*)(p.ws + WS_WIN);
  bf16_t* PROJ = (bf16_t*)(p.ws + WS_PROJ); float* GATES = (float*)(p.ws + WS_GATES);
  const float* bias = p.b_in + (size_t)l * IN_W;
  constexpr int nM = T / 128, nN = NP / 128;
  for (int u = BID; u < nM * nN; u += NBLK) {
    const int pm = u % nM, pn = u / nM;
    f32x4 acc[4][2]; zero_acc(acc);
    RowPlain ra{H + (size_t)pm * 128 * D, (size_t)D};
    gemm_kloop(lds, ra, W + (size_t)pn * 128 * D, D, D, acc);
    const int etid = TID, lane = etid & 63, w = etid >> 6, wm = w >> 2, wn = w & 3;
    UNR for (int nt = 0; nt < 2; ++nt) {
      const int col = pn * 128 + wn * 32 + nt * 16 + (lane & 15);
      if (col >= IN_W) continue;
      const float bv = bias[col];
      UNR for (int mt = 0; mt < 4; ++mt) UNR for (int i = 0; i < 4; ++i) {
        const int row = pm * 128 + wm * 64 + mt * 16 + (lane >> 4) * 4 + i; const float v = acc[mt][nt][i] + bv;
        PROJ[(size_t)row * NP + col] = f2bf(v);
        if (col >= C_GATES && col < C_GATES + 16) GATES[(size_t)row * 16 + (col - C_GATES)] = v;
      }
    }
  }
}
DEV void phase_gemm_merge(const Params& p) {
  char* lds = LDS_PTR();
  const bf16_t* YM = (const bf16_t*)(p.ws + WS_YM); const bf16_t* YA = (const bf16_t*)(p.ws + WS_YA);
  const bf16_t* WM = (const bf16_t*)(p.ws + WS_WBM); const bf16_t* WA = (const bf16_t*)(p.ws + WS_WBA);
  const bf16_t* PROJ = (const bf16_t*)(p.ws + WS_PROJ); bf16_t* MG = (bf16_t*)(p.ws + WS_MERGED);
  constexpr int nM = T / 128, nN = D / 128;
  for (int u = BID; u < nM * nN; u += NBLK) {
    const int pm = u / nN, pn = u % nN;
    f32x4 acc[4][2]; zero_acc(acc);
    RowPlain r1{YM + (size_t)pm * 128 * MW, (size_t)MW}; gemm_kloop(lds, r1, WM + (size_t)pn * 128 * MW, MW, MW, acc);
    float* park = (float*)(lds + 40960);
    { const int ptid = TID; UNR for (int mt = 0; mt < 4; ++mt) UNR for (int nt = 0; nt < 2; ++nt) UNR for (int i = 0; i < 4; ++i) park[((mt * 2 + nt) * 4 + i) * NTHREADS + ptid] = acc[mt][nt][i]; }
    zero_acc(acc);
    RowPlain r2{YA + (size_t)pm * 128 * AW, (size_t)AW}; gemm_kloop(lds, r2, WA + (size_t)pn * 128 * AW, AW, AW, acc);
    const int etid = TID, lane = etid & 63, w = etid >> 6, wm = w >> 2, wn = w & 3;
    UNR for (int nt = 0; nt < 2; ++nt) { const int col = pn * 128 + wn * 32 + nt * 16 + (lane & 15);
      UNR for (int mt = 0; mt < 4; ++mt) UNR for (int i = 0; i < 4; ++i) {
        const int row = pm * 128 + wm * 64 + mt * 16 + (lane >> 4) * 4 + i;
        const float gm = bf2f(PROJ[(size_t)row * NP + C_GM + col]), ga = bf2f(PROJ[(size_t)row * NP + C_GA + col]);
        MG[(size_t)row * D + col] = f2bf(sigmoidf_(gm) * park[((mt * 2 + nt) * 4 + i) * NTHREADS + etid] + sigmoidf_(ga) * acc[mt][nt][i]); } }
  }
}
DEV void phase_gemm_out(const Params& p, int l) {
  char* lds = LDS_PTR();
  const bf16_t* MG = (const bf16_t*)(p.ws + WS_MERGED); const bf16_t* W = (const bf16_t*)(p.ws + WS_WOUT);
  const float* mod = (const float*)(p.ws + WS_MOD);
  constexpr int nM = T / 128, nN = D / 128;
  for (int u = BID; u < nM * nN; u += NBLK) {
    const int pm = u / nN, pn = u % nN;
    f32x4 acc[4][2]; zero_acc(acc);
    RowPlain ra{MG + (size_t)pm * 128 * D, (size_t)D}; gemm_kloop(lds, ra, W + (size_t)pn * 128 * D, D, D, acc);
    const int etid = TID, lane = etid & 63, w = etid >> 6, wm = w >> 2, wn = w & 3;
    const int b = (pm * 128) / SEQ;
    UNR for (int nt = 0; nt < 2; ++nt) { const int col = pn * 128 + wn * 32 + nt * 16 + (lane & 15);
      const float g1 = mod[((size_t)l * BATCH + b) * 6 * D + 2 * D + col];
      UNR for (int mt = 0; mt < 4; ++mt) UNR for (int i = 0; i < 4; ++i) {
        const int row = pm * 128 + wm * 64 + mt * 16 + (lane >> 4) * 4 + i;
        p.out[(size_t)row * D + col] += g1 * acc[mt][nt][i]; } }
  }
}
DEV void phase_moe_up(const Params& p, int l) {
  char* lds = LDS_PTR(); int* s_pref = (int*)(lds + LDS_PHASE_BYTES + 64);
  moe_tiles(p, l, s_pref);
  const bf16_t* HS = (const bf16_t*)(p.ws + WS_HS); const bf16_t* W = (const bf16_t*)(p.ws + WS_WGU); bf16_t* ACT = (bf16_t*)(p.ws + WS_ACT);
  const int* slot_ent = (const int*)(p.ws + WS_SLOT_ENT); const float* slot_w = (const float*)(p.ws + WS_SLOT_W);
  const int ntile = s_pref[NE] * 2;
  for (int u = BID; u < ntile * 8; u += NBLK) {
    const int rt = u >> 3, ct = u & 7;
    int e = 0; while (s_pref[e + 1] <= (rt >> 1)) ++e;
    f32x4 acc[4][2]; zero_acc(acc);
    RowPlain ra{HS + (size_t)rt * 128 * D, (size_t)D};
    gemm_kloop(lds, ra, W + ((size_t)e * 2 * FF + ct * 128) * D, D, D, acc);
    const int etid = TID, lane = etid & 63, w = etid >> 6, wm = w >> 2, wn = w & 3;
    const int f = (ct * 4 + wn) * 16 + (lane & 15);
    UNR for (int mt = 0; mt < 4; ++mt) UNR for (int i = 0; i < 4; ++i) {
      const int slot = rt * 128 + wm * 64 + mt * 16 + (lane >> 4) * 4 + i;
      if (slot_ent[slot] >= 0) { const float wt = slot_w[slot]; const float a = acc[mt][0][i], uu = acc[mt][1][i];
        ACT[(size_t)slot * FF + f] = f2bf(siluf_(a) * uu * wt); } }
  }
}
DEV void phase_moe_down(const Params& p, int l) {
  char* lds = LDS_PTR(); int* s_pref = (int*)(lds + LDS_PHASE_BYTES + 64);
  moe_tiles(p, l, s_pref);
  const bf16_t* ACT = (const bf16_t*)(p.ws + WS_ACT); const bf16_t* W = (const bf16_t*)(p.ws + WS_WD); bf16_t* Y = (bf16_t*)(p.ws + WS_Y);
  const int* slot_ent = (const int*)(p.ws + WS_SLOT_ENT);
  const int ntile = s_pref[NE] * 2;
  for (int u = BID; u < ntile * 8; u += NBLK) {
    const int rt = u >> 3, ct = u & 7;
    int e = 0; while (s_pref[e + 1] <= (rt >> 1)) ++e;
    f32x4 acc[4][2]; zero_acc(acc);
    RowPlain ra{ACT + (size_t)rt * 128 * FF, (size_t)FF};
    gemm_kloop(lds, ra, W + ((size_t)e * D + ct * 128) * FF, FF, FF, acc);
    const int etid = TID, lane = etid & 63, w = etid >> 6, wm = w >> 2, wn = w & 3;
    UNR for (int nt = 0; nt < 2; ++nt) { const int col = ct * 128 + wn * 32 + nt * 16 + (lane & 15);
      UNR for (int mt = 0; mt < 4; ++mt) UNR for (int i = 0; i < 4; ++i) {
        const int slot = rt * 128 + wm * 64 + mt * 16 + (lane >> 4) * 4 + i; const int ent = slot_ent[slot];
        if (ent >= 0) Y[(size_t)ent * D + col] = f2bf(acc[mt][nt][i]); } }
  }
}
#else
namespace pg8 {
#define PG8_LAS __attribute__((address_space(3)))
typedef unsigned short bf16_t;
typedef short bf16x8 __attribute__((ext_vector_type(8)));
typedef float f32x4 __attribute__((ext_vector_type(4)));
typedef unsigned u32x4 __attribute__((ext_vector_type(4)));
constexpr int BM = 256, BK = 64, HALF = 128, HTB = HALF * BK * 2  , STAGE_BYTES = 8 * HTB, NXCD = 8, WGM = 8;

__host__ __device__ __forceinline__ int lds_byte(int r, int c) { const int st = (r >> 4) * 2 + (c >> 5), rr = r & 15, cc = c & 31, ob = rr * 64 + cc * 2; return st * 1024 + (ob ^ (((ob >> 9) & 1) << 5)); }
__host__ __device__ __forceinline__ void stage_rc(int b, int& R, int& C) { const int st = b / 1024, sb = b % 1024, swz = sb ^ (((sb >> 9) & 1) << 5); R = (st >> 1) * 16 + swz / 64; C = (st & 1) * 32 + (swz % 64) / 2; }
__host__ __device__ __forceinline__ int perm32(int rho) { const int n = rho >> 4, i = rho & 15; return 8 * (i >> 2) + 4 * n + (i & 3); }

struct Unit { int pm, pn; };
struct Gemm { const bf16_t* A; const bf16_t* Bt; int M, N, K; };

struct StaticOrder {
    int nM, nN, nwg, G, c;
    __host__ __device__ void init(int M, int N, int G_, int c_) { nM = M / BM; nN = N / BM; nwg = nM * nN; G = G_; c = c_; }
    __host__ __device__ bool next(int i, Unit& u) const {
        const long L = (long)i * G + c; if (L >= nwg) return false;
        int wgid = (int)L; { const int q = nwg / NXCD, r = nwg % NXCD, xcd = wgid % NXCD, off = wgid / NXCD; wgid = (xcd < r ? xcd * (q + 1) : r * (q + 1) + (xcd - r) * q) + off; }
        const int nig = WGM * nN, gid = wgid / nig, fm = gid * WGM, gsz = (nM - fm) < WGM ? (nM - fm) : WGM;
        u.pm = fm + ((wgid % nig) % gsz); u.pn = (wgid % nig) / gsz; return true;
    }
    __device__ __forceinline__ void a_ready(const Unit&) const {}
    __device__ __forceinline__ void done(const Unit&) const {}
};
__device__ __forceinline__ unsigned cvt_pk_bf16(float lo, float hi) { unsigned r; asm volatile("v_cvt_pk_bf16_f32 %0, %1, %2" : "=v"(r) : "v"(lo), "v"(hi)); return r; }
template <class Epi, class Sched, bool ALIGN_EPI = false, bool SP2 = false>
__device__ __forceinline__ void gemm_phase(PG8_LAS unsigned char* lds, const Gemm g, const Sched& S, const Epi& E) {
    const int tid = TID, wid = __builtin_amdgcn_readfirstlane(tid >> 6), lane = tid & 63, wr = wid >> 2, wc = wid & 3, fr = lane & 15, fq = lane >> 4;
    const int K = g.K, nt = K / BK;
    unsigned voffA[2], voffB[2];
#pragma unroll
    for (int i = 0; i < 2; ++i) { int R, C; stage_rc(tid * 16 + i * 8192, R, C); const int Rb = Epi::PERM ? ((R & ~31) + perm32(R & 31)) : R;
        voffA[i] = (unsigned)(R * K + C) * 2u; voffB[i] = (unsigned)(Rb * K + C) * 2u; }
    const size_t kstep = (size_t)(BK * 2);
    const size_t hstep = (size_t)HALF * K * 2;
    const size_t tstep = 2 * hstep;
    const unsigned ldsw = (unsigned)wid * 1024u;
    const int aoff = lds_byte(wr * 64 + fr, fq * 8), boff = lds_byte(wc * 32 + fr, fq * 8);
#define PG8_SA(b, h) (((b) * 2 + (h)) * HTB)
#define PG8_SB(b, h) ((4 + (b) * 2 + (h)) * HTB)
#define PG8_STAGE(bufoff, gbase, voff) do { _Pragma("unroll") for (int _i = 0; _i < 2; ++_i) \
        __builtin_amdgcn_global_load_lds((const unsigned*)((const char*)(gbase) + (voff)[_i]), (PG8_LAS unsigned*)(lds + (bufoff) + ldsw + _i * 8192), 16, 0, 0); } while (0)
#define PG8_LDA(dst, b, h) do { _Pragma("unroll") for (int m = 0; m < 4; ++m) _Pragma("unroll") for (int k = 0; k < 2; ++k) dst[m][k] = *(const PG8_LAS bf16x8*)(lds + PG8_SA(b, h) + aoff + m * 2048 + k * 1024); } while (0)
#define PG8_LDB(dst, b, h) do { _Pragma("unroll") for (int n = 0; n < 2; ++n) _Pragma("unroll") for (int k = 0; k < 2; ++k) dst[n][k] = *(const PG8_LAS bf16x8*)(lds + PG8_SB(b, h) + boff + n * 2048 + k * 1024); } while (0)
#define PG8_MMA(ai, bj, At, Bt) do { __builtin_amdgcn_s_setprio(1); _Pragma("unroll") for (int m = 0; m < 4; ++m) _Pragma("unroll") for (int n = 0; n < 2; ++n) _Pragma("unroll") for (int k = 0; k < 2; ++k) \
        acc[ai][bj][m][n] = __builtin_amdgcn_mfma_f32_16x16x32_bf16(Bt[n][k], At[m][k], acc[ai][bj][m][n], 0, 0, 0); __builtin_amdgcn_s_setprio(0); } while (0)
#define PG8_WAIT_V(n) asm volatile("s_waitcnt vmcnt(" #n ")" ::: "memory")
#define PG8_WAIT_L(n) asm volatile("s_waitcnt lgkmcnt(" #n ")" ::: "memory")
#define PG8_BAR __builtin_amdgcn_s_barrier()
#define PG8_SCHED __builtin_amdgcn_sched_barrier(0)
    Unit cur, nxt; int ui = 0;
    if (!S.next(0, cur)) return;
    f32x4 acc[2][2][4][2];
#pragma unroll
    for (int a = 0; a < 2; ++a)
#pragma unroll
        for (int b = 0; b < 2; ++b)
#pragma unroll
            for (int m = 0; m < 4; ++m)
#pragma unroll
                for (int n = 0; n < 2; ++n) acc[a][b][m][n] = (f32x4){0.f, 0.f, 0.f, 0.f};
    bf16x8 At[4][2], B0[2][2], B1[2][2];
    const char* cA = (const char*)g.A + (size_t)cur.pm * tstep; const char* cB = (const char*)g.Bt + (size_t)cur.pn * tstep;
    S.a_ready(cur);
    if constexpr (SP2) {
        PG8_STAGE(PG8_SB(0, 0), cB, voffB); PG8_STAGE(PG8_SB(0, 1), cB + hstep, voffB); PG8_STAGE(PG8_SA(0, 0), cA, voffA); PG8_STAGE(PG8_SA(0, 1), cA + hstep, voffA);
        if (wr == 1) PG8_BAR;
        PG8_WAIT_V(2); PG8_BAR;
        PG8_STAGE(PG8_SB(1, 0), cB + kstep, voffB); PG8_STAGE(PG8_SA(1, 0), cA + kstep, voffA); PG8_STAGE(PG8_SB(1, 1), cB + hstep + kstep, voffB);
        PG8_WAIT_V(6); PG8_BAR;
    } else {
        PG8_STAGE(PG8_SB(0, 0), cB, voffB); PG8_STAGE(PG8_SA(0, 0), cA, voffA); PG8_STAGE(PG8_SB(0, 1), cB + hstep, voffB); PG8_STAGE(PG8_SA(0, 1), cA + hstep, voffA);
        if (wr == 1) PG8_BAR;
        PG8_WAIT_V(4); PG8_BAR;
        PG8_STAGE(PG8_SB(1, 0), cB + kstep, voffB); PG8_STAGE(PG8_SA(1, 0), cA + kstep, voffA); PG8_STAGE(PG8_SB(1, 1), cB + hstep + kstep, voffB);
        PG8_WAIT_V(6); PG8_BAR;
    }
    for (;;) {
        const bool has_next = S.next(ui + 1, nxt);
        const char* nA = has_next ? (const char*)g.A + (size_t)nxt.pm * tstep : cA; const char* nB = has_next ? (const char*)g.Bt + (size_t)nxt.pn * tstep : cB;
        for (int t = 0; t < nt; t += 2) {
            const bool last = (t == nt - 2);
            const char* a1 = cA + (size_t)(t + 1) * kstep;
            const char* a2 = last ? nA : cA + (size_t)(t + 2) * kstep; const char* b2 = last ? nB : cB + (size_t)(t + 2) * kstep;
            const char* a3 = a2 + kstep; const char* b3 = b2 + kstep;
            if (last && has_next) S.a_ready(nxt);
            if constexpr (SP2) {
            PG8_LDB(B0, 0, 0); PG8_LDB(B1, 0, 1); PG8_SCHED; PG8_LDA(At, 0, 0); PG8_STAGE(PG8_SA(1, 1), a1 + hstep, voffA);
            PG8_WAIT_V(8); PG8_WAIT_L(0); PG8_BAR; PG8_MMA(0, 0, At, B0); PG8_MMA(0, 1, At, B1); PG8_BAR; PG8_SCHED;
            PG8_LDA(At, 0, 1); PG8_STAGE(PG8_SB(0, 0), b2, voffB); PG8_STAGE(PG8_SB(0, 1), b2 + hstep, voffB); PG8_STAGE(PG8_SA(0, 0), a2, voffA);
            PG8_WAIT_V(8); PG8_WAIT_L(0); PG8_BAR; PG8_MMA(1, 0, At, B0); PG8_MMA(1, 1, At, B1); PG8_BAR; PG8_SCHED;
            PG8_LDB(B0, 1, 0); PG8_LDB(B1, 1, 1); PG8_SCHED; PG8_LDA(At, 1, 0); PG8_STAGE(PG8_SA(0, 1), a2 + hstep, voffA);
            PG8_WAIT_V(8); PG8_WAIT_L(0); PG8_BAR; PG8_MMA(0, 0, At, B0); PG8_MMA(0, 1, At, B1); PG8_BAR; PG8_SCHED;
            PG8_LDA(At, 1, 1); PG8_STAGE(PG8_SB(1, 0), b3, voffB); PG8_STAGE(PG8_SB(1, 1), b3 + hstep, voffB); PG8_STAGE(PG8_SA(1, 0), a3, voffA);
            PG8_WAIT_V(8); PG8_WAIT_L(0); PG8_BAR; PG8_MMA(1, 0, At, B0); PG8_MMA(1, 1, At, B1); PG8_BAR; PG8_SCHED;
            } else {
            PG8_LDB(B0, 0, 0); PG8_SCHED; PG8_LDA(At, 0, 0); PG8_STAGE(PG8_SA(1, 1), a1 + hstep, voffA);
            PG8_WAIT_L(8); PG8_BAR; PG8_WAIT_L(0); PG8_MMA(0, 0, At, B0); PG8_BAR; PG8_SCHED;
            PG8_LDB(B1, 0, 1); PG8_STAGE(PG8_SB(0, 0), b2, voffB);
            PG8_BAR; PG8_WAIT_L(0); PG8_MMA(0, 1, At, B1); PG8_BAR;
            PG8_LDA(At, 0, 1); PG8_STAGE(PG8_SA(0, 0), a2, voffA);
            PG8_BAR; PG8_WAIT_L(0); PG8_MMA(1, 0, At, B0); PG8_BAR; PG8_SCHED;
            PG8_STAGE(PG8_SB(0, 1), b2 + hstep, voffB);
            PG8_WAIT_V(6); PG8_BAR; PG8_MMA(1, 1, At, B1); PG8_BAR;
            PG8_LDB(B0, 1, 0); PG8_SCHED; PG8_LDA(At, 1, 0); PG8_STAGE(PG8_SA(0, 1), a2 + hstep, voffA);
            PG8_WAIT_L(8); PG8_BAR; PG8_WAIT_L(0); PG8_MMA(0, 0, At, B0); PG8_BAR; PG8_SCHED;
            PG8_LDB(B1, 1, 1); PG8_STAGE(PG8_SB(1, 0), b3, voffB);
            PG8_BAR; PG8_WAIT_L(0); PG8_MMA(0, 1, At, B1); PG8_BAR;
            PG8_LDA(At, 1, 1); PG8_STAGE(PG8_SA(1, 0), a3, voffA);
            PG8_BAR; PG8_WAIT_L(0); PG8_MMA(1, 0, At, B0); PG8_BAR; PG8_SCHED;
            PG8_STAGE(PG8_SB(1, 1), b3 + hstep, voffB);
            PG8_WAIT_V(6); PG8_BAR; PG8_MMA(1, 1, At, B1); PG8_BAR;
            }
        }
        if constexpr (ALIGN_EPI) { if (wr == 0) PG8_BAR; }
        if constexpr (!Epi::AFTER_DRAIN) { E(acc, cur, wr, wc, fr, fq); S.done(cur); }
        if (!has_next) break;
#pragma unroll
        for (int a = 0; a < 2; ++a)
#pragma unroll
            for (int b = 0; b < 2; ++b)
#pragma unroll
                for (int m = 0; m < 4; ++m)
#pragma unroll
                    for (int n = 0; n < 2; ++n) acc[a][b][m][n] = (f32x4){0.f, 0.f, 0.f, 0.f};
        cur = nxt; cA = nA; cB = nB; ++ui;
        if constexpr (ALIGN_EPI) { if (wr == 1) PG8_BAR; }
    }
    PG8_WAIT_V(0);
    if constexpr (!ALIGN_EPI) { if (wr == 0) PG8_BAR; }
    PG8_BAR;
    if constexpr (Epi::AFTER_DRAIN) { E.fused(acc, cur, wr, wc, fr, fq, lds, wid, lane); S.done(cur); }
#undef PG8_SA
#undef PG8_SB
#undef PG8_STAGE
#undef PG8_LDA
#undef PG8_LDB
#undef PG8_MMA
#undef PG8_WAIT_V
#undef PG8_WAIT_L
#undef PG8_BAR
#undef PG8_SCHED
}
}

typedef pg8::Unit GUnit;
typedef f32x4 GAcc[2][2][4][2];
DEV u32x4 pack8(const f32x4& v0, const f32x4& v1) { u32x4 w; w.x = pg8::cvt_pk_bf16(v0[0], v0[1]); w.y = pg8::cvt_pk_bf16(v0[2], v0[3]); w.z = pg8::cvt_pk_bf16(v1[0], v1[1]); w.w = pg8::cvt_pk_bf16(v1[2], v1[3]); return w; }
DEV void unpack8(const u32x4& w, f32x4& v0, f32x4& v1) {
  v0[0] = __builtin_bit_cast(float, w.x << 16); v0[1] = __builtin_bit_cast(float, w.x & 0xffff0000u); v0[2] = __builtin_bit_cast(float, w.y << 16); v0[3] = __builtin_bit_cast(float, w.y & 0xffff0000u);
  v1[0] = __builtin_bit_cast(float, w.z << 16); v1[1] = __builtin_bit_cast(float, w.z & 0xffff0000u); v1[2] = __builtin_bit_cast(float, w.w << 16); v1[3] = __builtin_bit_cast(float, w.w & 0xffff0000u); }
DEV f32x4 sig4(const f32x4& x) { f32x4 r; UNR for (int i = 0; i < 4; ++i) r[i] = sigmoidf_(x[i]); return r; }
struct EpiIn { static constexpr bool PERM = true, AFTER_DRAIN = false; bf16_t* PROJ; float* GATES; const float* bias;
  DEVM void operator()(const GAcc& acc, const GUnit& u, int wr, int wc, int fr, int fq) const {
    const int row0 = u.pm * 256 + wr * 64 + fr;
    UNR for (int bj = 0; bj < 2; ++bj) { const int c = u.pn * 256 + bj * 128 + wc * 32 + 8 * fq;
      if (c < IN_W) { const f32x4 b0 = *(const f32x4*)(bias + c), b1 = *(const f32x4*)(bias + c + 4);
        UNR for (int ai = 0; ai < 2; ++ai) UNR for (int m = 0; m < 4; ++m) { const int row = row0 + ai * 128 + m * 16;
          const f32x4 v0 = acc[ai][bj][m][0] + b0, v1 = acc[ai][bj][m][1] + b1;
          *(u32x4*)(PROJ + (size_t)row * NP + c) = pack8(v0, v1);
          if (c >= C_GATES && c < C_GATES + 16) { float* gp = GATES + (size_t)row * 16 + (c - C_GATES); *(f32x4*)gp = v0; *(f32x4*)(gp + 4) = v1; } } } }
  } };
struct EpiBm { static constexpr bool PERM = true, AFTER_DRAIN = false; const bf16_t* PROJ; float* TMP;
  DEVM void operator()(const GAcc& acc, const GUnit& u, int wr, int wc, int fr, int fq) const {
    const int row0 = u.pm * 256 + wr * 64 + fr;
    UNR for (int bj = 0; bj < 2; ++bj) { const int c = u.pn * 256 + bj * 128 + wc * 32 + 8 * fq;
      UNR for (int ai = 0; ai < 2; ++ai) UNR for (int m = 0; m < 4; ++m) { const int row = row0 + ai * 128 + m * 16;
        f32x4 g0, g1; unpack8(*(const u32x4*)(PROJ + (size_t)row * NP + C_GM + c), g0, g1);
        float* tp = TMP + (size_t)row * D + c; *(f32x4*)tp = sig4(g0) * acc[ai][bj][m][0]; *(f32x4*)(tp + 4) = sig4(g1) * acc[ai][bj][m][1]; asm volatile("" ::: "memory"); } }
  } };
struct EpiBa { static constexpr bool PERM = true, AFTER_DRAIN = false; const bf16_t* PROJ; const float* TMP; bf16_t* MG;
  DEVM void operator()(const GAcc& acc, const GUnit& u, int wr, int wc, int fr, int fq) const {
    const int row0 = u.pm * 256 + wr * 64 + fr;
    UNR for (int bj = 0; bj < 2; ++bj) { const int c = u.pn * 256 + bj * 128 + wc * 32 + 8 * fq;
      UNR for (int ai = 0; ai < 2; ++ai) UNR for (int m = 0; m < 4; ++m) { const int row = row0 + ai * 128 + m * 16;
        f32x4 g0, g1; unpack8(*(const u32x4*)(PROJ + (size_t)row * NP + C_GA + c), g0, g1);
        const float* tp = TMP + (size_t)row * D + c;
        *(u32x4*)(MG + (size_t)row * D + c) = pack8(*(const f32x4*)tp + sig4(g0) * acc[ai][bj][m][0], *(const f32x4*)(tp + 4) + sig4(g1) * acc[ai][bj][m][1]); asm volatile("" ::: "memory"); } }
  } };
struct EpiOut { static constexpr bool PERM = true, AFTER_DRAIN = false; float* X; const float* modl;
  DEVM void operator()(const GAcc& acc, const GUnit& u, int wr, int wc, int fr, int fq) const {
    const int row0 = u.pm * 256 + wr * 64 + fr; const float* g1p = modl + (size_t)((u.pm * 256) / SEQ) * 6 * D + 2 * D;
    UNR for (int bj = 0; bj < 2; ++bj) { const int c = u.pn * 256 + bj * 128 + wc * 32 + 8 * fq;
      const f32x4 ga = *(const f32x4*)(g1p + c), gb = *(const f32x4*)(g1p + c + 4);
      UNR for (int ai = 0; ai < 2; ++ai) UNR for (int m = 0; m < 4; ++m) { float* xp = X + (size_t)(row0 + ai * 128 + m * 16) * D + c;
        *(f32x4*)xp = *(const f32x4*)xp + ga * acc[ai][bj][m][0]; *(f32x4*)(xp + 4) = *(const f32x4*)(xp + 4) + gb * acc[ai][bj][m][1];
        asm volatile("" ::: "memory"); } }
  } };
struct EpiUp { static constexpr bool PERM = false, AFTER_DRAIN = false; bf16_t* ACT; const int* slot_ent; const float* slot_w;
  DEVM void operator()(const GAcc& acc, const GUnit& u, int wr, int wc, int fr, int fq) const {
    const int ct = u.pn & 3;
    UNR for (int ai = 0; ai < 2; ++ai) UNR for (int m = 0; m < 4; ++m) { const int slot = u.pm * 256 + ai * 128 + wr * 64 + m * 16 + fr;
      if (slot_ent[slot] >= 0) { const float wt = slot_w[slot];
        UNR for (int bj = 0; bj < 2; ++bj) { const int f = (8 * ct + 4 * bj + wc) * 16 + 4 * fq; const f32x4 a = acc[ai][bj][m][0], uu = acc[ai][bj][m][1];
          u32x2 o; o.x = pg8::cvt_pk_bf16(siluf_(a[0]) * uu[0] * wt, siluf_(a[1]) * uu[1] * wt); o.y = pg8::cvt_pk_bf16(siluf_(a[2]) * uu[2] * wt, siluf_(a[3]) * uu[3] * wt);
          *(u32x2*)(ACT + (size_t)slot * FF + f) = o; } } }
  } };
struct EpiDown { static constexpr bool PERM = true, AFTER_DRAIN = false; bf16_t* Y; const int* slot_ent;
  DEVM void operator()(const GAcc& acc, const GUnit& u, int wr, int wc, int fr, int fq) const {
    const int ct = u.pn & 3;
    UNR for (int ai = 0; ai < 2; ++ai) UNR for (int m = 0; m < 4; ++m) { const int ent = slot_ent[u.pm * 256 + ai * 128 + wr * 64 + m * 16 + fr];
      if (ent >= 0) { UNR for (int bj = 0; bj < 2; ++bj) { const int c = ct * 256 + bj * 128 + wc * 32 + 8 * fq;
          *(u32x4*)(Y + (size_t)ent * D + c) = pack8(acc[ai][bj][m][0], acc[ai][bj][m][1]); } } }
  } };
struct MoeOrder { const int* pref; int nunits, G, c;
  DEVM bool next(int i, GUnit& u) const { const long idx = (long)i * G + c; if (idx >= nunits) return false; const int rt = (int)(idx >> 2), ct = (int)(idx & 3);
    int e = 0; while (pref[e + 1] <= rt) ++e; u.pm = rt; u.pn = e * 4 + ct; return true; }
  DEVM void a_ready(const GUnit&) const {}
  DEVM void done(const GUnit&) const {} };
#define GEMM_LDS ((PG8_LAS unsigned char*)dyn_lds)
DEV void phase_gemm_in(const Params& p, int l) {
  pg8::Gemm g{(const bf16_t*)(p.ws + WS_H), (const bf16_t*)(p.ws + WS_WIN), T, NP, D}; pg8::StaticOrder S; S.init(T, NP, NBLK, BID);
  EpiIn E{(bf16_t*)(p.ws + WS_PROJ), (float*)(p.ws + WS_GATES), p.b_in + (size_t)l * IN_W};
  pg8::gemm_phase<EpiIn, pg8::StaticOrder, true, true>(GEMM_LDS, g, S, E);
}
DEV void phase_gemm_merge(const Params& p) {
  { pg8::Gemm g{(const bf16_t*)(p.ws + WS_YM), (const bf16_t*)(p.ws + WS_WBM), T, D, MW}; pg8::StaticOrder S; S.init(T, D, NBLK, BID);
    EpiBm E{(const bf16_t*)(p.ws + WS_PROJ), (float*)(p.ws + WS_TMP)};
    pg8::gemm_phase<EpiBm, pg8::StaticOrder, true, true>(GEMM_LDS, g, S, E); }
  { pg8::Gemm g{(const bf16_t*)(p.ws + WS_YA), (const bf16_t*)(p.ws + WS_WBA), T, D, AW}; pg8::StaticOrder S; S.init(T, D, NBLK, BID);
    EpiBa E{(const bf16_t*)(p.ws + WS_PROJ), (const float*)(p.ws + WS_TMP), (bf16_t*)(p.ws + WS_MERGED)};
    pg8::gemm_phase<EpiBa, pg8::StaticOrder, true, true>(GEMM_LDS, g, S, E); }
}
DEV void phase_gemm_out(const Params& p, int l) {
  pg8::Gemm g{(const bf16_t*)(p.ws + WS_MERGED), (const bf16_t*)(p.ws + WS_WOUT), T, D, D}; pg8::StaticOrder S; S.init(T, D, NBLK, BID);
  EpiOut E{p.out, (const float*)(p.ws + WS_MOD) + (size_t)l * BATCH * 6 * D};
  pg8::gemm_phase<EpiOut, pg8::StaticOrder, true, true>(GEMM_LDS, g, S, E);
}
DEV void phase_moe_up(const Params& p, int l) {
  int* s_pref = (int*)(LDS_PTR() + LDS_PHASE_BYTES + 64);
  moe_tiles(p, l, s_pref);
  pg8::Gemm g{(const bf16_t*)(p.ws + WS_HS), (const bf16_t*)(p.ws + WS_WGU), SLOT_ROWS, NE * 2 * FF, D};
  MoeOrder S{s_pref, s_pref[NE] * 4, NBLK, BID};
  EpiUp E{(bf16_t*)(p.ws + WS_ACT), (const int*)(p.ws + WS_SLOT_ENT), (const float*)(p.ws + WS_SLOT_W)};
  pg8::gemm_phase<EpiUp, MoeOrder, true, true>(GEMM_LDS, g, S, E);
}
DEV void phase_moe_down(const Params& p, int l) {
  int* s_pref = (int*)(LDS_PTR() + LDS_PHASE_BYTES + 64);
  moe_tiles(p, l, s_pref);
  pg8::Gemm g{(const bf16_t*)(p.ws + WS_ACT), (const bf16_t*)(p.ws + WS_WD), SLOT_ROWS, NE * D, FF};
  MoeOrder S{s_pref, s_pref[NE] * 4, NBLK, BID};
  EpiDown E{(bf16_t*)(p.ws + WS_Y), (const int*)(p.ws + WS_SLOT_ENT)};
  pg8::gemm_phase<EpiDown, MoeOrder, true, true>(GEMM_LDS, g, S, E);
}
#endif
DEV void phase_prep(const Params& p, int l) {
  const bf16_t* PROJ = (const bf16_t*)(p.ws + WS_PROJ);
  bf16_t* QC = (bf16_t*)(p.ws + WS_QC); bf16_t* KC = (bf16_t*)(p.ws + WS_KC);
  const int gtid = BID * NTHREADS + TID, gstride = NBLK * NTHREADS;
  const float* cw = p.conv_w + (size_t)l * CONVW * 2 * MW; const float* cb = p.conv_b + (size_t)l * 2 * MW;
  for (int it = gtid; it < T * 128; it += gstride) {
    const int t = it >> 7, c8 = (it & 127) * 8, s = t % SEQ;
    float a[8]; UNR for (int j = 0; j < 8; ++j) a[j] = cb[c8 + j];
    UNR for (int wi = 0; wi < CONVW; ++wi) { const int ss = s + wi - 2; if (ss < 0 || ss >= SEQ) continue;
      const bf16x8 v = ld8(PROJ + (size_t)(t + wi - 2) * NP + c8);
      UNR for (int j = 0; j < 8; ++j) a[j] += bf2f((bf16_t)v[j]) * cw[wi * 2 * MW + c8 + j]; }
    const float sc = (c8 < MW) ? 0.08838834764831845f : 1.f;
    u32x4 o; o.x = pk2(siluf_(a[0]) * sc, siluf_(a[1]) * sc); o.y = pk2(siluf_(a[2]) * sc, siluf_(a[3]) * sc); o.z = pk2(siluf_(a[4]) * sc, siluf_(a[5]) * sc); o.w = pk2(siluf_(a[6]) * sc, siluf_(a[7]) * sc);
    if (c8 < MW) *(u32x4*)(QC + (size_t)t * MW + c8) = o; else *(u32x4*)(KC + (size_t)t * MW + c8 - MW) = o;
  }
  bf16_t* AQN = (bf16_t*)(p.ws + WS_AQN); bf16_t* AKN = (bf16_t*)(p.ws + WS_AKN); bf16_t* VT = (bf16_t*)(p.ws + WS_VT);
  const float* rope = (const float*)(p.ws + WS_ROPE); constexpr int NR = SEQ / GRID_W;
  for (int it0 = BID * NTHREADS; it0 < T * 10 * 8; it0 += gstride) {
    const int it = it0 + TID, j = it & 7, th = it >> 3, hh = th / T, t = th % T, s = t % SEQ;
    const bool isq = hh < AH;
    const bf16_t* src = PROJ + (size_t)t * NP + (isq ? C_AQ + hh * 64 : C_AK + (hh - AH) * 64) + j * 8;
    const float* g = (isq ? p.q_norm_g : p.k_norm_g) + (size_t)l * AHD + j * 8;
    const bf16x8 x8 = ld8(src);
    float v[8], pr[8]; float ss = 0.f;
#pragma unroll
    for (int k = 0; k < 8; ++k) { v[k] = bf2f((bf16_t)x8[k]); ss += v[k] * v[k]; }
    ss += shfl_xor_f(ss, 1); ss += shfl_xor_f(ss, 2); ss += shfl_xor_f(ss, 4);
    const float rs = 1.f / sqrtf(ss * (1.f / 64.f) + EPS);
#pragma unroll
    for (int k = 0; k < 8; ++k) v[k] = v[k] * rs * g[k];
#pragma unroll
    for (int k = 0; k < 8; ++k) pr[k] = shfl_xor_f(v[k], 2);
    const int pos = (j < 4) ? s / GRID_W : s % GRID_W;
    const float* ct = rope + (j < 4 ? 0 : 2 * NR * 16) + pos * 16 + (j & 1) * 8;
    const float* st = ct + (j < 4 ? NR * 16 : 64 * 16);
    const float sgn = (j & 2) ? 1.f : -1.f, qs = isq ? 0.125f * 1.4426950408889634f : 1.f;
    float o[8];
#pragma unroll
    for (int k = 0; k < 8; ++k) o[k] = (v[k] * ct[k] + sgn * pr[k] * st[k]) * qs;
    u32x4 w4; w4.x = pk2(o[0], o[1]); w4.y = pk2(o[2], o[3]); w4.z = pk2(o[4], o[5]); w4.w = pk2(o[6], o[7]);
    bf16_t* dst = isq ? AQN + (size_t)t * AW + hh * 64 + j * 8 : AKN + (size_t)t * KVW + (hh - AH) * 64 + j * 8;
    *(u32x4*)dst = w4;
  }
#ifdef EMU
  for (int it = gtid; it < T * KVH * 8; it += gstride) {
    const int s = it % SEQ, d8 = (it / SEQ) & 7, bk = it / (SEQ * 8), b = bk / KVH, kv = bk % KVH;
    const bf16x8 v8 = ld8(PROJ + (size_t)(b * SEQ + s) * NP + C_AV + kv * 64 + d8 * 8);
#pragma unroll
    for (int k = 0; k < 8; ++k) VT[((size_t)bk * 64 + d8 * 8 + k) * SEQ + s] = (bf16_t)v8[k];
  }
#else
  (void)VT;
#endif
}

#ifdef EMU
DEV void phase_attn(const Params& p) {
  char* lds = LDS_PTR();
  bf16_t* Ks = (bf16_t*)lds; bf16_t* Vs = Ks + 64 * GP; bf16_t* Ps = Vs + 64 * GP;
  const bf16_t* AQN = (const bf16_t*)(p.ws + WS_AQN); const bf16_t* AKN = (const bf16_t*)(p.ws + WS_AKN); const bf16_t* VT = (const bf16_t*)(p.ws + WS_VT);
  bf16_t* YA = (bf16_t*)(p.ws + WS_YA);
  const int tid = TID, lane = tid & 63, w = tid >> 6;
  constexpr int NQB = SEQ / 128, NU = BATCH * AH * NQB;
  bf16_t* Pw = Ps + w * 16 * GP;
  for (int u = BID; u < NU; u += NBLK) {
    const int qb = u % NQB, h = (u / NQB) % AH, b = u / (NQB * AH), kv = h / (AH / KVH);
    const int r0 = qb * 128 + w * 16;
    bf16x8 qa[2];
    UNR for (int ks = 0; ks < 2; ++ks) qa[ks] = ld8(AQN + (size_t)(b * SEQ + r0 + (lane & 15)) * AW + h * 64 + ks * 32 + (lane >> 4) * 8);
    f32x4 o[4]; UNR for (int i = 0; i < 4; ++i) o[i] = (f32x4){0.f, 0.f, 0.f, 0.f};
    float mrow[4], lrow[4]; UNR for (int i = 0; i < 4; ++i) { mrow[i] = -3.0e38f; lrow[i] = 0.f; }
    for (int kt = 0; kt < SEQ / 64; ++kt) {
      SYNC();
      { const int r = tid >> 3, pc = (tid & 7) * 8;
        *(u32x4*)(Ks + r * GP + pc) = *(const u32x4*)(AKN + (size_t)(b * SEQ + kt * 64 + r) * KVW + kv * 64 + pc);
        *(u32x4*)(Vs + r * GP + pc) = *(const u32x4*)(VT + ((size_t)(b * KVH + kv) * 64 + r) * SEQ + kt * 64 + pc); }
      SYNC();
      f32x4 s[4];
      UNR for (int nt = 0; nt < 4; ++nt) { s[nt] = (f32x4){0.f, 0.f, 0.f, 0.f};
        UNR for (int ks = 0; ks < 2; ++ks) s[nt] = mfma16(qa[ks], ld8(Ks + (nt * 16 + (lane & 15)) * GP + ks * 32 + (lane >> 4) * 8), s[nt]); }
      UNR for (int i = 0; i < 4; ++i) {
        float mx = fmaxf(fmaxf(s[0][i], s[1][i]), fmaxf(s[2][i], s[3][i])); mx = grp16_max(mx);
        const float mnew = fmaxf(mrow[i], mx), alpha = exp2f(mrow[i] - mnew); mrow[i] = mnew;
        float rsum = 0.f;
        UNR for (int nt = 0; nt < 4; ++nt) { const float pv = exp2f(s[nt][i] - mnew); rsum += pv; Pw[((lane >> 4) * 4 + i) * GP + nt * 16 + (lane & 15)] = f2bf(pv); }
        lrow[i] = lrow[i] * alpha + rsum;
        UNR for (int nd = 0; nd < 4; ++nd) o[nd][i] *= alpha;
      }
      SYNC();
      UNR for (int ks = 0; ks < 2; ++ks) { const bf16x8 pa = ld8(Pw + (lane & 15) * GP + ks * 32 + (lane >> 4) * 8);
        UNR for (int nd = 0; nd < 4; ++nd) o[nd] = mfma16(pa, ld8(Vs + (nd * 16 + (lane & 15)) * GP + ks * 32 + (lane >> 4) * 8), o[nd]); }
    }
    UNR for (int i = 0; i < 4; ++i) { const float lt = grp16_sum(lrow[i]), inv = 1.f / lt; const int row = b * SEQ + r0 + (lane >> 4) * 4 + i;
      UNR for (int nd = 0; nd < 4; ++nd) YA[(size_t)row * AW + h * 64 + nd * 16 + (lane & 15)] = f2bf(o[nd][i] * inv); }
  }
}

#else
namespace attn_body {
using bf16=unsigned short;
using bf16x8=__attribute__((ext_vector_type(8)))short;
using s16x4=__attribute__((ext_vector_type(4)))short;
using f32x16=__attribute__((ext_vector_type(16)))float;
using u32x4=__attribute__((ext_vector_type(4)))unsigned;
constexpr int SEQ=::SEQ,D=64;
constexpr int NW=8,QBLK=32,QB=QBLK*NW,KVBLK=64,NQB=SEQ/QB;
constexpr int ATTN_UNIT_ROWS=QB;
__device__ __forceinline__ int crow(int r,int hi){return (r&3)+8*(r>>2)+4*hi;}
#define SBAR() __builtin_amdgcn_sched_barrier(0)
constexpr int NSLOT=3, SLOTB=8192;
constexpr int LDS_K=0, LDS_V=NSLOT*SLOTB, LDS_WS=2*NSLOT*SLOTB, LDS_OST=LDS_WS+NW*64*4, LDS_BYTES=LDS_OST+NW*4096;
constexpr float C2=0.125f*1.4426950408889634f;
__device__ __forceinline__ void glds16(const void*gsrc,unsigned lds_dst){unsigned keep;
  asm volatile("s_mov_b32 %0, m0\n\ts_mov_b32 m0, %2\n\ts_nop 0\n\tglobal_load_lds_dwordx4 %1, off\n\ts_mov_b32 m0, %0":"=&s"(keep):"v"(gsrc),"s"(lds_dst):"memory");}
__device__ __forceinline__ float max3f(float a,float b,float c){float r;asm("v_max3_f32 %0, %1, %2, %3":"=v"(r):"v"(a),"v"(b),"v"(c));return r;}
__device__ __forceinline__ float max2f(float a,float b){float r;asm("v_max_f32_e32 %0, %1, %2":"=v"(r):"v"(a),"v"(b));return r;}
__device__ __forceinline__ float fadd_s(float a,float b){float r;asm("v_add_f32_e32 %0, %1, %2":"=v"(r):"v"(a),"v"(b));return r;}
__device__ __forceinline__ float fsub_s(float a,float b){float r;asm("v_sub_f32_e32 %0, %1, %2":"=v"(r):"v"(a),"v"(b));return r;}
typedef float f32x2_t __attribute__((ext_vector_type(2))); typedef __bf16 bf16x2_t __attribute__((ext_vector_type(2)));
__device__ __forceinline__ unsigned cvtpk_s(float lo,float hi){f32x2_t v={lo,hi};bf16x2_t b=__builtin_convertvector(v,bf16x2_t);return __builtin_bit_cast(unsigned,b);}
#define WAIT_BAR(N) asm volatile("s_waitcnt vmcnt(" #N ") lgkmcnt(0)\n\ts_barrier":::"memory")

__device__ __forceinline__ void qkt(f32x16&p0,f32x16&p1,const char*Kslot,const bf16x8*qr,const f32x16&negm,int r32,int hi){
  const char*kb=Kslot+hi*1024+r32*16;
  #pragma unroll
  for(int d0=0;d0<4;++d0){
    const bf16x8 b0=*reinterpret_cast<const bf16x8*>(kb+d0*2048);
    const bf16x8 b1=*reinterpret_cast<const bf16x8*>(kb+d0*2048+512);
    if(d0==0){p0=__builtin_amdgcn_mfma_f32_32x32x16_bf16(b0,qr[0],negm,0,0,0);p1=__builtin_amdgcn_mfma_f32_32x32x16_bf16(b1,qr[0],negm,0,0,0);}
    else{p0=__builtin_amdgcn_mfma_f32_32x32x16_bf16(b0,qr[d0],p0,0,0,0);p1=__builtin_amdgcn_mfma_f32_32x32x16_bf16(b1,qr[d0],p1,0,0,0);}}
}
typedef __attribute__((address_space(3))) const char* lds_cptr;
typedef short v4i16_t __attribute__((ext_vector_type(4)));
__device__ __forceinline__ void kload8(bf16x8*kf,lds_cptr kp){
  kf[0]=*(const __attribute__((address_space(3))) bf16x8*)(kp);      kf[1]=*(const __attribute__((address_space(3))) bf16x8*)(kp+512);
  kf[2]=*(const __attribute__((address_space(3))) bf16x8*)(kp+2048); kf[3]=*(const __attribute__((address_space(3))) bf16x8*)(kp+2560);
  kf[4]=*(const __attribute__((address_space(3))) bf16x8*)(kp+4096); kf[5]=*(const __attribute__((address_space(3))) bf16x8*)(kp+4608);
  kf[6]=*(const __attribute__((address_space(3))) bf16x8*)(kp+6144); kf[7]=*(const __attribute__((address_space(3))) bf16x8*)(kp+6656);
}
__device__ __forceinline__ void kload2(bf16x8*kf,lds_cptr kp,int j){ kf[2*j]=*(const __attribute__((address_space(3))) bf16x8*)(kp+j*2048); kf[2*j+1]=*(const __attribute__((address_space(3))) bf16x8*)(kp+j*2048+512); }
__device__ __forceinline__ s16x4 vtr(lds_cptr p){ return __builtin_bit_cast(s16x4,__builtin_amdgcn_ds_read_tr16_b64_v4i16((__attribute__((address_space(3))) v4i16_t*)p)); }
__device__ __forceinline__ float rowmax(const f32x16&p0,const f32x16&p1){
  float a=max3f(p0[0],p0[1],p1[0]),b=max3f(p0[2],p0[3],p1[1]);a=max3f(a,p1[2],p1[3]);
  #pragma unroll
  for(int r=4;r<16;r+=4){a=max3f(a,p0[r],p0[r+1]);b=max3f(b,p0[r+2],p0[r+3]);a=max3f(a,p1[r],p1[r+1]);b=max3f(b,p1[r+2],p1[r+3]);}
  const float m=max2f(a,b);
  auto rr=__builtin_amdgcn_permlane32_swap(__float_as_uint(m),__float_as_uint(m),false,false);
  return max2f(__uint_as_float(rr[0]),__uint_as_float(rr[1]));
}
__device__ __forceinline__ void pv(f32x16*o,int vb,bf16x8 pa0,bf16x8 pa1,bf16x8 pa2,bf16x8 pa3){
  #pragma unroll
  for(int d0=0;d0<2;++d0){s16x4 lo[4],hi[4];
    #pragma unroll
    for(int ks=0;ks<4;++ks){
      asm volatile("ds_read_b64_tr_b16 %0,%1 offset:%c2":"=&v"(lo[ks]):"v"(vb),"i"(d0*4096+ks*1024):"memory");
      asm volatile("ds_read_b64_tr_b16 %0,%1 offset:%c2":"=&v"(hi[ks]):"v"(vb),"i"(d0*4096+ks*1024+512):"memory");}
    asm volatile("s_waitcnt lgkmcnt(0)":::"memory");SBAR();
    #define PK(k) (bf16x8){lo[k][0],lo[k][1],lo[k][2],lo[k][3],hi[k][0],hi[k][1],hi[k][2],hi[k][3]}
    o[d0]=__builtin_amdgcn_mfma_f32_32x32x16_bf16(pa0,PK(0),o[d0],0,0,0);
    o[d0]=__builtin_amdgcn_mfma_f32_32x32x16_bf16(pa1,PK(1),o[d0],0,0,0);
    o[d0]=__builtin_amdgcn_mfma_f32_32x32x16_bf16(pa2,PK(2),o[d0],0,0,0);
    o[d0]=__builtin_amdgcn_mfma_f32_32x32x16_bf16(pa3,PK(3),o[d0],0,0,0);
    #undef PK
  }
}

#ifndef ATTN_STORE16
#define ATTN_STORE16(p,v) (*(u32x4*)(p)=(v))
#endif
template<int THRL,int QP,int KP,int VP> __device__ __forceinline__ void attn_unit(long rowbase,int qb,const bf16*Q,const bf16*__restrict__ K,const bf16*__restrict__ V,bf16*O,char*shm){
  const int tid=TID,lane=tid&63,r32=lane&31,hi=lane>>5; const int wid=__builtin_amdgcn_readfirstlane(tid>>6);
  const int q0=qb*QB;
  const bf16*Qw=Q+(rowbase+q0+wid*QBLK)*QP;
  const bf16*Kh=K+rowbase*KP,*Vh=V+rowbase*VP;
  const unsigned lds0=(unsigned)(uintptr_t)shm;
  float*wsf=(float*)(shm+LDS_WS)+wid*64;
  const bf16*ksrc=Kh+(long)lane*KP+wid*8;
  const bf16*vsrc=Vh+(long)(16*(wid&3)+(lane>>2))*VP+(wid>>2)*32+(lane&3)*8;
  const unsigned kdst=lds0+LDS_K+wid*1024, vdst=lds0+LDS_V+wid*1024;
  #define DMA_K(t,slot) glds16(ksrc+(long)(t)*KVBLK*KP,(unsigned)__builtin_amdgcn_readfirstlane(kdst+(slot)))
  #define DMA_V(t,slot) glds16(vsrc+(long)(t)*KVBLK*VP,(unsigned)__builtin_amdgcn_readfirstlane(vdst+(slot)))
  const int vb0=(int)(lds0+LDS_V)+((lane>>4)&1)*32+(lane&3)*8+(4*hi+((lane&15)>>2))*64;
  const char*Kbase=shm+LDS_K; bf16x8 kf[8];
  const lds_cptr shm3=(lds_cptr)shm; const lds_cptr kp0=shm3+LDS_K+hi*1024+r32*16; const lds_cptr vp0=shm3+LDS_V+((lane>>4)&1)*32+(lane&3)*8+(4*hi+((lane&15)>>2))*64;
  int NT=SEQ/KVBLK; asm volatile("":"+s"(NT));
  DMA_K(0,0);DMA_V(0,0);DMA_K(1,SLOTB);
  bf16x8 qr[4];
  #pragma unroll
  for(int d0=0;d0<4;++d0)qr[d0]=*reinterpret_cast<const bf16x8*>(&Qw[(long)r32*QP+d0*16+hi*8]);
  float mhat=0.f,l_reg=0.f;f32x16 o[2];o[0]=f32x16{};o[1]=f32x16{};f32x16 negm=f32x16{};asm volatile("":"+v"(negm));
  #define CMASK(P0,P1,t) do{}while(0)
  bool resc=false;
  #define START(P0,P1) do{ const float rm=rowmax(P0,P1); resc=false; \
    { const float dl=rm; mhat=fadd_s(mhat,dl); \
      _Pragma("unroll") for(int r=0;r<16;++r){P0[r]=fsub_s(P0[r],dl);P1[r]=fsub_s(P1[r],dl);} \
      _Pragma("unroll") for(int r=0;r<16;++r)negm[r]=-mhat; asm volatile("":"+v"(negm)); } \
    _Pragma("unroll") for(int r=0;r<16;++r)P0[r]=__builtin_amdgcn_exp2f(P0[r]); }while(0)
  #define RESC() do{ if(resc){ asm volatile("s_waitcnt lgkmcnt(0)":::"memory"); \
      _Pragma("unroll") for(int d_=0;d_<2;++d_) _Pragma("unroll") for(int r=0;r<16;++r)o[d_][r]*=wsf[crow(r,hi)]; } }while(0)
  f32x16 pA0,pA1,pB0,pB1;
  int sl_prev=0,sl_cur=0,sl_next=SLOTB;
  #define ROT() do{sl_prev=sl_cur;sl_cur=sl_next;sl_next=(sl_next==(NSLOT-1)*SLOTB)?0:sl_next+SLOTB;}while(0)
  DMA_K(2,2*SLOTB);
  WAIT_BAR(3);
  qkt(pA0,pA1,Kbase,qr,negm,r32,hi);asm volatile("s_nop 15\n\ts_nop 7":"+v"(pA0),"+v"(pA1));CMASK(pA0,pA1,0);
  START(pA0,pA1);
  _Pragma("unroll") for(int r=0;r<16;++r)pA1[r]=__builtin_amdgcn_exp2f(pA1[r]);
  WAIT_BAR(0);
  DMA_K(3,0);DMA_V(1,SLOTB);
  ROT();
  kload8(kf,kp0+sl_cur);
  WAIT_BAR(2);
  s16x4 vlo[8],vhi[8]; u32x4 pw0,pw1,pw2,pw3;
  #define PKW(P,B) cvtpk_s(P[B],P[B+1])
  #define PAF(k) __builtin_bit_cast(bf16x8,pw##k)
  #define VFR(i) (bf16x8){vlo[i][0],vlo[i][1],vlo[i][2],vlo[i][3],vhi[i][0],vhi[i][1],vhi[i][2],vhi[i][3]}
  #define PIN(x) asm volatile("":"+v"(x))
  #define MX3(a,b,c) __builtin_fmaxf(__builtin_fmaxf((a),(b)),(c))
  #define GAPA(MF,A0,A1,A2,A3,W0,W1,PW) do{ MF; sacc+=A0; sacc+=A1; sacc+=A2; sacc+=A3; PIN(sacc); W0; W1; PIN(PW); SBAR(); }while(0)
  #define EX(v) __builtin_amdgcn_exp2f(v)
  #define GAPB(MF,X,B) do{ MF; X[B]=EX(X[B]); X[B+1]=EX(X[B+1]); X[B+2]=EX(X[B+2]); X[B+3]=EX(X[B+3]); PIN(X); SBAR(); }while(0)
  #define VRD(i) do{ vlo[i]=vtr(vp_+(((i)>>2)*4096+((i)&3)*1024)); vhi[i]=vtr(vp_+(((i)>>2)*4096+((i)&3)*1024+512)); }while(0)
  #define KRD(G,j) do{ if(G){ kload2(kf,kp0+sl_next,j); SBAR(); } }while(0)
  #define STEP(C0,C1,P0,P1,t,GK,GV,GL) do{ SBAR(); \
    const lds_cptr vp_=vp0+sl_prev; \
    VRD(0); SBAR(); float sacc=(P0[0]+P0[1]); \
    GAPA(C0=__builtin_amdgcn_mfma_f32_32x32x16_bf16(kf[0],qr[0],negm,0,0,0), P0[2],P0[3],P0[4],P0[5],     pw0[0]=PKW(P0,0), pw0[1]=PKW(P0,2), pw0); \
    VRD(4); SBAR(); GAPA(C1=__builtin_amdgcn_mfma_f32_32x32x16_bf16(kf[1],qr[0],negm,0,0,0), P0[6],P0[7],P0[8],P0[9],     pw0[2]=PKW(P0,4), pw0[3]=PKW(P0,6), pw0); \
    VRD(1); SBAR(); GAPA(C0=__builtin_amdgcn_mfma_f32_32x32x16_bf16(kf[2],qr[1],C0,0,0,0),   P0[10],P0[11],P0[12],P0[13], pw1[0]=PKW(P0,8), pw1[1]=PKW(P0,10), pw1); \
    VRD(5); SBAR(); GAPA(C1=__builtin_amdgcn_mfma_f32_32x32x16_bf16(kf[3],qr[1],C1,0,0,0),   P0[14],P0[15],P1[0],P1[1],   pw1[2]=PKW(P0,12),pw1[3]=PKW(P0,14), pw1); \
    VRD(2); SBAR(); GAPA(C0=__builtin_amdgcn_mfma_f32_32x32x16_bf16(kf[4],qr[2],C0,0,0,0),   P1[2],P1[3],P1[4],P1[5],     pw2[0]=PKW(P1,0), pw2[1]=PKW(P1,2), pw2); \
    VRD(6); SBAR(); GAPA(C1=__builtin_amdgcn_mfma_f32_32x32x16_bf16(kf[5],qr[2],C1,0,0,0),   P1[6],P1[7],P1[8],P1[9],     pw2[2]=PKW(P1,4), pw2[3]=PKW(P1,6), pw2); \
    VRD(3); SBAR(); GAPA(C0=__builtin_amdgcn_mfma_f32_32x32x16_bf16(kf[6],qr[3],C0,0,0,0),   P1[10],P1[11],P1[12],P1[13], pw3[0]=PKW(P1,8), pw3[1]=PKW(P1,10), pw3); \
    VRD(7); SBAR(); GAPA(C1=__builtin_amdgcn_mfma_f32_32x32x16_bf16(kf[7],qr[3],C1,0,0,0),   P1[14],P1[15],0.f,0.f,       pw3[2]=PKW(P1,12),pw3[3]=PKW(P1,14), pw3); \
    l_reg+=sacc; \
    if(GK){DMA_K((t)+3,sl_cur);} if(GV){DMA_V((t)+1,sl_next);} \
    CMASK(C0,C1,t); \
    { float a=MX3(C0[0],C0[1],C1[0]),b=MX3(C0[2],C0[3],C1[1]); a=MX3(a,C1[2],C1[3]); \
      _Pragma("unroll") for(int r=4;r<16;r+=4){a=MX3(a,C0[r],C0[r+1]);b=MX3(b,C0[r+2],C0[r+3]);a=MX3(a,C1[r],C1[r+1]);b=MX3(b,C1[r+2],C1[r+3]);} \
      float rm=__builtin_fmaxf(a,b); { auto rr=__builtin_amdgcn_permlane32_swap(__float_as_uint(rm),__float_as_uint(rm),false,false); rm=__builtin_fmaxf(__uint_as_float(rr[0]),__uint_as_float(rr[1])); } \
      resc=false; \
      if(__builtin_expect(__any(rm>(float)THRL),0)){ const float dl=__builtin_fmaxf(rm,0.f); mhat+=dl; \
        _Pragma("unroll") for(int r=0;r<16;++r){C0[r]-=dl;C1[r]-=dl;} \
        _Pragma("unroll") for(int r=0;r<16;++r)negm[r]=-mhat; asm volatile("":"+v"(negm)); \
        const float f=__builtin_amdgcn_exp2f(-dl); l_reg*=f; if(hi==0)wsf[r32]=f; resc=true; } } \
    SBAR(); \
    GAPB(o[0]=__builtin_amdgcn_mfma_f32_32x32x16_bf16(PAF(0),VFR(0),o[0],0,0,0), C0,0); \
    GAPB(o[1]=__builtin_amdgcn_mfma_f32_32x32x16_bf16(PAF(0),VFR(4),o[1],0,0,0), C0,4); \
    KRD(GL,0); GAPB(o[0]=__builtin_amdgcn_mfma_f32_32x32x16_bf16(PAF(1),VFR(1),o[0],0,0,0), C0,8); \
    KRD(GL,1); GAPB(o[1]=__builtin_amdgcn_mfma_f32_32x32x16_bf16(PAF(1),VFR(5),o[1],0,0,0), C0,12); \
    KRD(GL,2); GAPB(o[0]=__builtin_amdgcn_mfma_f32_32x32x16_bf16(PAF(2),VFR(2),o[0],0,0,0), C1,0); \
    KRD(GL,3); GAPB(o[1]=__builtin_amdgcn_mfma_f32_32x32x16_bf16(PAF(2),VFR(6),o[1],0,0,0), C1,4); \
    GAPB(o[0]=__builtin_amdgcn_mfma_f32_32x32x16_bf16(PAF(3),VFR(3),o[0],0,0,0), C1,8); \
    GAPB(o[1]=__builtin_amdgcn_mfma_f32_32x32x16_bf16(PAF(3),VFR(7),o[1],0,0,0), C1,12); \
    }while(0)
  int t=1;
  for(;t+5<NT;t+=2){
    STEP(pB0,pB1,pA0,pA1,t,true,true,true);     WAIT_BAR(2); RESC(); ROT();
    STEP(pA0,pA1,pB0,pB1,t+1,true,true,true);   WAIT_BAR(2); RESC(); ROT();
  }
  #define ENDW(tt) do{ if((tt)+3<NT){WAIT_BAR(2);} else if((tt)+2<NT){WAIT_BAR(1);} else {WAIT_BAR(0);} }while(0)
  for(;t+1<NT;t+=2){
    STEP(pB0,pB1,pA0,pA1,t,(t+3<NT),(t+1<NT),(t+1<NT));       ENDW(t);   RESC(); ROT();
    STEP(pA0,pA1,pB0,pB1,t+1,(t+4<NT),(t+2<NT),(t+2<NT));     ENDW(t+1); RESC(); ROT();
  }
  STEP(pB0,pB1,pA0,pA1,NT-1,false,false,false); RESC();
  { float sacc=pB0[0]+pB0[1]; _Pragma("unroll") for(int r=2;r<16;++r)sacc+=pB0[r]; _Pragma("unroll") for(int r=0;r<16;++r)sacc+=pB1[r]; l_reg+=sacc;
    pw0=(u32x4){PKW(pB0,0),PKW(pB0,2),PKW(pB0,4),PKW(pB0,6)};pw1=(u32x4){PKW(pB0,8),PKW(pB0,10),PKW(pB0,12),PKW(pB0,14)};pw2=(u32x4){PKW(pB1,0),PKW(pB1,2),PKW(pB1,4),PKW(pB1,6)};pw3=(u32x4){PKW(pB1,8),PKW(pB1,10),PKW(pB1,12),PKW(pB1,14)};
    SBAR(); pv(o,vb0+sl_cur,PAF(0),PAF(1),PAF(2),PAF(3)); }
  #undef PKW
  #undef PAF
  #undef VFR
  #undef PIN
  #undef MX3
  #undef GAPA
  #undef GAPB
  #undef EX
  #undef VRD
  #undef KRD
  #undef STEP
  #undef ENDW
  {auto rr=__builtin_amdgcn_permlane32_swap(__float_as_uint(l_reg),__float_as_uint(l_reg),false,false);l_reg=__uint_as_float(rr[0])+__uint_as_float(rr[1]);}
  if(hi==0)wsf[32+r32]=l_reg;asm volatile("s_waitcnt lgkmcnt(0)":::"memory");
  float rli[16];
  #pragma unroll
  for(int r=0;r<16;++r)rli[r]=__builtin_amdgcn_rcpf(wsf[32+crow(r,hi)]);
  bf16*Ow=O+(rowbase+q0+wid*QBLK)*QP;
  { bf16*stg=(bf16*)(shm+LDS_OST)+wid*2048;
    #pragma unroll
    for(int r=0;r<16;++r){const int orow=crow(r,hi);
      #pragma unroll
      for(int d0=0;d0<2;++d0)stg[orow*64+d0*32+r32]=f2bf(o[d0][r]*rli[r]);}
    asm volatile("s_waitcnt lgkmcnt(0)":::"memory");
    #pragma unroll
    for(int i=0;i<4;++i){const int row=i*8+(lane>>3),ch=lane&7; const u32x4 v=*(const u32x4*)(stg+row*64+ch*8); ATTN_STORE16(Ow+(long)row*QP+ch*8,v);} }
  asm volatile("s_waitcnt lgkmcnt(0)\n\ts_barrier":::"memory");
  #undef DMA_K
  #undef DMA_V
  #undef CMASK
  #undef START
  #undef RESC
  #undef ROT
}
#undef SBAR
#undef WAIT_BAR
}

DEV void phase_attn(const Params& p) {
  char* lds = LDS_PTR();
  const bf16_t* AQN = (const bf16_t*)(p.ws + WS_AQN); const bf16_t* AKN = (const bf16_t*)(p.ws + WS_AKN); const bf16_t* PROJ = (const bf16_t*)(p.ws + WS_PROJ);
  bf16_t* YA = (bf16_t*)(p.ws + WS_YA);
  constexpr int NQB = SEQ / 256, NU = BATCH * AH * NQB;
  for (int u = BID; u < NU; u += NBLK) {
    const int qb = u % NQB, h = (u / NQB) % AH, b = u / (NQB * AH), kv = h / (AH / KVH);
    attn_body::attn_unit<8, AW, KVW, NP>((long)b * SEQ, qb, AQN + h * 64, AKN + kv * 64, PROJ + C_AV + kv * 64, YA + h * 64, lds);
  }
}
#endif
DEV void phase_mlstm_a(const Params& p) {
  char* lds = LDS_PTR();
  bf16_t* VW = (bf16_t*)lds;
  bf16_t* KT = VW + 2 * 128 * GP;
  float* sc = (float*)(KT + 128 * GP);
  float* s_lf = sc; float* s_a = sc + 128; float* s_w = sc + 256;
  const bf16_t* PROJ = (const bf16_t*)(p.ws + WS_PROJ); const bf16_t* KC = (const bf16_t*)(p.ws + WS_KC); const float* GATES = (const float*)(p.ws + WS_GATES);
  bf16_t* CST = (bf16_t*)(p.ws + WS_CST); float* NST = (float*)(p.ws + WS_NST); float* AMAX = (float*)(p.ws + WS_AMAX); float* BLAST = (float*)(p.ws + WS_BLAST);
  const int tid = TID, lane = tid & 63, w = tid >> 6;
  for (int u = BID; u < BHC; u += NBLK) {
    const int c = u % NC, h = (u / NC) % MH, b = u / (NC * MH);
    const int t0 = b * SEQ + c * ML;
    SYNC();
    if (tid < 128) { const int dir = tid >> 6, l = tid & 63; s_lf[dir * 64 + l] = logsigmoidf_(GATES[(size_t)(t0 + l) * 16 + (dir ? 12 : 4) + h]); }
    SYNC();
    if (tid < 128) { const int dir = tid >> 6, l = tid & 63; const float li = GATES[(size_t)(t0 + l) * 16 + (dir ? 8 : 0) + h];
      float a = li;
      if (dir == 0) { for (int q = l + 1; q < 64; ++q) a += s_lf[q]; } else { for (int q = 0; q < l; ++q) a += s_lf[64 + q]; }
      s_a[dir * 64 + l] = a; }
    SYNC();
    if (tid < 128) { const int dir = tid >> 6, l = tid & 63; float mx = -3.0e38f, tot = 0.f;
      for (int q = 0; q < 64; ++q) { mx = fmaxf(mx, s_a[dir * 64 + q]); tot += s_lf[dir * 64 + q]; }
      s_w[dir * 64 + l] = expf(s_a[dir * 64 + l] - mx);
      if (l == 0) { AMAX[dir * BHC + u] = mx; BLAST[dir * BHC + u] = tot; } }
    SYNC();
    for (int it = tid; it < 1024; it += NTHREADS) { const int l = it >> 4, d8 = (it & 15) * 8;
      const bf16x8 v8 = ld8(PROJ + (size_t)(t0 + l) * NP + C_MV + h * 128 + d8); const bf16x8 k8 = ld8(KC + (size_t)(t0 + l) * MW + h * 128 + d8);
      const float wf = s_w[l], wb = s_w[64 + l];
      UNR for (int j = 0; j < 8; ++j) { const float vf = bf2f((bf16_t)v8[j]); VW[(d8 + j) * GP + l] = f2bf(vf * wf); VW[(128 + d8 + j) * GP + l] = f2bf(vf * wb); KT[(d8 + j) * GP + l] = (bf16_t)k8[j]; } }
    SYNC();
    { const int dir = w >> 2, m2 = w & 3;
      UNR for (int mi = 0; mi < 2; ++mi) { const int mt = m2 * 2 + mi;
        bf16x8 af[2]; UNR for (int ks = 0; ks < 2; ++ks) af[ks] = ld8(VW + (dir * 128 + mt * 16 + (lane & 15)) * GP + ks * 32 + (lane >> 4) * 8);
        UNR for (int nt = 0; nt < 8; ++nt) { f32x4 acc = (f32x4){0.f, 0.f, 0.f, 0.f};
          UNR for (int ks = 0; ks < 2; ++ks) acc = mfma16(af[ks], ld8(KT + (nt * 16 + (lane & 15)) * GP + ks * 32 + (lane >> 4) * 8), acc);
          bf16_t* dst = CST + ((size_t)(dir * BHC + u) * 128 + mt * 16 + (lane >> 4) * 4) * 128 + nt * 16 + (lane & 15);
          UNR for (int i = 0; i < 4; ++i) dst[i * 128] = f2bf(acc[i]); } } }
    if (tid < 256) { const int dir = tid >> 7, e = tid & 127; float s = 0.f; for (int l = 0; l < 64; ++l) s += s_w[dir * 64 + l] * bf2f(KT[e * GP + l]); NST[(size_t)(dir * BHC + u) * 128 + e] = s; }
  }
}
DEV void phase_mlstm_scan(const Params& p) {
  bf16_t* CST = (bf16_t*)(p.ws + WS_CST); float* NST = (float*)(p.ws + WS_NST);
  const float* AMAX = (const float*)(p.ws + WS_AMAX); const float* BLAST = (const float*)(p.ws + WS_BLAST); float* MPREV = (float*)(p.ws + WS_MPREV);
  const int gtid = BID * NTHREADS + TID, gstride = NBLK * NTHREADS;
  constexpr int PER = 8192 + 64;
  for (int it = gtid; it < 2 * BATCH * MH * PER; it += gstride) {
    const int pi = it % PER, dbh = it / PER, dir = dbh / (BATCH * MH), bh = dbh % (BATCH * MH);
    float s0 = 0.f, s1 = 0.f, m = 0.f;
    for (int cc = 0; cc < NC; ++cc) {
      const int c = dir ? NC - 1 - cc : cc; const int u = bh * NC + c;
      const float bl = BLAST[dir * BHC + u], am = AMAX[dir * BHC + u];
      const float mn = fmaxf(bl + m, am), dec = expf(bl + m - mn), inj = expf(am - mn);
      if (pi < 8192) { unsigned* ptr = (unsigned*)(CST + (size_t)(dir * BHC + u) * 16384) + pi; const unsigned in = *ptr;
        *ptr = pk2(s0, s1); s0 = dec * s0 + inj * bf2f((bf16_t)(in & 0xffff)); s1 = dec * s1 + inj * bf2f((bf16_t)(in >> 16)); }
      else { float* ptr = NST + (size_t)(dir * BHC + u) * 128 + 2 * (pi - 8192); const float i0 = ptr[0], i1 = ptr[1];
        ptr[0] = s0; ptr[1] = s1; s0 = dec * s0 + inj * i0; s1 = dec * s1 + inj * i1; }
      if (pi == 0) MPREV[dir * BHC + u] = m;
      m = mn;
    }
  }
}
constexpr int QP = 136;
constexpr int C_HALF_BYTES = (64 * QP * 2) * 2 + 128 * GP * 2 + 4 * 16 * GP * 2 + (4 * 64 + 2 * 128 + 4) * 4;
DEV void phase_mlstm_c(const Params& p, int l) {
  char* lds = LDS_PTR();
  const int tid = TID, lane = tid & 63, w = tid >> 6, half = w >> 2, wv = w & 3, htid = tid & 255;
  char* hb = lds + half * ((C_HALF_BYTES + 255) & ~255);
  bf16_t* Qs = (bf16_t*)hb; bf16_t* Ks = Qs + 64 * QP; bf16_t* VTs = Ks + 64 * QP; bf16_t* Ps = VTs + 128 * GP;
  float* s_b = (float*)(Ps + 4 * 16 * GP);
  float* s_li = s_b + 128;
  float* s_n = s_li + 128;
  float* s_m = s_n + 256;
  bf16_t* Pw = Ps + wv * 16 * GP;
  const bf16_t* PROJ = (const bf16_t*)(p.ws + WS_PROJ); const bf16_t* QC = (const bf16_t*)(p.ws + WS_QC); const bf16_t* KC = (const bf16_t*)(p.ws + WS_KC);
  const float* GATES = (const float*)(p.ws + WS_GATES); const bf16_t* CST = (const bf16_t*)(p.ws + WS_CST); const float* NST = (const float*)(p.ws + WS_NST);
  const float* MPREV = (const float*)(p.ws + WS_MPREV); bf16_t* YM = (bf16_t*)(p.ws + WS_YM);
  const float* ng = p.mlstm_norm_g + (size_t)l * MW;
  for (int u0 = BID * 2; u0 < BHC; u0 += NBLK * 2) {
    const int u = u0 + half;
    const int c = u % NC, h = (u / NC) % MH, b = u / (NC * MH);
    const int t0 = b * SEQ + c * ML;
    SYNC();
    for (int it = htid; it < 1024; it += 256) { const int r = it >> 4, d8 = (it & 15) * 8;
      *(u32x4*)(Qs + r * QP + d8) = *(const u32x4*)(QC + (size_t)(t0 + r) * MW + h * 128 + d8);
      *(u32x4*)(Ks + r * QP + d8) = *(const u32x4*)(KC + (size_t)(t0 + r) * MW + h * 128 + d8);
      const bf16x8 v8 = ld8(PROJ + (size_t)(t0 + r) * NP + C_MV + h * 128 + d8);
      UNR for (int j = 0; j < 8; ++j) VTs[(d8 + j) * GP + r] = (bf16_t)v8[j]; }
    if (htid < 128) { const int dir = htid >> 6, q = htid & 63; s_li[dir * 64 + q] = GATES[(size_t)(t0 + q) * 16 + (dir ? 8 : 0) + h];
      s_b[dir * 64 + q] = logsigmoidf_(GATES[(size_t)(t0 + q) * 16 + (dir ? 12 : 4) + h]); }
    s_n[htid] = NST[(size_t)((htid >> 7) * BHC + u) * 128 + (htid & 127)];
    if (htid < 2) s_m[htid] = MPREV[htid * BHC + u];
    SYNC();
    float cum = 0.f;
    if (htid < 128) { const int dir = htid >> 6, q = htid & 63;
      if (dir == 0) { for (int z = 0; z <= q; ++z) cum += s_b[z]; } else { for (int z = q; z < 64; ++z) cum += s_b[64 + z]; } }
    SYNC();
    if (htid < 128) s_b[htid] = cum;
    SYNC();
    const int j0 = wv * 16;
    bf16x8 qa[4]; UNR for (int ks = 0; ks < 4; ++ks) qa[ks] = ld8(Qs + (j0 + (lane & 15)) * QP + ks * 32 + (lane >> 4) * 8);
    f32x4 S[4];
    UNR for (int nt = 0; nt < 4; ++nt) { S[nt] = (f32x4){0.f, 0.f, 0.f, 0.f};
      UNR for (int ks = 0; ks < 4; ++ks) S[nt] = mfma16(qa[ks], ld8(Ks + (nt * 16 + (lane & 15)) * QP + ks * 32 + (lane >> 4) * 8), S[nt]); }
    f32x4 hs[8]; UNR for (int nd = 0; nd < 8; ++nd) hs[nd] = (f32x4){0.f, 0.f, 0.f, 0.f};
#pragma unroll 1
    for (int dir = 0; dir < 2; ++dir) {
      float qn = 0.f; { const int e0 = (lane >> 4) * 32;
        for (int e = 0; e < 32; ++e) qn += bf2f(Qs[(j0 + (lane & 15)) * QP + e0 + e]) * s_n[dir * 128 + e0 + e];
        qn += shfl_xor_f(qn, 16); qn += shfl_xor_f(qn, 32); }
      const float* bb = s_b + dir * 64; const float* li = s_li + dir * 64; const float mp = s_m[dir];
      float fsc[4];
      UNR for (int i = 0; i < 4; ++i) {
        const int j = j0 + (lane >> 4) * 4 + i; const float bj = bb[j];
        float dv[4], sv[4], mx = -3.0e38f;
        UNR for (int nt = 0; nt < 4; ++nt) { const int lk = nt * 16 + (lane & 15); const bool ok = dir ? (lk >= j) : (lk <= j);
          dv[nt] = ok ? (bj - bb[lk] + li[lk]) : -3.0e38f; mx = fmaxf(mx, dv[nt]); }
        mx = grp16_max(mx);
        const float mi = bj + mp, mo = fmaxf(mi, mx);
        float rsum = 0.f;
        UNR for (int nt = 0; nt < 4; ++nt) { sv[nt] = (dv[nt] > -1.0e38f) ? S[nt][i] * expf(dv[nt] - mo) : 0.f; rsum += sv[nt]; }
        rsum = grp16_sum(rsum);
        const float iw = expf(mi - mo);
        const float qnj = shfl_f(qn, (lane >> 4) * 4 + i);
        const float den = rsum + iw * qnj;
        const float dinv = 1.f / fmaxf(fabsf(den), expf(-mo));
        UNR for (int nt = 0; nt < 4; ++nt) Pw[((lane >> 4) * 4 + i) * GP + nt * 16 + (lane & 15)] = f2bf(sv[nt] * dinv);
        fsc[i] = iw * dinv;
      }
      float fa = 0.f;
      UNR for (int i = 0; i < 4; ++i) { const float tv = shfl_f(fsc[i], ((lane & 15) >> 2) * 16); fa = ((lane & 3) == i) ? tv : fa; }
      SYNC();
      UNR for (int ks = 0; ks < 2; ++ks) { const bf16x8 pa = ld8(Pw + (lane & 15) * GP + ks * 32 + (lane >> 4) * 8);
        UNR for (int nd = 0; nd < 8; ++nd) hs[nd] = mfma16(pa, ld8(VTs + (nd * 16 + (lane & 15)) * GP + ks * 32 + (lane >> 4) * 8), hs[nd]); }
      const bf16_t* Cp = CST + (size_t)(dir * BHC + u) * 16384;
      UNR for (int ks = 0; ks < 4; ++ks) {
        bf16x8 qs; UNR for (int e = 0; e < 8; ++e) qs[e] = (short)f2bf(bf2f((bf16_t)qa[ks][e]) * fa);
        UNR for (int nd = 0; nd < 8; ++nd) hs[nd] = mfma16(qs, ld8(Cp + (size_t)(nd * 16 + (lane & 15)) * 128 + ks * 32 + (lane >> 4) * 8), hs[nd]); }
      SYNC();
    }
    UNR for (int i = 0; i < 4; ++i) { float ss = 0.f; UNR for (int nd = 0; nd < 8; ++nd) ss += hs[nd][i] * hs[nd][i];
      ss = grp16_sum(ss); const float rs = 1.f / sqrtf(ss * (1.f / 128.f) + EPS);
      const int t = t0 + j0 + (lane >> 4) * 4 + i;
      UNR for (int nd = 0; nd < 8; ++nd) { const int d = nd * 16 + (lane & 15); const float og = bf2f(PROJ[(size_t)t * NP + C_MO + h * 128 + d]);
        YM[(size_t)t * MW + h * 128 + d] = f2bf(hs[nd][i] * rs * ng[h * 128 + d] * sigmoidf_(og)); } }
  }
}

#ifndef EMU
#define XB_TMO      128
#define XB_XCNT(j)  (256  + 64 * (j))
#define XB_XSUB(j)  (1280 + 64 * (j))
#define XB_XGEN(j)  (2304 + 64 * (j))
#define XB_TOP      3328
#define XB_TOPGEN   3392
#define XCD_BAR_WORDS 3456
#define XB_SPIN_CAP (1u << 18)
#define LAS __attribute__((address_space(3)))
__device__ __forceinline__ unsigned xb_ld(unsigned* p)              { return __hip_atomic_load(p, __ATOMIC_RELAXED, __HIP_MEMORY_SCOPE_AGENT); }
__device__ __forceinline__ unsigned xb_add(unsigned* p, unsigned v) { return __hip_atomic_fetch_add(p, v, __ATOMIC_RELAXED, __HIP_MEMORY_SCOPE_AGENT); }
__device__ __forceinline__ unsigned xb_xcc_id() { return (unsigned)__builtin_amdgcn_s_getreg((3 << 11) | 20) & 0xFu; }
#define XB_SPIN(cond, bar) do { unsigned _sp = 0; while (cond) { __builtin_amdgcn_s_sleep(1); \
    if ((++_sp & 255u) == 0u) { if (xb_ld(&(bar)[XB_TMO])) break; if (_sp > XB_SPIN_CAP) { atomicAdd(&(bar)[XB_TMO], 1u); break; } } } } while (0)
struct XcdBarrier { unsigned* bar; unsigned x; volatile LAS unsigned* st; };
__device__ __forceinline__ XcdBarrier xcd_barrier_post(unsigned* bar, volatile LAS unsigned* st) {
    XcdBarrier b; b.bar = bar; b.x = xb_xcc_id(); b.st = st;
    if (threadIdx.x == 0) (void)xb_add(&bar[XB_XCNT(b.x)], 1u);
    return b;
}
__device__ __forceinline__ void xcd_barrier_complete(unsigned* bar, unsigned x, unsigned& nloc, unsigned& nx) {
    const unsigned G = gridDim.x * gridDim.y * gridDim.z;
    unsigned sum, cnt, mine, sp = 0u;
    for (;;) {
        sum = 0u; cnt = 0u; mine = 0u;
#pragma unroll
        for (unsigned j = 0; j < 16; ++j) { const unsigned c = xb_ld(&bar[XB_XCNT(j)]); sum += c; cnt += (c > 0u) ? 1u : 0u; mine = (j == x) ? c : mine; }
        if (sum == G) break;
        __builtin_amdgcn_s_sleep(1);
        if ((++sp & 255u) == 0u) { if (xb_ld(&bar[XB_TMO])) break; if (sp > XB_SPIN_CAP) { atomicAdd(&bar[XB_TMO], 1u); break; } }
    }
    nloc = mine > 0u ? mine : 1u; nx = cnt > 0u ? cnt : 1u;
}
__device__ __forceinline__ void xcd_barrier(const XcdBarrier& b) {
    asm volatile("s_waitcnt vmcnt(0)" ::: "memory");
    __syncthreads();
    if (threadIdx.x == 0) {
        unsigned* bar = b.bar;
        __builtin_amdgcn_s_waitcnt(0);
        unsigned nloc = b.st[0], nx = b.st[1];
        if (nloc == 0u) { xcd_barrier_complete(bar, b.x, nloc, nx); b.st[0] = nloc; b.st[1] = nx; }
        const unsigned old = xb_add(&bar[XB_XSUB(b.x)], 1u);
        const unsigned gen = old / nloc;
        if (old + 1u == (gen + 1u) * nloc) {
            __builtin_amdgcn_fence(__ATOMIC_RELEASE, "agent");
            asm volatile("s_waitcnt vmcnt(0)" ::: "memory");
            const unsigned og = xb_add(&bar[XB_TOP], 1u);
            const unsigned tg = og / nx;
            if (og + 1u == (tg + 1u) * nx) xb_add(&bar[XB_TOPGEN], 1u);
            else XB_SPIN(xb_ld(&bar[XB_TOPGEN]) == tg, bar);
            __builtin_amdgcn_fence(__ATOMIC_ACQUIRE, "agent");
            xb_add(&bar[XB_XGEN(b.x)], 1u);
            asm volatile("s_waitcnt vmcnt(0)" ::: "memory");
        } else {
            XB_SPIN(xb_ld(&bar[XB_XGEN(b.x)]) == gen, bar);
            __builtin_amdgcn_fence(__ATOMIC_ACQUIRE, "agent");
            asm volatile("s_waitcnt vmcnt(0)" ::: "memory");
        }
    }
    __syncthreads();
}
__device__ __forceinline__ Params fresh(const Params& p) { Params q = p; unsigned long long w = (unsigned long long)q.ws; asm volatile("" : "+s"(w)); q.ws = (unsigned char*)w; return q; }
#define GRID_BAR() do { XcdBarrier xb_ = xbar; unsigned long long bw_ = (unsigned long long)xb_.bar; asm volatile("" : "+s"(bw_)); xb_.bar = (unsigned*)bw_; xcd_barrier(xb_); } while (0)
__global__ void __launch_bounds__(NTHREADS, 2) k_fwd(Params p) {
  {
    volatile LAS unsigned* st = (volatile LAS unsigned*)(LAS char*)(dyn_lds + LDS_PHASE_BYTES);
    if (threadIdx.x == 0) { st[0] = 0u; st[1] = 0u; st[2] = 0u; st[3] = 0u; }
    __syncthreads();
  }
  const XcdBarrier xbar = xcd_barrier_post((unsigned*)(p.ws + WS_CTL) + CW_BAR, (volatile LAS unsigned*)(LAS char*)(dyn_lds + LDS_PHASE_BYTES));
#else
#define GRID_BAR() emu_gridsync()
static inline Params fresh(const Params& p) { return p; }
static void k_fwd(Params p) {
#endif
  if (PHMASK & (1u << 0)) { phase_mod_rope(fresh(p)); }
  for (int l = 0; l < DEPTH; ++l) {
    if (PHMASK & (1u << 1)) { phase_convert(fresh(p), l); }
    GRID_BAR();
    if (PHMASK & (1u << 2)) { if (l == 0) phase_norm(fresh(p), l, 0, 0); else phase_norm(fresh(p), l, 1, 0); }
    GRID_BAR();
    if (PHMASK & (1u << 3)) { phase_gemm_in(fresh(p), l); }
    GRID_BAR();
    if (PHMASK & (1u << 4)) { phase_prep(fresh(p), l); }
    GRID_BAR();
    if (PHMASK & (1u << 5)) { phase_mlstm_a(fresh(p)); }
    GRID_BAR();
    if (PHMASK & (1u << 6)) { phase_mlstm_scan(fresh(p)); }
    if (PHMASK & (1u << 7)) { phase_attn(fresh(p)); }
    GRID_BAR();
    if (PHMASK & (1u << 8)) { phase_mlstm_c(fresh(p), l); }
    GRID_BAR();
    if (PHMASK & (1u << 9)) { phase_gemm_merge(fresh(p)); }
    GRID_BAR();
    if (PHMASK & (1u << 10)) { phase_gemm_out(fresh(p), l); }
    GRID_BAR();
    if (PHMASK & (1u << 11)) { phase_norm2_router(fresh(p), l); }
    GRID_BAR();
    if (PHMASK & (1u << 15)) { phase_moe_gather(fresh(p), l); }
    GRID_BAR();
    if (PHMASK & (1u << 12)) { phase_moe_up(fresh(p), l); }
    GRID_BAR();
    if (PHMASK & (1u << 13)) { phase_moe_down(fresh(p), l); }
    GRID_BAR();
  }
  if (PHMASK & (1u << 14)) { phase_norm(fresh(p), DEPTH, 1, 2); }
}

#ifdef EMU
static int emu_grid_size = 8;
static int emu_stop_after = 1000;
#endif
extern "C" void kernel_launch(void* const* d_in, const int* in_sizes, int n_in, void* d_out, int out_size, void* d_ws, size_t ws_size, hipStream_t stream) {
  (void)in_sizes; (void)n_in; (void)out_size;
  if (ws_size < WS_TOTAL) { fprintf(stderr, "workspace too small: %zu < %zu\n", ws_size, (size_t)WS_TOTAL); return; }
  Params prm{};
  const float** f = (const float**)&prm;
  for (int i = 0; i < 24; ++i) f[i] = (const float*)d_in[i];
  prm.out = (float*)d_out; prm.ws = (unsigned char*)d_ws;
#ifdef EMU
  memset(d_ws, 0, CTL_BYTES);
  emu_launch(emu_grid_size, NTHREADS, LDS_BYTES, [=]() { k_fwd(prm); }, true);
#else
  static int grid = 0;
  if (!grid) {
    int dev = 0, cus = 0, per_cu = 0;
    (void)hipGetDevice(&dev);
    (void)hipDeviceGetAttribute(&cus, hipDeviceAttributeMultiprocessorCount, dev);
    (void)hipFuncSetAttribute((const void*)k_fwd, hipFuncAttributeMaxDynamicSharedMemorySize, LDS_BYTES);
    (void)hipOccupancyMaxActiveBlocksPerMultiprocessor(&per_cu, k_fwd, NTHREADS, LDS_BYTES);
    grid = cus * (per_cu < 1 ? per_cu : 1);
    if (grid <= 0) { fprintf(stderr, "occupancy query says the kernel does not fit (cus %d per_cu %d)\n", cus, per_cu); grid = 0; return; }
  }
  (void)hipMemsetAsync(d_ws, 0, CTL_BYTES, stream);
  k_fwd<<<grid, NTHREADS, LDS_BYTES, stream>>>(prm);
#endif
}
```

```cpp
#ifdef EMU
#include "emu.h"
#define TID emu_tid()
#define BID emu_bid()
#define NBLK emu_nblk()
#define SYNC() emu_syncthreads()
#define DEV static inline
#define DEVM inline
#else
#include <hip/hip_runtime.h>
#include <cstdio>
#include <cstdint>
__device__ __forceinline__ int tid_opaque() { int t = (int)threadIdx.x; asm volatile("" : "+v"(t)); return t; }
#define TID tid_opaque()
#define BID ((int)blockIdx.x)
#define NBLK ((int)gridDim.x)
#define SYNC() __syncthreads()
#define DEV __device__ __forceinline__
#define DEVM __device__ __forceinline__
#endif

#ifndef CFG_SEQ
#define CFG_SEQ 8192
#endif
#ifndef CFG_BATCH
#define CFG_BATCH 2
#endif

#ifndef DUP_PHASE
#define DUP_PHASE (-1)
#endif
#ifndef PHMASK
#define PHMASK 0xFFFFFFFFu
#endif
#define UNR _Pragma("unroll")
typedef unsigned short bf16_t;
typedef short bf16x8 __attribute__((ext_vector_type(8)));
typedef float f32x4 __attribute__((ext_vector_type(4)));
typedef unsigned u32x4 __attribute__((ext_vector_type(4)));
typedef unsigned u32x2 __attribute__((ext_vector_type(2)));

constexpr int D = 1024, BATCH = CFG_BATCH, SEQ = CFG_SEQ, DEPTH = 2, T = BATCH * SEQ;
constexpr int GRID_W = 64;
constexpr int MH = 4, MHD = 128, MW = 512, ML = 64, NC = SEQ / ML, CONVW = 5;
constexpr int AH = 8, KVH = 2, AHD = 64, AW = 512, KVW = 128;
constexpr int NG = 4, EPG = 8, NE = 32, FF = 512;
constexpr float EPS = 1e-6f;
constexpr int IN_W = 4880, NP = 5120;
constexpr int C_MQ = 0, C_MK = 512, C_MV = 1024, C_MO = 1536, C_GATES = 2048, C_AQ = 2064, C_AK = 2576, C_AV = 2704, C_GM = 2832, C_GA = 3856;
constexpr int NTHREADS = 512;
constexpr int BHC = BATCH * MH * NC;
constexpr int ROWT_MAX = (2 * T) / 256 + NE;
constexpr int SLOT_ROWS = ROWT_MAX * 256;

constexpr size_t al256(size_t x) { return (x + 255) & ~(size_t)255; }
constexpr size_t WS_CTL = 0, CTL_BYTES = 1 << 20;
constexpr size_t WS_MOD = WS_CTL + CTL_BYTES;
constexpr size_t WS_ROPE = WS_MOD + al256((size_t)DEPTH * BATCH * 6 * D * 4);
constexpr size_t WS_WIN = WS_ROPE + al256((size_t)(2 * (SEQ / GRID_W) * 16 + 2 * 64 * 16) * 4);
constexpr size_t WS_WBM = WS_WIN + (size_t)NP * D * 2;
constexpr size_t WS_WBA = WS_WBM + (size_t)D * MW * 2;
constexpr size_t WS_WOUT = WS_WBA + (size_t)D * AW * 2;
constexpr size_t WS_WGU = WS_WOUT + (size_t)D * D * 2;
constexpr size_t WS_WD = WS_WGU + (size_t)NE * 2 * FF * D * 2;
constexpr size_t WS_PROJ = WS_WD + (size_t)NE * D * FF * 2;
constexpr size_t WS_ACT = WS_PROJ;
constexpr size_t WS_Y = WS_ACT + al256((size_t)SLOT_ROWS * FF * 2);
constexpr size_t PROJ_BYTES = (size_t)T * NP * 2;
constexpr size_t OVL_BYTES = (WS_Y + (size_t)2 * T * D * 2 - WS_PROJ) > PROJ_BYTES ? (WS_Y + (size_t)2 * T * D * 2 - WS_PROJ) : PROJ_BYTES;
constexpr size_t WS_GATES = WS_PROJ + al256(OVL_BYTES);
constexpr size_t WS_QC = WS_GATES + (size_t)T * 16 * 4;
constexpr size_t WS_KC = WS_QC + (size_t)T * MW * 2;
constexpr size_t WS_MERGED = WS_QC;
constexpr size_t WS_AQN = WS_KC + (size_t)T * MW * 2;
constexpr size_t WS_AKN = WS_AQN + (size_t)T * AW * 2;
constexpr size_t WS_VT = WS_AKN + (size_t)T * KVW * 2;
constexpr size_t WS_YM = WS_VT + (size_t)T * KVW * 2;
constexpr size_t WS_YA = WS_YM + (size_t)T * MW * 2;
constexpr size_t QCYA_BYTES = WS_YA + (size_t)T * AW * 2 - WS_QC;
constexpr size_t HS_BYTES = (size_t)SLOT_ROWS * D * 2;
constexpr size_t WS_HS = WS_QC;
constexpr size_t WS_CST = WS_QC + al256(HS_BYTES > QCYA_BYTES ? HS_BYTES : QCYA_BYTES);
constexpr size_t WS_H = WS_CST;
constexpr size_t WS_TMP = WS_CST;
constexpr size_t CST_BYTES = (size_t)2 * BHC * 128 * 128 * 2;
static_assert((size_t)T * D * 4 <= CST_BYTES, "H and TMP fit in CST");
constexpr size_t WS_NST = WS_CST + CST_BYTES;
constexpr size_t WS_AMAX = WS_NST + (size_t)2 * BHC * 128 * 4;
constexpr size_t WS_BLAST = WS_AMAX + al256((size_t)2 * BHC * 4);
constexpr size_t WS_MPREV = WS_BLAST + al256((size_t)2 * BHC * 4);
constexpr size_t WS_ENT_E = WS_MPREV + al256((size_t)2 * BHC * 4);
constexpr size_t WS_ENT_POS = WS_ENT_E + (size_t)2 * T * 4;
constexpr size_t WS_WENT = WS_ENT_POS + (size_t)2 * T * 4;
constexpr size_t WS_SLOT_ENT = WS_WENT + (size_t)2 * T * 4;
constexpr size_t WS_SLOT_W = WS_SLOT_ENT + (size_t)SLOT_ROWS * 4;
constexpr size_t WS_TOTAL = WS_SLOT_W + (size_t)SLOT_ROWS * 4;
constexpr int CW_CNT = 64;
constexpr int CW_BAR = 4096;

struct Params {
  const float *x, *c, *w_ada, *b_ada, *norm1_g, *w_in, *b_in, *conv_w, *conv_b, *mlstm_norm_g, *q_norm_g, *k_norm_g, *w_branch_m, *w_branch_a, *w_out, *norm2_g,
      *w_rg, *b_rg, *w_re, *b_re, *w_gate, *w_up, *w_down, *final_g;
  float* out; unsigned char* ws;
};

DEV float bf2f(bf16_t h) { return __builtin_bit_cast(float, (unsigned)h << 16); }
DEV bf16_t f2bf(float f) { unsigned u = __builtin_bit_cast(unsigned, f); return (bf16_t)((u + 0x7fffu + ((u >> 16) & 1u)) >> 16); }
DEV unsigned pk2(float lo, float hi) { return (unsigned)f2bf(lo) | ((unsigned)f2bf(hi) << 16); }
DEV float sigmoidf_(float x) { return 1.f / (1.f + expf(-x)); }
DEV float siluf_(float x) { return x / (1.f + expf(-x)); }
DEV float logsigmoidf_(float x) { return fminf(x, 0.f) - log1pf(expf(-fabsf(x))); }

#ifdef EMU
static inline f32x4 mfma16(bf16x8 a, bf16x8 b, f32x4 c) {
  struct In { bf16x8 a, b; f32x4 c; } in{a, b, c}; f32x4 out;
  emu_collective(&in, sizeof(In), &out, sizeof(out), [](char (*I)[64], char (*O)[32]) {
    float Dm[16][16];
    for (int r = 0; r < 16; ++r) for (int cc = 0; cc < 16; ++cc) { In* L = (In*)I[(r >> 2) * 16 + cc]; Dm[r][cc] = L->c[r & 3]; }
    for (int r = 0; r < 16; ++r) for (int cc = 0; cc < 16; ++cc) { float s = 0.f;
      for (int g = 0; g < 4; ++g) { In* LA = (In*)I[g * 16 + r]; In* LB = (In*)I[g * 16 + cc]; for (int j = 0; j < 8; ++j) s += bf2f((bf16_t)LA->a[j]) * bf2f((bf16_t)LB->b[j]); }
      Dm[r][cc] += s; }
    for (int l = 0; l < 64; ++l) { f32x4 o; for (int i = 0; i < 4; ++i) o[i] = Dm[(l >> 4) * 4 + i][l & 15]; memcpy(O[l], &o, 16); } });
  return out;
}
static inline f32x4 mfma4f32(float a, float b, f32x4 c) {
  struct In { float a, b; f32x4 c; } in{a, b, c}; f32x4 out;
  emu_collective(&in, sizeof(In), &out, sizeof(out), [](char (*I)[64], char (*O)[32]) {
    for (int l = 0; l < 64; ++l) { f32x4 o; UNR for (int i = 0; i < 4; ++i) { const int r = (l >> 4) * 4 + i, cc = l & 15; float s = ((In*)I[l])->c[i];
      for (int k = 0; k < 4; ++k) s = fmaf(((In*)I[k * 16 + r])->a, ((In*)I[k * 16 + cc])->b, s); o[i] = s; } memcpy(O[l], &o, 16); } });
  return out;
}
static inline float shfl_xor_f(float v, int m) { float out; emu_collective(&v, 4, &out, 4, [m](char (*I)[64], char (*O)[32]) { for (int l = 0; l < 64; ++l) memcpy(O[l], I[l ^ m], 4); }); return out; }
static inline float shfl_f(float v, int src) { struct In { float v; int s; } in{v, src}; float out;
  emu_collective(&in, 8, &out, 4, [](char (*I)[64], char (*O)[32]) { for (int l = 0; l < 64; ++l) { In* me = (In*)I[l]; memcpy(O[l], I[me->s & 63], 4); } }); return out; }
static inline int atomic_add_i(int* p, int v) { return __atomic_fetch_add(p, v, __ATOMIC_RELAXED); }
#define LDS_PTR() emu_lds()
#else
DEV f32x4 mfma16(bf16x8 a, bf16x8 b, f32x4 c) { return __builtin_amdgcn_mfma_f32_16x16x32_bf16(a, b, c, 0, 0, 0); }
DEV f32x4 mfma4f32(float a, float b, f32x4 c) { return __builtin_amdgcn_mfma_f32_16x16x4f32(a, b, c, 0, 0, 0); }
DEV float shfl_xor_f(float v, int m) {
  const int iv = __builtin_bit_cast(int, v);
  switch (m) {
    case 1: return __builtin_bit_cast(float, __builtin_amdgcn_ds_swizzle(iv, (1 << 10) | 0x1f));
    case 2: return __builtin_bit_cast(float, __builtin_amdgcn_ds_swizzle(iv, (2 << 10) | 0x1f));
    case 4: return __builtin_bit_cast(float, __builtin_amdgcn_ds_swizzle(iv, (4 << 10) | 0x1f));
    case 8: return __builtin_bit_cast(float, __builtin_amdgcn_ds_swizzle(iv, (8 << 10) | 0x1f));
    case 16: return __builtin_bit_cast(float, __builtin_amdgcn_ds_swizzle(iv, (16 << 10) | 0x1f));
    default: { const int lane = TID & 63; return __builtin_bit_cast(float, __builtin_amdgcn_ds_bpermute(((lane ^ m) & 63) << 2, iv)); }
  }
}
DEV float shfl_f(float v, int src) { return __builtin_bit_cast(float, __builtin_amdgcn_ds_bpermute((src & 63) << 2, __builtin_bit_cast(int, v))); }
DEV int atomic_add_i(int* p, int v) { return atomicAdd(p, v); }
extern __shared__ __attribute__((aligned(16))) char dyn_lds[];
#define LDS_PTR() (dyn_lds)
#endif
DEV float grp16_sum(float v) { v += shfl_xor_f(v, 1); v += shfl_xor_f(v, 2); v += shfl_xor_f(v, 4); v += shfl_xor_f(v, 8); return v; }
DEV float grp16_max(float v) { v = fmaxf(v, shfl_xor_f(v, 1)); v = fmaxf(v, shfl_xor_f(v, 2)); v = fmaxf(v, shfl_xor_f(v, 4)); v = fmaxf(v, shfl_xor_f(v, 8)); return v; }
DEV float wave_sum(float v) { v = grp16_sum(v); v += shfl_xor_f(v, 16); v += shfl_xor_f(v, 32); return v; }
DEV bf16x8 ld8(const bf16_t* p) { return __builtin_bit_cast(bf16x8, *(const u32x4*)p); }

DEV void phase_mod_rope(const Params& p) {
  float* mod = (float*)(p.ws + WS_MOD);
  const int gtid = BID * NTHREADS + TID, gstride = NBLK * NTHREADS;
  {
    float* red = (float*)LDS_PTR();
    const int tid = TID, j = tid & 63, q = tid >> 6;
    for (int it = BID; it < DEPTH * (6 * D / 64); it += NBLK) {
      const int l = it / (6 * D / 64), n0 = (it % (6 * D / 64)) * 64;
      const float* w = p.w_ada + (size_t)l * D * 6 * D + (size_t)(128 * q) * 6 * D + n0 + j;
      float s[BATCH]; UNR for (int b = 0; b < BATCH; ++b) s[b] = 0.f;
#pragma unroll 16
      for (int k = 0; k < 128; ++k) { const float wv = w[(size_t)k * 6 * D];
        UNR for (int b = 0; b < BATCH; ++b) s[b] += siluf_(p.c[b * D + 128 * q + k]) * wv; }
      SYNC();
      UNR for (int b = 0; b < BATCH; ++b) red[(q * BATCH + b) * 64 + j] = s[b];
      SYNC();
      if (tid < BATCH * 64) { const int b = tid >> 6; float a = p.b_ada[l * 6 * D + n0 + j];
        UNR for (int qq = 0; qq < 8; ++qq) a += red[(qq * BATCH + b) * 64 + j];
        mod[((size_t)l * BATCH + b) * 6 * D + n0 + j] = a; }
    }
    SYNC();
  }
  float* rope = (float*)(p.ws + WS_ROPE);
  constexpr int NR = SEQ / GRID_W;
  for (int o = gtid; o < (NR + 64) * 16; o += gstride) {
    const int i = o & 15, pos = o >> 4;
    const float inv = powf(10000.f, -(float)(2 * i) / 32.f);
    if (pos < NR) { const float a = (float)pos * inv; rope[pos * 16 + i] = cosf(a); rope[NR * 16 + pos * 16 + i] = sinf(a); }
    else { const int cpos = pos - NR; const float a = (float)cpos * inv; rope[2 * NR * 16 + cpos * 16 + i] = cosf(a); rope[2 * NR * 16 + 64 * 16 + cpos * 16 + i] = sinf(a); }
  }
}
DEV void transpose_item(char* lds, const float* src, int K, int N, bf16_t* dst, int mode, int item) {
  float* tile = (float*)lds;
  const int ntn = (N + 63) / 64, tk = item / ntn, tn = item % ntn, tid = TID;
  const int k0 = tk * 64, n0 = tn * 64;
  { const int kk = tid >> 3, c8 = (tid & 7) * 8;
    const float* s = src + (size_t)(k0 + kk) * N + n0 + c8;
    UNR for (int j = 0; j < 8; ++j) tile[kk * 65 + c8 + j] = (n0 + c8 + j < N) ? s[j] : 0.f; }
  SYNC();
  { const int nn = tid >> 3, k8 = (tid & 7) * 8, n = n0 + nn;
    if (n < N) {
      int row = n; if (mode == 1) row = 32 * (n >> 4) + (n & 15); else if (mode == 2) row = 32 * (n >> 4) + 16 + (n & 15);
      u32x4 v; v.x = pk2(tile[(k8 + 0) * 65 + nn], tile[(k8 + 1) * 65 + nn]); v.y = pk2(tile[(k8 + 2) * 65 + nn], tile[(k8 + 3) * 65 + nn]);
      v.z = pk2(tile[(k8 + 4) * 65 + nn], tile[(k8 + 5) * 65 + nn]); v.w = pk2(tile[(k8 + 6) * 65 + nn], tile[(k8 + 7) * 65 + nn]);
      *(u32x4*)(dst + (size_t)row * K + k0 + k8) = v; } }
  SYNC();
}
DEV void phase_convert(const Params& p, int l) {
  char* lds = LDS_PTR();
  constexpr int I_IN = (D / 64) * ((IN_W + 63) / 64), I_BM = (MW / 64) * (D / 64), I_BA = (AW / 64) * (D / 64), I_OUT = (D / 64) * (D / 64);
  constexpr int I_G = (D / 64) * (FF / 64), I_D = (FF / 64) * (D / 64);
  constexpr int B1 = I_IN, B2 = B1 + I_BM, B3 = B2 + I_BA, B4 = B3 + I_OUT, B5 = B4 + NE * I_G, B6 = B5 + NE * I_G, B7 = B6 + NE * I_D;
  for (int it = BID; it < B7; it += NBLK) {
    if (it < B1) transpose_item(lds, p.w_in + (size_t)l * D * IN_W, D, IN_W, (bf16_t*)(p.ws + WS_WIN), 0, it);
    else if (it < B2) transpose_item(lds, p.w_branch_m + (size_t)l * MW * D, MW, D, (bf16_t*)(p.ws + WS_WBM), 0, it - B1);
    else if (it < B3) transpose_item(lds, p.w_branch_a + (size_t)l * AW * D, AW, D, (bf16_t*)(p.ws + WS_WBA), 0, it - B2);
    else if (it < B4) transpose_item(lds, p.w_out + (size_t)l * D * D, D, D, (bf16_t*)(p.ws + WS_WOUT), 0, it - B3);
    else if (it < B5) { const int e = (it - B4) / I_G, r = (it - B4) % I_G; transpose_item(lds, p.w_gate + ((size_t)l * NE + e) * D * FF, D, FF, (bf16_t*)(p.ws + WS_WGU) + (size_t)e * 2 * FF * D, 1, r); }
    else if (it < B6) { const int e = (it - B5) / I_G, r = (it - B5) % I_G; transpose_item(lds, p.w_up + ((size_t)l * NE + e) * D * FF, D, FF, (bf16_t*)(p.ws + WS_WGU) + (size_t)e * 2 * FF * D, 2, r); }
    else { const int e = (it - B6) / I_D, r = (it - B6) % I_D; transpose_item(lds, p.w_down + ((size_t)l * NE + e) * FF * D, FF, D, (bf16_t*)(p.ws + WS_WD) + (size_t)e * D * FF, 0, r); }
  }
}

DEV void phase_norm(const Params& p, int l, int mode, int which) {
  const int lane = TID & 63, wv = TID >> 6, nwv = NTHREADS / 64;
  const float* mod = (const float*)(p.ws + WS_MOD);
  bf16_t* H = (bf16_t*)(p.ws + WS_H);
  const bf16_t* Y = (const bf16_t*)(p.ws + WS_Y);
  for (int t = BID * nwv + wv; t < T; t += NBLK * nwv) {
    const int b = t / SEQ;
    f32x4 v[4]; float ss = 0.f;
    UNR for (int i = 0; i < 4; ++i) {
      const int c4 = lane + 64 * i;
      if (mode == 0) v[i] = ((const f32x4*)(p.x + (size_t)t * D))[c4];
      else {
        v[i] = ((const f32x4*)(p.out + (size_t)t * D))[c4];
        if (mode == 1) {
          const f32x4 g2 = ((const f32x4*)(mod + ((size_t)(l - 1) * BATCH + b) * 6 * D + 5 * D))[c4];
          const u32x2 y0 = ((const u32x2*)(Y + (size_t)(2 * t) * D))[c4], y1 = ((const u32x2*)(Y + (size_t)(2 * t + 1) * D))[c4];
          v[i][0] += g2[0] * (bf2f((bf16_t)(y0.x & 0xffff)) + bf2f((bf16_t)(y1.x & 0xffff)));
          v[i][1] += g2[1] * (bf2f((bf16_t)(y0.x >> 16)) + bf2f((bf16_t)(y1.x >> 16)));
          v[i][2] += g2[2] * (bf2f((bf16_t)(y0.y & 0xffff)) + bf2f((bf16_t)(y1.y & 0xffff)));
          v[i][3] += g2[3] * (bf2f((bf16_t)(y0.y >> 16)) + bf2f((bf16_t)(y1.y >> 16)));
        }
      }
      ss += v[i][0] * v[i][0] + v[i][1] * v[i][1] + v[i][2] * v[i][2] + v[i][3] * v[i][3];
    }
    ss = wave_sum(ss);
    const float rs = 1.f / sqrtf(ss * (1.f / D) + EPS);
    if (which == 2) {
      UNR for (int i = 0; i < 4; ++i) { const int c4 = lane + 64 * i; const f32x4 g = ((const f32x4*)p.final_g)[c4];
        f32x4 o; UNR for (int j = 0; j < 4; ++j) o[j] = v[i][j] * rs * g[j]; ((f32x4*)(p.out + (size_t)t * D))[c4] = o; }
      continue;
    }
    if (mode != 2) UNR for (int i = 0; i < 4; ++i) ((f32x4*)(p.out + (size_t)t * D))[lane + 64 * i] = v[i];
    const float* mb = mod + ((size_t)l * BATCH + b) * 6 * D + (which == 0 ? 0 : 3 * D);
    const float* gw = (which == 0 ? p.norm1_g : p.norm2_g) + (size_t)l * D;
    f32x4 hv[4];
    UNR for (int i = 0; i < 4; ++i) { const int c4 = lane + 64 * i;
      const f32x4 g = ((const f32x4*)gw)[c4], sh = ((const f32x4*)mb)[c4], sc = ((const f32x4*)(mb + D))[c4];
      UNR for (int j = 0; j < 4; ++j) hv[i][j] = (v[i][j] * rs * g[j]) * (1.f + sc[j]) + sh[j];
      u32x2 o; o.x = pk2(hv[i][0], hv[i][1]); o.y = pk2(hv[i][2], hv[i][3]); ((u32x2*)(H + (size_t)t * D))[c4] = o; }
  }
}
constexpr int HSP = 1028;
DEV void phase_norm2_router(const Params& p, int l) {
  char* lds = LDS_PTR();
  float* HS = (float*)lds;
  float* PART = HS + 16 * HSP;
  const int tid = TID, lane = tid & 63, w = tid >> 6;
  const float* mod = (const float*)(p.ws + WS_MOD);
  bf16_t* H = (bf16_t*)(p.ws + WS_H);
  const float* wrg = p.w_rg + (size_t)l * D * NG; const float* wre = p.w_re + (size_t)l * D * NE;
  const float* gw = p.norm2_g + (size_t)l * D;
  for (int tb = BID * 16; tb < T; tb += NBLK * 16) {
    SYNC();
    UNR for (int q = 0; q < 2; ++q) {
      const int tl = 2 * w + q, t = tb + tl, b = t / SEQ;
      f32x4 v[4]; float ss = 0.f;
      UNR for (int i = 0; i < 4; ++i) { v[i] = ((const f32x4*)(p.out + (size_t)t * D))[lane + 64 * i]; ss += v[i][0] * v[i][0] + v[i][1] * v[i][1] + v[i][2] * v[i][2] + v[i][3] * v[i][3]; }
      ss = wave_sum(ss);
      const float rs = 1.f / sqrtf(ss * (1.f / D) + EPS);
      const float* mb = mod + ((size_t)l * BATCH + b) * 6 * D + 3 * D;
      UNR for (int i = 0; i < 4; ++i) { const int c4 = lane + 64 * i;
        const f32x4 g = ((const f32x4*)gw)[c4], sh = ((const f32x4*)mb)[c4], sc = ((const f32x4*)(mb + D))[c4];
        f32x4 hv; UNR for (int j = 0; j < 4; ++j) hv[j] = (v[i][j] * rs * g[j]) * (1.f + sc[j]) + sh[j];
        u32x2 o; o.x = pk2(hv[0], hv[1]); o.y = pk2(hv[2], hv[3]); ((u32x2*)(H + (size_t)t * D))[c4] = o;
        *(f32x4*)(HS + tl * HSP + 4 * c4) = hv; }
    }
    SYNC();
    f32x4 acc[3]; UNR for (int nt = 0; nt < 3; ++nt) acc[nt] = (f32x4){0.f, 0.f, 0.f, 0.f};
#pragma unroll 4
    for (int kk = 0; kk < 32; ++kk) {
      const int d = 128 * w + 4 * kk + (lane >> 4);
      const float a = HS[(lane & 15) * HSP + d];
      const int o0 = lane & 15;
      const float b0 = (o0 < NG) ? wrg[(size_t)d * NG + o0] : wre[(size_t)d * NE + o0 - NG];
      const float b1 = wre[(size_t)d * NE + 16 + o0 - NG];
      const float b2 = (o0 < NG) ? wre[(size_t)d * NE + 32 + o0 - NG] : 0.f;
      acc[0] = mfma4f32(a, b0, acc[0]); acc[1] = mfma4f32(a, b1, acc[1]); acc[2] = mfma4f32(a, b2, acc[2]);
    }
    UNR for (int nt = 0; nt < 3; ++nt) UNR for (int i = 0; i < 4; ++i) PART[(w * 16 + (lane >> 4) * 4 + i) * 48 + nt * 16 + (lane & 15)] = acc[nt][i];
    SYNC();
    if (tid < 16) {
      const int t = tb + tid;
      float lg[NG];
      int g = 0; float gmx = -3.0e38f;
#pragma unroll
      for (int o = 0; o < NG; ++o) { float s = p.b_rg[l * NG + o];
#pragma unroll 1
        for (int ww = 0; ww < 8; ++ww) s += PART[(ww * 16 + tid) * 48 + o]; lg[o] = s; if (s > gmx) { gmx = s; g = o; } }
      float gsum = 0.f; UNR for (int o = 0; o < NG; ++o) gsum += expf(lg[o] - gmx);
      const float ptop = 1.f / gsum;
      int e0 = 0, e1 = 0; float m0 = -3.0e38f, m1 = -3.0e38f;
#pragma unroll 1
      for (int j = 0; j < EPG; ++j) { float s = p.b_re[l * NE + g * EPG + j];
#pragma unroll 1
        for (int ww = 0; ww < 8; ++ww) s += PART[(ww * 16 + tid) * 48 + NG + g * EPG + j];
        if (s > m0) { m1 = m0; e1 = e0; m0 = s; e0 = j; } else if (s > m1) { m1 = s; e1 = j; } }
      const float x1 = expf(m1 - m0), w0 = ptop / (1.f + x1), w1 = ptop * x1 / (1.f + x1);
      int* cnt = (int*)(p.ws + WS_CTL) + CW_CNT + l * NE; int* ent_e = (int*)(p.ws + WS_ENT_E); int* ent_pos = (int*)(p.ws + WS_ENT_POS); float* went = (float*)(p.ws + WS_WENT);
      const int ea = g * EPG + e0, eb = g * EPG + e1;
      ent_e[2 * t] = ea; ent_pos[2 * t] = atomic_add_i(cnt + ea, 1); went[2 * t] = w0;
      ent_e[2 * t + 1] = eb; ent_pos[2 * t + 1] = atomic_add_i(cnt + eb, 1); went[2 * t + 1] = w1;
    }
  }
}

constexpr int GP = 72;
constexpr int LDS_PHASE_BYTES = 131072;
constexpr int LDS_BYTES = LDS_PHASE_BYTES + 256;
DEV void moe_tiles(const Params& p, int l, int* s_pref) {
  SYNC();
  if (TID == 0) { const int* cnt = (const int*)(p.ws + WS_CTL) + CW_CNT + l * NE; int a = 0; for (int e = 0; e < NE; ++e) { s_pref[e] = a; a += (cnt[e] + 255) / 256; } s_pref[NE] = a; }
  SYNC();
}
DEV void phase_moe_gather(const Params& p, int l) {
  int* s_pref = (int*)(LDS_PTR() + LDS_PHASE_BYTES + 64);
  moe_tiles(p, l, s_pref);
  const int* cnt = (const int*)(p.ws + WS_CTL) + CW_CNT + l * NE; const int* ent_e = (const int*)(p.ws + WS_ENT_E); const int* ent_pos = (const int*)(p.ws + WS_ENT_POS);
  const float* went = (const float*)(p.ws + WS_WENT); int* slot_ent = (int*)(p.ws + WS_SLOT_ENT); float* slot_w = (float*)(p.ws + WS_SLOT_W);
  const bf16_t* H = (const bf16_t*)(p.ws + WS_H); bf16_t* HS = (bf16_t*)(p.ws + WS_HS);
  const int tid = TID, lane = tid & 63, wv = tid >> 6;
  for (int i = BID * 8 + wv; i < 2 * T; i += NBLK * 8) {
    const int slot = s_pref[ent_e[i]] * 256 + ent_pos[i];
    const u32x4* src = (const u32x4*)(H + (size_t)(i >> 1) * D); u32x4* dst = (u32x4*)(HS + (size_t)slot * D);
    dst[lane] = src[lane]; dst[lane + 64] = src[lane + 64];
    if (lane == 0) { slot_ent[slot] = i; slot_w[slot] = went[i]; }
  }
  for (int e = BID; e < NE; e += NBLK) { const int s0 = s_pref[e] * 256 + cnt[e], s1 = s_pref[e + 1] * 256; for (int q = s0 + tid; q < s1; q += NTHREADS) slot_ent[q] = -1; }
}
#ifdef EMU
struct RowPlain { const bf16_t* base; size_t ld; DEVM const bf16_t* operator()(int r) const { return base + (size_t)r * ld; } };
template <class RowA>
DEV void gemm_kloop(char* lds, const RowA& rowA, const bf16_t* Bt, size_t ldb, int K, f32x4 (&acc)[4][2]) {
  bf16_t* As = (bf16_t*)lds; bf16_t* Bs = As + 128 * GP;
  const int tid = TID, lane = tid & 63, w = tid >> 6, wm = w >> 2, wn = w & 3;
  const int r0 = tid >> 3, pc = (tid & 7) * 8;
  const bf16_t* a0 = rowA(r0) + pc; const bf16_t* a1 = rowA(r0 + 64) + pc;
  const bf16_t* b0 = Bt + (size_t)r0 * ldb + pc; const bf16_t* b1 = Bt + (size_t)(r0 + 64) * ldb + pc;
  u32x4 ra0 = *(const u32x4*)a0, ra1 = *(const u32x4*)a1, rb0 = *(const u32x4*)b0, rb1 = *(const u32x4*)b1;
  const int nk = K / 64;
  for (int kt = 0; kt < nk; ++kt) {
    SYNC();
    *(u32x4*)(As + r0 * GP + pc) = ra0; *(u32x4*)(As + (r0 + 64) * GP + pc) = ra1;
    *(u32x4*)(Bs + r0 * GP + pc) = rb0; *(u32x4*)(Bs + (r0 + 64) * GP + pc) = rb1;
    SYNC();
    if (kt + 1 < nk) { const int ko = (kt + 1) * 64; ra0 = *(const u32x4*)(a0 + ko); ra1 = *(const u32x4*)(a1 + ko); rb0 = *(const u32x4*)(b0 + ko); rb1 = *(const u32x4*)(b1 + ko); }
#pragma unroll
    for (int ks = 0; ks < 2; ++ks) {
      const int kof = ks * 32 + (lane >> 4) * 8;
      bf16x8 af[4], bfr[2];
#pragma unroll
      for (int mt = 0; mt < 4; ++mt) af[mt] = ld8(As + (wm * 64 + mt * 16 + (lane & 15)) * GP + kof);
#pragma unroll
      for (int nt = 0; nt < 2; ++nt) bfr[nt] = ld8(Bs + (wn * 32 + nt * 16 + (lane & 15)) * GP + kof);
#pragma unroll
      for (int mt = 0; mt < 4; ++mt)
#pragma unroll
        for (int nt = 0; nt < 2; ++nt) acc[mt][nt] = mfma16(af[mt], bfr[nt], acc[mt][nt]);
    }
  }
}
DEV void zero_acc(f32x4 (&acc)[4][2]) { UNR for (int i = 0; i < 4; ++i) UNR for (int j = 0; j < 2; ++j) acc[i][j] = (f32x4){0.f, 0.f, 0.f, 0.f}; }

DEV void phase_gemm_in(const Params& p, int l) {
  char* lds = LDS_PTR();
  const bf16_t* H = (const bf16_t*)(p.ws + WS_H); const bf16_t* W = (const bf16_t*)(p.ws + WS_WIN);
  bf16_t* PROJ = (bf16_t*)(p.ws + WS_PROJ); float* GATES = (float*)(p.ws + WS_GATES);
  const float* bias = p.b_in + (size_t)l * IN_W;
  constexpr int nM = T / 128, nN = NP / 128;
  for (int u = BID; u < nM * nN; u += NBLK) {
    const int pm = u % nM, pn = u / nM;
    f32x4 acc[4][2]; zero_acc(acc);
    RowPlain ra{H + (size_t)pm * 128 * D, (size_t)D};
    gemm_kloop(lds, ra, W + (size_t)pn * 128 * D, D, D, acc);
    const int etid = TID, lane = etid & 63, w = etid >> 6, wm = w >> 2, wn = w & 3;
    UNR for (int nt = 0; nt < 2; ++nt) {
      const int col = pn * 128 + wn * 32 + nt * 16 + (lane & 15);
      if (col >= IN_W) continue;
      const float bv = bias[col];
      UNR for (int mt = 0; mt < 4; ++mt) UNR for (int i = 0; i < 4; ++i) {
        const int row = pm * 128 + wm * 64 + mt * 16 + (lane >> 4) * 4 + i; const float v = acc[mt][nt][i] + bv;
        PROJ[(size_t)row * NP + col] = f2bf(v);
        if (col >= C_GATES && col < C_GATES + 16) GATES[(size_t)row * 16 + (col - C_GATES)] = v;
      }
    }
  }
}
DEV void phase_gemm_merge(const Params& p) {
  char* lds = LDS_PTR();
  const bf16_t* YM = (const bf16_t*)(p.ws + WS_YM); const bf16_t* YA = (const bf16_t*)(p.ws + WS_YA);
  const bf16_t* WM = (const bf16_t*)(p.ws + WS_WBM); const bf16_t* WA = (const bf16_t*)(p.ws + WS_WBA);
  const bf16_t* PROJ = (const bf16_t*)(p.ws + WS_PROJ); bf16_t* MG = (bf16_t*)(p.ws + WS_MERGED);
  constexpr int nM = T / 128, nN = D / 128;
  for (int u = BID; u < nM * nN; u += NBLK) {
    const int pm = u / nN, pn = u % nN;
    f32x4 acc[4][2]; zero_acc(acc);
    RowPlain r1{YM + (size_t)pm * 128 * MW, (size_t)MW}; gemm_kloop(lds, r1, WM + (size_t)pn * 128 * MW, MW, MW, acc);
    float* park = (float*)(lds + 40960);
    { const int ptid = TID; UNR for (int mt = 0; mt < 4; ++mt) UNR for (int nt = 0; nt < 2; ++nt) UNR for (int i = 0; i < 4; ++i) park[((mt * 2 + nt) * 4 + i) * NTHREADS + ptid] = acc[mt][nt][i]; }
    zero_acc(acc);
    RowPlain r2{YA + (size_t)pm * 128 * AW, (size_t)AW}; gemm_kloop(lds, r2, WA + (size_t)pn * 128 * AW, AW, AW, acc);
    const int etid = TID, lane = etid & 63, w = etid >> 6, wm = w >> 2, wn = w & 3;
    UNR for (int nt = 0; nt < 2; ++nt) { const int col = pn * 128 + wn * 32 + nt * 16 + (lane & 15);
      UNR for (int mt = 0; mt < 4; ++mt) UNR for (int i = 0; i < 4; ++i) {
        const int row = pm * 128 + wm * 64 + mt * 16 + (lane >> 4) * 4 + i;
        const float gm = bf2f(PROJ[(size_t)row * NP + C_GM + col]), ga = bf2f(PROJ[(size_t)row * NP + C_GA + col]);
        MG[(size_t)row * D + col] = f2bf(sigmoidf_(gm) * park[((mt * 2 + nt) * 4 + i) * NTHREADS + etid] + sigmoidf_(ga) * acc[mt][nt][i]); } }
  }
}
DEV void phase_gemm_out(const Params& p, int l) {
  char* lds = LDS_PTR();
  const bf16_t* MG = (const bf16_t*)(p.ws + WS_MERGED); const bf16_t* W = (const bf16_t*)(p.ws + WS_WOUT);
  const float* mod = (const float*)(p.ws + WS_MOD);
  constexpr int nM = T / 128, nN = D / 128;
  for (int u = BID; u < nM * nN; u += NBLK) {
    const int pm = u / nN, pn = u % nN;
    f32x4 acc[4][2]; zero_acc(acc);
    RowPlain ra{MG + (size_t)pm * 128 * D, (size_t)D}; gemm_kloop(lds, ra, W + (size_t)pn * 128 * D, D, D, acc);
    const int etid = TID, lane = etid & 63, w = etid >> 6, wm = w >> 2, wn = w & 3;
    const int b = (pm * 128) / SEQ;
    UNR for (int nt = 0; nt < 2; ++nt) { const int col = pn * 128 + wn * 32 + nt * 16 + (lane & 15);
      const float g1 = mod[((size_t)l * BATCH + b) * 6 * D + 2 * D + col];
      UNR for (int mt = 0; mt < 4; ++mt) UNR for (int i = 0; i < 4; ++i) {
        const int row = pm * 128 + wm * 64 + mt * 16 + (lane >> 4) * 4 + i;
        p.out[(size_t)row * D + col] += g1 * acc[mt][nt][i]; } }
  }
}
DEV void phase_moe_up(const Params& p, int l) {
  char* lds = LDS_PTR(); int* s_pref = (int*)(lds + LDS_PHASE_BYTES + 64);
  moe_tiles(p, l, s_pref);
  const bf16_t* HS = (const bf16_t*)(p.ws + WS_HS); const bf16_t* W = (const bf16_t*)(p.ws + WS_WGU); bf16_t* ACT = (bf16_t*)(p.ws + WS_ACT);
  const int* slot_ent = (const int*)(p.ws + WS_SLOT_ENT); const float* slot_w = (const float*)(p.ws + WS_SLOT_W);
  const int ntile = s_pref[NE] * 2;
  for (int u = BID; u < ntile * 8; u += NBLK) {
    const int rt = u >> 3, ct = u & 7;
    int e = 0; while (s_pref[e + 1] <= (rt >> 1)) ++e;
    f32x4 acc[4][2]; zero_acc(acc);
    RowPlain ra{HS + (size_t)rt * 128 * D, (size_t)D};
    gemm_kloop(lds, ra, W + ((size_t)e * 2 * FF + ct * 128) * D, D, D, acc);
    const int etid = TID, lane = etid & 63, w = etid >> 6, wm = w >> 2, wn = w & 3;
    const int f = (ct * 4 + wn) * 16 + (lane & 15);
    UNR for (int mt = 0; mt < 4; ++mt) UNR for (int i = 0; i < 4; ++i) {
      const int slot = rt * 128 + wm * 64 + mt * 16 + (lane >> 4) * 4 + i;
      if (slot_ent[slot] >= 0) { const float wt = slot_w[slot]; const float a = acc[mt][0][i], uu = acc[mt][1][i];
        ACT[(size_t)slot * FF + f] = f2bf(siluf_(a) * uu * wt); } }
  }
}
DEV void phase_moe_down(const Params& p, int l) {
  char* lds = LDS_PTR(); int* s_pref = (int*)(lds + LDS_PHASE_BYTES + 64);
  moe_tiles(p, l, s_pref);
  const bf16_t* ACT = (const bf16_t*)(p.ws + WS_ACT); const bf16_t* W = (const bf16_t*)(p.ws + WS_WD); bf16_t* Y = (bf16_t*)(p.ws + WS_Y);
  const int* slot_ent = (const int*)(p.ws + WS_SLOT_ENT);
  const int ntile = s_pref[NE] * 2;
  for (int u = BID; u < ntile * 8; u += NBLK) {
    const int rt = u >> 3, ct = u & 7;
    int e = 0; while (s_pref[e + 1] <= (rt >> 1)) ++e;
    f32x4 acc[4][2]; zero_acc(acc);
    RowPlain ra{ACT + (size_t)rt * 128 * FF, (size_t)FF};
    gemm_kloop(lds, ra, W + ((size_t)e * D + ct * 128) * FF, FF, FF, acc);
    const int etid = TID, lane = etid & 63, w = etid >> 6, wm = w >> 2, wn = w & 3;
    UNR for (int nt = 0; nt < 2; ++nt) { const int col = ct * 128 + wn * 32 + nt * 16 + (lane & 15);
      UNR for (int mt = 0; mt < 4; ++mt) UNR for (int i = 0; i < 4; ++i) {
        const int slot = rt * 128 + wm * 64 + mt * 16 + (lane >> 4) * 4 + i; const int ent = slot_ent[slot];
        if (ent >= 0) Y[(size_t)ent * D + col] = f2bf(acc[mt][nt][i]); } }
  }
}
#else
namespace pg8 {
#define PG8_LAS __attribute__((address_space(3)))
typedef unsigned short bf16_t;
typedef short bf16x8 __attribute__((ext_vector_type(8)));
typedef float f32x4 __attribute__((ext_vector_type(4)));
typedef unsigned u32x4 __attribute__((ext_vector_type(4)));
constexpr int BM = 256, BK = 64, HALF = 128, HTB = HALF * BK * 2  , STAGE_BYTES = 8 * HTB, NXCD = 8, WGM = 8;

__host__ __device__ __forceinline__ int lds_byte(int r, int c) { const int st = (r >> 4) * 2 + (c >> 5), rr = r & 15, cc = c & 31, ob = rr * 64 + cc * 2; return st * 1024 + (ob ^ (((ob >> 9) & 1) << 5)); }
__host__ __device__ __forceinline__ void stage_rc(int b, int& R, int& C) { const int st = b / 1024, sb = b % 1024, swz = sb ^ (((sb >> 9) & 1) << 5); R = (st >> 1) * 16 + swz / 64; C = (st & 1) * 32 + (swz % 64) / 2; }
__host__ __device__ __forceinline__ int perm32(int rho) { const int n = rho >> 4, i = rho & 15; return 8 * (i >> 2) + 4 * n + (i & 3); }

struct Unit { int pm, pn; };
struct Gemm { const bf16_t* A; const bf16_t* Bt; int M, N, K; };

struct StaticOrder {
    int nM, nN, nwg, G, c;
    __host__ __device__ void init(int M, int N, int G_, int c_) { nM = M / BM; nN = N / BM; nwg = nM * nN; G = G_; c = c_; }
    __host__ __device__ bool next(int i, Unit& u) const {
        const long L = (long)i * G + c; if (L >= nwg) return false;
        int wgid = (int)L; { const int q = nwg / NXCD, r = nwg % NXCD, xcd = wgid % NXCD, off = wgid / NXCD; wgid = (xcd < r ? xcd * (q + 1) : r * (q + 1) + (xcd - r) * q) + off; }
        const int nig = WGM * nN, gid = wgid / nig, fm = gid * WGM, gsz = (nM - fm) < WGM ? (nM - fm) : WGM;
        u.pm = fm + ((wgid % nig) % gsz); u.pn = (wgid % nig) / gsz; return true;
    }
    __device__ __forceinline__ void a_ready(const Unit&) const {}
    __device__ __forceinline__ void done(const Unit&) const {}
};
__device__ __forceinline__ unsigned cvt_pk_bf16(float lo, float hi) { unsigned r; asm volatile("v_cvt_pk_bf16_f32 %0, %1, %2" : "=v"(r) : "v"(lo), "v"(hi)); return r; }
template <class Epi, class Sched, bool ALIGN_EPI = false, bool SP2 = false>
__device__ __forceinline__ void gemm_phase(PG8_LAS unsigned char* lds, const Gemm g, const Sched& S, const Epi& E) {
    const int tid = TID, wid = __builtin_amdgcn_readfirstlane(tid >> 6), lane = tid & 63, wr = wid >> 2, wc = wid & 3, fr = lane & 15, fq = lane >> 4;
    const int K = g.K, nt = K / BK;
    unsigned voffA[2], voffB[2];
#pragma unroll
    for (int i = 0; i < 2; ++i) { int R, C; stage_rc(tid * 16 + i * 8192, R, C); const int Rb = Epi::PERM ? ((R & ~31) + perm32(R & 31)) : R;
        voffA[i] = (unsigned)(R * K + C) * 2u; voffB[i] = (unsigned)(Rb * K + C) * 2u; }
    const size_t kstep = (size_t)(BK * 2);
    const size_t hstep = (size_t)HALF * K * 2;
    const size_t tstep = 2 * hstep;
    const unsigned ldsw = (unsigned)wid * 1024u;
    const int aoff = lds_byte(wr * 64 + fr, fq * 8), boff = lds_byte(wc * 32 + fr, fq * 8);
#define PG8_SA(b, h) (((b) * 2 + (h)) * HTB)
#define PG8_SB(b, h) ((4 + (b) * 2 + (h)) * HTB)
#define PG8_STAGE(bufoff, gbase, voff) do { _Pragma("unroll") for (int _i = 0; _i < 2; ++_i) \
        __builtin_amdgcn_global_load_lds((const unsigned*)((const char*)(gbase) + (voff)[_i]), (PG8_LAS unsigned*)(lds + (bufoff) + ldsw + _i * 8192), 16, 0, 0); } while (0)
#define PG8_LDA(dst, b, h) do { _Pragma("unroll") for (int m = 0; m < 4; ++m) _Pragma("unroll") for (int k = 0; k < 2; ++k) dst[m][k] = *(const PG8_LAS bf16x8*)(lds + PG8_SA(b, h) + aoff + m * 2048 + k * 1024); } while (0)
#define PG8_LDB(dst, b, h) do { _Pragma("unroll") for (int n = 0; n < 2; ++n) _Pragma("unroll") for (int k = 0; k < 2; ++k) dst[n][k] = *(const PG8_LAS bf16x8*)(lds + PG8_SB(b, h) + boff + n * 2048 + k * 1024); } while (0)
#define PG8_MMA(ai, bj, At, Bt) do { __builtin_amdgcn_s_setprio(1); _Pragma("unroll") for (int m = 0; m < 4; ++m) _Pragma("unroll") for (int n = 0; n < 2; ++n) _Pragma("unroll") for (int k = 0; k < 2; ++k) \
        acc[ai][bj][m][n] = __builtin_amdgcn_mfma_f32_16x16x32_bf16(Bt[n][k], At[m][k], acc[ai][bj][m][n], 0, 0, 0); __builtin_amdgcn_s_setprio(0); } while (0)
#define PG8_WAIT_V(n) asm volatile("s_waitcnt vmcnt(" #n ")" ::: "memory")
#define PG8_WAIT_L(n) asm volatile("s_waitcnt lgkmcnt(" #n ")" ::: "memory")
#define PG8_BAR __builtin_amdgcn_s_barrier()
#define PG8_SCHED __builtin_amdgcn_sched_barrier(0)
    Unit cur, nxt; int ui = 0;
    if (!S.next(0, cur)) return;
    f32x4 acc[2][2][4][2];
#pragma unroll
    for (int a = 0; a < 2; ++a)
#pragma unroll
        for (int b = 0; b < 2; ++b)
#pragma unroll
            for (int m = 0; m < 4; ++m)
#pragma unroll
                for (int n = 0; n < 2; ++n) acc[a][b][m][n] = (f32x4){0.f, 0.f, 0.f, 0.f};
    bf16x8 At[4][2], B0[2][2], B1[2][2];
    const char* cA = (const char*)g.A + (size_t)cur.pm * tstep; const char* cB = (const char*)g.Bt + (size_t)cur.pn * tstep;
    S.a_ready(cur);
    if constexpr (SP2) {
        PG8_STAGE(PG8_SB(0, 0), cB, voffB); PG8_STAGE(PG8_SB(0, 1), cB + hstep, voffB); PG8_STAGE(PG8_SA(0, 0), cA, voffA); PG8_STAGE(PG8_SA(0, 1), cA + hstep, voffA);
        if (wr == 1) PG8_BAR;
        PG8_WAIT_V(2); PG8_BAR;
        PG8_STAGE(PG8_SB(1, 0), cB + kstep, voffB); PG8_STAGE(PG8_SA(1, 0), cA + kstep, voffA); PG8_STAGE(PG8_SB(1, 1), cB + hstep + kstep, voffB);
        PG8_WAIT_V(6); PG8_BAR;
    } else {
        PG8_STAGE(PG8_SB(0, 0), cB, voffB); PG8_STAGE(PG8_SA(0, 0), cA, voffA); PG8_STAGE(PG8_SB(0, 1), cB + hstep, voffB); PG8_STAGE(PG8_SA(0, 1), cA + hstep, voffA);
        if (wr == 1) PG8_BAR;
        PG8_WAIT_V(4); PG8_BAR;
        PG8_STAGE(PG8_SB(1, 0), cB + kstep, voffB); PG8_STAGE(PG8_SA(1, 0), cA + kstep, voffA); PG8_STAGE(PG8_SB(1, 1), cB + hstep + kstep, voffB);
        PG8_WAIT_V(6); PG8_BAR;
    }
    for (;;) {
        const bool has_next = S.next(ui + 1, nxt);
        const char* nA = has_next ? (const char*)g.A + (size_t)nxt.pm * tstep : cA; const char* nB = has_next ? (const char*)g.Bt + (size_t)nxt.pn * tstep : cB;
        for (int t = 0; t < nt; t += 2) {
            const bool last = (t == nt - 2);
            const char* a1 = cA + (size_t)(t + 1) * kstep;
            const char* a2 = last ? nA : cA + (size_t)(t + 2) * kstep; const char* b2 = last ? nB : cB + (size_t)(t + 2) * kstep;
            const char* a3 = a2 + kstep; const char* b3 = b2 + kstep;
            if (last && has_next) S.a_ready(nxt);
            if constexpr (SP2) {
            PG8_LDB(B0, 0, 0); PG8_LDB(B1, 0, 1); PG8_SCHED; PG8_LDA(At, 0, 0); PG8_STAGE(PG8_SA(1, 1), a1 + hstep, voffA);
            PG8_WAIT_V(8); PG8_WAIT_L(0); PG8_BAR; PG8_MMA(0, 0, At, B0); PG8_MMA(0, 1, At, B1); PG8_BAR; PG8_SCHED;
            PG8_LDA(At, 0, 1); PG8_STAGE(PG8_SB(0, 0), b2, voffB); PG8_STAGE(PG8_SB(0, 1), b2 + hstep, voffB); PG8_STAGE(PG8_SA(0, 0), a2, voffA);
            PG8_WAIT_V(8); PG8_WAIT_L(0); PG8_BAR; PG8_MMA(1, 0, At, B0); PG8_MMA(1, 1, At, B1); PG8_BAR; PG8_SCHED;
            PG8_LDB(B0, 1, 0); PG8_LDB(B1, 1, 1); PG8_SCHED; PG8_LDA(At, 1, 0); PG8_STAGE(PG8_SA(0, 1), a2 + hstep, voffA);
            PG8_WAIT_V(8); PG8_WAIT_L(0); PG8_BAR; PG8_MMA(0, 0, At, B0); PG8_MMA(0, 1, At, B1); PG8_BAR; PG8_SCHED;
            PG8_LDA(At, 1, 1); PG8_STAGE(PG8_SB(1, 0), b3, voffB); PG8_STAGE(PG8_SB(1, 1), b3 + hstep, voffB); PG8_STAGE(PG8_SA(1, 0), a3, voffA);
            PG8_WAIT_V(8); PG8_WAIT_L(0); PG8_BAR; PG8_MMA(1, 0, At, B0); PG8_MMA(1, 1, At, B1); PG8_BAR; PG8_SCHED;
            } else {
            PG8_LDB(B0, 0, 0); PG8_SCHED; PG8_LDA(At, 0, 0); PG8_STAGE(PG8_SA(1, 1), a1 + hstep, voffA);
            PG8_WAIT_L(8); PG8_BAR; PG8_WAIT_L(0); PG8_MMA(0, 0, At, B0); PG8_BAR; PG8_SCHED;
            PG8_LDB(B1, 0, 1); PG8_STAGE(PG8_SB(0, 0), b2, voffB);
            PG8_BAR; PG8_WAIT_L(0); PG8_MMA(0, 1, At, B1); PG8_BAR;
            PG8_LDA(At, 0, 1); PG8_STAGE(PG8_SA(0, 0), a2, voffA);
            PG8_BAR; PG8_WAIT_L(0); PG8_MMA(1, 0, At, B0); PG8_BAR; PG8_SCHED;
            PG8_STAGE(PG8_SB(0, 1), b2 + hstep, voffB);
            PG8_WAIT_V(6); PG8_BAR; PG8_MMA(1, 1, At, B1); PG8_BAR;
            PG8_LDB(B0, 1, 0); PG8_SCHED; PG8_LDA(At, 1, 0); PG8_STAGE(PG8_SA(0, 1), a2 + hstep, voffA);
            PG8_WAIT_L(8); PG8_BAR; PG8_WAIT_L(0); PG8_MMA(0, 0, At, B0); PG8_BAR; PG8_SCHED;
            PG8_LDB(B1, 1, 1); PG8_STAGE(PG8_SB(1, 0), b3, voffB);
            PG8_BAR; PG8_WAIT_L(0); PG8_MMA(0, 1, At, B1); PG8_BAR;
            PG8_LDA(At, 1, 1); PG8_STAGE(PG8_SA(1, 0), a3, voffA);
            PG8_BAR; PG8_WAIT_L(0); PG8_MMA(1, 0, At, B0); PG8_BAR; PG8_SCHED;
            PG8_STAGE(PG8_SB(1, 1), b3 + hstep, voffB);
            PG8_WAIT_V(6); PG8_BAR; PG8_MMA(1, 1, At, B1); PG8_BAR;
            }
        }
        if constexpr (ALIGN_EPI) { if (wr == 0) PG8_BAR; }
        if constexpr (!Epi::AFTER_DRAIN) { E(acc, cur, wr, wc, fr, fq); S.done(cur); }
        if (!has_next) break;
#pragma unroll
        for (int a = 0; a < 2; ++a)
#pragma unroll
            for (int b = 0; b < 2; ++b)
#pragma unroll
                for (int m = 0; m < 4; ++m)
#pragma unroll
                    for (int n = 0; n < 2; ++n) acc[a][b][m][n] = (f32x4){0.f, 0.f, 0.f, 0.f};
        cur = nxt; cA = nA; cB = nB; ++ui;
        if constexpr (ALIGN_EPI) { if (wr == 1) PG8_BAR; }
    }
    PG8_WAIT_V(0);
    if constexpr (!ALIGN_EPI) { if (wr == 0) PG8_BAR; }
    PG8_BAR;
    if constexpr (Epi::AFTER_DRAIN) { E.fused(acc, cur, wr, wc, fr, fq, lds, wid, lane); S.done(cur); }
#undef PG8_SA
#undef PG8_SB
#undef PG8_STAGE
#undef PG8_LDA
#undef PG8_LDB
#undef PG8_MMA
#undef PG8_WAIT_V
#undef PG8_WAIT_L
#undef PG8_BAR
#undef PG8_SCHED
}
}

typedef pg8::Unit GUnit;
typedef f32x4 GAcc[2][2][4][2];
DEV u32x4 pack8(const f32x4& v0, const f32x4& v1) { u32x4 w; w.x = pg8::cvt_pk_bf16(v0[0], v0[1]); w.y = pg8::cvt_pk_bf16(v0[2], v0[3]); w.z = pg8::cvt_pk_bf16(v1[0], v1[1]); w.w = pg8::cvt_pk_bf16(v1[2], v1[3]); return w; }
DEV void unpack8(const u32x4& w, f32x4& v0, f32x4& v1) {
  v0[0] = __builtin_bit_cast(float, w.x << 16); v0[1] = __builtin_bit_cast(float, w.x & 0xffff0000u); v0[2] = __builtin_bit_cast(float, w.y << 16); v0[3] = __builtin_bit_cast(float, w.y & 0xffff0000u);
  v1[0] = __builtin_bit_cast(float, w.z << 16); v1[1] = __builtin_bit_cast(float, w.z & 0xffff0000u); v1[2] = __builtin_bit_cast(float, w.w << 16); v1[3] = __builtin_bit_cast(float, w.w & 0xffff0000u); }
DEV f32x4 sig4(const f32x4& x) { f32x4 r; UNR for (int i = 0; i < 4; ++i) r[i] = sigmoidf_(x[i]); return r; }
struct EpiIn { static constexpr bool PERM = true, AFTER_DRAIN = false; bf16_t* PROJ; float* GATES; const float* bias;
  DEVM void operator()(const GAcc& acc, const GUnit& u, int wr, int wc, int fr, int fq) const {
    const int row0 = u.pm * 256 + wr * 64 + fr;
    UNR for (int bj = 0; bj < 2; ++bj) { const int c = u.pn * 256 + bj * 128 + wc * 32 + 8 * fq;
      if (c < IN_W) { const f32x4 b0 = *(const f32x4*)(bias + c), b1 = *(const f32x4*)(bias + c + 4);
        UNR for (int ai = 0; ai < 2; ++ai) UNR for (int m = 0; m < 4; ++m) { const int row = row0 + ai * 128 + m * 16;
          const f32x4 v0 = acc[ai][bj][m][0] + b0, v1 = acc[ai][bj][m][1] + b1;
          *(u32x4*)(PROJ + (size_t)row * NP + c) = pack8(v0, v1);
          if (c >= C_GATES && c < C_GATES + 16) { float* gp = GATES + (size_t)row * 16 + (c - C_GATES); *(f32x4*)gp = v0; *(f32x4*)(gp + 4) = v1; } } } }
  } };
struct EpiBm { static constexpr bool PERM = true, AFTER_DRAIN = false; const bf16_t* PROJ; float* TMP;
  DEVM void operator()(const GAcc& acc, const GUnit& u, int wr, int wc, int fr, int fq) const {
    const int row0 = u.pm * 256 + wr * 64 + fr;
    UNR for (int bj = 0; bj < 2; ++bj) { const int c = u.pn * 256 + bj * 128 + wc * 32 + 8 * fq;
      UNR for (int ai = 0; ai < 2; ++ai) UNR for (int m = 0; m < 4; ++m) { const int row = row0 + ai * 128 + m * 16;
        f32x4 g0, g1; unpack8(*(const u32x4*)(PROJ + (size_t)row * NP + C_GM + c), g0, g1);
        float* tp = TMP + (size_t)row * D + c; *(f32x4*)tp = sig4(g0) * acc[ai][bj][m][0]; *(f32x4*)(tp + 4) = sig4(g1) * acc[ai][bj][m][1]; asm volatile("" ::: "memory"); } }
  } };
struct EpiBa { static constexpr bool PERM = true, AFTER_DRAIN = false; const bf16_t* PROJ; const float* TMP; bf16_t* MG;
  DEVM void operator()(const GAcc& acc, const GUnit& u, int wr, int wc, int fr, int fq) const {
    const int row0 = u.pm * 256 + wr * 64 + fr;
    UNR for (int bj = 0; bj < 2; ++bj) { const int c = u.pn * 256 + bj * 128 + wc * 32 + 8 * fq;
      UNR for (int ai = 0; ai < 2; ++ai) UNR for (int m = 0; m < 4; ++m) { const int row = row0 + ai * 128 + m * 16;
        f32x4 g0, g1; unpack8(*(const u32x4*)(PROJ + (size_t)row * NP + C_GA + c), g0, g1);
        const float* tp = TMP + (size_t)row * D + c;
        *(u32x4*)(MG + (size_t)row * D + c) = pack8(*(const f32x4*)tp + sig4(g0) * acc[ai][bj][m][0], *(const f32x4*)(tp + 4) + sig4(g1) * acc[ai][bj][m][1]); asm volatile("" ::: "memory"); } }
  } };
struct EpiOut { static constexpr bool PERM = true, AFTER_DRAIN = false; float* X; const float* modl;
  DEVM void operator()(const GAcc& acc, const GUnit& u, int wr, int wc, int fr, int fq) const {
    const int row0 = u.pm * 256 + wr * 64 + fr; const float* g1p = modl + (size_t)((u.pm * 256) / SEQ) * 6 * D + 2 * D;
    UNR for (int bj = 0; bj < 2; ++bj) { const int c = u.pn * 256 + bj * 128 + wc * 32 + 8 * fq;
      const f32x4 ga = *(const f32x4*)(g1p + c), gb = *(const f32x4*)(g1p + c + 4);
      UNR for (int ai = 0; ai < 2; ++ai) UNR for (int m = 0; m < 4; ++m) { float* xp = X + (size_t)(row0 + ai * 128 + m * 16) * D + c;
        *(f32x4*)xp = *(const f32x4*)xp + ga * acc[ai][bj][m][0]; *(f32x4*)(xp + 4) = *(const f32x4*)(xp + 4) + gb * acc[ai][bj][m][1];
        asm volatile("" ::: "memory"); } }
  } };
struct EpiUp { static constexpr bool PERM = false, AFTER_DRAIN = false; bf16_t* ACT; const int* slot_ent; const float* slot_w;
  DEVM void operator()(const GAcc& acc, const GUnit& u, int wr, int wc, int fr, int fq) const {
    const int ct = u.pn & 3;
    UNR for (int ai = 0; ai < 2; ++ai) UNR for (int m = 0; m < 4; ++m) { const int slot = u.pm * 256 + ai * 128 + wr * 64 + m * 16 + fr;
      if (slot_ent[slot] >= 0) { const float wt = slot_w[slot];
        UNR for (int bj = 0; bj < 2; ++bj) { const int f = (8 * ct + 4 * bj + wc) * 16 + 4 * fq; const f32x4 a = acc[ai][bj][m][0], uu = acc[ai][bj][m][1];
          u32x2 o; o.x = pg8::cvt_pk_bf16(siluf_(a[0]) * uu[0] * wt, siluf_(a[1]) * uu[1] * wt); o.y = pg8::cvt_pk_bf16(siluf_(a[2]) * uu[2] * wt, siluf_(a[3]) * uu[3] * wt);
          *(u32x2*)(ACT + (size_t)slot * FF + f) = o; } } }
  } };
struct EpiDown { static constexpr bool PERM = true, AFTER_DRAIN = false; bf16_t* Y; const int* slot_ent;
  DEVM void operator()(const GAcc& acc, const GUnit& u, int wr, int wc, int fr, int fq) const {
    const int ct = u.pn & 3;
    UNR for (int ai = 0; ai < 2; ++ai) UNR for (int m = 0; m < 4; ++m) { const int ent = slot_ent[u.pm * 256 + ai * 128 + wr * 64 + m * 16 + fr];
      if (ent >= 0) { UNR for (int bj = 0; bj < 2; ++bj) { const int c = ct * 256 + bj * 128 + wc * 32 + 8 * fq;
          *(u32x4*)(Y + (size_t)ent * D + c) = pack8(acc[ai][bj][m][0], acc[ai][bj][m][1]); } } }
  } };
struct MoeOrder { const int* pref; int nunits, G, c;
  DEVM bool next(int i, GUnit& u) const { const long idx = (long)i * G + c; if (idx >= nunits) return false; const int rt = (int)(idx >> 2), ct = (int)(idx & 3);
    int e = 0; while (pref[e + 1] <= rt) ++e; u.pm = rt; u.pn = e * 4 + ct; return true; }
  DEVM void a_ready(const GUnit&) const {}
  DEVM void done(const GUnit&) const {} };
#define GEMM_LDS ((PG8_LAS unsigned char*)dyn_lds)
DEV void phase_gemm_in(const Params& p, int l) {
  pg8::Gemm g{(const bf16_t*)(p.ws + WS_H), (const bf16_t*)(p.ws + WS_WIN), T, NP, D}; pg8::StaticOrder S; S.init(T, NP, NBLK, BID);
  EpiIn E{(bf16_t*)(p.ws + WS_PROJ), (float*)(p.ws + WS_GATES), p.b_in + (size_t)l * IN_W};
  pg8::gemm_phase<EpiIn, pg8::StaticOrder, true, true>(GEMM_LDS, g, S, E);
}
DEV void phase_gemm_merge(const Params& p) {
  { pg8::Gemm g{(const bf16_t*)(p.ws + WS_YM), (const bf16_t*)(p.ws + WS_WBM), T, D, MW}; pg8::StaticOrder S; S.init(T, D, NBLK, BID);
    EpiBm E{(const bf16_t*)(p.ws + WS_PROJ), (float*)(p.ws + WS_TMP)};
    pg8::gemm_phase<EpiBm, pg8::StaticOrder, true, true>(GEMM_LDS, g, S, E); }
  { pg8::Gemm g{(const bf16_t*)(p.ws + WS_YA), (const bf16_t*)(p.ws + WS_WBA), T, D, AW}; pg8::StaticOrder S; S.init(T, D, NBLK, BID);
    EpiBa E{(const bf16_t*)(p.ws + WS_PROJ), (const float*)(p.ws + WS_TMP), (bf16_t*)(p.ws + WS_MERGED)};
    pg8::gemm_phase<EpiBa, pg8::StaticOrder, true, true>(GEMM_LDS, g, S, E); }
}
DEV void phase_gemm_out(const Params& p, int l) {
  pg8::Gemm g{(const bf16_t*)(p.ws + WS_MERGED), (const bf16_t*)(p.ws + WS_WOUT), T, D, D}; pg8::StaticOrder S; S.init(T, D, NBLK, BID);
  EpiOut E{p.out, (const float*)(p.ws + WS_MOD) + (size_t)l * BATCH * 6 * D};
  pg8::gemm_phase<EpiOut, pg8::StaticOrder, true, true>(GEMM_LDS, g, S, E);
}
DEV void phase_moe_up(const Params& p, int l) {
  int* s_pref = (int*)(LDS_PTR() + LDS_PHASE_BYTES + 64);
  moe_tiles(p, l, s_pref);
  pg8::Gemm g{(const bf16_t*)(p.ws + WS_HS), (const bf16_t*)(p.ws + WS_WGU), SLOT_ROWS, NE * 2 * FF, D};
  MoeOrder S{s_pref, s_pref[NE] * 4, NBLK, BID};
  EpiUp E{(bf16_t*)(p.ws + WS_ACT), (const int*)(p.ws + WS_SLOT_ENT), (const float*)(p.ws + WS_SLOT_W)};
  pg8::gemm_phase<EpiUp, MoeOrder, true, true>(GEMM_LDS, g, S, E);
}
DEV void phase_moe_down(const Params& p, int l) {
  int* s_pref = (int*)(LDS_PTR() + LDS_PHASE_BYTES + 64);
  moe_tiles(p, l, s_pref);
  pg8::Gemm g{(const bf16_t*)(p.ws + WS_ACT), (const bf16_t*)(p.ws + WS_WD), SLOT_ROWS, NE * D, FF};
  MoeOrder S{s_pref, s_pref[NE] * 4, NBLK, BID};
  EpiDown E{(bf16_t*)(p.ws + WS_Y), (const int*)(p.ws + WS_SLOT_ENT)};
  pg8::gemm_phase<EpiDown, MoeOrder, true, true>(GEMM_LDS, g, S, E);
}
#endif
DEV void phase_prep(const Params& p, int l) {
  const bf16_t* PROJ = (const bf16_t*)(p.ws + WS_PROJ);
  bf16_t* QC = (bf16_t*)(p.ws + WS_QC); bf16_t* KC = (bf16_t*)(p.ws + WS_KC);
  const int gtid = BID * NTHREADS + TID, gstride = NBLK * NTHREADS;
  const float* cw = p.conv_w + (size_t)l * CONVW * 2 * MW; const float* cb = p.conv_b + (size_t)l * 2 * MW;
  for (int it = gtid; it < T * 128; it += gstride) {
    const int t = it >> 7, c8 = (it & 127) * 8, s = t % SEQ;
    float a[8]; UNR for (int j = 0; j < 8; ++j) a[j] = cb[c8 + j];
    UNR for (int wi = 0; wi < CONVW; ++wi) { const int ss = s + wi - 2; if (ss < 0 || ss >= SEQ) continue;
      const bf16x8 v = ld8(PROJ + (size_t)(t + wi - 2) * NP + c8);
      UNR for (int j = 0; j < 8; ++j) a[j] += bf2f((bf16_t)v[j]) * cw[wi * 2 * MW + c8 + j]; }
    const float sc = (c8 < MW) ? 0.08838834764831845f : 1.f;
    u32x4 o; o.x = pk2(siluf_(a[0]) * sc, siluf_(a[1]) * sc); o.y = pk2(siluf_(a[2]) * sc, siluf_(a[3]) * sc); o.z = pk2(siluf_(a[4]) * sc, siluf_(a[5]) * sc); o.w = pk2(siluf_(a[6]) * sc, siluf_(a[7]) * sc);
    if (c8 < MW) *(u32x4*)(QC + (size_t)t * MW + c8) = o; else *(u32x4*)(KC + (size_t)t * MW + c8 - MW) = o;
  }
  bf16_t* AQN = (bf16_t*)(p.ws + WS_AQN); bf16_t* AKN = (bf16_t*)(p.ws + WS_AKN); bf16_t* VT = (bf16_t*)(p.ws + WS_VT);
  const float* rope = (const float*)(p.ws + WS_ROPE); constexpr int NR = SEQ / GRID_W;
  for (int it0 = BID * NTHREADS; it0 < T * 10 * 8; it0 += gstride) {
    const int it = it0 + TID, j = it & 7, th = it >> 3, hh = th / T, t = th % T, s = t % SEQ;
    const bool isq = hh < AH;
    const bf16_t* src = PROJ + (size_t)t * NP + (isq ? C_AQ + hh * 64 : C_AK + (hh - AH) * 64) + j * 8;
    const float* g = (isq ? p.q_norm_g : p.k_norm_g) + (size_t)l * AHD + j * 8;
    const bf16x8 x8 = ld8(src);
    float v[8], pr[8]; float ss = 0.f;
#pragma unroll
    for (int k = 0; k < 8; ++k) { v[k] = bf2f((bf16_t)x8[k]); ss += v[k] * v[k]; }
    ss += shfl_xor_f(ss, 1); ss += shfl_xor_f(ss, 2); ss += shfl_xor_f(ss, 4);
    const float rs = 1.f / sqrtf(ss * (1.f / 64.f) + EPS);
#pragma unroll
    for (int k = 0; k < 8; ++k) v[k] = v[k] * rs * g[k];
#pragma unroll
    for (int k = 0; k < 8; ++k) pr[k] = shfl_xor_f(v[k], 2);
    const int pos = (j < 4) ? s / GRID_W : s % GRID_W;
    const float* ct = rope + (j < 4 ? 0 : 2 * NR * 16) + pos * 16 + (j & 1) * 8;
    const float* st = ct + (j < 4 ? NR * 16 : 64 * 16);
    const float sgn = (j & 2) ? 1.f : -1.f, qs = isq ? 0.125f * 1.4426950408889634f : 1.f;
    float o[8];
#pragma unroll
    for (int k = 0; k < 8; ++k) o[k] = (v[k] * ct[k] + sgn * pr[k] * st[k]) * qs;
    u32x4 w4; w4.x = pk2(o[0], o[1]); w4.y = pk2(o[2], o[3]); w4.z = pk2(o[4], o[5]); w4.w = pk2(o[6], o[7]);
    bf16_t* dst = isq ? AQN + (size_t)t * AW + hh * 64 + j * 8 : AKN + (size_t)t * KVW + (hh - AH) * 64 + j * 8;
    *(u32x4*)dst = w4;
  }
#ifdef EMU
  for (int it = gtid; it < T * KVH * 8; it += gstride) {
    const int s = it % SEQ, d8 = (it / SEQ) & 7, bk = it / (SEQ * 8), b = bk / KVH, kv = bk % KVH;
    const bf16x8 v8 = ld8(PROJ + (size_t)(b * SEQ + s) * NP + C_AV + kv * 64 + d8 * 8);
#pragma unroll
    for (int k = 0; k < 8; ++k) VT[((size_t)bk * 64 + d8 * 8 + k) * SEQ + s] = (bf16_t)v8[k];
  }
#else
  (void)VT;
#endif
}

#ifdef EMU
DEV void phase_attn(const Params& p) {
  char* lds = LDS_PTR();
  bf16_t* Ks = (bf16_t*)lds; bf16_t* Vs = Ks + 64 * GP; bf16_t* Ps = Vs + 64 * GP;
  const bf16_t* AQN = (const bf16_t*)(p.ws + WS_AQN); const bf16_t* AKN = (const bf16_t*)(p.ws + WS_AKN); const bf16_t* VT = (const bf16_t*)(p.ws + WS_VT);
  bf16_t* YA = (bf16_t*)(p.ws + WS_YA);
  const int tid = TID, lane = tid & 63, w = tid >> 6;
  constexpr int NQB = SEQ / 128, NU = BATCH * AH * NQB;
  bf16_t* Pw = Ps + w * 16 * GP;
  for (int u = BID; u < NU; u += NBLK) {
    const int qb = u % NQB, h = (u / NQB) % AH, b = u / (NQB * AH), kv = h / (AH / KVH);
    const int r0 = qb * 128 + w * 16;
    bf16x8 qa[2];
    UNR for (int ks = 0; ks < 2; ++ks) qa[ks] = ld8(AQN + (size_t)(b * SEQ + r0 + (lane & 15)) * AW + h * 64 + ks * 32 + (lane >> 4) * 8);
    f32x4 o[4]; UNR for (int i = 0; i < 4; ++i) o[i] = (f32x4){0.f, 0.f, 0.f, 0.f};
    float mrow[4], lrow[4]; UNR for (int i = 0; i < 4; ++i) { mrow[i] = -3.0e38f; lrow[i] = 0.f; }
    for (int kt = 0; kt < SEQ / 64; ++kt) {
      SYNC();
      { const int r = tid >> 3, pc = (tid & 7) * 8;
        *(u32x4*)(Ks + r * GP + pc) = *(const u32x4*)(AKN + (size_t)(b * SEQ + kt * 64 + r) * KVW + kv * 64 + pc);
        *(u32x4*)(Vs + r * GP + pc) = *(const u32x4*)(VT + ((size_t)(b * KVH + kv) * 64 + r) * SEQ + kt * 64 + pc); }
      SYNC();
      f32x4 s[4];
      UNR for (int nt = 0; nt < 4; ++nt) { s[nt] = (f32x4){0.f, 0.f, 0.f, 0.f};
        UNR for (int ks = 0; ks < 2; ++ks) s[nt] = mfma16(qa[ks], ld8(Ks + (nt * 16 + (lane & 15)) * GP + ks * 32 + (lane >> 4) * 8), s[nt]); }
      UNR for (int i = 0; i < 4; ++i) {
        float mx = fmaxf(fmaxf(s[0][i], s[1][i]), fmaxf(s[2][i], s[3][i])); mx = grp16_max(mx);
        const float mnew = fmaxf(mrow[i], mx), alpha = exp2f(mrow[i] - mnew); mrow[i] = mnew;
        float rsum = 0.f;
        UNR for (int nt = 0; nt < 4; ++nt) { const float pv = exp2f(s[nt][i] - mnew); rsum += pv; Pw[((lane >> 4) * 4 + i) * GP + nt * 16 + (lane & 15)] = f2bf(pv); }
        lrow[i] = lrow[i] * alpha + rsum;
        UNR for (int nd = 0; nd < 4; ++nd) o[nd][i] *= alpha;
      }
      SYNC();
      UNR for (int ks = 0; ks < 2; ++ks) { const bf16x8 pa = ld8(Pw + (lane & 15) * GP + ks * 32 + (lane >> 4) * 8);
        UNR for (int nd = 0; nd < 4; ++nd) o[nd] = mfma16(pa, ld8(Vs + (nd * 16 + (lane & 15)) * GP + ks * 32 + (lane >> 4) * 8), o[nd]); }
    }
    UNR for (int i = 0; i < 4; ++i) { const float lt = grp16_sum(lrow[i]), inv = 1.f / lt; const int row = b * SEQ + r0 + (lane >> 4) * 4 + i;
      UNR for (int nd = 0; nd < 4; ++nd) YA[(size_t)row * AW + h * 64 + nd * 16 + (lane & 15)] = f2bf(o[nd][i] * inv); }
  }
}

#else
namespace attn_body {
using bf16=unsigned short;
using bf16x8=__attribute__((ext_vector_type(8)))short;
using s16x4=__attribute__((ext_vector_type(4)))short;
using f32x16=__attribute__((ext_vector_type(16)))float;
using u32x4=__attribute__((ext_vector_type(4)))unsigned;
constexpr int SEQ=::SEQ,D=64;
constexpr int NW=8,QBLK=32,QB=QBLK*NW,KVBLK=64,NQB=SEQ/QB;
constexpr int ATTN_UNIT_ROWS=QB;
__device__ __forceinline__ int crow(int r,int hi){return (r&3)+8*(r>>2)+4*hi;}
#define SBAR() __builtin_amdgcn_sched_barrier(0)
constexpr int NSLOT=3, SLOTB=8192;
constexpr int LDS_K=0, LDS_V=NSLOT*SLOTB, LDS_WS=2*NSLOT*SLOTB, LDS_OST=LDS_WS+NW*64*4, LDS_BYTES=LDS_OST+NW*4096;
constexpr float C2=0.125f*1.4426950408889634f;
__device__ __forceinline__ void glds16(const void*gsrc,unsigned lds_dst){unsigned keep;
  asm volatile("s_mov_b32 %0, m0\n\ts_mov_b32 m0, %2\n\ts_nop 0\n\tglobal_load_lds_dwordx4 %1, off\n\ts_mov_b32 m0, %0":"=&s"(keep):"v"(gsrc),"s"(lds_dst):"memory");}
__device__ __forceinline__ float max3f(float a,float b,float c){float r;asm("v_max3_f32 %0, %1, %2, %3":"=v"(r):"v"(a),"v"(b),"v"(c));return r;}
__device__ __forceinline__ float max2f(float a,float b){float r;asm("v_max_f32_e32 %0, %1, %2":"=v"(r):"v"(a),"v"(b));return r;}
__device__ __forceinline__ float fadd_s(float a,float b){float r;asm("v_add_f32_e32 %0, %1, %2":"=v"(r):"v"(a),"v"(b));return r;}
__device__ __forceinline__ float fsub_s(float a,float b){float r;asm("v_sub_f32_e32 %0, %1, %2":"=v"(r):"v"(a),"v"(b));return r;}
typedef float f32x2_t __attribute__((ext_vector_type(2))); typedef __bf16 bf16x2_t __attribute__((ext_vector_type(2)));
__device__ __forceinline__ unsigned cvtpk_s(float lo,float hi){f32x2_t v={lo,hi};bf16x2_t b=__builtin_convertvector(v,bf16x2_t);return __builtin_bit_cast(unsigned,b);}
#define WAIT_BAR(N) asm volatile("s_waitcnt vmcnt(" #N ") lgkmcnt(0)\n\ts_barrier":::"memory")

__device__ __forceinline__ void qkt(f32x16&p0,f32x16&p1,const char*Kslot,const bf16x8*qr,const f32x16&negm,int r32,int hi){
  const char*kb=Kslot+hi*1024+r32*16;
  #pragma unroll
  for(int d0=0;d0<4;++d0){
    const bf16x8 b0=*reinterpret_cast<const bf16x8*>(kb+d0*2048);
    const bf16x8 b1=*reinterpret_cast<const bf16x8*>(kb+d0*2048+512);
    if(d0==0){p0=__builtin_amdgcn_mfma_f32_32x32x16_bf16(b0,qr[0],negm,0,0,0);p1=__builtin_amdgcn_mfma_f32_32x32x16_bf16(b1,qr[0],negm,0,0,0);}
    else{p0=__builtin_amdgcn_mfma_f32_32x32x16_bf16(b0,qr[d0],p0,0,0,0);p1=__builtin_amdgcn_mfma_f32_32x32x16_bf16(b1,qr[d0],p1,0,0,0);}}
}
typedef __attribute__((address_space(3))) const char* lds_cptr;
typedef short v4i16_t __attribute__((ext_vector_type(4)));
__device__ __forceinline__ void kload8(bf16x8*kf,lds_cptr kp){
  kf[0]=*(const __attribute__((address_space(3))) bf16x8*)(kp);      kf[1]=*(const __attribute__((address_space(3))) bf16x8*)(kp+512);
  kf[2]=*(const __attribute__((address_space(3))) bf16x8*)(kp+2048); kf[3]=*(const __attribute__((address_space(3))) bf16x8*)(kp+2560);
  kf[4]=*(const __attribute__((address_space(3))) bf16x8*)(kp+4096); kf[5]=*(const __attribute__((address_space(3))) bf16x8*)(kp+4608);
  kf[6]=*(const __attribute__((address_space(3))) bf16x8*)(kp+6144); kf[7]=*(const __attribute__((address_space(3))) bf16x8*)(kp+6656);
}
__device__ __forceinline__ void kload2(bf16x8*kf,lds_cptr kp,int j){ kf[2*j]=*(const __attribute__((address_space(3))) bf16x8*)(kp+j*2048); kf[2*j+1]=*(const __attribute__((address_space(3))) bf16x8*)(kp+j*2048+512); }
__device__ __forceinline__ s16x4 vtr(lds_cptr p){ return __builtin_bit_cast(s16x4,__builtin_amdgcn_ds_read_tr16_b64_v4i16((__attribute__((address_space(3))) v4i16_t*)p)); }
__device__ __forceinline__ float rowmax(const f32x16&p0,const f32x16&p1){
  float a=max3f(p0[0],p0[1],p1[0]),b=max3f(p0[2],p0[3],p1[1]);a=max3f(a,p1[2],p1[3]);
  #pragma unroll
  for(int r=4;r<16;r+=4){a=max3f(a,p0[r],p0[r+1]);b=max3f(b,p0[r+2],p0[r+3]);a=max3f(a,p1[r],p1[r+1]);b=max3f(b,p1[r+2],p1[r+3]);}
  const float m=max2f(a,b);
  auto rr=__builtin_amdgcn_permlane32_swap(__float_as_uint(m),__float_as_uint(m),false,false);
  return max2f(__uint_as_float(rr[0]),__uint_as_float(rr[1]));
}
__device__ __forceinline__ void pv(f32x16*o,int vb,bf16x8 pa0,bf16x8 pa1,bf16x8 pa2,bf16x8 pa3){
  #pragma unroll
  for(int d0=0;d0<2;++d0){s16x4 lo[4],hi[4];
    #pragma unroll
    for(int ks=0;ks<4;++ks){
      asm volatile("ds_read_b64_tr_b16 %0,%1 offset:%c2":"=&v"(lo[ks]):"v"(vb),"i"(d0*4096+ks*1024):"memory");
      asm volatile("ds_read_b64_tr_b16 %0,%1 offset:%c2":"=&v"(hi[ks]):"v"(vb),"i"(d0*4096+ks*1024+512):"memory");}
    asm volatile("s_waitcnt lgkmcnt(0)":::"memory");SBAR();
    #define PK(k) (bf16x8){lo[k][0],lo[k][1],lo[k][2],lo[k][3],hi[k][0],hi[k][1],hi[k][2],hi[k][3]}
    o[d0]=__builtin_amdgcn_mfma_f32_32x32x16_bf16(pa0,PK(0),o[d0],0,0,0);
    o[d0]=__builtin_amdgcn_mfma_f32_32x32x16_bf16(pa1,PK(1),o[d0],0,0,0);
    o[d0]=__builtin_amdgcn_mfma_f32_32x32x16_bf16(pa2,PK(2),o[d0],0,0,0);
    o[d0]=__builtin_amdgcn_mfma_f32_32x32x16_bf16(pa3,PK(3),o[d0],0,0,0);
    #undef PK
  }
}

#ifndef ATTN_STORE16
#define ATTN_STORE16(p,v) (*(u32x4*)(p)=(v))
#endif
template<int THRL,int QP,int KP,int VP> __device__ __forceinline__ void attn_unit(long rowbase,int qb,const bf16*Q,const bf16*__restrict__ K,const bf16*__restrict__ V,bf16*O,char*shm){
  const int tid=TID,lane=tid&63,r32=lane&31,hi=lane>>5; const int wid=__builtin_amdgcn_readfirstlane(tid>>6);
  const int q0=qb*QB;
  const bf16*Qw=Q+(rowbase+q0+wid*QBLK)*QP;
  const bf16*Kh=K+rowbase*KP,*Vh=V+rowbase*VP;
  const unsigned lds0=(unsigned)(uintptr_t)shm;
  float*wsf=(float*)(shm+LDS_WS)+wid*64;
  const bf16*ksrc=Kh+(long)lane*KP+wid*8;
  const bf16*vsrc=Vh+(long)(16*(wid&3)+(lane>>2))*VP+(wid>>2)*32+(lane&3)*8;
  const unsigned kdst=lds0+LDS_K+wid*1024, vdst=lds0+LDS_V+wid*1024;
  #define DMA_K(t,slot) glds16(ksrc+(long)(t)*KVBLK*KP,(unsigned)__builtin_amdgcn_readfirstlane(kdst+(slot)))
  #define DMA_V(t,slot) glds16(vsrc+(long)(t)*KVBLK*VP,(unsigned)__builtin_amdgcn_readfirstlane(vdst+(slot)))
  const int vb0=(int)(lds0+LDS_V)+((lane>>4)&1)*32+(lane&3)*8+(4*hi+((lane&15)>>2))*64;
  const char*Kbase=shm+LDS_K; bf16x8 kf[8];
  const lds_cptr shm3=(lds_cptr)shm; const lds_cptr kp0=shm3+LDS_K+hi*1024+r32*16; const lds_cptr vp0=shm3+LDS_V+((lane>>4)&1)*32+(lane&3)*8+(4*hi+((lane&15)>>2))*64;
  int NT=SEQ/KVBLK; asm volatile("":"+s"(NT));
  DMA_K(0,0);DMA_V(0,0);DMA_K(1,SLOTB);
  bf16x8 qr[4];
  #pragma unroll
  for(int d0=0;d0<4;++d0)qr[d0]=*reinterpret_cast<const bf16x8*>(&Qw[(long)r32*QP+d0*16+hi*8]);
  float mhat=0.f,l_reg=0.f;f32x16 o[2];o[0]=f32x16{};o[1]=f32x16{};f32x16 negm=f32x16{};asm volatile("":"+v"(negm));
  #define CMASK(P0,P1,t) do{}while(0)
  bool resc=false;
  #define START(P0,P1) do{ const float rm=rowmax(P0,P1); resc=false; \
    { const float dl=rm; mhat=fadd_s(mhat,dl); \
      _Pragma("unroll") for(int r=0;r<16;++r){P0[r]=fsub_s(P0[r],dl);P1[r]=fsub_s(P1[r],dl);} \
      _Pragma("unroll") for(int r=0;r<16;++r)negm[r]=-mhat; asm volatile("":"+v"(negm)); } \
    _Pragma("unroll") for(int r=0;r<16;++r)P0[r]=__builtin_amdgcn_exp2f(P0[r]); }while(0)
  #define RESC() do{ if(resc){ asm volatile("s_waitcnt lgkmcnt(0)":::"memory"); \
      _Pragma("unroll") for(int d_=0;d_<2;++d_) _Pragma("unroll") for(int r=0;r<16;++r)o[d_][r]*=wsf[crow(r,hi)]; } }while(0)
  f32x16 pA0,pA1,pB0,pB1;
  int sl_prev=0,sl_cur=0,sl_next=SLOTB;
  #define ROT() do{sl_prev=sl_cur;sl_cur=sl_next;sl_next=(sl_next==(NSLOT-1)*SLOTB)?0:sl_next+SLOTB;}while(0)
  DMA_K(2,2*SLOTB);
  WAIT_BAR(3);
  qkt(pA0,pA1,Kbase,qr,negm,r32,hi);asm volatile("s_nop 15\n\ts_nop 7":"+v"(pA0),"+v"(pA1));CMASK(pA0,pA1,0);
  START(pA0,pA1);
  _Pragma("unroll") for(int r=0;r<16;++r)pA1[r]=__builtin_amdgcn_exp2f(pA1[r]);
  WAIT_BAR(0);
  DMA_K(3,0);DMA_V(1,SLOTB);
  ROT();
  kload8(kf,kp0+sl_cur);
  WAIT_BAR(2);
  s16x4 vlo[8],vhi[8]; u32x4 pw0,pw1,pw2,pw3;
  #define PKW(P,B) cvtpk_s(P[B],P[B+1])
  #define PAF(k) __builtin_bit_cast(bf16x8,pw##k)
  #define VFR(i) (bf16x8){vlo[i][0],vlo[i][1],vlo[i][2],vlo[i][3],vhi[i][0],vhi[i][1],vhi[i][2],vhi[i][3]}
  #define PIN(x) asm volatile("":"+v"(x))
  #define MX3(a,b,c) __builtin_fmaxf(__builtin_fmaxf((a),(b)),(c))
  #define GAPA(MF,A0,A1,A2,A3,W0,W1,PW) do{ MF; sacc+=A0; sacc+=A1; sacc+=A2; sacc+=A3; PIN(sacc); W0; W1; PIN(PW); SBAR(); }while(0)
  #define EX(v) __builtin_amdgcn_exp2f(v)
  #define GAPB(MF,X,B) do{ MF; X[B]=EX(X[B]); X[B+1]=EX(X[B+1]); X[B+2]=EX(X[B+2]); X[B+3]=EX(X[B+3]); PIN(X); SBAR(); }while(0)
  #define VRD(i) do{ vlo[i]=vtr(vp_+(((i)>>2)*4096+((i)&3)*1024)); vhi[i]=vtr(vp_+(((i)>>2)*4096+((i)&3)*1024+512)); }while(0)
  #define KRD(G,j) do{ if(G){ kload2(kf,kp0+sl_next,j); SBAR(); } }while(0)
  #define STEP(C0,C1,P0,P1,t,GK,GV,GL) do{ SBAR(); \
    const lds_cptr vp_=vp0+sl_prev; \
    VRD(0); SBAR(); float sacc=(P0[0]+P0[1]); \
    GAPA(C0=__builtin_amdgcn_mfma_f32_32x32x16_bf16(kf[0],qr[0],negm,0,0,0), P0[2],P0[3],P0[4],P0[5],     pw0[0]=PKW(P0,0), pw0[1]=PKW(P0,2), pw0); \
    VRD(4); SBAR(); GAPA(C1=__builtin_amdgcn_mfma_f32_32x32x16_bf16(kf[1],qr[0],negm,0,0,0), P0[6],P0[7],P0[8],P0[9],     pw0[2]=PKW(P0,4), pw0[3]=PKW(P0,6), pw0); \
    VRD(1); SBAR(); GAPA(C0=__builtin_amdgcn_mfma_f32_32x32x16_bf16(kf[2],qr[1],C0,0,0,0),   P0[10],P0[11],P0[12],P0[13], pw1[0]=PKW(P0,8), pw1[1]=PKW(P0,10), pw1); \
    VRD(5); SBAR(); GAPA(C1=__builtin_amdgcn_mfma_f32_32x32x16_bf16(kf[3],qr[1],C1,0,0,0),   P0[14],P0[15],P1[0],P1[1],   pw1[2]=PKW(P0,12),pw1[3]=PKW(P0,14), pw1); \
    VRD(2); SBAR(); GAPA(C0=__builtin_amdgcn_mfma_f32_32x32x16_bf16(kf[4],qr[2],C0,0,0,0),   P1[2],P1[3],P1[4],P1[5],     pw2[0]=PKW(P1,0), pw2[1]=PKW(P1,2), pw2); \
    VRD(6); SBAR(); GAPA(C1=__builtin_amdgcn_mfma_f32_32x32x16_bf16(kf[5],qr[2],C1,0,0,0),   P1[6],P1[7],P1[8],P1[9],     pw2[2]=PKW(P1,4), pw2[3]=PKW(P1,6), pw2); \
    VRD(3); SBAR(); GAPA(C0=__builtin_amdgcn_mfma_f32_32x32x16_bf16(kf[6],qr[3],C0,0,0,0),   P1[10],P1[11],P1[12],P1[13], pw3[0]=PKW(P1,8), pw3[1]=PKW(P1,10), pw3); \
    VRD(7); SBAR(); GAPA(C1=__builtin_amdgcn_mfma_f32_32x32x16_bf16(kf[7],qr[3],C1,0,0,0),   P1[14],P1[15],0.f,0.f,       pw3[2]=PKW(P1,12),pw3[3]=PKW(P1,14), pw3); \
    l_reg+=sacc; \
    if(GK){DMA_K((t)+3,sl_cur);} if(GV){DMA_V((t)+1,sl_next);} \
    CMASK(C0,C1,t); \
    { float a=MX3(C0[0],C0[1],C1[0]),b=MX3(C0[2],C0[3],C1[1]); a=MX3(a,C1[2],C1[3]); \
      _Pragma("unroll") for(int r=4;r<16;r+=4){a=MX3(a,C0[r],C0[r+1]);b=MX3(b,C0[r+2],C0[r+3]);a=MX3(a,C1[r],C1[r+1]);b=MX3(b,C1[r+2],C1[r+3]);} \
      float rm=__builtin_fmaxf(a,b); { auto rr=__builtin_amdgcn_permlane32_swap(__float_as_uint(rm),__float_as_uint(rm),false,false); rm=__builtin_fmaxf(__uint_as_float(rr[0]),__uint_as_float(rr[1])); } \
      resc=false; \
      if(__builtin_expect(__any(rm>(float)THRL),0)){ const float dl=__builtin_fmaxf(rm,0.f); mhat+=dl; \
        _Pragma("unroll") for(int r=0;r<16;++r){C0[r]-=dl;C1[r]-=dl;} \
        _Pragma("unroll") for(int r=0;r<16;++r)negm[r]=-mhat; asm volatile("":"+v"(negm)); \
        const float f=__builtin_amdgcn_exp2f(-dl); l_reg*=f; if(hi==0)wsf[r32]=f; resc=true; } } \
    SBAR(); \
    GAPB(o[0]=__builtin_amdgcn_mfma_f32_32x32x16_bf16(PAF(0),VFR(0),o[0],0,0,0), C0,0); \
    GAPB(o[1]=__builtin_amdgcn_mfma_f32_32x32x16_bf16(PAF(0),VFR(4),o[1],0,0,0), C0,4); \
    KRD(GL,0); GAPB(o[0]=__builtin_amdgcn_mfma_f32_32x32x16_bf16(PAF(1),VFR(1),o[0],0,0,0), C0,8); \
    KRD(GL,1); GAPB(o[1]=__builtin_amdgcn_mfma_f32_32x32x16_bf16(PAF(1),VFR(5),o[1],0,0,0), C0,12); \
    KRD(GL,2); GAPB(o[0]=__builtin_amdgcn_mfma_f32_32x32x16_bf16(PAF(2),VFR(2),o[0],0,0,0), C1,0); \
    KRD(GL,3); GAPB(o[1]=__builtin_amdgcn_mfma_f32_32x32x16_bf16(PAF(2),VFR(6),o[1],0,0,0), C1,4); \
    GAPB(o[0]=__builtin_amdgcn_mfma_f32_32x32x16_bf16(PAF(3),VFR(3),o[0],0,0,0), C1,8); \
    GAPB(o[1]=__builtin_amdgcn_mfma_f32_32x32x16_bf16(PAF(3),VFR(7),o[1],0,0,0), C1,12); \
    }while(0)
  int t=1;
  for(;t+5<NT;t+=2){
    STEP(pB0,pB1,pA0,pA1,t,true,true,true);     WAIT_BAR(2); RESC(); ROT();
    STEP(pA0,pA1,pB0,pB1,t+1,true,true,true);   WAIT_BAR(2); RESC(); ROT();
  }
  #define ENDW(tt) do{ if((tt)+3<NT){WAIT_BAR(2);} else if((tt)+2<NT){WAIT_BAR(1);} else {WAIT_BAR(0);} }while(0)
  for(;t+1<NT;t+=2){
    STEP(pB0,pB1,pA0,pA1,t,(t+3<NT),(t+1<NT),(t+1<NT));       ENDW(t);   RESC(); ROT();
    STEP(pA0,pA1,pB0,pB1,t+1,(t+4<NT),(t+2<NT),(t+2<NT));     ENDW(t+1); RESC(); ROT();
  }
  STEP(pB0,pB1,pA0,pA1,NT-1,false,false,false); RESC();
  { float sacc=pB0[0]+pB0[1]; _Pragma("unroll") for(int r=2;r<16;++r)sacc+=pB0[r]; _Pragma("unroll") for(int r=0;r<16;++r)sacc+=pB1[r]; l_reg+=sacc;
    pw0=(u32x4){PKW(pB0,0),PKW(pB0,2),PKW(pB0,4),PKW(pB0,6)};pw1=(u32x4){PKW(pB0,8),PKW(pB0,10),PKW(pB0,12),PKW(pB0,14)};pw2=(u32x4){PKW(pB1,0),PKW(pB1,2),PKW(pB1,4),PKW(pB1,6)};pw3=(u32x4){PKW(pB1,8),PKW(pB1,10),PKW(pB1,12),PKW(pB1,14)};
    SBAR(); pv(o,vb0+sl_cur,PAF(0),PAF(1),PAF(2),PAF(3)); }
  #undef PKW
  #undef PAF
  #undef VFR
  #undef PIN
  #undef MX3
  #undef GAPA
  #undef GAPB
  #undef EX
  #undef VRD
  #undef KRD
  #undef STEP
  #undef ENDW
  {auto rr=__builtin_amdgcn_permlane32_swap(__float_as_uint(l_reg),__float_as_uint(l_reg),false,false);l_reg=__uint_as_float(rr[0])+__uint_as_float(rr[1]);}
  if(hi==0)wsf[32+r32]=l_reg;asm volatile("s_waitcnt lgkmcnt(0)":::"memory");
  float rli[16];
  #pragma unroll
  for(int r=0;r<16;++r)rli[r]=__builtin_amdgcn_rcpf(wsf[32+crow(r,hi)]);
  bf16*Ow=O+(rowbase+q0+wid*QBLK)*QP;
  { bf16*stg=(bf16*)(shm+LDS_OST)+wid*2048;
    #pragma unroll
    for(int r=0;r<16;++r){const int orow=crow(r,hi);
      #pragma unroll
      for(int d0=0;d0<2;++d0)stg[orow*64+d0*32+r32]=f2bf(o[d0][r]*rli[r]);}
    asm volatile("s_waitcnt lgkmcnt(0)":::"memory");
    #pragma unroll
    for(int i=0;i<4;++i){const int row=i*8+(lane>>3),ch=lane&7; const u32x4 v=*(const u32x4*)(stg+row*64+ch*8); ATTN_STORE16(Ow+(long)row*QP+ch*8,v);} }
  asm volatile("s_waitcnt lgkmcnt(0)\n\ts_barrier":::"memory");
  #undef DMA_K
  #undef DMA_V
  #undef CMASK
  #undef START
  #undef RESC
  #undef ROT
}
#undef SBAR
#undef WAIT_BAR
}

DEV void phase_attn(const Params& p) {
  char* lds = LDS_PTR();
  const bf16_t* AQN = (const bf16_t*)(p.ws + WS_AQN); const bf16_t* AKN = (const bf16_t*)(p.ws + WS_AKN); const bf16_t* PROJ = (const bf16_t*)(p.ws + WS_PROJ);
  bf16_t* YA = (bf16_t*)(p.ws + WS_YA);
  constexpr int NQB = SEQ / 256, NU = BATCH * AH * NQB;
  for (int u = BID; u < NU; u += NBLK) {
    const int qb = u % NQB, h = (u / NQB) % AH, b = u / (NQB * AH), kv = h / (AH / KVH);
    attn_body::attn_unit<8, AW, KVW, NP>((long)b * SEQ, qb, AQN + h * 64, AKN + kv * 64, PROJ + C_AV + kv * 64, YA + h * 64, lds);
  }
}
#endif
DEV void phase_mlstm_a(const Params& p) {
  char* lds = LDS_PTR();
  bf16_t* VW = (bf16_t*)lds;
  bf16_t* KT = VW + 2 * 128 * GP;
  float* sc = (float*)(KT + 128 * GP);
  float* s_lf = sc; float* s_a = sc + 128; float* s_w = sc + 256;
  const bf16_t* PROJ = (const bf16_t*)(p.ws + WS_PROJ); const bf16_t* KC = (const bf16_t*)(p.ws + WS_KC); const float* GATES = (const float*)(p.ws + WS_GATES);
  bf16_t* CST = (bf16_t*)(p.ws + WS_CST); float* NST = (float*)(p.ws + WS_NST); float* AMAX = (float*)(p.ws + WS_AMAX); float* BLAST = (float*)(p.ws + WS_BLAST);
  const int tid = TID, lane = tid & 63, w = tid >> 6;
  for (int u = BID; u < BHC; u += NBLK) {
    const int c = u % NC, h = (u / NC) % MH, b = u / (NC * MH);
    const int t0 = b * SEQ + c * ML;
    SYNC();
    if (tid < 128) { const int dir = tid >> 6, l = tid & 63; s_lf[dir * 64 + l] = logsigmoidf_(GATES[(size_t)(t0 + l) * 16 + (dir ? 12 : 4) + h]); }
    SYNC();
    if (tid < 128) { const int dir = tid >> 6, l = tid & 63; const float li = GATES[(size_t)(t0 + l) * 16 + (dir ? 8 : 0) + h];
      float a = li;
      if (dir == 0) { for (int q = l + 1; q < 64; ++q) a += s_lf[q]; } else { for (int q = 0; q < l; ++q) a += s_lf[64 + q]; }
      s_a[dir * 64 + l] = a; }
    SYNC();
    if (tid < 128) { const int dir = tid >> 6, l = tid & 63; float mx = -3.0e38f, tot = 0.f;
      for (int q = 0; q < 64; ++q) { mx = fmaxf(mx, s_a[dir * 64 + q]); tot += s_lf[dir * 64 + q]; }
      s_w[dir * 64 + l] = expf(s_a[dir * 64 + l] - mx);
      if (l == 0) { AMAX[dir * BHC + u] = mx; BLAST[dir * BHC + u] = tot; } }
    SYNC();
    for (int it = tid; it < 1024; it += NTHREADS) { const int l = it >> 4, d8 = (it & 15) * 8;
      const bf16x8 v8 = ld8(PROJ + (size_t)(t0 + l) * NP + C_MV + h * 128 + d8); const bf16x8 k8 = ld8(KC + (size_t)(t0 + l) * MW + h * 128 + d8);
      const float wf = s_w[l], wb = s_w[64 + l];
      UNR for (int j = 0; j < 8; ++j) { const float vf = bf2f((bf16_t)v8[j]); VW[(d8 + j) * GP + l] = f2bf(vf * wf); VW[(128 + d8 + j) * GP + l] = f2bf(vf * wb); KT[(d8 + j) * GP + l] = (bf16_t)k8[j]; } }
    SYNC();
    { const int dir = w >> 2, m2 = w & 3;
      UNR for (int mi = 0; mi < 2; ++mi) { const int mt = m2 * 2 + mi;
        bf16x8 af[2]; UNR for (int ks = 0; ks < 2; ++ks) af[ks] = ld8(VW + (dir * 128 + mt * 16 + (lane & 15)) * GP + ks * 32 + (lane >> 4) * 8);
        UNR for (int nt = 0; nt < 8; ++nt) { f32x4 acc = (f32x4){0.f, 0.f, 0.f, 0.f};
          UNR for (int ks = 0; ks < 2; ++ks) acc = mfma16(af[ks], ld8(KT + (nt * 16 + (lane & 15)) * GP + ks * 32 + (lane >> 4) * 8), acc);
          bf16_t* dst = CST + ((size_t)(dir * BHC + u) * 128 + mt * 16 + (lane >> 4) * 4) * 128 + nt * 16 + (lane & 15);
          UNR for (int i = 0; i < 4; ++i) dst[i * 128] = f2bf(acc[i]); } } }
    if (tid < 256) { const int dir = tid >> 7, e = tid & 127; float s = 0.f; for (int l = 0; l < 64; ++l) s += s_w[dir * 64 + l] * bf2f(KT[e * GP + l]); NST[(size_t)(dir * BHC + u) * 128 + e] = s; }
  }
}
DEV void phase_mlstm_scan(const Params& p) {
  bf16_t* CST = (bf16_t*)(p.ws + WS_CST); float* NST = (float*)(p.ws + WS_NST);
  const float* AMAX = (const float*)(p.ws + WS_AMAX); const float* BLAST = (const float*)(p.ws + WS_BLAST); float* MPREV = (float*)(p.ws + WS_MPREV);
  const int gtid = BID * NTHREADS + TID, gstride = NBLK * NTHREADS;
  constexpr int PER = 8192, SB = (NC % 8 == 0) ? 8 : 4;
  for (int it = gtid; it < 2 * BATCH * MH * PER; it += gstride) {
    const int pi = it % PER, dbh = it / PER, dir = dbh / (BATCH * MH), bh = dbh % (BATCH * MH);
    const bool hasn = pi < 64;
    float s0 = 0.f, s1 = 0.f, n0 = 0.f, n1 = 0.f, m = 0.f;
    for (int cc0 = 0; cc0 < NC; cc0 += SB) {
      unsigned in[SB]; float bl[SB], am[SB], i0[SB], i1[SB];
      UNR for (int j = 0; j < SB; ++j) { const int c = dir ? NC - 1 - (cc0 + j) : cc0 + j; const int u = dir * BHC + bh * NC + c;
        in[j] = *((const unsigned*)(CST + (size_t)u * 16384) + pi); bl[j] = BLAST[u]; am[j] = AMAX[u];
        if (hasn) { i0[j] = NST[(size_t)u * 128 + 2 * pi]; i1[j] = NST[(size_t)u * 128 + 2 * pi + 1]; } else { i0[j] = 0.f; i1[j] = 0.f; } }
      UNR for (int j = 0; j < SB; ++j) { const int c = dir ? NC - 1 - (cc0 + j) : cc0 + j; const int u = dir * BHC + bh * NC + c;
        const float mn = fmaxf(bl[j] + m, am[j]), dec = expf(bl[j] + m - mn), inj = expf(am[j] - mn);
        *((unsigned*)(CST + (size_t)u * 16384) + pi) = pk2(s0, s1);
        s0 = dec * s0 + inj * bf2f((bf16_t)(in[j] & 0xffff)); s1 = dec * s1 + inj * bf2f((bf16_t)(in[j] >> 16));
        if (hasn) { NST[(size_t)u * 128 + 2 * pi] = n0; NST[(size_t)u * 128 + 2 * pi + 1] = n1; n0 = dec * n0 + inj * i0[j]; n1 = dec * n1 + inj * i1[j]; }
        if (pi == 0) MPREV[u] = m;
        m = mn; }
    }
  }
}
constexpr int QP = 136;
constexpr int C_HALF_BYTES = (64 * QP * 2) * 2 + 128 * GP * 2 + 4 * 16 * GP * 2 + (4 * 64 + 2 * 128 + 4) * 4;
DEV void phase_mlstm_c(const Params& p, int l) {
  char* lds = LDS_PTR();
  const int tid = TID, lane = tid & 63, w = tid >> 6, half = w >> 2, wv = w & 3, htid = tid & 255;
  char* hb = lds + half * ((C_HALF_BYTES + 255) & ~255);
  bf16_t* Qs = (bf16_t*)hb; bf16_t* Ks = Qs + 64 * QP; bf16_t* VTs = Ks + 64 * QP; bf16_t* Ps = VTs + 128 * GP;
  float* s_b = (float*)(Ps + 4 * 16 * GP);
  float* s_li = s_b + 128;
  float* s_n = s_li + 128;
  float* s_m = s_n + 256;
  bf16_t* Pw = Ps + wv * 16 * GP;
  const bf16_t* PROJ = (const bf16_t*)(p.ws + WS_PROJ); const bf16_t* QC = (const bf16_t*)(p.ws + WS_QC); const bf16_t* KC = (const bf16_t*)(p.ws + WS_KC);
  const float* GATES = (const float*)(p.ws + WS_GATES); const bf16_t* CST = (const bf16_t*)(p.ws + WS_CST); const float* NST = (const float*)(p.ws + WS_NST);
  const float* MPREV = (const float*)(p.ws + WS_MPREV); bf16_t* YM = (bf16_t*)(p.ws + WS_YM);
  const float* ng = p.mlstm_norm_g + (size_t)l * MW;
  for (int u0 = BID * 2; u0 < BHC; u0 += NBLK * 2) {
    const int u = u0 + half;
    const int c = u % NC, h = (u / NC) % MH, b = u / (NC * MH);
    const int t0 = b * SEQ + c * ML;
    SYNC();
    for (int it = htid; it < 1024; it += 256) { const int r = it >> 4, d8 = (it & 15) * 8;
      *(u32x4*)(Qs + r * QP + d8) = *(const u32x4*)(QC + (size_t)(t0 + r) * MW + h * 128 + d8);
      *(u32x4*)(Ks + r * QP + d8) = *(const u32x4*)(KC + (size_t)(t0 + r) * MW + h * 128 + d8);
      const bf16x8 v8 = ld8(PROJ + (size_t)(t0 + r) * NP + C_MV + h * 128 + d8);
      UNR for (int j = 0; j < 8; ++j) VTs[(d8 + j) * GP + r] = (bf16_t)v8[j]; }
    if (htid < 128) { const int dir = htid >> 6, q = htid & 63; s_li[dir * 64 + q] = GATES[(size_t)(t0 + q) * 16 + (dir ? 8 : 0) + h];
      s_b[dir * 64 + q] = logsigmoidf_(GATES[(size_t)(t0 + q) * 16 + (dir ? 12 : 4) + h]); }
    s_n[htid] = NST[(size_t)((htid >> 7) * BHC + u) * 128 + (htid & 127)];
    if (htid < 2) s_m[htid] = MPREV[htid * BHC + u];
    SYNC();
    float cum = 0.f;
    if (htid < 128) { const int dir = htid >> 6, q = htid & 63;
      if (dir == 0) { for (int z = 0; z <= q; ++z) cum += s_b[z]; } else { for (int z = q; z < 64; ++z) cum += s_b[64 + z]; } }
    SYNC();
    if (htid < 128) s_b[htid] = cum;
    SYNC();
    const int j0 = wv * 16;
    bf16x8 qa[4]; UNR for (int ks = 0; ks < 4; ++ks) qa[ks] = ld8(Qs + (j0 + (lane & 15)) * QP + ks * 32 + (lane >> 4) * 8);
    f32x4 S[4];
    UNR for (int nt = 0; nt < 4; ++nt) { S[nt] = (f32x4){0.f, 0.f, 0.f, 0.f};
      UNR for (int ks = 0; ks < 4; ++ks) S[nt] = mfma16(qa[ks], ld8(Ks + (nt * 16 + (lane & 15)) * QP + ks * 32 + (lane >> 4) * 8), S[nt]); }
    f32x4 hs[8]; UNR for (int nd = 0; nd < 8; ++nd) hs[nd] = (f32x4){0.f, 0.f, 0.f, 0.f};
#pragma unroll 1
    for (int dir = 0; dir < 2; ++dir) {
      float qn = 0.f; { const int e0 = (lane >> 4) * 32;
        for (int e = 0; e < 32; ++e) qn += bf2f(Qs[(j0 + (lane & 15)) * QP + e0 + e]) * s_n[dir * 128 + e0 + e];
        qn += shfl_xor_f(qn, 16); qn += shfl_xor_f(qn, 32); }
      const float* bb = s_b + dir * 64; const float* li = s_li + dir * 64; const float mp = s_m[dir];
      float fsc[4];
      UNR for (int i = 0; i < 4; ++i) {
        const int j = j0 + (lane >> 4) * 4 + i; const float bj = bb[j];
        float dv[4], sv[4], mx = -3.0e38f;
        UNR for (int nt = 0; nt < 4; ++nt) { const int lk = nt * 16 + (lane & 15); const bool ok = dir ? (lk >= j) : (lk <= j);
          dv[nt] = ok ? (bj - bb[lk] + li[lk]) : -3.0e38f; mx = fmaxf(mx, dv[nt]); }
        mx = grp16_max(mx);
        const float mi = bj + mp, mo = fmaxf(mi, mx);
        float rsum = 0.f;
        UNR for (int nt = 0; nt < 4; ++nt) { sv[nt] = (dv[nt] > -1.0e38f) ? S[nt][i] * expf(dv[nt] - mo) : 0.f; rsum += sv[nt]; }
        rsum = grp16_sum(rsum);
        const float iw = expf(mi - mo);
        const float qnj = shfl_f(qn, (lane >> 4) * 4 + i);
        const float den = rsum + iw * qnj;
        const float dinv = 1.f / fmaxf(fabsf(den), expf(-mo));
        UNR for (int nt = 0; nt < 4; ++nt) Pw[((lane >> 4) * 4 + i) * GP + nt * 16 + (lane & 15)] = f2bf(sv[nt] * dinv);
        fsc[i] = iw * dinv;
      }
      float fa = 0.f;
      UNR for (int i = 0; i < 4; ++i) { const float tv = shfl_f(fsc[i], ((lane & 15) >> 2) * 16); fa = ((lane & 3) == i) ? tv : fa; }
      SYNC();
      UNR for (int ks = 0; ks < 2; ++ks) { const bf16x8 pa = ld8(Pw + (lane & 15) * GP + ks * 32 + (lane >> 4) * 8);
        UNR for (int nd = 0; nd < 8; ++nd) hs[nd] = mfma16(pa, ld8(VTs + (nd * 16 + (lane & 15)) * GP + ks * 32 + (lane >> 4) * 8), hs[nd]); }
      const bf16_t* Cp = CST + (size_t)(dir * BHC + u) * 16384;
      UNR for (int ks = 0; ks < 4; ++ks) {
        bf16x8 qs; UNR for (int e = 0; e < 8; ++e) qs[e] = (short)f2bf(bf2f((bf16_t)qa[ks][e]) * fa);
        UNR for (int nd = 0; nd < 8; ++nd) hs[nd] = mfma16(qs, ld8(Cp + (size_t)(nd * 16 + (lane & 15)) * 128 + ks * 32 + (lane >> 4) * 8), hs[nd]); }
      SYNC();
    }
    UNR for (int i = 0; i < 4; ++i) { float ss = 0.f; UNR for (int nd = 0; nd < 8; ++nd) ss += hs[nd][i] * hs[nd][i];
      ss = grp16_sum(ss); const float rs = 1.f / sqrtf(ss * (1.f / 128.f) + EPS);
      const int t = t0 + j0 + (lane >> 4) * 4 + i;
      UNR for (int nd = 0; nd < 8; ++nd) { const int d = nd * 16 + (lane & 15); const float og = bf2f(PROJ[(size_t)t * NP + C_MO + h * 128 + d]);
        YM[(size_t)t * MW + h * 128 + d] = f2bf(hs[nd][i] * rs * ng[h * 128 + d] * sigmoidf_(og)); } }
  }
}

#ifndef EMU
#define XB_TMO      128
#define XB_XCNT(j)  (256  + 64 * (j))
#define XB_XSUB(j)  (1280 + 64 * (j))
#define XB_XGEN(j)  (2304 + 64 * (j))
#define XB_TOP      3328
#define XB_TOPGEN   3392
#define XCD_BAR_WORDS 3456
#define XB_SPIN_CAP (1u << 18)
#define LAS __attribute__((address_space(3)))
__device__ __forceinline__ unsigned xb_ld(unsigned* p)              { return __hip_atomic_load(p, __ATOMIC_RELAXED, __HIP_MEMORY_SCOPE_AGENT); }
__device__ __forceinline__ unsigned xb_add(unsigned* p, unsigned v) { return __hip_atomic_fetch_add(p, v, __ATOMIC_RELAXED, __HIP_MEMORY_SCOPE_AGENT); }
__device__ __forceinline__ unsigned xb_xcc_id() { return (unsigned)__builtin_amdgcn_s_getreg((3 << 11) | 20) & 0xFu; }
#define XB_SPIN(cond, bar) do { unsigned _sp = 0; while (cond) { __builtin_amdgcn_s_sleep(1); \
    if ((++_sp & 255u) == 0u) { if (xb_ld(&(bar)[XB_TMO])) break; if (_sp > XB_SPIN_CAP) { atomicAdd(&(bar)[XB_TMO], 1u); break; } } } } while (0)
struct XcdBarrier { unsigned* bar; unsigned x; volatile LAS unsigned* st; };
__device__ __forceinline__ XcdBarrier xcd_barrier_post(unsigned* bar, volatile LAS unsigned* st) {
    XcdBarrier b; b.bar = bar; b.x = xb_xcc_id(); b.st = st;
    if (threadIdx.x == 0) (void)xb_add(&bar[XB_XCNT(b.x)], 1u);
    return b;
}
__device__ __forceinline__ void xcd_barrier_complete(unsigned* bar, unsigned x, unsigned& nloc, unsigned& nx) {
    const unsigned G = gridDim.x * gridDim.y * gridDim.z;
    unsigned sum, cnt, mine, sp = 0u;
    for (;;) {
        sum = 0u; cnt = 0u; mine = 0u;
#pragma unroll
        for (unsigned j = 0; j < 16; ++j) { const unsigned c = xb_ld(&bar[XB_XCNT(j)]); sum += c; cnt += (c > 0u) ? 1u : 0u; mine = (j == x) ? c : mine; }
        if (sum == G) break;
        __builtin_amdgcn_s_sleep(1);
        if ((++sp & 255u) == 0u) { if (xb_ld(&bar[XB_TMO])) break; if (sp > XB_SPIN_CAP) { atomicAdd(&bar[XB_TMO], 1u); break; } }
    }
    nloc = mine > 0u ? mine : 1u; nx = cnt > 0u ? cnt : 1u;
}
__device__ __forceinline__ void xcd_barrier(const XcdBarrier& b) {
    asm volatile("s_waitcnt vmcnt(0)" ::: "memory");
    __syncthreads();
    if (threadIdx.x == 0) {
        unsigned* bar = b.bar;
        __builtin_amdgcn_s_waitcnt(0);
        unsigned nloc = b.st[0], nx = b.st[1];
        if (nloc == 0u) { xcd_barrier_complete(bar, b.x, nloc, nx); b.st[0] = nloc; b.st[1] = nx; }
        const unsigned old = xb_add(&bar[XB_XSUB(b.x)], 1u);
        const unsigned gen = old / nloc;
        if (old + 1u == (gen + 1u) * nloc) {
            __builtin_amdgcn_fence(__ATOMIC_RELEASE, "agent");
            asm volatile("s_waitcnt vmcnt(0)" ::: "memory");
            const unsigned og = xb_add(&bar[XB_TOP], 1u);
            const unsigned tg = og / nx;
            if (og + 1u == (tg + 1u) * nx) xb_add(&bar[XB_TOPGEN], 1u);
            else XB_SPIN(xb_ld(&bar[XB_TOPGEN]) == tg, bar);
            __builtin_amdgcn_fence(__ATOMIC_ACQUIRE, "agent");
            xb_add(&bar[XB_XGEN(b.x)], 1u);
            asm volatile("s_waitcnt vmcnt(0)" ::: "memory");
        } else {
            XB_SPIN(xb_ld(&bar[XB_XGEN(b.x)]) == gen, bar);
            __builtin_amdgcn_fence(__ATOMIC_ACQUIRE, "agent");
            asm volatile("s_waitcnt vmcnt(0)" ::: "memory");
        }
    }
    __syncthreads();
}
__device__ __forceinline__ Params fresh(const Params& p) { Params q = p; unsigned long long w = (unsigned long long)q.ws; asm volatile("" : "+s"(w)); q.ws = (unsigned char*)w; return q; }
#define GRID_BAR() do { XcdBarrier xb_ = xbar; unsigned long long bw_ = (unsigned long long)xb_.bar; asm volatile("" : "+s"(bw_)); xb_.bar = (unsigned*)bw_; xcd_barrier(xb_); } while (0)
__global__ void __launch_bounds__(NTHREADS, 2) k_fwd(Params p) {
  {
    volatile LAS unsigned* st = (volatile LAS unsigned*)(LAS char*)(dyn_lds + LDS_PHASE_BYTES);
    if (threadIdx.x == 0) { st[0] = 0u; st[1] = 0u; st[2] = 0u; st[3] = 0u; }
    __syncthreads();
  }
  const XcdBarrier xbar = xcd_barrier_post((unsigned*)(p.ws + WS_CTL) + CW_BAR, (volatile LAS unsigned*)(LAS char*)(dyn_lds + LDS_PHASE_BYTES));
#else
#define GRID_BAR() emu_gridsync()
static inline Params fresh(const Params& p) { return p; }
static void k_fwd(Params p) {
#endif
  if (PHMASK & (1u << 0)) { phase_mod_rope(fresh(p)); if (DUP_PHASE == 0) { GRID_BAR(); phase_mod_rope(fresh(p)); } }
  for (int l = 0; l < DEPTH; ++l) {
    if (PHMASK & (1u << 1)) { phase_convert(fresh(p), l); if (DUP_PHASE == 1) { GRID_BAR(); phase_convert(fresh(p), l); } }
    GRID_BAR();
    if (PHMASK & (1u << 2)) { if (l == 0) phase_norm(fresh(p), l, 0, 0); else phase_norm(fresh(p), l, 1, 0); if (DUP_PHASE == 2) { GRID_BAR(); if (l == 0) phase_norm(fresh(p), l, 0, 0); else phase_norm(fresh(p), l, 1, 0); } }
    GRID_BAR();
    if (PHMASK & (1u << 3)) { phase_gemm_in(fresh(p), l); if (DUP_PHASE == 3) { GRID_BAR(); phase_gemm_in(fresh(p), l); } }
    GRID_BAR();
    if (PHMASK & (1u << 4)) { phase_prep(fresh(p), l); if (DUP_PHASE == 4) { GRID_BAR(); phase_prep(fresh(p), l); } }
    GRID_BAR();
    if (PHMASK & (1u << 5)) { phase_mlstm_a(fresh(p)); if (DUP_PHASE == 5) { GRID_BAR(); phase_mlstm_a(fresh(p)); } }
    GRID_BAR();
    if (PHMASK & (1u << 6)) { phase_mlstm_scan(fresh(p)); if (DUP_PHASE == 6) { GRID_BAR(); phase_mlstm_scan(fresh(p)); } }
    if (PHMASK & (1u << 7)) { phase_attn(fresh(p)); if (DUP_PHASE == 7) { GRID_BAR(); phase_attn(fresh(p)); } }
    GRID_BAR();
    if (PHMASK & (1u << 8)) { phase_mlstm_c(fresh(p), l); if (DUP_PHASE == 8) { GRID_BAR(); phase_mlstm_c(fresh(p), l); } }
    GRID_BAR();
    if (PHMASK & (1u << 9)) { phase_gemm_merge(fresh(p)); if (DUP_PHASE == 9) { GRID_BAR(); phase_gemm_merge(fresh(p)); } }
    GRID_BAR();
    if (PHMASK & (1u << 10)) { phase_gemm_out(fresh(p), l); if (DUP_PHASE == 10) { GRID_BAR(); phase_gemm_out(fresh(p), l); } }
    GRID_BAR();
    if (PHMASK & (1u << 11)) { phase_norm2_router(fresh(p), l); if (DUP_PHASE == 11) { GRID_BAR(); phase_norm2_router(fresh(p), l); } }
    GRID_BAR();
    if (PHMASK & (1u << 15)) { phase_moe_gather(fresh(p), l); if (DUP_PHASE == 15) { GRID_BAR(); phase_moe_gather(fresh(p), l); } }
    GRID_BAR();
    if (PHMASK & (1u << 12)) { phase_moe_up(fresh(p), l); if (DUP_PHASE == 12) { GRID_BAR(); phase_moe_up(fresh(p), l); } }
    GRID_BAR();
    if (PHMASK & (1u << 13)) { phase_moe_down(fresh(p), l); if (DUP_PHASE == 13) { GRID_BAR(); phase_moe_down(fresh(p), l); } }
    GRID_BAR();
  }
  if (PHMASK & (1u << 14)) { phase_norm(fresh(p), DEPTH, 1, 2); if (DUP_PHASE == 14) { GRID_BAR(); phase_norm(fresh(p), DEPTH, 1, 2); } }
}

#ifdef EMU
static int emu_grid_size = 8;
static int emu_stop_after = 1000;
#endif
extern "C" void kernel_launch(void* const* d_in, const int* in_sizes, int n_in, void* d_out, int out_size, void* d_ws, size_t ws_size, hipStream_t stream) {
  (void)in_sizes; (void)n_in; (void)out_size;
  if (ws_size < WS_TOTAL) { fprintf(stderr, "workspace too small: %zu < %zu\n", ws_size, (size_t)WS_TOTAL); return; }
  Params prm{};
  const float** f = (const float**)&prm;
  for (int i = 0; i < 24; ++i) f[i] = (const float*)d_in[i];
  prm.out = (float*)d_out; prm.ws = (unsigned char*)d_ws;
#ifdef EMU
  memset(d_ws, 0, CTL_BYTES);
  emu_launch(emu_grid_size, NTHREADS, LDS_BYTES, [=]() { k_fwd(prm); }, true);
#else
  static int grid = 0;
  if (!grid) {
    int dev = 0, cus = 0, per_cu = 0;
    (void)hipGetDevice(&dev);
    (void)hipDeviceGetAttribute(&cus, hipDeviceAttributeMultiprocessorCount, dev);
    (void)hipFuncSetAttribute((const void*)k_fwd, hipFuncAttributeMaxDynamicSharedMemorySize, LDS_BYTES);
    (void)hipOccupancyMaxActiveBlocksPerMultiprocessor(&per_cu, k_fwd, NTHREADS, LDS_BYTES);
    grid = cus * (per_cu < 1 ? per_cu : 1);
    if (grid <= 0) { fprintf(stderr, "occupancy query says the kernel does not fit (cus %d per_cu %d)\n", cus, per_cu); grid = 0; return; }
  }
  (void)hipMemsetAsync(d_ws, 0, CTL_BYTES, stream);
  k_fwd<<<grid, NTHREADS, LDS_BYTES, stream>>>(prm);
#endif
}
```

```cpp
#ifdef EMU
#include "emu.h"
#define TID emu_tid()
#define BID emu_bid()
#define NBLK emu_nblk()
#define SYNC() emu_syncthreads()
#define DEV static inline
#define DEVM inline
#else
#include <hip/hip_runtime.h>
#include <cstdio>
#include <cstdint>
__device__ __forceinline__ int tid_opaque() { int t = (int)threadIdx.x; asm volatile("" : "+v"(t)); return t; }
#define TID tid_opaque()
#define BID ((int)blockIdx.x)
#define NBLK ((int)gridDim.x)
#define SYNC() __syncthreads()
#define DEV __device__ __forceinline__
#define DEVM __device__ __forceinline__
#endif

#ifndef CFG_SEQ
#define CFG_SEQ 8192
#endif
#ifndef CFG_BATCH
#define CFG_BATCH 2
#endif

#ifndef DUP_PHASE
#define DUP_PHASE (-1)
#endif
#ifndef PHMASK
#define PHMASK 0xFFFFFFFFu
#endif
#define UNR _Pragma("unroll")
typedef unsigned short bf16_t;
typedef short bf16x8 __attribute__((ext_vector_type(8)));
typedef float f32x4 __attribute__((ext_vector_type(4)));
typedef unsigned u32x4 __attribute__((ext_vector_type(4)));
typedef unsigned u32x2 __attribute__((ext_vector_type(2)));

constexpr int D = 1024, BATCH = CFG_BATCH, SEQ = CFG_SEQ, DEPTH = 2, T = BATCH * SEQ;
constexpr int GRID_W = 64;
constexpr int MH = 4, MHD = 128, MW = 512, ML = 64, NC = SEQ / ML, CONVW = 5;
constexpr int AH = 8, KVH = 2, AHD = 64, AW = 512, KVW = 128;
constexpr int NG = 4, EPG = 8, NE = 32, FF = 512;
constexpr float EPS = 1e-6f;
constexpr int IN_W = 4880, NP = 5120;
constexpr int C_MQ = 0, C_MK = 512, C_MV = 1024, C_MO = 1536, C_GATES = 2048, C_AQ = 2064, C_AK = 2576, C_AV = 2704, C_GM = 2832, C_GA = 3856;
constexpr int NTHREADS = 512;
constexpr int BHC = BATCH * MH * NC;
constexpr int ROWT_MAX = (2 * T) / 256 + NE;
constexpr int SLOT_ROWS = ROWT_MAX * 256;

constexpr size_t al256(size_t x) { return (x + 255) & ~(size_t)255; }
constexpr size_t WS_CTL = 0, CTL_BYTES = 1 << 20;
constexpr size_t WS_MOD = WS_CTL + CTL_BYTES;
constexpr size_t WS_ROPE = WS_MOD + al256((size_t)DEPTH * BATCH * 6 * D * 4);
constexpr size_t WS_WIN = WS_ROPE + al256((size_t)(2 * (SEQ / GRID_W) * 16 + 2 * 64 * 16) * 4);
constexpr size_t WS_WBM = WS_WIN + (size_t)NP * D * 2;
constexpr size_t WS_WBA = WS_WBM + (size_t)D * MW * 2;
constexpr size_t WS_WOUT = WS_WBA + (size_t)D * AW * 2;
constexpr size_t WS_WGU = WS_WOUT + (size_t)D * D * 2;
constexpr size_t WS_WD = WS_WGU + (size_t)NE * 2 * FF * D * 2;
constexpr size_t WS_PROJ = WS_WD + (size_t)NE * D * FF * 2;
constexpr size_t WS_ACT = WS_PROJ;
constexpr size_t WS_Y = WS_ACT + al256((size_t)SLOT_ROWS * FF * 2);
constexpr size_t PROJ_BYTES = (size_t)T * NP * 2;
constexpr size_t OVL_BYTES = (WS_Y + (size_t)2 * T * D * 2 - WS_PROJ) > PROJ_BYTES ? (WS_Y + (size_t)2 * T * D * 2 - WS_PROJ) : PROJ_BYTES;
constexpr size_t WS_GATES = WS_PROJ + al256(OVL_BYTES);
constexpr size_t WS_QC = WS_GATES + (size_t)T * 16 * 4;
constexpr size_t WS_KC = WS_QC + (size_t)T * MW * 2;
constexpr size_t WS_MERGED = WS_QC;
constexpr size_t WS_AQN = WS_KC + (size_t)T * MW * 2;
constexpr size_t WS_AKN = WS_AQN + (size_t)T * AW * 2;
constexpr size_t WS_VT = WS_AKN + (size_t)T * KVW * 2;
constexpr size_t WS_YM = WS_VT + (size_t)T * KVW * 2;
constexpr size_t WS_YA = WS_YM + (size_t)T * MW * 2;
constexpr size_t QCYA_BYTES = WS_YA + (size_t)T * AW * 2 - WS_QC;
constexpr size_t HS_BYTES = (size_t)SLOT_ROWS * D * 2;
constexpr size_t WS_HS = WS_QC;
constexpr size_t WS_CST = WS_QC + al256(HS_BYTES > QCYA_BYTES ? HS_BYTES : QCYA_BYTES);
constexpr size_t WS_H = WS_CST;
constexpr size_t WS_TMP = WS_CST;
constexpr size_t CST_BYTES = (size_t)2 * BHC * 128 * 128 * 2;
static_assert((size_t)T * D * 4 <= CST_BYTES, "H and TMP fit in CST");
constexpr size_t WS_NST = WS_CST + CST_BYTES;
constexpr size_t WS_AMAX = WS_NST + (size_t)2 * BHC * 128 * 4;
constexpr size_t WS_BLAST = WS_AMAX + al256((size_t)2 * BHC * 4);
constexpr size_t WS_MPREV = WS_BLAST + al256((size_t)2 * BHC * 4);
constexpr size_t WS_ENT_E = WS_MPREV + al256((size_t)2 * BHC * 4);
constexpr size_t WS_ENT_POS = WS_ENT_E + (size_t)2 * T * 4;
constexpr size_t WS_WENT = WS_ENT_POS + (size_t)2 * T * 4;
constexpr size_t WS_SLOT_ENT = WS_WENT + (size_t)2 * T * 4;
constexpr size_t WS_SLOT_W = WS_SLOT_ENT + (size_t)SLOT_ROWS * 4;
constexpr size_t WS_TOTAL = WS_SLOT_W + (size_t)SLOT_ROWS * 4;
constexpr int CW_CNT = 64;
constexpr int CW_BAR = 4096;

struct Params {
  const float *x, *c, *w_ada, *b_ada, *norm1_g, *w_in, *b_in, *conv_w, *conv_b, *mlstm_norm_g, *q_norm_g, *k_norm_g, *w_branch_m, *w_branch_a, *w_out, *norm2_g,
      *w_rg, *b_rg, *w_re, *b_re, *w_gate, *w_up, *w_down, *final_g;
  float* out; unsigned char* ws;
};

DEV float bf2f(bf16_t h) { return __builtin_bit_cast(float, (unsigned)h << 16); }
DEV bf16_t f2bf(float f) { unsigned u = __builtin_bit_cast(unsigned, f); return (bf16_t)((u + 0x7fffu + ((u >> 16) & 1u)) >> 16); }
DEV unsigned pk2(float lo, float hi) { return (unsigned)f2bf(lo) | ((unsigned)f2bf(hi) << 16); }
#ifdef EMU
DEV float sigmoidf_(float x) { return 1.f / (1.f + expf(-x)); }
DEV float siluf_(float x) { return x / (1.f + expf(-x)); }
#else
DEV float sigmoidf_(float x) { return __builtin_amdgcn_rcpf(1.f + __builtin_amdgcn_exp2f(-1.4426950408889634f * x)); }
DEV float siluf_(float x) { return x * __builtin_amdgcn_rcpf(1.f + __builtin_amdgcn_exp2f(-1.4426950408889634f * x)); }
#endif
DEV float logsigmoidf_(float x) { return fminf(x, 0.f) - log1pf(expf(-fabsf(x))); }

#ifdef EMU
static inline f32x4 mfma16(bf16x8 a, bf16x8 b, f32x4 c) {
  struct In { bf16x8 a, b; f32x4 c; } in{a, b, c}; f32x4 out;
  emu_collective(&in, sizeof(In), &out, sizeof(out), [](char (*I)[64], char (*O)[32]) {
    float Dm[16][16];
    for (int r = 0; r < 16; ++r) for (int cc = 0; cc < 16; ++cc) { In* L = (In*)I[(r >> 2) * 16 + cc]; Dm[r][cc] = L->c[r & 3]; }
    for (int r = 0; r < 16; ++r) for (int cc = 0; cc < 16; ++cc) { float s = 0.f;
      for (int g = 0; g < 4; ++g) { In* LA = (In*)I[g * 16 + r]; In* LB = (In*)I[g * 16 + cc]; for (int j = 0; j < 8; ++j) s += bf2f((bf16_t)LA->a[j]) * bf2f((bf16_t)LB->b[j]); }
      Dm[r][cc] += s; }
    for (int l = 0; l < 64; ++l) { f32x4 o; for (int i = 0; i < 4; ++i) o[i] = Dm[(l >> 4) * 4 + i][l & 15]; memcpy(O[l], &o, 16); } });
  return out;
}
static inline f32x4 mfma4f32(float a, float b, f32x4 c) {
  struct In { float a, b; f32x4 c; } in{a, b, c}; f32x4 out;
  emu_collective(&in, sizeof(In), &out, sizeof(out), [](char (*I)[64], char (*O)[32]) {
    for (int l = 0; l < 64; ++l) { f32x4 o; UNR for (int i = 0; i < 4; ++i) { const int r = (l >> 4) * 4 + i, cc = l & 15; float s = ((In*)I[l])->c[i];
      for (int k = 0; k < 4; ++k) s = fmaf(((In*)I[k * 16 + r])->a, ((In*)I[k * 16 + cc])->b, s); o[i] = s; } memcpy(O[l], &o, 16); } });
  return out;
}
static inline float shfl_xor_f(float v, int m) { float out; emu_collective(&v, 4, &out, 4, [m](char (*I)[64], char (*O)[32]) { for (int l = 0; l < 64; ++l) memcpy(O[l], I[l ^ m], 4); }); return out; }
static inline float shfl_f(float v, int src) { struct In { float v; int s; } in{v, src}; float out;
  emu_collective(&in, 8, &out, 4, [](char (*I)[64], char (*O)[32]) { for (int l = 0; l < 64; ++l) { In* me = (In*)I[l]; memcpy(O[l], I[me->s & 63], 4); } }); return out; }
static inline int atomic_add_i(int* p, int v) { return __atomic_fetch_add(p, v, __ATOMIC_RELAXED); }
#define LDS_PTR() emu_lds()
#else
DEV f32x4 mfma16(bf16x8 a, bf16x8 b, f32x4 c) { return __builtin_amdgcn_mfma_f32_16x16x32_bf16(a, b, c, 0, 0, 0); }
DEV f32x4 mfma4f32(float a, float b, f32x4 c) { return __builtin_amdgcn_mfma_f32_16x16x4f32(a, b, c, 0, 0, 0); }
DEV float shfl_xor_f(float v, int m) {
  const int iv = __builtin_bit_cast(int, v);
  switch (m) {
    case 1: return __builtin_bit_cast(float, __builtin_amdgcn_ds_swizzle(iv, (1 << 10) | 0x1f));
    case 2: return __builtin_bit_cast(float, __builtin_amdgcn_ds_swizzle(iv, (2 << 10) | 0x1f));
    case 4: return __builtin_bit_cast(float, __builtin_amdgcn_ds_swizzle(iv, (4 << 10) | 0x1f));
    case 8: return __builtin_bit_cast(float, __builtin_amdgcn_ds_swizzle(iv, (8 << 10) | 0x1f));
    case 16: return __builtin_bit_cast(float, __builtin_amdgcn_ds_swizzle(iv, (16 << 10) | 0x1f));
    default: { const int lane = TID & 63; return __builtin_bit_cast(float, __builtin_amdgcn_ds_bpermute(((lane ^ m) & 63) << 2, iv)); }
  }
}
DEV float shfl_f(float v, int src) { return __builtin_bit_cast(float, __builtin_amdgcn_ds_bpermute((src & 63) << 2, __builtin_bit_cast(int, v))); }
DEV int atomic_add_i(int* p, int v) { return atomicAdd(p, v); }
extern __shared__ __attribute__((aligned(16))) char dyn_lds[];
#define LDS_PTR() (dyn_lds)
#endif
DEV float grp16_sum(float v) { v += shfl_xor_f(v, 1); v += shfl_xor_f(v, 2); v += shfl_xor_f(v, 4); v += shfl_xor_f(v, 8); return v; }
DEV float grp16_max(float v) { v = fmaxf(v, shfl_xor_f(v, 1)); v = fmaxf(v, shfl_xor_f(v, 2)); v = fmaxf(v, shfl_xor_f(v, 4)); v = fmaxf(v, shfl_xor_f(v, 8)); return v; }
DEV float wave_sum(float v) { v = grp16_sum(v); v += shfl_xor_f(v, 16); v += shfl_xor_f(v, 32); return v; }
DEV bf16x8 ld8(const bf16_t* p) { return __builtin_bit_cast(bf16x8, *(const u32x4*)p); }

DEV void phase_mod_rope(const Params& p) {
  float* mod = (float*)(p.ws + WS_MOD);
  const int gtid = BID * NTHREADS + TID, gstride = NBLK * NTHREADS;
  {
    float* red = (float*)LDS_PTR();
    const int tid = TID, j = tid & 63, q = tid >> 6;
    for (int it = BID; it < DEPTH * (6 * D / 64); it += NBLK) {
      const int l = it / (6 * D / 64), n0 = (it % (6 * D / 64)) * 64;
      const float* w = p.w_ada + (size_t)l * D * 6 * D + (size_t)(128 * q) * 6 * D + n0 + j;
      float s[BATCH]; UNR for (int b = 0; b < BATCH; ++b) s[b] = 0.f;
#pragma unroll 16
      for (int k = 0; k < 128; ++k) { const float wv = w[(size_t)k * 6 * D];
        UNR for (int b = 0; b < BATCH; ++b) s[b] += siluf_(p.c[b * D + 128 * q + k]) * wv; }
      SYNC();
      UNR for (int b = 0; b < BATCH; ++b) red[(q * BATCH + b) * 64 + j] = s[b];
      SYNC();
      if (tid < BATCH * 64) { const int b = tid >> 6; float a = p.b_ada[l * 6 * D + n0 + j];
        UNR for (int qq = 0; qq < 8; ++qq) a += red[(qq * BATCH + b) * 64 + j];
        mod[((size_t)l * BATCH + b) * 6 * D + n0 + j] = a; }
    }
    SYNC();
  }
  float* rope = (float*)(p.ws + WS_ROPE);
  constexpr int NR = SEQ / GRID_W;
  for (int o = gtid; o < (NR + 64) * 16; o += gstride) {
    const int i = o & 15, pos = o >> 4;
    const float inv = powf(10000.f, -(float)(2 * i) / 32.f);
    if (pos < NR) { const float a = (float)pos * inv; rope[pos * 16 + i] = cosf(a); rope[NR * 16 + pos * 16 + i] = sinf(a); }
    else { const int cpos = pos - NR; const float a = (float)cpos * inv; rope[2 * NR * 16 + cpos * 16 + i] = cosf(a); rope[2 * NR * 16 + 64 * 16 + cpos * 16 + i] = sinf(a); }
  }
}
constexpr int TPP = 257;
DEV void transpose_item(char* lds, const float* src, int K, int N, bf16_t* dst, int mode, int item) {
  float* tile = (float*)lds;
  const int ntn = (N + 255) / 256, tk = item / ntn, tn = item % ntn, tid = TID;
  const int k0 = tk * 64, n0 = tn * 256;
  { const int c = (tid & 63) * 4; f32x4 v[8];
    UNR for (int i = 0; i < 8; ++i) { const int kk = (tid >> 6) + 8 * i; v[i] = (n0 + c < N) ? *(const f32x4*)(src + (size_t)(k0 + kk) * N + n0 + c) : (f32x4){0.f, 0.f, 0.f, 0.f}; }
    UNR for (int i = 0; i < 8; ++i) { const int kk = (tid >> 6) + 8 * i; UNR for (int j = 0; j < 4; ++j) tile[kk * TPP + c + j] = v[i][j]; } }
  SYNC();
  { const int k8 = (tid & 7) * 8;
    UNR for (int i = 0; i < 4; ++i) { const int nn = (tid >> 3) + 64 * i, n = n0 + nn;
      if (n < N) {
        int row = n; if (mode == 1) row = 32 * (n >> 4) + (n & 15); else if (mode == 2) row = 32 * (n >> 4) + 16 + (n & 15);
        u32x4 w; w.x = pk2(tile[(k8 + 0) * TPP + nn], tile[(k8 + 1) * TPP + nn]); w.y = pk2(tile[(k8 + 2) * TPP + nn], tile[(k8 + 3) * TPP + nn]);
        w.z = pk2(tile[(k8 + 4) * TPP + nn], tile[(k8 + 5) * TPP + nn]); w.w = pk2(tile[(k8 + 6) * TPP + nn], tile[(k8 + 7) * TPP + nn]);
        *(u32x4*)(dst + (size_t)row * K + k0 + k8) = w; } } }
  SYNC();
}
DEV void phase_convert(const Params& p, int l) {
  char* lds = LDS_PTR();
  constexpr int I_IN = (D / 64) * ((IN_W + 255) / 256), I_BM = (MW / 64) * (D / 256), I_BA = (AW / 64) * (D / 256), I_OUT = (D / 64) * (D / 256);
  constexpr int I_G = (D / 64) * (FF / 256), I_D = (FF / 64) * (D / 256);
  constexpr int B1 = I_IN, B2 = B1 + I_BM, B3 = B2 + I_BA, B4 = B3 + I_OUT, B5 = B4 + NE * I_G, B6 = B5 + NE * I_G, B7 = B6 + NE * I_D;
  for (int it = BID; it < B7; it += NBLK) {
    if (it < B1) transpose_item(lds, p.w_in + (size_t)l * D * IN_W, D, IN_W, (bf16_t*)(p.ws + WS_WIN), 0, it);
    else if (it < B2) transpose_item(lds, p.w_branch_m + (size_t)l * MW * D, MW, D, (bf16_t*)(p.ws + WS_WBM), 0, it - B1);
    else if (it < B3) transpose_item(lds, p.w_branch_a + (size_t)l * AW * D, AW, D, (bf16_t*)(p.ws + WS_WBA), 0, it - B2);
    else if (it < B4) transpose_item(lds, p.w_out + (size_t)l * D * D, D, D, (bf16_t*)(p.ws + WS_WOUT), 0, it - B3);
    else if (it < B5) { const int e = (it - B4) / I_G, r = (it - B4) % I_G; transpose_item(lds, p.w_gate + ((size_t)l * NE + e) * D * FF, D, FF, (bf16_t*)(p.ws + WS_WGU) + (size_t)e * 2 * FF * D, 1, r); }
    else if (it < B6) { const int e = (it - B5) / I_G, r = (it - B5) % I_G; transpose_item(lds, p.w_up + ((size_t)l * NE + e) * D * FF, D, FF, (bf16_t*)(p.ws + WS_WGU) + (size_t)e * 2 * FF * D, 2, r); }
    else { const int e = (it - B6) / I_D, r = (it - B6) % I_D; transpose_item(lds, p.w_down + ((size_t)l * NE + e) * FF * D, FF, D, (bf16_t*)(p.ws + WS_WD) + (size_t)e * D * FF, 0, r); }
  }
}

DEV void phase_norm(const Params& p, int l, int mode, int which) {
  const int lane = TID & 63, wv = TID >> 6, nwv = NTHREADS / 64;
  const float* mod = (const float*)(p.ws + WS_MOD);
  bf16_t* H = (bf16_t*)(p.ws + WS_H);
  const bf16_t* Y = (const bf16_t*)(p.ws + WS_Y);
  for (int t = BID * nwv + wv; t < T; t += NBLK * nwv) {
    const int b = t / SEQ;
    f32x4 v[4]; float ss = 0.f;
    UNR for (int i = 0; i < 4; ++i) {
      const int c4 = lane + 64 * i;
      if (mode == 0) v[i] = ((const f32x4*)(p.x + (size_t)t * D))[c4];
      else {
        v[i] = ((const f32x4*)(p.out + (size_t)t * D))[c4];
        if (mode == 1) {
          const f32x4 g2 = ((const f32x4*)(mod + ((size_t)(l - 1) * BATCH + b) * 6 * D + 5 * D))[c4];
          const u32x2 y0 = ((const u32x2*)(Y + (size_t)(2 * t) * D))[c4], y1 = ((const u32x2*)(Y + (size_t)(2 * t + 1) * D))[c4];
          v[i][0] += g2[0] * (bf2f((bf16_t)(y0.x & 0xffff)) + bf2f((bf16_t)(y1.x & 0xffff)));
          v[i][1] += g2[1] * (bf2f((bf16_t)(y0.x >> 16)) + bf2f((bf16_t)(y1.x >> 16)));
          v[i][2] += g2[2] * (bf2f((bf16_t)(y0.y & 0xffff)) + bf2f((bf16_t)(y1.y & 0xffff)));
          v[i][3] += g2[3] * (bf2f((bf16_t)(y0.y >> 16)) + bf2f((bf16_t)(y1.y >> 16)));
        }
      }
      ss += v[i][0] * v[i][0] + v[i][1] * v[i][1] + v[i][2] * v[i][2] + v[i][3] * v[i][3];
    }
    ss = wave_sum(ss);
    const float rs = 1.f / sqrtf(ss * (1.f / D) + EPS);
    if (which == 2) {
      UNR for (int i = 0; i < 4; ++i) { const int c4 = lane + 64 * i; const f32x4 g = ((const f32x4*)p.final_g)[c4];
        f32x4 o; UNR for (int j = 0; j < 4; ++j) o[j] = v[i][j] * rs * g[j]; ((f32x4*)(p.out + (size_t)t * D))[c4] = o; }
      continue;
    }
    if (mode != 2) UNR for (int i = 0; i < 4; ++i) ((f32x4*)(p.out + (size_t)t * D))[lane + 64 * i] = v[i];
    const float* mb = mod + ((size_t)l * BATCH + b) * 6 * D + (which == 0 ? 0 : 3 * D);
    const float* gw = (which == 0 ? p.norm1_g : p.norm2_g) + (size_t)l * D;
    f32x4 hv[4];
    UNR for (int i = 0; i < 4; ++i) { const int c4 = lane + 64 * i;
      const f32x4 g = ((const f32x4*)gw)[c4], sh = ((const f32x4*)mb)[c4], sc = ((const f32x4*)(mb + D))[c4];
      UNR for (int j = 0; j < 4; ++j) hv[i][j] = (v[i][j] * rs * g[j]) * (1.f + sc[j]) + sh[j];
      u32x2 o; o.x = pk2(hv[i][0], hv[i][1]); o.y = pk2(hv[i][2], hv[i][3]); ((u32x2*)(H + (size_t)t * D))[c4] = o; }
  }
}
constexpr int HSP = 1028;
DEV void phase_norm2_router(const Params& p, int l, bool dry = false) {
  char* lds = LDS_PTR();
  float* HS = (float*)lds;
  float* PART = HS + 16 * HSP;
  float* SUM = PART + 8 * 16 * 48;
  const int tid = TID, lane = tid & 63, w = tid >> 6;
  const float* mod = (const float*)(p.ws + WS_MOD);
  bf16_t* H = (bf16_t*)(p.ws + WS_H);
  const float* wrg = p.w_rg + (size_t)l * D * NG; const float* wre = p.w_re + (size_t)l * D * NE;
  const float* gw = p.norm2_g + (size_t)l * D;
  float bq[32][3];
  { const int o0 = lane & 15;
    UNR for (int kk = 0; kk < 32; ++kk) { const int d = 128 * w + 4 * kk + (lane >> 4);
      bq[kk][0] = (o0 < NG) ? wrg[(size_t)d * NG + o0] : wre[(size_t)d * NE + o0 - NG];
      bq[kk][1] = wre[(size_t)d * NE + 16 + o0 - NG];
      bq[kk][2] = (o0 < NG) ? wre[(size_t)d * NE + 32 + o0 - NG] : 0.f; } }
  f32x4 v[2][4];
  int tb = BID * 16;
  if (tb < T) { UNR for (int q = 0; q < 2; ++q) UNR for (int i = 0; i < 4; ++i) v[q][i] = ((const f32x4*)(p.out + (size_t)(tb + 2 * w + q) * D))[lane + 64 * i]; }
  for (; tb < T; tb += NBLK * 16) {
    SYNC();
    UNR for (int q = 0; q < 2; ++q) {
      const int tl = 2 * w + q, t = tb + tl, b = t / SEQ;
      float ss = 0.f;
      UNR for (int i = 0; i < 4; ++i) ss += v[q][i][0] * v[q][i][0] + v[q][i][1] * v[q][i][1] + v[q][i][2] * v[q][i][2] + v[q][i][3] * v[q][i][3];
      ss = wave_sum(ss);
      const float rs = 1.f / sqrtf(ss * (1.f / D) + EPS);
      const float* mb = mod + ((size_t)l * BATCH + b) * 6 * D + 3 * D;
      UNR for (int i = 0; i < 4; ++i) { const int c4 = lane + 64 * i;
        const f32x4 g = ((const f32x4*)gw)[c4], sh = ((const f32x4*)mb)[c4], sc = ((const f32x4*)(mb + D))[c4];
        f32x4 hv; UNR for (int j = 0; j < 4; ++j) hv[j] = (v[q][i][j] * rs * g[j]) * (1.f + sc[j]) + sh[j];
        u32x2 o; o.x = pk2(hv[0], hv[1]); o.y = pk2(hv[2], hv[3]); ((u32x2*)(H + (size_t)t * D))[c4] = o;
        *(f32x4*)(HS + tl * HSP + 4 * c4) = hv; }
    }
    { const int tn = tb + NBLK * 16;
      if (tn < T) { UNR for (int q = 0; q < 2; ++q) UNR for (int i = 0; i < 4; ++i) v[q][i] = ((const f32x4*)(p.out + (size_t)(tn + 2 * w + q) * D))[lane + 64 * i]; } }
    SYNC();
    f32x4 acc[3]; UNR for (int nt = 0; nt < 3; ++nt) acc[nt] = (f32x4){0.f, 0.f, 0.f, 0.f};
    UNR for (int kk = 0; kk < 32; ++kk) {
      const float a = HS[(lane & 15) * HSP + 128 * w + 4 * kk + (lane >> 4)];
      acc[0] = mfma4f32(a, bq[kk][0], acc[0]); acc[1] = mfma4f32(a, bq[kk][1], acc[1]); acc[2] = mfma4f32(a, bq[kk][2], acc[2]);
    }
    UNR for (int nt = 0; nt < 3; ++nt) UNR for (int i = 0; i < 4; ++i) PART[(w * 16 + (lane >> 4) * 4 + i) * 48 + nt * 16 + (lane & 15)] = acc[nt][i];
    SYNC();
    for (int o = tid; o < 16 * 48; o += NTHREADS) { float sacc = 0.f; UNR for (int ww = 0; ww < 8; ++ww) sacc += PART[ww * 16 * 48 + o]; SUM[o] = sacc; }
    SYNC();
    if (tid < 16) {
      const int t = tb + tid;
      float lg[NG];
      int g = 0; float gmx = -3.0e38f;
      UNR for (int o = 0; o < NG; ++o) { const float sv = p.b_rg[l * NG + o] + SUM[tid * 48 + o]; lg[o] = sv; if (sv > gmx) { gmx = sv; g = o; } }
      float gsum = 0.f; UNR for (int o = 0; o < NG; ++o) gsum += expf(lg[o] - gmx);
      const float ptop = 1.f / gsum;
      int e0 = 0, e1 = 0; float m0 = -3.0e38f, m1 = -3.0e38f;
#pragma unroll 1
      for (int j = 0; j < EPG; ++j) { const float sv = p.b_re[l * NE + g * EPG + j] + SUM[tid * 48 + NG + g * EPG + j];
        if (sv > m0) { m1 = m0; e1 = e0; m0 = sv; e0 = j; } else if (sv > m1) { m1 = sv; e1 = j; } }
      const float x1 = expf(m1 - m0), w0 = ptop / (1.f + x1), w1 = ptop * x1 / (1.f + x1);
      int* cnt = (int*)(p.ws + WS_CTL) + CW_CNT + l * NE; int* ent_e = (int*)(p.ws + WS_ENT_E); int* ent_pos = (int*)(p.ws + WS_ENT_POS); float* went = (float*)(p.ws + WS_WENT);
      const int ea = g * EPG + e0, eb = g * EPG + e1;
      if (!dry) { ent_e[2 * t] = ea; ent_pos[2 * t] = atomic_add_i(cnt + ea, 1); went[2 * t] = w0;
        ent_e[2 * t + 1] = eb; ent_pos[2 * t + 1] = atomic_add_i(cnt + eb, 1); went[2 * t + 1] = w1; }
      else if (w0 + w1 < -1.f) went[2 * t] = w0;
    }
  }
}
constexpr int GP = 72;
constexpr int LDS_PHASE_BYTES = 131072;
constexpr int LDS_BYTES = LDS_PHASE_BYTES + 256;
DEV void moe_tiles(const Params& p, int l, int* s_pref) {
  SYNC();
  if (TID == 0) { const int* cnt = (const int*)(p.ws + WS_CTL) + CW_CNT + l * NE; int a = 0; for (int e = 0; e < NE; ++e) { s_pref[e] = a; a += (cnt[e] + 255) / 256; } s_pref[NE] = a; }
  SYNC();
}
DEV void phase_moe_gather(const Params& p, int l) {
  int* s_pref = (int*)(LDS_PTR() + LDS_PHASE_BYTES + 64);
  moe_tiles(p, l, s_pref);
  const int* cnt = (const int*)(p.ws + WS_CTL) + CW_CNT + l * NE; const int* ent_e = (const int*)(p.ws + WS_ENT_E); const int* ent_pos = (const int*)(p.ws + WS_ENT_POS);
  const float* went = (const float*)(p.ws + WS_WENT); int* slot_ent = (int*)(p.ws + WS_SLOT_ENT); float* slot_w = (float*)(p.ws + WS_SLOT_W);
  const bf16_t* H = (const bf16_t*)(p.ws + WS_H); bf16_t* HS = (bf16_t*)(p.ws + WS_HS);
  const int tid = TID, lane = tid & 63, wv = tid >> 6;
  for (int i = BID * 8 + wv; i < 2 * T; i += NBLK * 8) {
    const int slot = s_pref[ent_e[i]] * 256 + ent_pos[i];
    const u32x4* src = (const u32x4*)(H + (size_t)(i >> 1) * D); u32x4* dst = (u32x4*)(HS + (size_t)slot * D);
    dst[lane] = src[lane]; dst[lane + 64] = src[lane + 64];
    if (lane == 0) { slot_ent[slot] = i; slot_w[slot] = went[i]; }
  }
  for (int e = BID; e < NE; e += NBLK) { const int s0 = s_pref[e] * 256 + cnt[e], s1 = s_pref[e + 1] * 256; for (int q = s0 + tid; q < s1; q += NTHREADS) slot_ent[q] = -1; }
}
#ifdef EMU
struct RowPlain { const bf16_t* base; size_t ld; DEVM const bf16_t* operator()(int r) const { return base + (size_t)r * ld; } };
template <class RowA>
DEV void gemm_kloop(char* lds, const RowA& rowA, const bf16_t* Bt, size_t ldb, int K, f32x4 (&acc)[4][2]) {
  bf16_t* As = (bf16_t*)lds; bf16_t* Bs = As + 128 * GP;
  const int tid = TID, lane = tid & 63, w = tid >> 6, wm = w >> 2, wn = w & 3;
  const int r0 = tid >> 3, pc = (tid & 7) * 8;
  const bf16_t* a0 = rowA(r0) + pc; const bf16_t* a1 = rowA(r0 + 64) + pc;
  const bf16_t* b0 = Bt + (size_t)r0 * ldb + pc; const bf16_t* b1 = Bt + (size_t)(r0 + 64) * ldb + pc;
  u32x4 ra0 = *(const u32x4*)a0, ra1 = *(const u32x4*)a1, rb0 = *(const u32x4*)b0, rb1 = *(const u32x4*)b1;
  const int nk = K / 64;
  for (int kt = 0; kt < nk; ++kt) {
    SYNC();
    *(u32x4*)(As + r0 * GP + pc) = ra0; *(u32x4*)(As + (r0 + 64) * GP + pc) = ra1;
    *(u32x4*)(Bs + r0 * GP + pc) = rb0; *(u32x4*)(Bs + (r0 + 64) * GP + pc) = rb1;
    SYNC();
    if (kt + 1 < nk) { const int ko = (kt + 1) * 64; ra0 = *(const u32x4*)(a0 + ko); ra1 = *(const u32x4*)(a1 + ko); rb0 = *(const u32x4*)(b0 + ko); rb1 = *(const u32x4*)(b1 + ko); }
#pragma unroll
    for (int ks = 0; ks < 2; ++ks) {
      const int kof = ks * 32 + (lane >> 4) * 8;
      bf16x8 af[4], bfr[2];
#pragma unroll
      for (int mt = 0; mt < 4; ++mt) af[mt] = ld8(As + (wm * 64 + mt * 16 + (lane & 15)) * GP + kof);
#pragma unroll
      for (int nt = 0; nt < 2; ++nt) bfr[nt] = ld8(Bs + (wn * 32 + nt * 16 + (lane & 15)) * GP + kof);
#pragma unroll
      for (int mt = 0; mt < 4; ++mt)
#pragma unroll
        for (int nt = 0; nt < 2; ++nt) acc[mt][nt] = mfma16(af[mt], bfr[nt], acc[mt][nt]);
    }
  }
}
DEV void zero_acc(f32x4 (&acc)[4][2]) { UNR for (int i = 0; i < 4; ++i) UNR for (int j = 0; j < 2; ++j) acc[i][j] = (f32x4){0.f, 0.f, 0.f, 0.f}; }

DEV void phase_gemm_in(const Params& p, int l) {
  char* lds = LDS_PTR();
  const bf16_t* H = (const bf16_t*)(p.ws + WS_H); const bf16_t* W = (const bf16_t*)(p.ws + WS_WIN);
  bf16_t* PROJ = (bf16_t*)(p.ws + WS_PROJ); float* GATES = (float*)(p.ws + WS_GATES);
  const float* bias = p.b_in + (size_t)l * IN_W;
  constexpr int nM = T / 128, nN = NP / 128;
  for (int u = BID; u < nM * nN; u += NBLK) {
    const int pm = u % nM, pn = u / nM;
    f32x4 acc[4][2]; zero_acc(acc);
    RowPlain ra{H + (size_t)pm * 128 * D, (size_t)D};
    gemm_kloop(lds, ra, W + (size_t)pn * 128 * D, D, D, acc);
    const int etid = TID, lane = etid & 63, w = etid >> 6, wm = w >> 2, wn = w & 3;
    UNR for (int nt = 0; nt < 2; ++nt) {
      const int col = pn * 128 + wn * 32 + nt * 16 + (lane & 15);
      if (col >= IN_W) continue;
      const float bv = bias[col];
      UNR for (int mt = 0; mt < 4; ++mt) UNR for (int i = 0; i < 4; ++i) {
        const int row = pm * 128 + wm * 64 + mt * 16 + (lane >> 4) * 4 + i; const float v = acc[mt][nt][i] + bv;
        PROJ[(size_t)row * NP + col] = f2bf(v);
        if (col >= C_GATES && col < C_GATES + 16) GATES[(size_t)row * 16 + (col - C_GATES)] = v;
      }
    }
  }
}
DEV void phase_gemm_merge(const Params& p) {
  char* lds = LDS_PTR();
  const bf16_t* YM = (const bf16_t*)(p.ws + WS_YM); const bf16_t* YA = (const bf16_t*)(p.ws + WS_YA);
  const bf16_t* WM = (const bf16_t*)(p.ws + WS_WBM); const bf16_t* WA = (const bf16_t*)(p.ws + WS_WBA);
  const bf16_t* PROJ = (const bf16_t*)(p.ws + WS_PROJ); bf16_t* MG = (bf16_t*)(p.ws + WS_MERGED);
  constexpr int nM = T / 128, nN = D / 128;
  for (int u = BID; u < nM * nN; u += NBLK) {
    const int pm = u / nN, pn = u % nN;
    f32x4 acc[4][2]; zero_acc(acc);
    RowPlain r1{YM + (size_t)pm * 128 * MW, (size_t)MW}; gemm_kloop(lds, r1, WM + (size_t)pn * 128 * MW, MW, MW, acc);
    float* park = (float*)(lds + 40960);
    { const int ptid = TID; UNR for (int mt = 0; mt < 4; ++mt) UNR for (int nt = 0; nt < 2; ++nt) UNR for (int i = 0; i < 4; ++i) park[((mt * 2 + nt) * 4 + i) * NTHREADS + ptid] = acc[mt][nt][i]; }
    zero_acc(acc);
    RowPlain r2{YA + (size_t)pm * 128 * AW, (size_t)AW}; gemm_kloop(lds, r2, WA + (size_t)pn * 128 * AW, AW, AW, acc);
    const int etid = TID, lane = etid & 63, w = etid >> 6, wm = w >> 2, wn = w & 3;
    UNR for (int nt = 0; nt < 2; ++nt) { const int col = pn * 128 + wn * 32 + nt * 16 + (lane & 15);
      UNR for (int mt = 0; mt < 4; ++mt) UNR for (int i = 0; i < 4; ++i) {
        const int row = pm * 128 + wm * 64 + mt * 16 + (lane >> 4) * 4 + i;
        const float gm = bf2f(PROJ[(size_t)row * NP + C_GM + col]), ga = bf2f(PROJ[(size_t)row * NP + C_GA + col]);
        MG[(size_t)row * D + col] = f2bf(sigmoidf_(gm) * park[((mt * 2 + nt) * 4 + i) * NTHREADS + etid] + sigmoidf_(ga) * acc[mt][nt][i]); } }
  }
}
DEV void phase_gemm_out(const Params& p, int l) {
  char* lds = LDS_PTR();
  const bf16_t* MG = (const bf16_t*)(p.ws + WS_MERGED); const bf16_t* W = (const bf16_t*)(p.ws + WS_WOUT);
  const float* mod = (const float*)(p.ws + WS_MOD);
  constexpr int nM = T / 128, nN = D / 128;
  for (int u = BID; u < nM * nN; u += NBLK) {
    const int pm = u / nN, pn = u % nN;
    f32x4 acc[4][2]; zero_acc(acc);
    RowPlain ra{MG + (size_t)pm * 128 * D, (size_t)D}; gemm_kloop(lds, ra, W + (size_t)pn * 128 * D, D, D, acc);
    const int etid = TID, lane = etid & 63, w = etid >> 6, wm = w >> 2, wn = w & 3;
    const int b = (pm * 128) / SEQ;
    UNR for (int nt = 0; nt < 2; ++nt) { const int col = pn * 128 + wn * 32 + nt * 16 + (lane & 15);
      const float g1 = mod[((size_t)l * BATCH + b) * 6 * D + 2 * D + col];
      UNR for (int mt = 0; mt < 4; ++mt) UNR for (int i = 0; i < 4; ++i) {
        const int row = pm * 128 + wm * 64 + mt * 16 + (lane >> 4) * 4 + i;
        p.out[(size_t)row * D + col] += g1 * acc[mt][nt][i]; } }
  }
}
DEV void phase_moe_up(const Params& p, int l) {
  char* lds = LDS_PTR(); int* s_pref = (int*)(lds + LDS_PHASE_BYTES + 64);
  moe_tiles(p, l, s_pref);
  const bf16_t* HS = (const bf16_t*)(p.ws + WS_HS); const bf16_t* W = (const bf16_t*)(p.ws + WS_WGU); bf16_t* ACT = (bf16_t*)(p.ws + WS_ACT);
  const int* slot_ent = (const int*)(p.ws + WS_SLOT_ENT); const float* slot_w = (const float*)(p.ws + WS_SLOT_W);
  const int ntile = s_pref[NE] * 2;
  for (int u = BID; u < ntile * 8; u += NBLK) {
    const int rt = u >> 3, ct = u & 7;
    int e = 0; while (s_pref[e + 1] <= (rt >> 1)) ++e;
    f32x4 acc[4][2]; zero_acc(acc);
    RowPlain ra{HS + (size_t)rt * 128 * D, (size_t)D};
    gemm_kloop(lds, ra, W + ((size_t)e * 2 * FF + ct * 128) * D, D, D, acc);
    const int etid = TID, lane = etid & 63, w = etid >> 6, wm = w >> 2, wn = w & 3;
    const int f = (ct * 4 + wn) * 16 + (lane & 15);
    UNR for (int mt = 0; mt < 4; ++mt) UNR for (int i = 0; i < 4; ++i) {
      const int slot = rt * 128 + wm * 64 + mt * 16 + (lane >> 4) * 4 + i;
      if (slot_ent[slot] >= 0) { const float wt = slot_w[slot]; const float a = acc[mt][0][i], uu = acc[mt][1][i];
        ACT[(size_t)slot * FF + f] = f2bf(siluf_(a) * uu * wt); } }
  }
}
DEV void phase_moe_down(const Params& p, int l) {
  char* lds = LDS_PTR(); int* s_pref = (int*)(lds + LDS_PHASE_BYTES + 64);
  moe_tiles(p, l, s_pref);
  const bf16_t* ACT = (const bf16_t*)(p.ws + WS_ACT); const bf16_t* W = (const bf16_t*)(p.ws + WS_WD); bf16_t* Y = (bf16_t*)(p.ws + WS_Y);
  const int* slot_ent = (const int*)(p.ws + WS_SLOT_ENT);
  const int ntile = s_pref[NE] * 2;
  for (int u = BID; u < ntile * 8; u += NBLK) {
    const int rt = u >> 3, ct = u & 7;
    int e = 0; while (s_pref[e + 1] <= (rt >> 1)) ++e;
    f32x4 acc[4][2]; zero_acc(acc);
    RowPlain ra{ACT + (size_t)rt * 128 * FF, (size_t)FF};
    gemm_kloop(lds, ra, W + ((size_t)e * D + ct * 128) * FF, FF, FF, acc);
    const int etid = TID, lane = etid & 63, w = etid >> 6, wm = w >> 2, wn = w & 3;
    UNR for (int nt = 0; nt < 2; ++nt) { const int col = ct * 128 + wn * 32 + nt * 16 + (lane & 15);
      UNR for (int mt = 0; mt < 4; ++mt) UNR for (int i = 0; i < 4; ++i) {
        const int slot = rt * 128 + wm * 64 + mt * 16 + (lane >> 4) * 4 + i; const int ent = slot_ent[slot];
        if (ent >= 0) Y[(size_t)ent * D + col] = f2bf(acc[mt][nt][i]); } }
  }
}
#else
namespace pg8 {
#define PG8_LAS __attribute__((address_space(3)))
typedef unsigned short bf16_t;
typedef short bf16x8 __attribute__((ext_vector_type(8)));
typedef float f32x4 __attribute__((ext_vector_type(4)));
typedef unsigned u32x4 __attribute__((ext_vector_type(4)));
constexpr int BM = 256, BK = 64, HALF = 128, HTB = HALF * BK * 2  , STAGE_BYTES = 8 * HTB, NXCD = 8, WGM = 8;

__host__ __device__ __forceinline__ int lds_byte(int r, int c) { const int st = (r >> 4) * 2 + (c >> 5), rr = r & 15, cc = c & 31, ob = rr * 64 + cc * 2; return st * 1024 + (ob ^ (((ob >> 9) & 1) << 5)); }
__host__ __device__ __forceinline__ void stage_rc(int b, int& R, int& C) { const int st = b / 1024, sb = b % 1024, swz = sb ^ (((sb >> 9) & 1) << 5); R = (st >> 1) * 16 + swz / 64; C = (st & 1) * 32 + (swz % 64) / 2; }
__host__ __device__ __forceinline__ int perm32(int rho) { const int n = rho >> 4, i = rho & 15; return 8 * (i >> 2) + 4 * n + (i & 3); }

struct Unit { int pm, pn; };
struct Gemm { const bf16_t* A; const bf16_t* Bt; int M, N, K; };

struct StaticOrder {
    int nM, nN, nwg, G, c;
    __host__ __device__ void init(int M, int N, int G_, int c_) { nM = M / BM; nN = N / BM; nwg = nM * nN; G = G_; c = c_; }
    __host__ __device__ bool next(int i, Unit& u) const {
        const long L = (long)i * G + c; if (L >= nwg) return false;
        int wgid = (int)L; { const int q = nwg / NXCD, r = nwg % NXCD, xcd = wgid % NXCD, off = wgid / NXCD; wgid = (xcd < r ? xcd * (q + 1) : r * (q + 1) + (xcd - r) * q) + off; }
        const int nig = WGM * nN, gid = wgid / nig, fm = gid * WGM, gsz = (nM - fm) < WGM ? (nM - fm) : WGM;
        u.pm = fm + ((wgid % nig) % gsz); u.pn = (wgid % nig) / gsz; return true;
    }
    __device__ __forceinline__ void a_ready(const Unit&) const {}
    __device__ __forceinline__ void done(const Unit&) const {}
};
__device__ __forceinline__ unsigned cvt_pk_bf16(float lo, float hi) { unsigned r; asm volatile("v_cvt_pk_bf16_f32 %0, %1, %2" : "=v"(r) : "v"(lo), "v"(hi)); return r; }
template <class Epi, class Sched, bool ALIGN_EPI = false, bool SP2 = false>
__device__ __forceinline__ void gemm_phase(PG8_LAS unsigned char* lds, const Gemm g, const Sched& S, const Epi& E) {
    const int tid = TID, wid = __builtin_amdgcn_readfirstlane(tid >> 6), lane = tid & 63, wr = wid >> 2, wc = wid & 3, fr = lane & 15, fq = lane >> 4;
    const int K = g.K, nt = K / BK;
    unsigned voffA[2], voffB[2];
#pragma unroll
    for (int i = 0; i < 2; ++i) { int R, C; stage_rc(tid * 16 + i * 8192, R, C); const int Rb = Epi::PERM ? ((R & ~31) + perm32(R & 31)) : R;
        voffA[i] = (unsigned)(R * K + C) * 2u; voffB[i] = (unsigned)(Rb * K + C) * 2u; }
    const size_t kstep = (size_t)(BK * 2);
    const size_t hstep = (size_t)HALF * K * 2;
    const size_t tstep = 2 * hstep;
    const unsigned ldsw = (unsigned)wid * 1024u;
    const int aoff = lds_byte(wr * 64 + fr, fq * 8), boff = lds_byte(wc * 32 + fr, fq * 8);
#define PG8_SA(b, h) (((b) * 2 + (h)) * HTB)
#define PG8_SB(b, h) ((4 + (b) * 2 + (h)) * HTB)
#define PG8_STAGE(bufoff, gbase, voff) do { _Pragma("unroll") for (int _i = 0; _i < 2; ++_i) \
        __builtin_amdgcn_global_load_lds((const unsigned*)((const char*)(gbase) + (voff)[_i]), (PG8_LAS unsigned*)(lds + (bufoff) + ldsw + _i * 8192), 16, 0, 0); } while (0)
#define PG8_LDA(dst, b, h) do { _Pragma("unroll") for (int m = 0; m < 4; ++m) _Pragma("unroll") for (int k = 0; k < 2; ++k) dst[m][k] = *(const PG8_LAS bf16x8*)(lds + PG8_SA(b, h) + aoff + m * 2048 + k * 1024); } while (0)
#define PG8_LDB(dst, b, h) do { _Pragma("unroll") for (int n = 0; n < 2; ++n) _Pragma("unroll") for (int k = 0; k < 2; ++k) dst[n][k] = *(const PG8_LAS bf16x8*)(lds + PG8_SB(b, h) + boff + n * 2048 + k * 1024); } while (0)
#define PG8_MMA(ai, bj, At, Bt) do { __builtin_amdgcn_s_setprio(1); _Pragma("unroll") for (int m = 0; m < 4; ++m) _Pragma("unroll") for (int n = 0; n < 2; ++n) _Pragma("unroll") for (int k = 0; k < 2; ++k) \
        acc[ai][bj][m][n] = __builtin_amdgcn_mfma_f32_16x16x32_bf16(Bt[n][k], At[m][k], acc[ai][bj][m][n], 0, 0, 0); __builtin_amdgcn_s_setprio(0); } while (0)
#define PG8_WAIT_V(n) asm volatile("s_waitcnt vmcnt(" #n ")" ::: "memory")
#define PG8_WAIT_L(n) asm volatile("s_waitcnt lgkmcnt(" #n ")" ::: "memory")
#define PG8_BAR __builtin_amdgcn_s_barrier()
#define PG8_SCHED __builtin_amdgcn_sched_barrier(0)
    Unit cur, nxt; int ui = 0;
    if (!S.next(0, cur)) return;
    f32x4 acc[2][2][4][2];
#pragma unroll
    for (int a = 0; a < 2; ++a)
#pragma unroll
        for (int b = 0; b < 2; ++b)
#pragma unroll
            for (int m = 0; m < 4; ++m)
#pragma unroll
                for (int n = 0; n < 2; ++n) acc[a][b][m][n] = (f32x4){0.f, 0.f, 0.f, 0.f};
    bf16x8 At[4][2], B0[2][2], B1[2][2];
    const char* cA = (const char*)g.A + (size_t)cur.pm * tstep; const char* cB = (const char*)g.Bt + (size_t)cur.pn * tstep;
    S.a_ready(cur);
    if constexpr (SP2) {
        PG8_STAGE(PG8_SB(0, 0), cB, voffB); PG8_STAGE(PG8_SB(0, 1), cB + hstep, voffB); PG8_STAGE(PG8_SA(0, 0), cA, voffA); PG8_STAGE(PG8_SA(0, 1), cA + hstep, voffA);
        if (wr == 1) PG8_BAR;
        PG8_WAIT_V(2); PG8_BAR;
        PG8_STAGE(PG8_SB(1, 0), cB + kstep, voffB); PG8_STAGE(PG8_SA(1, 0), cA + kstep, voffA); PG8_STAGE(PG8_SB(1, 1), cB + hstep + kstep, voffB);
        PG8_WAIT_V(6); PG8_BAR;
    } else {
        PG8_STAGE(PG8_SB(0, 0), cB, voffB); PG8_STAGE(PG8_SA(0, 0), cA, voffA); PG8_STAGE(PG8_SB(0, 1), cB + hstep, voffB); PG8_STAGE(PG8_SA(0, 1), cA + hstep, voffA);
        if (wr == 1) PG8_BAR;
        PG8_WAIT_V(4); PG8_BAR;
        PG8_STAGE(PG8_SB(1, 0), cB + kstep, voffB); PG8_STAGE(PG8_SA(1, 0), cA + kstep, voffA); PG8_STAGE(PG8_SB(1, 1), cB + hstep + kstep, voffB);
        PG8_WAIT_V(6); PG8_BAR;
    }
    for (;;) {
        const bool has_next = S.next(ui + 1, nxt);
        const char* nA = has_next ? (const char*)g.A + (size_t)nxt.pm * tstep : cA; const char* nB = has_next ? (const char*)g.Bt + (size_t)nxt.pn * tstep : cB;
        for (int t = 0; t < nt; t += 2) {
            const bool last = (t == nt - 2);
            const char* a1 = cA + (size_t)(t + 1) * kstep;
            const char* a2 = last ? nA : cA + (size_t)(t + 2) * kstep; const char* b2 = last ? nB : cB + (size_t)(t + 2) * kstep;
            const char* a3 = a2 + kstep; const char* b3 = b2 + kstep;
            if (last && has_next) S.a_ready(nxt);
            if constexpr (SP2) {
            PG8_LDB(B0, 0, 0); PG8_LDB(B1, 0, 1); PG8_SCHED; PG8_LDA(At, 0, 0); PG8_STAGE(PG8_SA(1, 1), a1 + hstep, voffA);
            PG8_WAIT_V(8); PG8_WAIT_L(0); PG8_BAR; PG8_MMA(0, 0, At, B0); PG8_MMA(0, 1, At, B1); PG8_BAR; PG8_SCHED;
            PG8_LDA(At, 0, 1); PG8_STAGE(PG8_SB(0, 0), b2, voffB); PG8_STAGE(PG8_SB(0, 1), b2 + hstep, voffB); PG8_STAGE(PG8_SA(0, 0), a2, voffA);
            PG8_WAIT_V(8); PG8_WAIT_L(0); PG8_BAR; PG8_MMA(1, 0, At, B0); PG8_MMA(1, 1, At, B1); PG8_BAR; PG8_SCHED;
            PG8_LDB(B0, 1, 0); PG8_LDB(B1, 1, 1); PG8_SCHED; PG8_LDA(At, 1, 0); PG8_STAGE(PG8_SA(0, 1), a2 + hstep, voffA);
            PG8_WAIT_V(8); PG8_WAIT_L(0); PG8_BAR; PG8_MMA(0, 0, At, B0); PG8_MMA(0, 1, At, B1); PG8_BAR; PG8_SCHED;
            PG8_LDA(At, 1, 1); PG8_STAGE(PG8_SB(1, 0), b3, voffB); PG8_STAGE(PG8_SB(1, 1), b3 + hstep, voffB); PG8_STAGE(PG8_SA(1, 0), a3, voffA);
            PG8_WAIT_V(8); PG8_WAIT_L(0); PG8_BAR; PG8_MMA(1, 0, At, B0); PG8_MMA(1, 1, At, B1); PG8_BAR; PG8_SCHED;
            } else {
            PG8_LDB(B0, 0, 0); PG8_SCHED; PG8_LDA(At, 0, 0); PG8_STAGE(PG8_SA(1, 1), a1 + hstep, voffA);
            PG8_WAIT_L(8); PG8_BAR; PG8_WAIT_L(0); PG8_MMA(0, 0, At, B0); PG8_BAR; PG8_SCHED;
            PG8_LDB(B1, 0, 1); PG8_STAGE(PG8_SB(0, 0), b2, voffB);
            PG8_BAR; PG8_WAIT_L(0); PG8_MMA(0, 1, At, B1); PG8_BAR;
            PG8_LDA(At, 0, 1); PG8_STAGE(PG8_SA(0, 0), a2, voffA);
            PG8_BAR; PG8_WAIT_L(0); PG8_MMA(1, 0, At, B0); PG8_BAR; PG8_SCHED;
            PG8_STAGE(PG8_SB(0, 1), b2 + hstep, voffB);
            PG8_WAIT_V(6); PG8_BAR; PG8_MMA(1, 1, At, B1); PG8_BAR;
            PG8_LDB(B0, 1, 0); PG8_SCHED; PG8_LDA(At, 1, 0); PG8_STAGE(PG8_SA(0, 1), a2 + hstep, voffA);
            PG8_WAIT_L(8); PG8_BAR; PG8_WAIT_L(0); PG8_MMA(0, 0, At, B0); PG8_BAR; PG8_SCHED;
            PG8_LDB(B1, 1, 1); PG8_STAGE(PG8_SB(1, 0), b3, voffB);
            PG8_BAR; PG8_WAIT_L(0); PG8_MMA(0, 1, At, B1); PG8_BAR;
            PG8_LDA(At, 1, 1); PG8_STAGE(PG8_SA(1, 0), a3, voffA);
            PG8_BAR; PG8_WAIT_L(0); PG8_MMA(1, 0, At, B0); PG8_BAR; PG8_SCHED;
            PG8_STAGE(PG8_SB(1, 1), b3 + hstep, voffB);
            PG8_WAIT_V(6); PG8_BAR; PG8_MMA(1, 1, At, B1); PG8_BAR;
            }
        }
        if constexpr (ALIGN_EPI) { if (wr == 0) PG8_BAR; }
        if constexpr (!Epi::AFTER_DRAIN) { E(acc, cur, wr, wc, fr, fq); S.done(cur); }
        if (!has_next) break;
#pragma unroll
        for (int a = 0; a < 2; ++a)
#pragma unroll
            for (int b = 0; b < 2; ++b)
#pragma unroll
                for (int m = 0; m < 4; ++m)
#pragma unroll
                    for (int n = 0; n < 2; ++n) acc[a][b][m][n] = (f32x4){0.f, 0.f, 0.f, 0.f};
        cur = nxt; cA = nA; cB = nB; ++ui;
        if constexpr (ALIGN_EPI) { if (wr == 1) PG8_BAR; }
    }
    PG8_WAIT_V(0);
    if constexpr (!ALIGN_EPI) { if (wr == 0) PG8_BAR; }
    PG8_BAR;
    if constexpr (Epi::AFTER_DRAIN) { E.fused(acc, cur, wr, wc, fr, fq, lds, wid, lane); S.done(cur); }
#undef PG8_SA
#undef PG8_SB
#undef PG8_STAGE
#undef PG8_LDA
#undef PG8_LDB
#undef PG8_MMA
#undef PG8_WAIT_V
#undef PG8_WAIT_L
#undef PG8_BAR
#undef PG8_SCHED
}
}

typedef pg8::Unit GUnit;
typedef f32x4 GAcc[2][2][4][2];
DEV u32x4 pack8(const f32x4& v0, const f32x4& v1) { u32x4 w; w.x = pg8::cvt_pk_bf16(v0[0], v0[1]); w.y = pg8::cvt_pk_bf16(v0[2], v0[3]); w.z = pg8::cvt_pk_bf16(v1[0], v1[1]); w.w = pg8::cvt_pk_bf16(v1[2], v1[3]); return w; }
DEV void unpack8(const u32x4& w, f32x4& v0, f32x4& v1) {
  v0[0] = __builtin_bit_cast(float, w.x << 16); v0[1] = __builtin_bit_cast(float, w.x & 0xffff0000u); v0[2] = __builtin_bit_cast(float, w.y << 16); v0[3] = __builtin_bit_cast(float, w.y & 0xffff0000u);
  v1[0] = __builtin_bit_cast(float, w.z << 16); v1[1] = __builtin_bit_cast(float, w.z & 0xffff0000u); v1[2] = __builtin_bit_cast(float, w.w << 16); v1[3] = __builtin_bit_cast(float, w.w & 0xffff0000u); }
DEV f32x4 sig4(const f32x4& x) { f32x4 r; UNR for (int i = 0; i < 4; ++i) r[i] = sigmoidf_(x[i]); return r; }
struct EpiIn { static constexpr bool PERM = true, AFTER_DRAIN = false; bf16_t* PROJ; float* GATES; const float* bias;
  DEVM void operator()(const GAcc& acc, const GUnit& u, int wr, int wc, int fr, int fq) const {
    const int row0 = u.pm * 256 + wr * 64 + fr;
    UNR for (int bj = 0; bj < 2; ++bj) { const int c = u.pn * 256 + bj * 128 + wc * 32 + 8 * fq;
      if (c < IN_W) { const f32x4 b0 = *(const f32x4*)(bias + c), b1 = *(const f32x4*)(bias + c + 4);
        UNR for (int ai = 0; ai < 2; ++ai) UNR for (int m = 0; m < 4; ++m) { const int row = row0 + ai * 128 + m * 16;
          const f32x4 v0 = acc[ai][bj][m][0] + b0, v1 = acc[ai][bj][m][1] + b1;
          *(u32x4*)(PROJ + (size_t)row * NP + c) = pack8(v0, v1);
          if (c >= C_GATES && c < C_GATES + 16) { float* gp = GATES + (size_t)row * 16 + (c - C_GATES); *(f32x4*)gp = v0; *(f32x4*)(gp + 4) = v1; } } } }
  } };
struct EpiMerge { static constexpr bool PERM = true, AFTER_DRAIN = false; const bf16_t* PROJ; float* TMP; bf16_t* MG;
  DEVM void operator()(const GAcc& acc, const GUnit& u, int wr, int wc, int fr, int fq) const {
    const bool second = u.pm >= T / 256; const int pm = second ? u.pm - T / 256 : u.pm, pn = second ? u.pn - 4 : u.pn;
    const int row0 = pm * 256 + wr * 64 + fr;
    UNR for (int bj = 0; bj < 2; ++bj) { const int c = pn * 256 + bj * 128 + wc * 32 + 8 * fq;
      UNR for (int ai = 0; ai < 2; ++ai) UNR for (int m = 0; m < 4; ++m) { const int row = row0 + ai * 128 + m * 16;
        f32x4 g0, g1; unpack8(*(const u32x4*)(PROJ + (size_t)row * NP + (second ? C_GA : C_GM) + c), g0, g1);
        float* tp = TMP + (size_t)row * D + c;
        const f32x4 v0 = sig4(g0) * acc[ai][bj][m][0], v1 = sig4(g1) * acc[ai][bj][m][1];
        if (!second) { *(f32x4*)tp = v0; *(f32x4*)(tp + 4) = v1; }
        else *(u32x4*)(MG + (size_t)row * D + c) = pack8(*(const f32x4*)tp + v0, *(const f32x4*)(tp + 4) + v1);
        asm volatile("" ::: "memory"); } }
  } };
struct MergeOrder { pg8::StaticOrder S;
  DEVM bool next(int i, GUnit& u) const { if (!S.next(i >> 1, u)) return false; if (i & 1) { u.pm += T / 256; u.pn += 4; } return true; }
  DEVM void a_ready(const GUnit&) const {}
  DEVM void done(const GUnit&) const {} };
struct EpiOut { static constexpr bool PERM = true, AFTER_DRAIN = false; float* X; const float* modl;
  DEVM void operator()(const GAcc& acc, const GUnit& u, int wr, int wc, int fr, int fq) const {
    const int row0 = u.pm * 256 + wr * 64 + fr; const float* g1p = modl + (size_t)((u.pm * 256) / SEQ) * 6 * D + 2 * D;
    UNR for (int bj = 0; bj < 2; ++bj) { const int c = u.pn * 256 + bj * 128 + wc * 32 + 8 * fq;
      const f32x4 ga = *(const f32x4*)(g1p + c), gb = *(const f32x4*)(g1p + c + 4);
      UNR for (int ai = 0; ai < 2; ++ai) UNR for (int m = 0; m < 4; ++m) { float* xp = X + (size_t)(row0 + ai * 128 + m * 16) * D + c;
        *(f32x4*)xp = *(const f32x4*)xp + ga * acc[ai][bj][m][0]; *(f32x4*)(xp + 4) = *(const f32x4*)(xp + 4) + gb * acc[ai][bj][m][1];
        asm volatile("" ::: "memory"); } }
  } };
struct EpiUp { static constexpr bool PERM = false, AFTER_DRAIN = false; bf16_t* ACT; const int* slot_ent; const float* slot_w;
  DEVM void operator()(const GAcc& acc, const GUnit& u, int wr, int wc, int fr, int fq) const {
    const int ct = u.pn & 3;
    UNR for (int ai = 0; ai < 2; ++ai) UNR for (int m = 0; m < 4; ++m) { const int slot = u.pm * 256 + ai * 128 + wr * 64 + m * 16 + fr;
      if (slot_ent[slot] >= 0) { const float wt = slot_w[slot];
        UNR for (int bj = 0; bj < 2; ++bj) { const int f = (8 * ct + 4 * bj + wc) * 16 + 4 * fq; const f32x4 a = acc[ai][bj][m][0], uu = acc[ai][bj][m][1];
          u32x2 o; o.x = pg8::cvt_pk_bf16(siluf_(a[0]) * uu[0] * wt, siluf_(a[1]) * uu[1] * wt); o.y = pg8::cvt_pk_bf16(siluf_(a[2]) * uu[2] * wt, siluf_(a[3]) * uu[3] * wt);
          *(u32x2*)(ACT + (size_t)slot * FF + f) = o; } } }
  } };
struct EpiDown { static constexpr bool PERM = true, AFTER_DRAIN = false; bf16_t* Y; const int* slot_ent;
  DEVM void operator()(const GAcc& acc, const GUnit& u, int wr, int wc, int fr, int fq) const {
    const int ct = u.pn & 3;
    UNR for (int ai = 0; ai < 2; ++ai) UNR for (int m = 0; m < 4; ++m) { const int ent = slot_ent[u.pm * 256 + ai * 128 + wr * 64 + m * 16 + fr];
      if (ent >= 0) { UNR for (int bj = 0; bj < 2; ++bj) { const int c = ct * 256 + bj * 128 + wc * 32 + 8 * fq;
          *(u32x4*)(Y + (size_t)ent * D + c) = pack8(acc[ai][bj][m][0], acc[ai][bj][m][1]); } } }
  } };
struct MoeOrder { const int* pref; int nunits, G, c;
  DEVM bool next(int i, GUnit& u) const { const long idx = (long)i * G + c; if (idx >= nunits) return false; const int rt = (int)(idx >> 2), ct = (int)(idx & 3);
    int e = 0; while (pref[e + 1] <= rt) ++e; u.pm = rt; u.pn = e * 4 + ct; return true; }
  DEVM void a_ready(const GUnit&) const {}
  DEVM void done(const GUnit&) const {} };
#define GEMM_LDS ((PG8_LAS unsigned char*)dyn_lds)
DEV void phase_gemm_in(const Params& p, int l) {
  pg8::Gemm g{(const bf16_t*)(p.ws + WS_H), (const bf16_t*)(p.ws + WS_WIN), T, NP, D}; pg8::StaticOrder S; S.init(T, NP, NBLK, BID);
  EpiIn E{(bf16_t*)(p.ws + WS_PROJ), (float*)(p.ws + WS_GATES), p.b_in + (size_t)l * IN_W};
  pg8::gemm_phase<EpiIn, pg8::StaticOrder, true, true>(GEMM_LDS, g, S, E);
}
DEV void phase_gemm_merge(const Params& p) {
  static_assert(WS_YA == WS_YM + (size_t)T * MW * 2 && WS_WBA == WS_WBM + (size_t)D * MW * 2 && MW == AW, "y_m|y_a and Wbm|Wba are stacked: one A, one Bt");
  pg8::Gemm g{(const bf16_t*)(p.ws + WS_YM), (const bf16_t*)(p.ws + WS_WBM), 2 * T, 2 * D, MW}; MergeOrder S; S.S.init(T, D, NBLK, BID);
  EpiMerge E{(const bf16_t*)(p.ws + WS_PROJ), (float*)(p.ws + WS_TMP), (bf16_t*)(p.ws + WS_MERGED)};
  pg8::gemm_phase<EpiMerge, MergeOrder, true, true>(GEMM_LDS, g, S, E);
}
DEV void phase_gemm_out(const Params& p, int l) {
  pg8::Gemm g{(const bf16_t*)(p.ws + WS_MERGED), (const bf16_t*)(p.ws + WS_WOUT), T, D, D}; pg8::StaticOrder S; S.init(T, D, NBLK, BID);
  EpiOut E{p.out, (const float*)(p.ws + WS_MOD) + (size_t)l * BATCH * 6 * D};
  pg8::gemm_phase<EpiOut, pg8::StaticOrder, true, true>(GEMM_LDS, g, S, E);
}
DEV void phase_moe_up(const Params& p, int l) {
  int* s_pref = (int*)(LDS_PTR() + LDS_PHASE_BYTES + 64);
  moe_tiles(p, l, s_pref);
  pg8::Gemm g{(const bf16_t*)(p.ws + WS_HS), (const bf16_t*)(p.ws + WS_WGU), SLOT_ROWS, NE * 2 * FF, D};
  MoeOrder S{s_pref, s_pref[NE] * 4, NBLK, BID};
  EpiUp E{(bf16_t*)(p.ws + WS_ACT), (const int*)(p.ws + WS_SLOT_ENT), (const float*)(p.ws + WS_SLOT_W)};
  pg8::gemm_phase<EpiUp, MoeOrder, true, true>(GEMM_LDS, g, S, E);
}
DEV void phase_moe_down(const Params& p, int l) {
  int* s_pref = (int*)(LDS_PTR() + LDS_PHASE_BYTES + 64);
  moe_tiles(p, l, s_pref);
  pg8::Gemm g{(const bf16_t*)(p.ws + WS_ACT), (const bf16_t*)(p.ws + WS_WD), SLOT_ROWS, NE * D, FF};
  MoeOrder S{s_pref, s_pref[NE] * 4, NBLK, BID};
  EpiDown E{(bf16_t*)(p.ws + WS_Y), (const int*)(p.ws + WS_SLOT_ENT)};
  pg8::gemm_phase<EpiDown, MoeOrder, true, true>(GEMM_LDS, g, S, E);
}
#endif
DEV void phase_prep(const Params& p, int l) {
  const bf16_t* PROJ = (const bf16_t*)(p.ws + WS_PROJ);
  bf16_t* QC = (bf16_t*)(p.ws + WS_QC); bf16_t* KC = (bf16_t*)(p.ws + WS_KC);
  const int gtid = BID * NTHREADS + TID, gstride = NBLK * NTHREADS;
  const float* cw = p.conv_w + (size_t)l * CONVW * 2 * MW; const float* cb = p.conv_b + (size_t)l * 2 * MW;
  for (int it = gtid; it < T * 128; it += gstride) {
    const int t = it >> 7, c8 = (it & 127) * 8, s = t % SEQ;
    float a[8]; UNR for (int j = 0; j < 8; ++j) a[j] = cb[c8 + j];
    UNR for (int wi = 0; wi < CONVW; ++wi) { const int ss = s + wi - 2; if (ss < 0 || ss >= SEQ) continue;
      const bf16x8 v = ld8(PROJ + (size_t)(t + wi - 2) * NP + c8);
      UNR for (int j = 0; j < 8; ++j) a[j] += bf2f((bf16_t)v[j]) * cw[wi * 2 * MW + c8 + j]; }
    const float sc = (c8 < MW) ? 0.08838834764831845f : 1.f;
    u32x4 o; o.x = pk2(siluf_(a[0]) * sc, siluf_(a[1]) * sc); o.y = pk2(siluf_(a[2]) * sc, siluf_(a[3]) * sc); o.z = pk2(siluf_(a[4]) * sc, siluf_(a[5]) * sc); o.w = pk2(siluf_(a[6]) * sc, siluf_(a[7]) * sc);
    if (c8 < MW) *(u32x4*)(QC + (size_t)t * MW + c8) = o; else *(u32x4*)(KC + (size_t)t * MW + c8 - MW) = o;
  }
  bf16_t* AQN = (bf16_t*)(p.ws + WS_AQN); bf16_t* AKN = (bf16_t*)(p.ws + WS_AKN); bf16_t* VT = (bf16_t*)(p.ws + WS_VT);
  const float* rope = (const float*)(p.ws + WS_ROPE); constexpr int NR = SEQ / GRID_W;
  for (int it0 = BID * NTHREADS; it0 < T * 10 * 8; it0 += gstride) {
    const int it = it0 + TID, j = it & 7, th = it >> 3, hh = th / T, t = th % T, s = t % SEQ;
    const bool isq = hh < AH;
    const bf16_t* src = PROJ + (size_t)t * NP + (isq ? C_AQ + hh * 64 : C_AK + (hh - AH) * 64) + j * 8;
    const float* g = (isq ? p.q_norm_g : p.k_norm_g) + (size_t)l * AHD + j * 8;
    const bf16x8 x8 = ld8(src);
    float v[8], pr[8]; float ss = 0.f;
#pragma unroll
    for (int k = 0; k < 8; ++k) { v[k] = bf2f((bf16_t)x8[k]); ss += v[k] * v[k]; }
    ss += shfl_xor_f(ss, 1); ss += shfl_xor_f(ss, 2); ss += shfl_xor_f(ss, 4);
    const float rs = 1.f / sqrtf(ss * (1.f / 64.f) + EPS);
#pragma unroll
    for (int k = 0; k < 8; ++k) v[k] = v[k] * rs * g[k];
#pragma unroll
    for (int k = 0; k < 8; ++k) pr[k] = shfl_xor_f(v[k], 2);
    const int pos = (j < 4) ? s / GRID_W : s % GRID_W;
    const float* ct = rope + (j < 4 ? 0 : 2 * NR * 16) + pos * 16 + (j & 1) * 8;
    const float* st = ct + (j < 4 ? NR * 16 : 64 * 16);
    const float sgn = (j & 2) ? 1.f : -1.f, qs = isq ? 0.125f * 1.4426950408889634f : 1.f;
    float o[8];
#pragma unroll
    for (int k = 0; k < 8; ++k) o[k] = (v[k] * ct[k] + sgn * pr[k] * st[k]) * qs;
    u32x4 w4; w4.x = pk2(o[0], o[1]); w4.y = pk2(o[2], o[3]); w4.z = pk2(o[4], o[5]); w4.w = pk2(o[6], o[7]);
    bf16_t* dst = isq ? AQN + (size_t)t * AW + hh * 64 + j * 8 : AKN + (size_t)t * KVW + (hh - AH) * 64 + j * 8;
    *(u32x4*)dst = w4;
  }
#ifdef EMU
  for (int it = gtid; it < T * KVH * 8; it += gstride) {
    const int s = it % SEQ, d8 = (it / SEQ) & 7, bk = it / (SEQ * 8), b = bk / KVH, kv = bk % KVH;
    const bf16x8 v8 = ld8(PROJ + (size_t)(b * SEQ + s) * NP + C_AV + kv * 64 + d8 * 8);
#pragma unroll
    for (int k = 0; k < 8; ++k) VT[((size_t)bk * 64 + d8 * 8 + k) * SEQ + s] = (bf16_t)v8[k];
  }
#else
  (void)VT;
#endif
}

#ifdef EMU
DEV void phase_attn(const Params& p) {
  char* lds = LDS_PTR();
  bf16_t* Ks = (bf16_t*)lds; bf16_t* Vs = Ks + 64 * GP; bf16_t* Ps = Vs + 64 * GP;
  const bf16_t* AQN = (const bf16_t*)(p.ws + WS_AQN); const bf16_t* AKN = (const bf16_t*)(p.ws + WS_AKN); const bf16_t* VT = (const bf16_t*)(p.ws + WS_VT);
  bf16_t* YA = (bf16_t*)(p.ws + WS_YA);
  const int tid = TID, lane = tid & 63, w = tid >> 6;
  constexpr int NQB = SEQ / 128, NU = BATCH * AH * NQB;
  bf16_t* Pw = Ps + w * 16 * GP;
  for (int u = BID; u < NU; u += NBLK) {
    const int qb = u % NQB, h = (u / NQB) % AH, b = u / (NQB * AH), kv = h / (AH / KVH);
    const int r0 = qb * 128 + w * 16;
    bf16x8 qa[2];
    UNR for (int ks = 0; ks < 2; ++ks) qa[ks] = ld8(AQN + (size_t)(b * SEQ + r0 + (lane & 15)) * AW + h * 64 + ks * 32 + (lane >> 4) * 8);
    f32x4 o[4]; UNR for (int i = 0; i < 4; ++i) o[i] = (f32x4){0.f, 0.f, 0.f, 0.f};
    float mrow[4], lrow[4]; UNR for (int i = 0; i < 4; ++i) { mrow[i] = -3.0e38f; lrow[i] = 0.f; }
    for (int kt = 0; kt < SEQ / 64; ++kt) {
      SYNC();
      { const int r = tid >> 3, pc = (tid & 7) * 8;
        *(u32x4*)(Ks + r * GP + pc) = *(const u32x4*)(AKN + (size_t)(b * SEQ + kt * 64 + r) * KVW + kv * 64 + pc);
        *(u32x4*)(Vs + r * GP + pc) = *(const u32x4*)(VT + ((size_t)(b * KVH + kv) * 64 + r) * SEQ + kt * 64 + pc); }
      SYNC();
      f32x4 s[4];
      UNR for (int nt = 0; nt < 4; ++nt) { s[nt] = (f32x4){0.f, 0.f, 0.f, 0.f};
        UNR for (int ks = 0; ks < 2; ++ks) s[nt] = mfma16(qa[ks], ld8(Ks + (nt * 16 + (lane & 15)) * GP + ks * 32 + (lane >> 4) * 8), s[nt]); }
      UNR for (int i = 0; i < 4; ++i) {
        float mx = fmaxf(fmaxf(s[0][i], s[1][i]), fmaxf(s[2][i], s[3][i])); mx = grp16_max(mx);
        const float mnew = fmaxf(mrow[i], mx), alpha = exp2f(mrow[i] - mnew); mrow[i] = mnew;
        float rsum = 0.f;
        UNR for (int nt = 0; nt < 4; ++nt) { const float pv = exp2f(s[nt][i] - mnew); rsum += pv; Pw[((lane >> 4) * 4 + i) * GP + nt * 16 + (lane & 15)] = f2bf(pv); }
        lrow[i] = lrow[i] * alpha + rsum;
        UNR for (int nd = 0; nd < 4; ++nd) o[nd][i] *= alpha;
      }
      SYNC();
      UNR for (int ks = 0; ks < 2; ++ks) { const bf16x8 pa = ld8(Pw + (lane & 15) * GP + ks * 32 + (lane >> 4) * 8);
        UNR for (int nd = 0; nd < 4; ++nd) o[nd] = mfma16(pa, ld8(Vs + (nd * 16 + (lane & 15)) * GP + ks * 32 + (lane >> 4) * 8), o[nd]); }
    }
    UNR for (int i = 0; i < 4; ++i) { const float lt = grp16_sum(lrow[i]), inv = 1.f / lt; const int row = b * SEQ + r0 + (lane >> 4) * 4 + i;
      UNR for (int nd = 0; nd < 4; ++nd) YA[(size_t)row * AW + h * 64 + nd * 16 + (lane & 15)] = f2bf(o[nd][i] * inv); }
  }
}

#else
namespace attn_body {
using bf16=unsigned short;
using bf16x8=__attribute__((ext_vector_type(8)))short;
using s16x4=__attribute__((ext_vector_type(4)))short;
using f32x16=__attribute__((ext_vector_type(16)))float;
using u32x4=__attribute__((ext_vector_type(4)))unsigned;
constexpr int SEQ=::SEQ,D=64;
constexpr int NW=8,QBLK=32,QB=QBLK*NW,KVBLK=64,NQB=SEQ/QB;
constexpr int ATTN_UNIT_ROWS=QB;
__device__ __forceinline__ int crow(int r,int hi){return (r&3)+8*(r>>2)+4*hi;}
#define SBAR() __builtin_amdgcn_sched_barrier(0)
constexpr int NSLOT=3, SLOTB=8192;
constexpr int LDS_K=0, LDS_V=NSLOT*SLOTB, LDS_WS=2*NSLOT*SLOTB, LDS_OST=LDS_WS+NW*64*4, LDS_BYTES=LDS_OST+NW*4096;
constexpr float C2=0.125f*1.4426950408889634f;
__device__ __forceinline__ void glds16(const void*gsrc,unsigned lds_dst){unsigned keep;
  asm volatile("s_mov_b32 %0, m0\n\ts_mov_b32 m0, %2\n\ts_nop 0\n\tglobal_load_lds_dwordx4 %1, off\n\ts_mov_b32 m0, %0":"=&s"(keep):"v"(gsrc),"s"(lds_dst):"memory");}
__device__ __forceinline__ float max3f(float a,float b,float c){float r;asm("v_max3_f32 %0, %1, %2, %3":"=v"(r):"v"(a),"v"(b),"v"(c));return r;}
__device__ __forceinline__ float max2f(float a,float b){float r;asm("v_max_f32_e32 %0, %1, %2":"=v"(r):"v"(a),"v"(b));return r;}
__device__ __forceinline__ float fadd_s(float a,float b){float r;asm("v_add_f32_e32 %0, %1, %2":"=v"(r):"v"(a),"v"(b));return r;}
__device__ __forceinline__ float fsub_s(float a,float b){float r;asm("v_sub_f32_e32 %0, %1, %2":"=v"(r):"v"(a),"v"(b));return r;}
typedef float f32x2_t __attribute__((ext_vector_type(2))); typedef __bf16 bf16x2_t __attribute__((ext_vector_type(2)));
__device__ __forceinline__ unsigned cvtpk_s(float lo,float hi){f32x2_t v={lo,hi};bf16x2_t b=__builtin_convertvector(v,bf16x2_t);return __builtin_bit_cast(unsigned,b);}
#define WAIT_BAR(N) asm volatile("s_waitcnt vmcnt(" #N ") lgkmcnt(0)\n\ts_barrier":::"memory")

__device__ __forceinline__ void qkt(f32x16&p0,f32x16&p1,const char*Kslot,const bf16x8*qr,const f32x16&negm,int r32,int hi){
  const char*kb=Kslot+hi*1024+r32*16;
  #pragma unroll
  for(int d0=0;d0<4;++d0){
    const bf16x8 b0=*reinterpret_cast<const bf16x8*>(kb+d0*2048);
    const bf16x8 b1=*reinterpret_cast<const bf16x8*>(kb+d0*2048+512);
    if(d0==0){p0=__builtin_amdgcn_mfma_f32_32x32x16_bf16(b0,qr[0],negm,0,0,0);p1=__builtin_amdgcn_mfma_f32_32x32x16_bf16(b1,qr[0],negm,0,0,0);}
    else{p0=__builtin_amdgcn_mfma_f32_32x32x16_bf16(b0,qr[d0],p0,0,0,0);p1=__builtin_amdgcn_mfma_f32_32x32x16_bf16(b1,qr[d0],p1,0,0,0);}}
}
typedef __attribute__((address_space(3))) const char* lds_cptr;
typedef short v4i16_t __attribute__((ext_vector_type(4)));
__device__ __forceinline__ void kload8(bf16x8*kf,lds_cptr kp){
  kf[0]=*(const __attribute__((address_space(3))) bf16x8*)(kp);      kf[1]=*(const __attribute__((address_space(3))) bf16x8*)(kp+512);
  kf[2]=*(const __attribute__((address_space(3))) bf16x8*)(kp+2048); kf[3]=*(const __attribute__((address_space(3))) bf16x8*)(kp+2560);
  kf[4]=*(const __attribute__((address_space(3))) bf16x8*)(kp+4096); kf[5]=*(const __attribute__((address_space(3))) bf16x8*)(kp+4608);
  kf[6]=*(const __attribute__((address_space(3))) bf16x8*)(kp+6144); kf[7]=*(const __attribute__((address_space(3))) bf16x8*)(kp+6656);
}
__device__ __forceinline__ void kload2(bf16x8*kf,lds_cptr kp,int j){ kf[2*j]=*(const __attribute__((address_space(3))) bf16x8*)(kp+j*2048); kf[2*j+1]=*(const __attribute__((address_space(3))) bf16x8*)(kp+j*2048+512); }
__device__ __forceinline__ s16x4 vtr(lds_cptr p){ return __builtin_bit_cast(s16x4,__builtin_amdgcn_ds_read_tr16_b64_v4i16((__attribute__((address_space(3))) v4i16_t*)p)); }
__device__ __forceinline__ float rowmax(const f32x16&p0,const f32x16&p1){
  float a=max3f(p0[0],p0[1],p1[0]),b=max3f(p0[2],p0[3],p1[1]);a=max3f(a,p1[2],p1[3]);
  #pragma unroll
  for(int r=4;r<16;r+=4){a=max3f(a,p0[r],p0[r+1]);b=max3f(b,p0[r+2],p0[r+3]);a=max3f(a,p1[r],p1[r+1]);b=max3f(b,p1[r+2],p1[r+3]);}
  const float m=max2f(a,b);
  auto rr=__builtin_amdgcn_permlane32_swap(__float_as_uint(m),__float_as_uint(m),false,false);
  return max2f(__uint_as_float(rr[0]),__uint_as_float(rr[1]));
}
__device__ __forceinline__ void pv(f32x16*o,int vb,bf16x8 pa0,bf16x8 pa1,bf16x8 pa2,bf16x8 pa3){
  #pragma unroll
  for(int d0=0;d0<2;++d0){s16x4 lo[4],hi[4];
    #pragma unroll
    for(int ks=0;ks<4;++ks){
      asm volatile("ds_read_b64_tr_b16 %0,%1 offset:%c2":"=&v"(lo[ks]):"v"(vb),"i"(d0*4096+ks*1024):"memory");
      asm volatile("ds_read_b64_tr_b16 %0,%1 offset:%c2":"=&v"(hi[ks]):"v"(vb),"i"(d0*4096+ks*1024+512):"memory");}
    asm volatile("s_waitcnt lgkmcnt(0)":::"memory");SBAR();
    #define PK(k) (bf16x8){lo[k][0],lo[k][1],lo[k][2],lo[k][3],hi[k][0],hi[k][1],hi[k][2],hi[k][3]}
    o[d0]=__builtin_amdgcn_mfma_f32_32x32x16_bf16(pa0,PK(0),o[d0],0,0,0);
    o[d0]=__builtin_amdgcn_mfma_f32_32x32x16_bf16(pa1,PK(1),o[d0],0,0,0);
    o[d0]=__builtin_amdgcn_mfma_f32_32x32x16_bf16(pa2,PK(2),o[d0],0,0,0);
    o[d0]=__builtin_amdgcn_mfma_f32_32x32x16_bf16(pa3,PK(3),o[d0],0,0,0);
    #undef PK
  }
}

#ifndef ATTN_STORE16
#define ATTN_STORE16(p,v) (*(u32x4*)(p)=(v))
#endif
template<int THRL,int QP,int KP,int VP> __device__ __forceinline__ void attn_unit(long rowbase,int qb,const bf16*Q,const bf16*__restrict__ K,const bf16*__restrict__ V,bf16*O,char*shm){
  const int tid=TID,lane=tid&63,r32=lane&31,hi=lane>>5; const int wid=__builtin_amdgcn_readfirstlane(tid>>6);
  const int q0=qb*QB;
  const bf16*Qw=Q+(rowbase+q0+wid*QBLK)*QP;
  const bf16*Kh=K+rowbase*KP,*Vh=V+rowbase*VP;
  const unsigned lds0=(unsigned)(uintptr_t)shm;
  float*wsf=(float*)(shm+LDS_WS)+wid*64;
  const bf16*ksrc=Kh+(long)lane*KP+wid*8;
  const bf16*vsrc=Vh+(long)(16*(wid&3)+(lane>>2))*VP+(wid>>2)*32+(lane&3)*8;
  const unsigned kdst=lds0+LDS_K+wid*1024, vdst=lds0+LDS_V+wid*1024;
  #define DMA_K(t,slot) glds16(ksrc+(long)(t)*KVBLK*KP,(unsigned)__builtin_amdgcn_readfirstlane(kdst+(slot)))
  #define DMA_V(t,slot) glds16(vsrc+(long)(t)*KVBLK*VP,(unsigned)__builtin_amdgcn_readfirstlane(vdst+(slot)))
  const int vb0=(int)(lds0+LDS_V)+((lane>>4)&1)*32+(lane&3)*8+(4*hi+((lane&15)>>2))*64;
  const char*Kbase=shm+LDS_K; bf16x8 kf[8];
  const lds_cptr shm3=(lds_cptr)shm; const lds_cptr kp0=shm3+LDS_K+hi*1024+r32*16; const lds_cptr vp0=shm3+LDS_V+((lane>>4)&1)*32+(lane&3)*8+(4*hi+((lane&15)>>2))*64;
  int NT=SEQ/KVBLK; asm volatile("":"+s"(NT));
  DMA_K(0,0);DMA_V(0,0);DMA_K(1,SLOTB);
  bf16x8 qr[4];
  #pragma unroll
  for(int d0=0;d0<4;++d0)qr[d0]=*reinterpret_cast<const bf16x8*>(&Qw[(long)r32*QP+d0*16+hi*8]);
  float mhat=0.f,l_reg=0.f;f32x16 o[2];o[0]=f32x16{};o[1]=f32x16{};f32x16 negm=f32x16{};asm volatile("":"+v"(negm));
  #define CMASK(P0,P1,t) do{}while(0)
  bool resc=false;
  #define START(P0,P1) do{ const float rm=rowmax(P0,P1); resc=false; \
    { const float dl=rm; mhat=fadd_s(mhat,dl); \
      _Pragma("unroll") for(int r=0;r<16;++r){P0[r]=fsub_s(P0[r],dl);P1[r]=fsub_s(P1[r],dl);} \
      _Pragma("unroll") for(int r=0;r<16;++r)negm[r]=-mhat; asm volatile("":"+v"(negm)); } \
    _Pragma("unroll") for(int r=0;r<16;++r)P0[r]=__builtin_amdgcn_exp2f(P0[r]); }while(0)
  #define RESC() do{ if(resc){ asm volatile("s_waitcnt lgkmcnt(0)":::"memory"); \
      _Pragma("unroll") for(int d_=0;d_<2;++d_) _Pragma("unroll") for(int r=0;r<16;++r)o[d_][r]*=wsf[crow(r,hi)]; } }while(0)
  f32x16 pA0,pA1,pB0,pB1;
  int sl_prev=0,sl_cur=0,sl_next=SLOTB;
  #define ROT() do{sl_prev=sl_cur;sl_cur=sl_next;sl_next=(sl_next==(NSLOT-1)*SLOTB)?0:sl_next+SLOTB;}while(0)
  DMA_K(2,2*SLOTB);
  WAIT_BAR(3);
  qkt(pA0,pA1,Kbase,qr,negm,r32,hi);asm volatile("s_nop 15\n\ts_nop 7":"+v"(pA0),"+v"(pA1));CMASK(pA0,pA1,0);
  START(pA0,pA1);
  _Pragma("unroll") for(int r=0;r<16;++r)pA1[r]=__builtin_amdgcn_exp2f(pA1[r]);
  WAIT_BAR(0);
  DMA_K(3,0);DMA_V(1,SLOTB);
  ROT();
  kload8(kf,kp0+sl_cur);
  WAIT_BAR(2);
  s16x4 vlo[8],vhi[8]; u32x4 pw0,pw1,pw2,pw3;
  #define PKW(P,B) cvtpk_s(P[B],P[B+1])
  #define PAF(k) __builtin_bit_cast(bf16x8,pw##k)
  #define VFR(i) (bf16x8){vlo[i][0],vlo[i][1],vlo[i][2],vlo[i][3],vhi[i][0],vhi[i][1],vhi[i][2],vhi[i][3]}
  #define PIN(x) asm volatile("":"+v"(x))
  #define MX3(a,b,c) __builtin_fmaxf(__builtin_fmaxf((a),(b)),(c))
  #define GAPA(MF,A0,A1,A2,A3,W0,W1,PW) do{ MF; sacc+=A0; sacc+=A1; sacc+=A2; sacc+=A3; PIN(sacc); W0; W1; PIN(PW); SBAR(); }while(0)
  #define EX(v) __builtin_amdgcn_exp2f(v)
  #define GAPB(MF,X,B) do{ MF; X[B]=EX(X[B]); X[B+1]=EX(X[B+1]); X[B+2]=EX(X[B+2]); X[B+3]=EX(X[B+3]); PIN(X); SBAR(); }while(0)
  #define VRD(i) do{ vlo[i]=vtr(vp_+(((i)>>2)*4096+((i)&3)*1024)); vhi[i]=vtr(vp_+(((i)>>2)*4096+((i)&3)*1024+512)); }while(0)
  #define KRD(G,j) do{ if(G){ kload2(kf,kp0+sl_next,j); SBAR(); } }while(0)
  #define STEP(C0,C1,P0,P1,t,GK,GV,GL) do{ SBAR(); \
    const lds_cptr vp_=vp0+sl_prev; \
    VRD(0); SBAR(); float sacc=(P0[0]+P0[1]); \
    GAPA(C0=__builtin_amdgcn_mfma_f32_32x32x16_bf16(kf[0],qr[0],negm,0,0,0), P0[2],P0[3],P0[4],P0[5],     pw0[0]=PKW(P0,0), pw0[1]=PKW(P0,2), pw0); \
    VRD(4); SBAR(); GAPA(C1=__builtin_amdgcn_mfma_f32_32x32x16_bf16(kf[1],qr[0],negm,0,0,0), P0[6],P0[7],P0[8],P0[9],     pw0[2]=PKW(P0,4), pw0[3]=PKW(P0,6), pw0); \
    VRD(1); SBAR(); GAPA(C0=__builtin_amdgcn_mfma_f32_32x32x16_bf16(kf[2],qr[1],C0,0,0,0),   P0[10],P0[11],P0[12],P0[13], pw1[0]=PKW(P0,8), pw1[1]=PKW(P0,10), pw1); \
    VRD(5); SBAR(); GAPA(C1=__builtin_amdgcn_mfma_f32_32x32x16_bf16(kf[3],qr[1],C1,0,0,0),   P0[14],P0[15],P1[0],P1[1],   pw1[2]=PKW(P0,12),pw1[3]=PKW(P0,14), pw1); \
    VRD(2); SBAR(); GAPA(C0=__builtin_amdgcn_mfma_f32_32x32x16_bf16(kf[4],qr[2],C0,0,0,0),   P1[2],P1[3],P1[4],P1[5],     pw2[0]=PKW(P1,0), pw2[1]=PKW(P1,2), pw2); \
    VRD(6); SBAR(); GAPA(C1=__builtin_amdgcn_mfma_f32_32x32x16_bf16(kf[5],qr[2],C1,0,0,0),   P1[6],P1[7],P1[8],P1[9],     pw2[2]=PKW(P1,4), pw2[3]=PKW(P1,6), pw2); \
    VRD(3); SBAR(); GAPA(C0=__builtin_amdgcn_mfma_f32_32x32x16_bf16(kf[6],qr[3],C0,0,0,0),   P1[10],P1[11],P1[12],P1[13], pw3[0]=PKW(P1,8), pw3[1]=PKW(P1,10), pw3); \
    VRD(7); SBAR(); GAPA(C1=__builtin_amdgcn_mfma_f32_32x32x16_bf16(kf[7],qr[3],C1,0,0,0),   P1[14],P1[15],0.f,0.f,       pw3[2]=PKW(P1,12),pw3[3]=PKW(P1,14), pw3); \
    l_reg+=sacc; \
    if(GK){DMA_K((t)+3,sl_cur);} if(GV){DMA_V((t)+1,sl_next);} \
    CMASK(C0,C1,t); \
    { float a=MX3(C0[0],C0[1],C1[0]),b=MX3(C0[2],C0[3],C1[1]); a=MX3(a,C1[2],C1[3]); \
      _Pragma("unroll") for(int r=4;r<16;r+=4){a=MX3(a,C0[r],C0[r+1]);b=MX3(b,C0[r+2],C0[r+3]);a=MX3(a,C1[r],C1[r+1]);b=MX3(b,C1[r+2],C1[r+3]);} \
      float rm=__builtin_fmaxf(a,b); { auto rr=__builtin_amdgcn_permlane32_swap(__float_as_uint(rm),__float_as_uint(rm),false,false); rm=__builtin_fmaxf(__uint_as_float(rr[0]),__uint_as_float(rr[1])); } \
      resc=false; \
      if(__builtin_expect(__any(rm>(float)THRL),0)){ const float dl=__builtin_fmaxf(rm,0.f); mhat+=dl; \
        _Pragma("unroll") for(int r=0;r<16;++r){C0[r]-=dl;C1[r]-=dl;} \
        _Pragma("unroll") for(int r=0;r<16;++r)negm[r]=-mhat; asm volatile("":"+v"(negm)); \
        const float f=__builtin_amdgcn_exp2f(-dl); l_reg*=f; if(hi==0)wsf[r32]=f; resc=true; } } \
    SBAR(); \
    GAPB(o[0]=__builtin_amdgcn_mfma_f32_32x32x16_bf16(PAF(0),VFR(0),o[0],0,0,0), C0,0); \
    GAPB(o[1]=__builtin_amdgcn_mfma_f32_32x32x16_bf16(PAF(0),VFR(4),o[1],0,0,0), C0,4); \
    KRD(GL,0); GAPB(o[0]=__builtin_amdgcn_mfma_f32_32x32x16_bf16(PAF(1),VFR(1),o[0],0,0,0), C0,8); \
    KRD(GL,1); GAPB(o[1]=__builtin_amdgcn_mfma_f32_32x32x16_bf16(PAF(1),VFR(5),o[1],0,0,0), C0,12); \
    KRD(GL,2); GAPB(o[0]=__builtin_amdgcn_mfma_f32_32x32x16_bf16(PAF(2),VFR(2),o[0],0,0,0), C1,0); \
    KRD(GL,3); GAPB(o[1]=__builtin_amdgcn_mfma_f32_32x32x16_bf16(PAF(2),VFR(6),o[1],0,0,0), C1,4); \
    GAPB(o[0]=__builtin_amdgcn_mfma_f32_32x32x16_bf16(PAF(3),VFR(3),o[0],0,0,0), C1,8); \
    GAPB(o[1]=__builtin_amdgcn_mfma_f32_32x32x16_bf16(PAF(3),VFR(7),o[1],0,0,0), C1,12); \
    }while(0)
  int t=1;
  for(;t+5<NT;t+=2){
    STEP(pB0,pB1,pA0,pA1,t,true,true,true);     WAIT_BAR(2); RESC(); ROT();
    STEP(pA0,pA1,pB0,pB1,t+1,true,true,true);   WAIT_BAR(2); RESC(); ROT();
  }
  #define ENDW(tt) do{ if((tt)+3<NT){WAIT_BAR(2);} else if((tt)+2<NT){WAIT_BAR(1);} else {WAIT_BAR(0);} }while(0)
  for(;t+1<NT;t+=2){
    STEP(pB0,pB1,pA0,pA1,t,(t+3<NT),(t+1<NT),(t+1<NT));       ENDW(t);   RESC(); ROT();
    STEP(pA0,pA1,pB0,pB1,t+1,(t+4<NT),(t+2<NT),(t+2<NT));     ENDW(t+1); RESC(); ROT();
  }
  STEP(pB0,pB1,pA0,pA1,NT-1,false,false,false); RESC();
  { float sacc=pB0[0]+pB0[1]; _Pragma("unroll") for(int r=2;r<16;++r)sacc+=pB0[r]; _Pragma("unroll") for(int r=0;r<16;++r)sacc+=pB1[r]; l_reg+=sacc;
    pw0=(u32x4){PKW(pB0,0),PKW(pB0,2),PKW(pB0,4),PKW(pB0,6)};pw1=(u32x4){PKW(pB0,8),PKW(pB0,10),PKW(pB0,12),PKW(pB0,14)};pw2=(u32x4){PKW(pB1,0),PKW(pB1,2),PKW(pB1,4),PKW(pB1,6)};pw3=(u32x4){PKW(pB1,8),PKW(pB1,10),PKW(pB1,12),PKW(pB1,14)};
    SBAR(); pv(o,vb0+sl_cur,PAF(0),PAF(1),PAF(2),PAF(3)); }
  #undef PKW
  #undef PAF
  #undef VFR
  #undef PIN
  #undef MX3
  #undef GAPA
  #undef GAPB
  #undef EX
  #undef VRD
  #undef KRD
  #undef STEP
  #undef ENDW
  {auto rr=__builtin_amdgcn_permlane32_swap(__float_as_uint(l_reg),__float_as_uint(l_reg),false,false);l_reg=__uint_as_float(rr[0])+__uint_as_float(rr[1]);}
  if(hi==0)wsf[32+r32]=l_reg;asm volatile("s_waitcnt lgkmcnt(0)":::"memory");
  float rli[16];
  #pragma unroll
  for(int r=0;r<16;++r)rli[r]=__builtin_amdgcn_rcpf(wsf[32+crow(r,hi)]);
  bf16*Ow=O+(rowbase+q0+wid*QBLK)*QP;
  { bf16*stg=(bf16*)(shm+LDS_OST)+wid*2048;
    #pragma unroll
    for(int r=0;r<16;++r){const int orow=crow(r,hi);
      #pragma unroll
      for(int d0=0;d0<2;++d0)stg[orow*64+d0*32+r32]=f2bf(o[d0][r]*rli[r]);}
    asm volatile("s_waitcnt lgkmcnt(0)":::"memory");
    #pragma unroll
    for(int i=0;i<4;++i){const int row=i*8+(lane>>3),ch=lane&7; const u32x4 v=*(const u32x4*)(stg+row*64+ch*8); ATTN_STORE16(Ow+(long)row*QP+ch*8,v);} }
  asm volatile("s_waitcnt lgkmcnt(0)\n\ts_barrier":::"memory");
  #undef DMA_K
  #undef DMA_V
  #undef CMASK
  #undef START
  #undef RESC
  #undef ROT
}
#undef SBAR
#undef WAIT_BAR
}

DEV void phase_attn(const Params& p) {
  char* lds = LDS_PTR();
  const bf16_t* AQN = (const bf16_t*)(p.ws + WS_AQN); const bf16_t* AKN = (const bf16_t*)(p.ws + WS_AKN); const bf16_t* PROJ = (const bf16_t*)(p.ws + WS_PROJ);
  bf16_t* YA = (bf16_t*)(p.ws + WS_YA);
  constexpr int NQB = SEQ / 256, NU = BATCH * AH * NQB;
  for (int u = BID; u < NU; u += NBLK) {
    const int qb = u % NQB, h = (u / NQB) % AH, b = u / (NQB * AH), kv = h / (AH / KVH);
    attn_body::attn_unit<8, AW, KVW, NP>((long)b * SEQ, qb, AQN + h * 64, AKN + kv * 64, PROJ + C_AV + kv * 64, YA + h * 64, lds);
  }
}
#endif
DEV void phase_mlstm_a(const Params& p) {
  char* lds = LDS_PTR();
  bf16_t* VW = (bf16_t*)lds;
  bf16_t* KT = VW + 2 * 128 * GP;
  float* sc = (float*)(KT + 128 * GP);
  float* s_lf = sc; float* s_a = sc + 128; float* s_w = sc + 256;
  const bf16_t* PROJ = (const bf16_t*)(p.ws + WS_PROJ); const bf16_t* KC = (const bf16_t*)(p.ws + WS_KC); const float* GATES = (const float*)(p.ws + WS_GATES);
  bf16_t* CST = (bf16_t*)(p.ws + WS_CST); float* NST = (float*)(p.ws + WS_NST); float* AMAX = (float*)(p.ws + WS_AMAX); float* BLAST = (float*)(p.ws + WS_BLAST);
  const int tid = TID, lane = tid & 63, w = tid >> 6;
  for (int u = BID; u < BHC; u += NBLK) {
    const int c = u % NC, h = (u / NC) % MH, b = u / (NC * MH);
    const int t0 = b * SEQ + c * ML;
    SYNC();
    if (tid < 128) { const int dir = tid >> 6, l = tid & 63; s_lf[dir * 64 + l] = logsigmoidf_(GATES[(size_t)(t0 + l) * 16 + (dir ? 12 : 4) + h]); }
    SYNC();
    if (tid < 128) { const int dir = tid >> 6, l = tid & 63; const float li = GATES[(size_t)(t0 + l) * 16 + (dir ? 8 : 0) + h];
      float a = li;
      if (dir == 0) { for (int q = l + 1; q < 64; ++q) a += s_lf[q]; } else { for (int q = 0; q < l; ++q) a += s_lf[64 + q]; }
      s_a[dir * 64 + l] = a; }
    SYNC();
    if (tid < 128) { const int dir = tid >> 6, l = tid & 63; float mx = -3.0e38f, tot = 0.f;
      for (int q = 0; q < 64; ++q) { mx = fmaxf(mx, s_a[dir * 64 + q]); tot += s_lf[dir * 64 + q]; }
      s_w[dir * 64 + l] = expf(s_a[dir * 64 + l] - mx);
      if (l == 0) { AMAX[dir * BHC + u] = mx; BLAST[dir * BHC + u] = tot; } }
    SYNC();
    for (int it = tid; it < 1024; it += NTHREADS) { const int l = it >> 4, d8 = (it & 15) * 8;
      const bf16x8 v8 = ld8(PROJ + (size_t)(t0 + l) * NP + C_MV + h * 128 + d8); const bf16x8 k8 = ld8(KC + (size_t)(t0 + l) * MW + h * 128 + d8);
      const float wf = s_w[l], wb = s_w[64 + l];
      UNR for (int j = 0; j < 8; ++j) { const float vf = bf2f((bf16_t)v8[j]); VW[(d8 + j) * GP + l] = f2bf(vf * wf); VW[(128 + d8 + j) * GP + l] = f2bf(vf * wb); KT[(d8 + j) * GP + l] = (bf16_t)k8[j]; } }
    SYNC();
    { const int dir = w >> 2, m2 = w & 3;
      UNR for (int mi = 0; mi < 2; ++mi) { const int mt = m2 * 2 + mi;
        bf16x8 af[2]; UNR for (int ks = 0; ks < 2; ++ks) af[ks] = ld8(VW + (dir * 128 + mt * 16 + (lane & 15)) * GP + ks * 32 + (lane >> 4) * 8);
        UNR for (int nt = 0; nt < 8; ++nt) { f32x4 acc = (f32x4){0.f, 0.f, 0.f, 0.f};
          UNR for (int ks = 0; ks < 2; ++ks) acc = mfma16(af[ks], ld8(KT + (nt * 16 + (lane & 15)) * GP + ks * 32 + (lane >> 4) * 8), acc);
          bf16_t* dst = CST + ((size_t)(dir * BHC + u) * 128 + mt * 16 + (lane >> 4) * 4) * 128 + nt * 16 + (lane & 15);
          UNR for (int i = 0; i < 4; ++i) dst[i * 128] = f2bf(acc[i]); } } }
    if (tid < 256) { const int dir = tid >> 7, e = tid & 127; float s = 0.f; for (int l = 0; l < 64; ++l) s += s_w[dir * 64 + l] * bf2f(KT[e * GP + l]); NST[(size_t)(dir * BHC + u) * 128 + e] = s; }
  }
}
DEV void phase_mlstm_scan(const Params& p) {
  bf16_t* CST = (bf16_t*)(p.ws + WS_CST); float* NST = (float*)(p.ws + WS_NST);
  const float* AMAX = (const float*)(p.ws + WS_AMAX); const float* BLAST = (const float*)(p.ws + WS_BLAST); float* MPREV = (float*)(p.ws + WS_MPREV);
  const int gtid = BID * NTHREADS + TID, gstride = NBLK * NTHREADS;
  constexpr int PER = 8192, SB = (NC % 8 == 0) ? 8 : 4;
  for (int it = gtid; it < 2 * BATCH * MH * PER; it += gstride) {
    const int pi = it % PER, dbh = it / PER, dir = dbh / (BATCH * MH), bh = dbh % (BATCH * MH);
    const bool hasn = pi < 64;
    float s0 = 0.f, s1 = 0.f, n0 = 0.f, n1 = 0.f, m = 0.f;
    for (int cc0 = 0; cc0 < NC; cc0 += SB) {
      unsigned in[SB]; float bl[SB], am[SB], i0[SB], i1[SB];
      UNR for (int j = 0; j < SB; ++j) { const int c = dir ? NC - 1 - (cc0 + j) : cc0 + j; const int u = dir * BHC + bh * NC + c;
        in[j] = *((const unsigned*)(CST + (size_t)u * 16384) + pi); bl[j] = BLAST[u]; am[j] = AMAX[u];
        if (hasn) { i0[j] = NST[(size_t)u * 128 + 2 * pi]; i1[j] = NST[(size_t)u * 128 + 2 * pi + 1]; } else { i0[j] = 0.f; i1[j] = 0.f; } }
      UNR for (int j = 0; j < SB; ++j) { const int c = dir ? NC - 1 - (cc0 + j) : cc0 + j; const int u = dir * BHC + bh * NC + c;
        const float mn = fmaxf(bl[j] + m, am[j]), dec = expf(bl[j] + m - mn), inj = expf(am[j] - mn);
        *((unsigned*)(CST + (size_t)u * 16384) + pi) = pk2(s0, s1);
        s0 = dec * s0 + inj * bf2f((bf16_t)(in[j] & 0xffff)); s1 = dec * s1 + inj * bf2f((bf16_t)(in[j] >> 16));
        if (hasn) { NST[(size_t)u * 128 + 2 * pi] = n0; NST[(size_t)u * 128 + 2 * pi + 1] = n1; n0 = dec * n0 + inj * i0[j]; n1 = dec * n1 + inj * i1[j]; }
        if (pi == 0) MPREV[u] = m;
        m = mn; }
    }
  }
}
constexpr int QP = 136;
constexpr int C_HALF_BYTES = (64 * QP * 2) * 2 + 128 * GP * 2 + 4 * 16 * GP * 2 + (4 * 64 + 2 * 128 + 4) * 4;
DEV void phase_mlstm_c(const Params& p, int l) {
  char* lds = LDS_PTR();
  const int tid = TID, lane = tid & 63, w = tid >> 6, half = w >> 2, wv = w & 3, htid = tid & 255;
  char* hb = lds + half * ((C_HALF_BYTES + 255) & ~255);
  bf16_t* Qs = (bf16_t*)hb; bf16_t* Ks = Qs + 64 * QP; bf16_t* VTs = Ks + 64 * QP; bf16_t* Ps = VTs + 128 * GP;
  float* s_b = (float*)(Ps + 4 * 16 * GP);
  float* s_li = s_b + 128;
  float* s_n = s_li + 128;
  float* s_m = s_n + 256;
  bf16_t* Pw = Ps + wv * 16 * GP;
  const bf16_t* PROJ = (const bf16_t*)(p.ws + WS_PROJ); const bf16_t* QC = (const bf16_t*)(p.ws + WS_QC); const bf16_t* KC = (const bf16_t*)(p.ws + WS_KC);
  const float* GATES = (const float*)(p.ws + WS_GATES); const bf16_t* CST = (const bf16_t*)(p.ws + WS_CST); const float* NST = (const float*)(p.ws + WS_NST);
  const float* MPREV = (const float*)(p.ws + WS_MPREV); bf16_t* YM = (bf16_t*)(p.ws + WS_YM);
  const float* ng = p.mlstm_norm_g + (size_t)l * MW;
  for (int u0 = BID * 2; u0 < BHC; u0 += NBLK * 2) {
    const int u = u0 + half;
    const int c = u % NC, h = (u / NC) % MH, b = u / (NC * MH);
    const int t0 = b * SEQ + c * ML;
    SYNC();
    for (int it = htid; it < 1024; it += 256) { const int r = it >> 4, d8 = (it & 15) * 8;
      *(u32x4*)(Qs + r * QP + d8) = *(const u32x4*)(QC + (size_t)(t0 + r) * MW + h * 128 + d8);
      *(u32x4*)(Ks + r * QP + d8) = *(const u32x4*)(KC + (size_t)(t0 + r) * MW + h * 128 + d8);
      const bf16x8 v8 = ld8(PROJ + (size_t)(t0 + r) * NP + C_MV + h * 128 + d8);
      UNR for (int j = 0; j < 8; ++j) VTs[(d8 + j) * GP + r] = (bf16_t)v8[j]; }
    if (htid < 128) { const int dir = htid >> 6, q = htid & 63; s_li[dir * 64 + q] = GATES[(size_t)(t0 + q) * 16 + (dir ? 8 : 0) + h];
      s_b[dir * 64 + q] = logsigmoidf_(GATES[(size_t)(t0 + q) * 16 + (dir ? 12 : 4) + h]); }
    s_n[htid] = NST[(size_t)((htid >> 7) * BHC + u) * 128 + (htid & 127)];
    if (htid < 2) s_m[htid] = MPREV[htid * BHC + u];
    SYNC();
    float cum = 0.f;
    if (htid < 128) { const int dir = htid >> 6, q = htid & 63;
      if (dir == 0) { for (int z = 0; z <= q; ++z) cum += s_b[z]; } else { for (int z = q; z < 64; ++z) cum += s_b[64 + z]; } }
    SYNC();
    if (htid < 128) s_b[htid] = cum;
    SYNC();
    const int j0 = wv * 16;
    bf16x8 qa[4]; UNR for (int ks = 0; ks < 4; ++ks) qa[ks] = ld8(Qs + (j0 + (lane & 15)) * QP + ks * 32 + (lane >> 4) * 8);
    f32x4 S[4];
    UNR for (int nt = 0; nt < 4; ++nt) { S[nt] = (f32x4){0.f, 0.f, 0.f, 0.f};
      UNR for (int ks = 0; ks < 4; ++ks) S[nt] = mfma16(qa[ks], ld8(Ks + (nt * 16 + (lane & 15)) * QP + ks * 32 + (lane >> 4) * 8), S[nt]); }
    f32x4 hs[8]; UNR for (int nd = 0; nd < 8; ++nd) hs[nd] = (f32x4){0.f, 0.f, 0.f, 0.f};
#pragma unroll 1
    for (int dir = 0; dir < 2; ++dir) {
      float qn = 0.f; { const int e0 = (lane >> 4) * 32;
        for (int e = 0; e < 32; ++e) qn += bf2f(Qs[(j0 + (lane & 15)) * QP + e0 + e]) * s_n[dir * 128 + e0 + e];
        qn += shfl_xor_f(qn, 16); qn += shfl_xor_f(qn, 32); }
      const float* bb = s_b + dir * 64; const float* li = s_li + dir * 64; const float mp = s_m[dir];
      float fsc[4];
      UNR for (int i = 0; i < 4; ++i) {
        const int j = j0 + (lane >> 4) * 4 + i; const float bj = bb[j];
        float dv[4], sv[4], mx = -3.0e38f;
        UNR for (int nt = 0; nt < 4; ++nt) { const int lk = nt * 16 + (lane & 15); const bool ok = dir ? (lk >= j) : (lk <= j);
          dv[nt] = ok ? (bj - bb[lk] + li[lk]) : -3.0e38f; mx = fmaxf(mx, dv[nt]); }
        mx = grp16_max(mx);
        const float mi = bj + mp, mo = fmaxf(mi, mx);
        float rsum = 0.f;
        UNR for (int nt = 0; nt < 4; ++nt) { sv[nt] = (dv[nt] > -1.0e38f) ? S[nt][i] * expf(dv[nt] - mo) : 0.f; rsum += sv[nt]; }
        rsum = grp16_sum(rsum);
        const float iw = expf(mi - mo);
        const float qnj = shfl_f(qn, (lane >> 4) * 4 + i);
        const float den = rsum + iw * qnj;
        const float dinv = 1.f / fmaxf(fabsf(den), expf(-mo));
        UNR for (int nt = 0; nt < 4; ++nt) Pw[((lane >> 4) * 4 + i) * GP + nt * 16 + (lane & 15)] = f2bf(sv[nt] * dinv);
        fsc[i] = iw * dinv;
      }
      float fa = 0.f;
      UNR for (int i = 0; i < 4; ++i) { const float tv = shfl_f(fsc[i], ((lane & 15) >> 2) * 16); fa = ((lane & 3) == i) ? tv : fa; }
      SYNC();
      UNR for (int ks = 0; ks < 2; ++ks) { const bf16x8 pa = ld8(Pw + (lane & 15) * GP + ks * 32 + (lane >> 4) * 8);
        UNR for (int nd = 0; nd < 8; ++nd) hs[nd] = mfma16(pa, ld8(VTs + (nd * 16 + (lane & 15)) * GP + ks * 32 + (lane >> 4) * 8), hs[nd]); }
      const bf16_t* Cp = CST + (size_t)(dir * BHC + u) * 16384;
      UNR for (int ks = 0; ks < 4; ++ks) {
        bf16x8 qs; UNR for (int e = 0; e < 8; ++e) qs[e] = (short)f2bf(bf2f((bf16_t)qa[ks][e]) * fa);
        UNR for (int nd = 0; nd < 8; ++nd) hs[nd] = mfma16(qs, ld8(Cp + (size_t)(nd * 16 + (lane & 15)) * 128 + ks * 32 + (lane >> 4) * 8), hs[nd]); }
      SYNC();
    }
    UNR for (int i = 0; i < 4; ++i) { float ss = 0.f; UNR for (int nd = 0; nd < 8; ++nd) ss += hs[nd][i] * hs[nd][i];
      ss = grp16_sum(ss); const float rs = 1.f / sqrtf(ss * (1.f / 128.f) + EPS);
      const int t = t0 + j0 + (lane >> 4) * 4 + i;
      UNR for (int nd = 0; nd < 8; ++nd) { const int d = nd * 16 + (lane & 15); const float og = bf2f(PROJ[(size_t)t * NP + C_MO + h * 128 + d]);
        YM[(size_t)t * MW + h * 128 + d] = f2bf(hs[nd][i] * rs * ng[h * 128 + d] * sigmoidf_(og)); } }
  }
}

#ifndef EMU
#define XB_TMO      128
#define XB_XCNT(j)  (256  + 64 * (j))
#define XB_XSUB(j)  (1280 + 64 * (j))
#define XB_XGEN(j)  (2304 + 64 * (j))
#define XB_TOP      3328
#define XB_TOPGEN   3392
#define XCD_BAR_WORDS 3456
#define XB_SPIN_CAP (1u << 18)
#define LAS __attribute__((address_space(3)))
__device__ __forceinline__ unsigned xb_ld(unsigned* p)              { return __hip_atomic_load(p, __ATOMIC_RELAXED, __HIP_MEMORY_SCOPE_AGENT); }
__device__ __forceinline__ unsigned xb_add(unsigned* p, unsigned v) { return __hip_atomic_fetch_add(p, v, __ATOMIC_RELAXED, __HIP_MEMORY_SCOPE_AGENT); }
__device__ __forceinline__ unsigned xb_xcc_id() { return (unsigned)__builtin_amdgcn_s_getreg((3 << 11) | 20) & 0xFu; }
#define XB_SPIN(cond, bar) do { unsigned _sp = 0; while (cond) { __builtin_amdgcn_s_sleep(1); \
    if ((++_sp & 255u) == 0u) { if (xb_ld(&(bar)[XB_TMO])) break; if (_sp > XB_SPIN_CAP) { atomicAdd(&(bar)[XB_TMO], 1u); break; } } } } while (0)
struct XcdBarrier { unsigned* bar; unsigned x; volatile LAS unsigned* st; };
__device__ __forceinline__ XcdBarrier xcd_barrier_post(unsigned* bar, volatile LAS unsigned* st) {
    XcdBarrier b; b.bar = bar; b.x = xb_xcc_id(); b.st = st;
    if (threadIdx.x == 0) (void)xb_add(&bar[XB_XCNT(b.x)], 1u);
    return b;
}
__device__ __forceinline__ void xcd_barrier_complete(unsigned* bar, unsigned x, unsigned& nloc, unsigned& nx) {
    const unsigned G = gridDim.x * gridDim.y * gridDim.z;
    unsigned sum, cnt, mine, sp = 0u;
    for (;;) {
        sum = 0u; cnt = 0u; mine = 0u;
#pragma unroll
        for (unsigned j = 0; j < 16; ++j) { const unsigned c = xb_ld(&bar[XB_XCNT(j)]); sum += c; cnt += (c > 0u) ? 1u : 0u; mine = (j == x) ? c : mine; }
        if (sum == G) break;
        __builtin_amdgcn_s_sleep(1);
        if ((++sp & 255u) == 0u) { if (xb_ld(&bar[XB_TMO])) break; if (sp > XB_SPIN_CAP) { atomicAdd(&bar[XB_TMO], 1u); break; } }
    }
    nloc = mine > 0u ? mine : 1u; nx = cnt > 0u ? cnt : 1u;
}
__device__ __forceinline__ void xcd_barrier(const XcdBarrier& b) {
    asm volatile("s_waitcnt vmcnt(0)" ::: "memory");
    __syncthreads();
    if (threadIdx.x == 0) {
        unsigned* bar = b.bar;
        __builtin_amdgcn_s_waitcnt(0);
        unsigned nloc = b.st[0], nx = b.st[1];
        if (nloc == 0u) { xcd_barrier_complete(bar, b.x, nloc, nx); b.st[0] = nloc; b.st[1] = nx; }
        const unsigned old = xb_add(&bar[XB_XSUB(b.x)], 1u);
        const unsigned gen = old / nloc;
        if (old + 1u == (gen + 1u) * nloc) {
            __builtin_amdgcn_fence(__ATOMIC_RELEASE, "agent");
            asm volatile("s_waitcnt vmcnt(0)" ::: "memory");
            const unsigned og = xb_add(&bar[XB_TOP], 1u);
            const unsigned tg = og / nx;
            if (og + 1u == (tg + 1u) * nx) xb_add(&bar[XB_TOPGEN], 1u);
            else XB_SPIN(xb_ld(&bar[XB_TOPGEN]) == tg, bar);
            __builtin_amdgcn_fence(__ATOMIC_ACQUIRE, "agent");
            xb_add(&bar[XB_XGEN(b.x)], 1u);
            asm volatile("s_waitcnt vmcnt(0)" ::: "memory");
        } else {
            XB_SPIN(xb_ld(&bar[XB_XGEN(b.x)]) == gen, bar);
            __builtin_amdgcn_fence(__ATOMIC_ACQUIRE, "agent");
            asm volatile("s_waitcnt vmcnt(0)" ::: "memory");
        }
    }
    __syncthreads();
}
__device__ __forceinline__ Params fresh(const Params& p) { Params q = p; unsigned long long w = (unsigned long long)q.ws; asm volatile("" : "+s"(w)); q.ws = (unsigned char*)w; return q; }
#define GRID_BAR() do { XcdBarrier xb_ = xbar; unsigned long long bw_ = (unsigned long long)xb_.bar; asm volatile("" : "+s"(bw_)); xb_.bar = (unsigned*)bw_; xcd_barrier(xb_); } while (0)
__global__ void __launch_bounds__(NTHREADS, 2) k_fwd(Params p) {
  {
    volatile LAS unsigned* st = (volatile LAS unsigned*)(LAS char*)(dyn_lds + LDS_PHASE_BYTES);
    if (threadIdx.x == 0) { st[0] = 0u; st[1] = 0u; st[2] = 0u; st[3] = 0u; }
    __syncthreads();
  }
  const XcdBarrier xbar = xcd_barrier_post((unsigned*)(p.ws + WS_CTL) + CW_BAR, (volatile LAS unsigned*)(LAS char*)(dyn_lds + LDS_PHASE_BYTES));
#else
#define GRID_BAR() emu_gridsync()
static inline Params fresh(const Params& p) { return p; }
static void k_fwd(Params p) {
#endif
  if (PHMASK & (1u << 0)) { phase_mod_rope(fresh(p)); if (DUP_PHASE == 0) { GRID_BAR(); phase_mod_rope(fresh(p)); } }
  for (int l = 0; l < DEPTH; ++l) {
    if (PHMASK & (1u << 1)) { phase_convert(fresh(p), l); if (DUP_PHASE == 1) { GRID_BAR(); phase_convert(fresh(p), l); } }
    GRID_BAR();
    if (PHMASK & (1u << 2)) { if (l == 0) phase_norm(fresh(p), l, 0, 0); else phase_norm(fresh(p), l, 1, 0); if (DUP_PHASE == 2 && l == 0) { GRID_BAR(); phase_norm(fresh(p), l, 0, 0); } }
    GRID_BAR();
    if (PHMASK & (1u << 3)) { phase_gemm_in(fresh(p), l); if (DUP_PHASE == 3) { GRID_BAR(); phase_gemm_in(fresh(p), l); } }
    GRID_BAR();
    if (PHMASK & (1u << 4)) { phase_prep(fresh(p), l); if (DUP_PHASE == 4) { GRID_BAR(); phase_prep(fresh(p), l); } }
    GRID_BAR();
    if (PHMASK & (1u << 5)) { phase_mlstm_a(fresh(p)); if (DUP_PHASE == 5) { GRID_BAR(); phase_mlstm_a(fresh(p)); } }
    GRID_BAR();
    if (PHMASK & (1u << 6)) { phase_mlstm_scan(fresh(p)); if (DUP_PHASE == 6) { GRID_BAR(); phase_mlstm_scan(fresh(p)); } }
    if (PHMASK & (1u << 7)) { phase_attn(fresh(p)); if (DUP_PHASE == 7) { GRID_BAR(); phase_attn(fresh(p)); } }
    GRID_BAR();
    if (PHMASK & (1u << 8)) { phase_mlstm_c(fresh(p), l); if (DUP_PHASE == 8) { GRID_BAR(); phase_mlstm_c(fresh(p), l); } }
    GRID_BAR();
    if (PHMASK & (1u << 9)) { phase_gemm_merge(fresh(p)); if (DUP_PHASE == 9) { GRID_BAR(); phase_gemm_merge(fresh(p)); } }
    GRID_BAR();
    if (PHMASK & (1u << 10)) { phase_gemm_out(fresh(p), l); if (DUP_PHASE == 10) { GRID_BAR(); phase_gemm_out(fresh(p), l); } }
    GRID_BAR();
    if (PHMASK & (1u << 11)) { phase_norm2_router(fresh(p), l); if (DUP_PHASE == 11) { GRID_BAR(); phase_norm2_router(fresh(p), l, true); } }
    GRID_BAR();
    if (PHMASK & (1u << 15)) { phase_moe_gather(fresh(p), l); if (DUP_PHASE == 15) { GRID_BAR(); phase_moe_gather(fresh(p), l); } }
    GRID_BAR();
    if (PHMASK & (1u << 12)) { phase_moe_up(fresh(p), l); if (DUP_PHASE == 12) { GRID_BAR(); phase_moe_up(fresh(p), l); } }
    GRID_BAR();
    if (PHMASK & (1u << 13)) { phase_moe_down(fresh(p), l); if (DUP_PHASE == 13) { GRID_BAR(); phase_moe_down(fresh(p), l); } }
    GRID_BAR();
  }
  if (PHMASK & (1u << 14)) { phase_norm(fresh(p), DEPTH, 1, 2); if (DUP_PHASE == 14) { GRID_BAR(); phase_norm(fresh(p), DEPTH, 1, 2); } }
}

#ifdef EMU
static int emu_grid_size = 8;
static int emu_stop_after = 1000;
#endif
extern "C" void kernel_launch(void* const* d_in, const int* in_sizes, int n_in, void* d_out, int out_size, void* d_ws, size_t ws_size, hipStream_t stream) {
  (void)in_sizes; (void)n_in; (void)out_size;
  if (ws_size < WS_TOTAL) { fprintf(stderr, "workspace too small: %zu < %zu\n", ws_size, (size_t)WS_TOTAL); return; }
  Params prm{};
  const float** f = (const float**)&prm;
  for (int i = 0; i < 24; ++i) f[i] = (const float*)d_in[i];
  prm.out = (float*)d_out; prm.ws = (unsigned char*)d_ws;
#ifdef EMU
  memset(d_ws, 0, CTL_BYTES);
  emu_launch(emu_grid_size, NTHREADS, LDS_BYTES, [=]() { k_fwd(prm); }, true);
#else
  static int grid = 0;
  if (!grid) {
    int dev = 0, cus = 0, per_cu = 0;
    (void)hipGetDevice(&dev);
    (void)hipDeviceGetAttribute(&cus, hipDeviceAttributeMultiprocessorCount, dev);
    (void)hipFuncSetAttribute((const void*)k_fwd, hipFuncAttributeMaxDynamicSharedMemorySize, LDS_BYTES);
    (void)hipOccupancyMaxActiveBlocksPerMultiprocessor(&per_cu, k_fwd, NTHREADS, LDS_BYTES);
    grid = cus * (per_cu < 1 ? per_cu : 1);
    if (grid <= 0) { fprintf(stderr, "occupancy query says the kernel does not fit (cus %d per_cu %d)\n", cus, per_cu); grid = 0; return; }
  }
  (void)hipMemsetAsync(d_ws, 0, CTL_BYTES, stream);
  k_fwd<<<grid, NTHREADS, LDS_BYTES, stream>>>(prm);
#endif
}
```

```cpp
#ifdef EMU
#include "emu.h"
#define TID emu_tid()
#define BID emu_bid()
#define NBLK emu_nblk()
#define SYNC() emu_syncthreads()
#define DEV static inline
#define DEVM inline
#else
#include <hip/hip_runtime.h>
#include <cstdio>
#include <cstdint>
__device__ __forceinline__ int tid_opaque() { int t = (int)threadIdx.x; asm volatile("" : "+v"(t)); return t; }
#define TID tid_opaque()
#define BID ((int)blockIdx.x)
#define NBLK ((int)gridDim.x)
#define SYNC() __syncthreads()
#define DEV __device__ __forceinline__
#define DEVM __device__ __forceinline__
#endif

#ifndef CFG_SEQ
#define CFG_SEQ 8192
#endif
#ifndef CFG_BATCH
#define CFG_BATCH 2
#endif

#ifndef DUP_PHASE
#define DUP_PHASE (-1)
#endif
#ifndef PHMASK
#define PHMASK 0xFFFFFFFFu
#endif
#define UNR _Pragma("unroll")
typedef unsigned short bf16_t;
typedef short bf16x8 __attribute__((ext_vector_type(8)));
typedef float f32x4 __attribute__((ext_vector_type(4)));
typedef unsigned u32x4 __attribute__((ext_vector_type(4)));
typedef unsigned u32x2 __attribute__((ext_vector_type(2)));

constexpr int D = 1024, BATCH = CFG_BATCH, SEQ = CFG_SEQ, DEPTH = 2, T = BATCH * SEQ;
constexpr int GRID_W = 64;
constexpr int MH = 4, MHD = 128, MW = 512, ML = 64, NC = SEQ / ML, CONVW = 5;
constexpr int AH = 8, KVH = 2, AHD = 64, AW = 512, KVW = 128;
constexpr int NG = 4, EPG = 8, NE = 32, FF = 512;
constexpr float EPS = 1e-6f;
constexpr int IN_W = 4880, NP = 5120;
constexpr int C_MQ = 0, C_MK = 512, C_MV = 1024, C_MO = 1536, C_GATES = 2048, C_AQ = 2064, C_AK = 2576, C_AV = 2704, C_GM = 2832, C_GA = 3856;
constexpr int NTHREADS = 512;
constexpr int BHC = BATCH * MH * NC;
constexpr int ROWT_MAX = (2 * T) / 256 + NE;
constexpr int SLOT_ROWS = ROWT_MAX * 256;

constexpr size_t al256(size_t x) { return (x + 255) & ~(size_t)255; }
constexpr size_t WS_CTL = 0, CTL_BYTES = 1 << 20;
constexpr size_t WS_MOD = WS_CTL + CTL_BYTES;
constexpr size_t WS_ROPE = WS_MOD + al256((size_t)DEPTH * BATCH * 6 * D * 4);
constexpr size_t WS_WIN = WS_ROPE + al256((size_t)(2 * (SEQ / GRID_W) * 16 + 2 * 64 * 16) * 4);
constexpr size_t WS_WBM = WS_WIN + (size_t)NP * D * 2;
constexpr size_t WS_WBA = WS_WBM + (size_t)D * MW * 2;
constexpr size_t WS_WOUT = WS_WBA + (size_t)D * AW * 2;
constexpr size_t WS_WGU = WS_WOUT + (size_t)D * D * 2;
constexpr size_t WS_WD = WS_WGU + (size_t)NE * 2 * FF * D * 2;
constexpr size_t WS_PROJ = WS_WD + (size_t)NE * D * FF * 2;
constexpr size_t WS_ACT = WS_PROJ;
constexpr size_t WS_Y = WS_ACT + al256((size_t)SLOT_ROWS * FF * 2);
constexpr size_t PROJ_BYTES = (size_t)T * NP * 2;
constexpr size_t OVL_BYTES = (WS_Y + (size_t)2 * T * D * 2 - WS_PROJ) > PROJ_BYTES ? (WS_Y + (size_t)2 * T * D * 2 - WS_PROJ) : PROJ_BYTES;
constexpr size_t WS_GATES = WS_PROJ + al256(OVL_BYTES);
constexpr size_t WS_QC = WS_GATES + (size_t)T * 16 * 4;
constexpr size_t WS_KC = WS_QC + (size_t)T * MW * 2;
constexpr size_t WS_MERGED = WS_QC;
constexpr size_t WS_AQN = WS_KC + (size_t)T * MW * 2;
constexpr size_t WS_AKN = WS_AQN + (size_t)T * AW * 2;
constexpr size_t WS_VT = WS_AKN + (size_t)T * KVW * 2;
constexpr size_t WS_YM = WS_VT + (size_t)T * KVW * 2;
constexpr size_t WS_YA = WS_YM + (size_t)T * MW * 2;
constexpr size_t QCYA_BYTES = WS_YA + (size_t)T * AW * 2 - WS_QC;
constexpr size_t HS_BYTES = (size_t)SLOT_ROWS * D * 2;
constexpr size_t WS_HS = WS_QC;
constexpr size_t WS_CST = WS_QC + al256(HS_BYTES > QCYA_BYTES ? HS_BYTES : QCYA_BYTES);
constexpr size_t WS_H = WS_CST;
constexpr size_t WS_TMP = WS_CST;
constexpr size_t CST_BYTES = (size_t)2 * BHC * 128 * 128 * 2;
static_assert((size_t)T * D * 4 <= CST_BYTES, "H and TMP fit in CST");
constexpr size_t WS_NST = WS_CST + CST_BYTES;
constexpr size_t WS_AMAX = WS_NST + (size_t)2 * BHC * 128 * 4;
constexpr size_t WS_BLAST = WS_AMAX + al256((size_t)2 * BHC * 4);
constexpr size_t WS_MPREV = WS_BLAST + al256((size_t)2 * BHC * 4);
constexpr size_t WS_ENT_E = WS_MPREV + al256((size_t)2 * BHC * 4);
constexpr size_t WS_ENT_POS = WS_ENT_E + (size_t)2 * T * 4;
constexpr size_t WS_WENT = WS_ENT_POS + (size_t)2 * T * 4;
constexpr size_t WS_SLOT_ENT = WS_WENT + (size_t)2 * T * 4;
constexpr size_t WS_SLOT_W = WS_SLOT_ENT + (size_t)SLOT_ROWS * 4;
constexpr size_t WS_TOTAL = WS_SLOT_W + (size_t)SLOT_ROWS * 4;
constexpr int CW_CNT = 64;
constexpr int CW_BAR = 4096;

struct Params {
  const float *x, *c, *w_ada, *b_ada, *norm1_g, *w_in, *b_in, *conv_w, *conv_b, *mlstm_norm_g, *q_norm_g, *k_norm_g, *w_branch_m, *w_branch_a, *w_out, *norm2_g,
      *w_rg, *b_rg, *w_re, *b_re, *w_gate, *w_up, *w_down, *final_g;
  float* out; unsigned char* ws;
};

DEV float bf2f(bf16_t h) { return __builtin_bit_cast(float, (unsigned)h << 16); }
DEV bf16_t f2bf(float f) { unsigned u = __builtin_bit_cast(unsigned, f); return (bf16_t)((u + 0x7fffu + ((u >> 16) & 1u)) >> 16); }
DEV unsigned pk2(float lo, float hi) { return (unsigned)f2bf(lo) | ((unsigned)f2bf(hi) << 16); }
#ifdef EMU
DEV float sigmoidf_(float x) { return 1.f / (1.f + expf(-x)); }
DEV float siluf_(float x) { return x / (1.f + expf(-x)); }
#else
DEV float sigmoidf_(float x) { return __builtin_amdgcn_rcpf(1.f + __builtin_amdgcn_exp2f(-1.4426950408889634f * x)); }
DEV float siluf_(float x) { return x * __builtin_amdgcn_rcpf(1.f + __builtin_amdgcn_exp2f(-1.4426950408889634f * x)); }
#endif
DEV float logsigmoidf_(float x) { return fminf(x, 0.f) - log1pf(expf(-fabsf(x))); }

#ifdef EMU
static inline f32x4 mfma16(bf16x8 a, bf16x8 b, f32x4 c) {
  struct In { bf16x8 a, b; f32x4 c; } in{a, b, c}; f32x4 out;
  emu_collective(&in, sizeof(In), &out, sizeof(out), [](char (*I)[64], char (*O)[32]) {
    float Dm[16][16];
    for (int r = 0; r < 16; ++r) for (int cc = 0; cc < 16; ++cc) { In* L = (In*)I[(r >> 2) * 16 + cc]; Dm[r][cc] = L->c[r & 3]; }
    for (int r = 0; r < 16; ++r) for (int cc = 0; cc < 16; ++cc) { float s = 0.f;
      for (int g = 0; g < 4; ++g) { In* LA = (In*)I[g * 16 + r]; In* LB = (In*)I[g * 16 + cc]; for (int j = 0; j < 8; ++j) s += bf2f((bf16_t)LA->a[j]) * bf2f((bf16_t)LB->b[j]); }
      Dm[r][cc] += s; }
    for (int l = 0; l < 64; ++l) { f32x4 o; for (int i = 0; i < 4; ++i) o[i] = Dm[(l >> 4) * 4 + i][l & 15]; memcpy(O[l], &o, 16); } });
  return out;
}
static inline f32x4 mfma4f32(float a, float b, f32x4 c) {
  struct In { float a, b; f32x4 c; } in{a, b, c}; f32x4 out;
  emu_collective(&in, sizeof(In), &out, sizeof(out), [](char (*I)[64], char (*O)[32]) {
    for (int l = 0; l < 64; ++l) { f32x4 o; UNR for (int i = 0; i < 4; ++i) { const int r = (l >> 4) * 4 + i, cc = l & 15; float s = ((In*)I[l])->c[i];
      for (int k = 0; k < 4; ++k) s = fmaf(((In*)I[k * 16 + r])->a, ((In*)I[k * 16 + cc])->b, s); o[i] = s; } memcpy(O[l], &o, 16); } });
  return out;
}
static inline float shfl_xor_f(float v, int m) { float out; emu_collective(&v, 4, &out, 4, [m](char (*I)[64], char (*O)[32]) { for (int l = 0; l < 64; ++l) memcpy(O[l], I[l ^ m], 4); }); return out; }
static inline float shfl_f(float v, int src) { struct In { float v; int s; } in{v, src}; float out;
  emu_collective(&in, 8, &out, 4, [](char (*I)[64], char (*O)[32]) { for (int l = 0; l < 64; ++l) { In* me = (In*)I[l]; memcpy(O[l], I[me->s & 63], 4); } }); return out; }
static inline int atomic_add_i(int* p, int v) { return __atomic_fetch_add(p, v, __ATOMIC_RELAXED); }
#define LDS_PTR() emu_lds()
#else
DEV f32x4 mfma16(bf16x8 a, bf16x8 b, f32x4 c) { return __builtin_amdgcn_mfma_f32_16x16x32_bf16(a, b, c, 0, 0, 0); }
DEV f32x4 mfma4f32(float a, float b, f32x4 c) { return __builtin_amdgcn_mfma_f32_16x16x4f32(a, b, c, 0, 0, 0); }
DEV float shfl_xor_f(float v, int m) {
  const int iv = __builtin_bit_cast(int, v);
  switch (m) {
    case 1: return __builtin_bit_cast(float, __builtin_amdgcn_ds_swizzle(iv, (1 << 10) | 0x1f));
    case 2: return __builtin_bit_cast(float, __builtin_amdgcn_ds_swizzle(iv, (2 << 10) | 0x1f));
    case 4: return __builtin_bit_cast(float, __builtin_amdgcn_ds_swizzle(iv, (4 << 10) | 0x1f));
    case 8: return __builtin_bit_cast(float, __builtin_amdgcn_ds_swizzle(iv, (8 << 10) | 0x1f));
    case 16: return __builtin_bit_cast(float, __builtin_amdgcn_ds_swizzle(iv, (16 << 10) | 0x1f));
    default: { const int lane = TID & 63; return __builtin_bit_cast(float, __builtin_amdgcn_ds_bpermute(((lane ^ m) & 63) << 2, iv)); }
  }
}
DEV float shfl_f(float v, int src) { return __builtin_bit_cast(float, __builtin_amdgcn_ds_bpermute((src & 63) << 2, __builtin_bit_cast(int, v))); }
DEV int atomic_add_i(int* p, int v) { return atomicAdd(p, v); }
extern __shared__ __attribute__((aligned(16))) char dyn_lds[];
#define LDS_PTR() (dyn_lds)
#endif
typedef short s16x4 __attribute__((ext_vector_type(4)));
#ifdef EMU
static inline s16x4 lds_tr16(const bf16_t* addr) { s16x4 out;
  emu_collective(&addr, sizeof(addr), &out, sizeof(out), [](char (*I)[64], char (*O)[32]) {
    for (int l = 0; l < 64; ++l) { const int g = l >> 4, i = l & 15; s16x4 o;
      for (int q = 0; q < 4; ++q) { const bf16_t* a; memcpy(&a, I[16 * g + 4 * q + (i >> 2)], sizeof(a)); o[q] = (short)a[i & 3]; }
      memcpy(O[l], &o, 8); } });
  return out; }
#else
DEV s16x4 lds_tr16(const bf16_t* addr) { return __builtin_bit_cast(s16x4, __builtin_amdgcn_ds_read_tr16_b64_v4i16((__attribute__((address_space(3))) s16x4*)addr)); }
#endif
DEV bf16x8 cat8(s16x4 a, s16x4 b) { return (bf16x8){a[0], a[1], a[2], a[3], b[0], b[1], b[2], b[3]}; }
DEV float grp16_sum(float v) { v += shfl_xor_f(v, 1); v += shfl_xor_f(v, 2); v += shfl_xor_f(v, 4); v += shfl_xor_f(v, 8); return v; }
DEV float grp16_max(float v) { v = fmaxf(v, shfl_xor_f(v, 1)); v = fmaxf(v, shfl_xor_f(v, 2)); v = fmaxf(v, shfl_xor_f(v, 4)); v = fmaxf(v, shfl_xor_f(v, 8)); return v; }
DEV float wave_prefix_incl(float v, int lane) { UNR for (int o = 0; o < 6; ++o) { const int off = 1 << o; const float t = shfl_f(v, lane - off); v += (lane >= off) ? t : 0.f; } return v; }
DEV float wave_max(float v) { v = grp16_max(v); v = fmaxf(v, shfl_xor_f(v, 16)); v = fmaxf(v, shfl_xor_f(v, 32)); return v; }
DEV float wave_sum(float v) { v = grp16_sum(v); v += shfl_xor_f(v, 16); v += shfl_xor_f(v, 32); return v; }
DEV bf16x8 ld8(const bf16_t* p) { return __builtin_bit_cast(bf16x8, *(const u32x4*)p); }

DEV void phase_mod_rope(const Params& p) {
  float* mod = (float*)(p.ws + WS_MOD);
  const int gtid = BID * NTHREADS + TID, gstride = NBLK * NTHREADS;
  {
    float* red = (float*)LDS_PTR();
    const int tid = TID, j = tid & 63, q = tid >> 6;
    for (int it = BID; it < DEPTH * (6 * D / 64); it += NBLK) {
      const int l = it / (6 * D / 64), n0 = (it % (6 * D / 64)) * 64;
      const float* w = p.w_ada + (size_t)l * D * 6 * D + (size_t)(128 * q) * 6 * D + n0 + j;
      float s[BATCH]; UNR for (int b = 0; b < BATCH; ++b) s[b] = 0.f;
#pragma unroll 16
      for (int k = 0; k < 128; ++k) { const float wv = w[(size_t)k * 6 * D];
        UNR for (int b = 0; b < BATCH; ++b) s[b] += siluf_(p.c[b * D + 128 * q + k]) * wv; }
      SYNC();
      UNR for (int b = 0; b < BATCH; ++b) red[(q * BATCH + b) * 64 + j] = s[b];
      SYNC();
      if (tid < BATCH * 64) { const int b = tid >> 6; float a = p.b_ada[l * 6 * D + n0 + j];
        UNR for (int qq = 0; qq < 8; ++qq) a += red[(qq * BATCH + b) * 64 + j];
        mod[((size_t)l * BATCH + b) * 6 * D + n0 + j] = a; }
    }
    SYNC();
  }
  float* rope = (float*)(p.ws + WS_ROPE);
  constexpr int NR = SEQ / GRID_W;
  for (int o = gtid; o < (NR + 64) * 16; o += gstride) {
    const int i = o & 15, pos = o >> 4;
    const float inv = powf(10000.f, -(float)(2 * i) / 32.f);
    if (pos < NR) { const float a = (float)pos * inv; rope[pos * 16 + i] = cosf(a); rope[NR * 16 + pos * 16 + i] = sinf(a); }
    else { const int cpos = pos - NR; const float a = (float)cpos * inv; rope[2 * NR * 16 + cpos * 16 + i] = cosf(a); rope[2 * NR * 16 + 64 * 16 + cpos * 16 + i] = sinf(a); }
  }
}
constexpr int TPP = 257;
DEV void transpose_item(char* lds, const float* src, int K, int N, bf16_t* dst, int mode, int item) {
  float* tile = (float*)lds;
  const int ntn = (N + 255) / 256, tk = item / ntn, tn = item % ntn, tid = TID;
  const int k0 = tk * 64, n0 = tn * 256;
  { const int c = (tid & 63) * 4; f32x4 v[8];
    UNR for (int i = 0; i < 8; ++i) { const int kk = (tid >> 6) + 8 * i; v[i] = (n0 + c < N) ? *(const f32x4*)(src + (size_t)(k0 + kk) * N + n0 + c) : (f32x4){0.f, 0.f, 0.f, 0.f}; }
    UNR for (int i = 0; i < 8; ++i) { const int kk = (tid >> 6) + 8 * i; UNR for (int j = 0; j < 4; ++j) tile[kk * TPP + c + j] = v[i][j]; } }
  SYNC();
  { const int k8 = (tid & 7) * 8;
    UNR for (int i = 0; i < 4; ++i) { const int nn = (tid >> 3) + 64 * i, n = n0 + nn;
      if (n < N) {
        int row = n; if (mode == 1) row = 32 * (n >> 4) + (n & 15); else if (mode == 2) row = 32 * (n >> 4) + 16 + (n & 15);
        u32x4 w; w.x = pk2(tile[(k8 + 0) * TPP + nn], tile[(k8 + 1) * TPP + nn]); w.y = pk2(tile[(k8 + 2) * TPP + nn], tile[(k8 + 3) * TPP + nn]);
        w.z = pk2(tile[(k8 + 4) * TPP + nn], tile[(k8 + 5) * TPP + nn]); w.w = pk2(tile[(k8 + 6) * TPP + nn], tile[(k8 + 7) * TPP + nn]);
        *(u32x4*)(dst + (size_t)row * K + k0 + k8) = w; } } }
  SYNC();
}
DEV void phase_convert(const Params& p, int l) {
  char* lds = LDS_PTR();
  constexpr int I_IN = (D / 64) * ((IN_W + 255) / 256), I_BM = (MW / 64) * (D / 256), I_BA = (AW / 64) * (D / 256), I_OUT = (D / 64) * (D / 256);
  constexpr int I_G = (D / 64) * (FF / 256), I_D = (FF / 64) * (D / 256);
  constexpr int B1 = I_IN, B2 = B1 + I_BM, B3 = B2 + I_BA, B4 = B3 + I_OUT, B5 = B4 + NE * I_G, B6 = B5 + NE * I_G, B7 = B6 + NE * I_D;
  for (int it = BID; it < B7; it += NBLK) {
    if (it < B1) transpose_item(lds, p.w_in + (size_t)l * D * IN_W, D, IN_W, (bf16_t*)(p.ws + WS_WIN), 0, it);
    else if (it < B2) transpose_item(lds, p.w_branch_m + (size_t)l * MW * D, MW, D, (bf16_t*)(p.ws + WS_WBM), 0, it - B1);
    else if (it < B3) transpose_item(lds, p.w_branch_a + (size_t)l * AW * D, AW, D, (bf16_t*)(p.ws + WS_WBA), 0, it - B2);
    else if (it < B4) transpose_item(lds, p.w_out + (size_t)l * D * D, D, D, (bf16_t*)(p.ws + WS_WOUT), 0, it - B3);
    else if (it < B5) { const int e = (it - B4) / I_G, r = (it - B4) % I_G; transpose_item(lds, p.w_gate + ((size_t)l * NE + e) * D * FF, D, FF, (bf16_t*)(p.ws + WS_WGU) + (size_t)e * 2 * FF * D, 1, r); }
    else if (it < B6) { const int e = (it - B5) / I_G, r = (it - B5) % I_G; transpose_item(lds, p.w_up + ((size_t)l * NE + e) * D * FF, D, FF, (bf16_t*)(p.ws + WS_WGU) + (size_t)e * 2 * FF * D, 2, r); }
    else { const int e = (it - B6) / I_D, r = (it - B6) % I_D; transpose_item(lds, p.w_down + ((size_t)l * NE + e) * FF * D, FF, D, (bf16_t*)(p.ws + WS_WD) + (size_t)e * D * FF, 0, r); }
  }
}

DEV void phase_norm(const Params& p, int l, int mode, int which) {
  const int lane = TID & 63, wv = TID >> 6, nwv = NTHREADS / 64;
  const float* mod = (const float*)(p.ws + WS_MOD);
  bf16_t* H = (bf16_t*)(p.ws + WS_H);
  const bf16_t* Y = (const bf16_t*)(p.ws + WS_Y);
  for (int t = BID * nwv + wv; t < T; t += NBLK * nwv) {
    const int b = t / SEQ;
    f32x4 v[4]; float ss = 0.f;
    UNR for (int i = 0; i < 4; ++i) {
      const int c4 = lane + 64 * i;
      if (mode == 0) v[i] = ((const f32x4*)(p.x + (size_t)t * D))[c4];
      else {
        v[i] = ((const f32x4*)(p.out + (size_t)t * D))[c4];
        if (mode == 1) {
          const f32x4 g2 = ((const f32x4*)(mod + ((size_t)(l - 1) * BATCH + b) * 6 * D + 5 * D))[c4];
          const u32x2 y0 = ((const u32x2*)(Y + (size_t)(2 * t) * D))[c4], y1 = ((const u32x2*)(Y + (size_t)(2 * t + 1) * D))[c4];
          v[i][0] += g2[0] * (bf2f((bf16_t)(y0.x & 0xffff)) + bf2f((bf16_t)(y1.x & 0xffff)));
          v[i][1] += g2[1] * (bf2f((bf16_t)(y0.x >> 16)) + bf2f((bf16_t)(y1.x >> 16)));
          v[i][2] += g2[2] * (bf2f((bf16_t)(y0.y & 0xffff)) + bf2f((bf16_t)(y1.y & 0xffff)));
          v[i][3] += g2[3] * (bf2f((bf16_t)(y0.y >> 16)) + bf2f((bf16_t)(y1.y >> 16)));
        }
      }
      ss += v[i][0] * v[i][0] + v[i][1] * v[i][1] + v[i][2] * v[i][2] + v[i][3] * v[i][3];
    }
    ss = wave_sum(ss);
    const float rs = 1.f / sqrtf(ss * (1.f / D) + EPS);
    if (which == 2) {
      UNR for (int i = 0; i < 4; ++i) { const int c4 = lane + 64 * i; const f32x4 g = ((const f32x4*)p.final_g)[c4];
        f32x4 o; UNR for (int j = 0; j < 4; ++j) o[j] = v[i][j] * rs * g[j]; ((f32x4*)(p.out + (size_t)t * D))[c4] = o; }
      continue;
    }
    if (mode != 2) UNR for (int i = 0; i < 4; ++i) ((f32x4*)(p.out + (size_t)t * D))[lane + 64 * i] = v[i];
    const float* mb = mod + ((size_t)l * BATCH + b) * 6 * D + (which == 0 ? 0 : 3 * D);
    const float* gw = (which == 0 ? p.norm1_g : p.norm2_g) + (size_t)l * D;
    f32x4 hv[4];
    UNR for (int i = 0; i < 4; ++i) { const int c4 = lane + 64 * i;
      const f32x4 g = ((const f32x4*)gw)[c4], sh = ((const f32x4*)mb)[c4], sc = ((const f32x4*)(mb + D))[c4];
      UNR for (int j = 0; j < 4; ++j) hv[i][j] = (v[i][j] * rs * g[j]) * (1.f + sc[j]) + sh[j];
      u32x2 o; o.x = pk2(hv[i][0], hv[i][1]); o.y = pk2(hv[i][2], hv[i][3]); ((u32x2*)(H + (size_t)t * D))[c4] = o; }
  }
}
constexpr int HSP = 1028;
DEV void phase_norm2_router(const Params& p, int l, bool dry = false) {
  char* lds = LDS_PTR();
  float* HS = (float*)lds;
  float* PART = HS + 16 * HSP;
  float* SUM = PART + 8 * 16 * 48;
  const int tid = TID, lane = tid & 63, w = tid >> 6;
  const float* mod = (const float*)(p.ws + WS_MOD);
  bf16_t* H = (bf16_t*)(p.ws + WS_H);
  const float* wrg = p.w_rg + (size_t)l * D * NG; const float* wre = p.w_re + (size_t)l * D * NE;
  const float* gw = p.norm2_g + (size_t)l * D;
  float bq[32][3];
  { const int o0 = lane & 15;
    UNR for (int kk = 0; kk < 32; ++kk) { const int d = 128 * w + 4 * kk + (lane >> 4);
      bq[kk][0] = (o0 < NG) ? wrg[(size_t)d * NG + o0] : wre[(size_t)d * NE + o0 - NG];
      bq[kk][1] = wre[(size_t)d * NE + 16 + o0 - NG];
      bq[kk][2] = (o0 < NG) ? wre[(size_t)d * NE + 32 + o0 - NG] : 0.f; } }
  f32x4 v[2][4];
  int tb = BID * 16;
  if (tb < T) { UNR for (int q = 0; q < 2; ++q) UNR for (int i = 0; i < 4; ++i) v[q][i] = ((const f32x4*)(p.out + (size_t)(tb + 2 * w + q) * D))[lane + 64 * i]; }
  for (; tb < T; tb += NBLK * 16) {
    SYNC();
    UNR for (int q = 0; q < 2; ++q) {
      const int tl = 2 * w + q, t = tb + tl, b = t / SEQ;
      float ss = 0.f;
      UNR for (int i = 0; i < 4; ++i) ss += v[q][i][0] * v[q][i][0] + v[q][i][1] * v[q][i][1] + v[q][i][2] * v[q][i][2] + v[q][i][3] * v[q][i][3];
      ss = wave_sum(ss);
      const float rs = 1.f / sqrtf(ss * (1.f / D) + EPS);
      const float* mb = mod + ((size_t)l * BATCH + b) * 6 * D + 3 * D;
      UNR for (int i = 0; i < 4; ++i) { const int c4 = lane + 64 * i;
        const f32x4 g = ((const f32x4*)gw)[c4], sh = ((const f32x4*)mb)[c4], sc = ((const f32x4*)(mb + D))[c4];
        f32x4 hv; UNR for (int j = 0; j < 4; ++j) hv[j] = (v[q][i][j] * rs * g[j]) * (1.f + sc[j]) + sh[j];
        u32x2 o; o.x = pk2(hv[0], hv[1]); o.y = pk2(hv[2], hv[3]); ((u32x2*)(H + (size_t)t * D))[c4] = o;
        *(f32x4*)(HS + tl * HSP + 4 * c4) = hv; }
    }
    { const int tn = tb + NBLK * 16;
      if (tn < T) { UNR for (int q = 0; q < 2; ++q) UNR for (int i = 0; i < 4; ++i) v[q][i] = ((const f32x4*)(p.out + (size_t)(tn + 2 * w + q) * D))[lane + 64 * i]; } }
    SYNC();
    f32x4 acc[3]; UNR for (int nt = 0; nt < 3; ++nt) acc[nt] = (f32x4){0.f, 0.f, 0.f, 0.f};
    UNR for (int kk = 0; kk < 32; ++kk) {
      const float a = HS[(lane & 15) * HSP + 128 * w + 4 * kk + (lane >> 4)];
      acc[0] = mfma4f32(a, bq[kk][0], acc[0]); acc[1] = mfma4f32(a, bq[kk][1], acc[1]); acc[2] = mfma4f32(a, bq[kk][2], acc[2]);
    }
    UNR for (int nt = 0; nt < 3; ++nt) UNR for (int i = 0; i < 4; ++i) PART[(w * 16 + (lane >> 4) * 4 + i) * 48 + nt * 16 + (lane & 15)] = acc[nt][i];
    SYNC();
    for (int o = tid; o < 16 * 48; o += NTHREADS) { float sacc = 0.f; UNR for (int ww = 0; ww < 8; ++ww) sacc += PART[ww * 16 * 48 + o]; SUM[o] = sacc; }
    SYNC();
    if (tid < 16) {
      const int t = tb + tid;
      float lg[NG];
      int g = 0; float gmx = -3.0e38f;
      UNR for (int o = 0; o < NG; ++o) { const float sv = p.b_rg[l * NG + o] + SUM[tid * 48 + o]; lg[o] = sv; if (sv > gmx) { gmx = sv; g = o; } }
      float gsum = 0.f; UNR for (int o = 0; o < NG; ++o) gsum += expf(lg[o] - gmx);
      const float ptop = 1.f / gsum;
      int e0 = 0, e1 = 0; float m0 = -3.0e38f, m1 = -3.0e38f;
#pragma unroll 1
      for (int j = 0; j < EPG; ++j) { const float sv = p.b_re[l * NE + g * EPG + j] + SUM[tid * 48 + NG + g * EPG + j];
        if (sv > m0) { m1 = m0; e1 = e0; m0 = sv; e0 = j; } else if (sv > m1) { m1 = sv; e1 = j; } }
      const float x1 = expf(m1 - m0), w0 = ptop / (1.f + x1), w1 = ptop * x1 / (1.f + x1);
      int* cnt = (int*)(p.ws + WS_CTL) + CW_CNT + l * NE; int* ent_e = (int*)(p.ws + WS_ENT_E); int* ent_pos = (int*)(p.ws + WS_ENT_POS); float* went = (float*)(p.ws + WS_WENT);
      const int ea = g * EPG + e0, eb = g * EPG + e1;
      if (!dry) { ent_e[2 * t] = ea; ent_pos[2 * t] = atomic_add_i(cnt + ea, 1); went[2 * t] = w0;
        ent_e[2 * t + 1] = eb; ent_pos[2 * t + 1] = atomic_add_i(cnt + eb, 1); went[2 * t + 1] = w1; }
      else if (w0 + w1 < -1.f) went[2 * t] = w0;
    }
  }
}
constexpr int GP = 72;
constexpr int LDS_PHASE_BYTES = 131072;
constexpr int LDS_BYTES = LDS_PHASE_BYTES + 256;
DEV void moe_tiles(const Params& p, int l, int* s_pref) {
  SYNC();
  if (TID == 0) { const int* cnt = (const int*)(p.ws + WS_CTL) + CW_CNT + l * NE; int a = 0; for (int e = 0; e < NE; ++e) { s_pref[e] = a; a += (cnt[e] + 255) / 256; } s_pref[NE] = a; }
  SYNC();
}
DEV void phase_moe_gather(const Params& p, int l) {
  int* s_pref = (int*)(LDS_PTR() + LDS_PHASE_BYTES + 64);
  moe_tiles(p, l, s_pref);
  const int* cnt = (const int*)(p.ws + WS_CTL) + CW_CNT + l * NE; const int* ent_e = (const int*)(p.ws + WS_ENT_E); const int* ent_pos = (const int*)(p.ws + WS_ENT_POS);
  const float* went = (const float*)(p.ws + WS_WENT); int* slot_ent = (int*)(p.ws + WS_SLOT_ENT); float* slot_w = (float*)(p.ws + WS_SLOT_W);
  const bf16_t* H = (const bf16_t*)(p.ws + WS_H); bf16_t* HS = (bf16_t*)(p.ws + WS_HS);
  const int tid = TID, lane = tid & 63, wv = tid >> 6;
  for (int i = BID * 8 + wv; i < 2 * T; i += NBLK * 8) {
    const int slot = s_pref[ent_e[i]] * 256 + ent_pos[i];
    const u32x4* src = (const u32x4*)(H + (size_t)(i >> 1) * D); u32x4* dst = (u32x4*)(HS + (size_t)slot * D);
    dst[lane] = src[lane]; dst[lane + 64] = src[lane + 64];
    if (lane == 0) { slot_ent[slot] = i; slot_w[slot] = went[i]; }
  }
  for (int e = BID; e < NE; e += NBLK) { const int s0 = s_pref[e] * 256 + cnt[e], s1 = s_pref[e + 1] * 256; for (int q = s0 + tid; q < s1; q += NTHREADS) slot_ent[q] = -1; }
}
#ifdef EMU
struct RowPlain { const bf16_t* base; size_t ld; DEVM const bf16_t* operator()(int r) const { return base + (size_t)r * ld; } };
template <class RowA>
DEV void gemm_kloop(char* lds, const RowA& rowA, const bf16_t* Bt, size_t ldb, int K, f32x4 (&acc)[4][2]) {
  bf16_t* As = (bf16_t*)lds; bf16_t* Bs = As + 128 * GP;
  const int tid = TID, lane = tid & 63, w = tid >> 6, wm = w >> 2, wn = w & 3;
  const int r0 = tid >> 3, pc = (tid & 7) * 8;
  const bf16_t* a0 = rowA(r0) + pc; const bf16_t* a1 = rowA(r0 + 64) + pc;
  const bf16_t* b0 = Bt + (size_t)r0 * ldb + pc; const bf16_t* b1 = Bt + (size_t)(r0 + 64) * ldb + pc;
  u32x4 ra0 = *(const u32x4*)a0, ra1 = *(const u32x4*)a1, rb0 = *(const u32x4*)b0, rb1 = *(const u32x4*)b1;
  const int nk = K / 64;
  for (int kt = 0; kt < nk; ++kt) {
    SYNC();
    *(u32x4*)(As + r0 * GP + pc) = ra0; *(u32x4*)(As + (r0 + 64) * GP + pc) = ra1;
    *(u32x4*)(Bs + r0 * GP + pc) = rb0; *(u32x4*)(Bs + (r0 + 64) * GP + pc) = rb1;
    SYNC();
    if (kt + 1 < nk) { const int ko = (kt + 1) * 64; ra0 = *(const u32x4*)(a0 + ko); ra1 = *(const u32x4*)(a1 + ko); rb0 = *(const u32x4*)(b0 + ko); rb1 = *(const u32x4*)(b1 + ko); }
#pragma unroll
    for (int ks = 0; ks < 2; ++ks) {
      const int kof = ks * 32 + (lane >> 4) * 8;
      bf16x8 af[4], bfr[2];
#pragma unroll
      for (int mt = 0; mt < 4; ++mt) af[mt] = ld8(As + (wm * 64 + mt * 16 + (lane & 15)) * GP + kof);
#pragma unroll
      for (int nt = 0; nt < 2; ++nt) bfr[nt] = ld8(Bs + (wn * 32 + nt * 16 + (lane & 15)) * GP + kof);
#pragma unroll
      for (int mt = 0; mt < 4; ++mt)
#pragma unroll
        for (int nt = 0; nt < 2; ++nt) acc[mt][nt] = mfma16(af[mt], bfr[nt], acc[mt][nt]);
    }
  }
}
DEV void zero_acc(f32x4 (&acc)[4][2]) { UNR for (int i = 0; i < 4; ++i) UNR for (int j = 0; j < 2; ++j) acc[i][j] = (f32x4){0.f, 0.f, 0.f, 0.f}; }

DEV void phase_gemm_in(const Params& p, int l) {
  char* lds = LDS_PTR();
  const bf16_t* H = (const bf16_t*)(p.ws + WS_H); const bf16_t* W = (const bf16_t*)(p.ws + WS_WIN);
  bf16_t* PROJ = (bf16_t*)(p.ws + WS_PROJ); float* GATES = (float*)(p.ws + WS_GATES);
  const float* bias = p.b_in + (size_t)l * IN_W;
  constexpr int nM = T / 128, nN = NP / 128;
  for (int u = BID; u < nM * nN; u += NBLK) {
    const int pm = u % nM, pn = u / nM;
    f32x4 acc[4][2]; zero_acc(acc);
    RowPlain ra{H + (size_t)pm * 128 * D, (size_t)D};
    gemm_kloop(lds, ra, W + (size_t)pn * 128 * D, D, D, acc);
    const int etid = TID, lane = etid & 63, w = etid >> 6, wm = w >> 2, wn = w & 3;
    UNR for (int nt = 0; nt < 2; ++nt) {
      const int col = pn * 128 + wn * 32 + nt * 16 + (lane & 15);
      if (col >= IN_W) continue;
      const float bv = bias[col];
      UNR for (int mt = 0; mt < 4; ++mt) UNR for (int i = 0; i < 4; ++i) {
        const int row = pm * 128 + wm * 64 + mt * 16 + (lane >> 4) * 4 + i; const float v = acc[mt][nt][i] + bv;
        PROJ[(size_t)row * NP + col] = f2bf(v);
        if (col >= C_GATES && col < C_GATES + 16) GATES[(size_t)row * 16 + (col - C_GATES)] = v;
      }
    }
  }
}
DEV void phase_gemm_merge(const Params& p) {
  char* lds = LDS_PTR();
  const bf16_t* YM = (const bf16_t*)(p.ws + WS_YM); const bf16_t* YA = (const bf16_t*)(p.ws + WS_YA);
  const bf16_t* WM = (const bf16_t*)(p.ws + WS_WBM); const bf16_t* WA = (const bf16_t*)(p.ws + WS_WBA);
  const bf16_t* PROJ = (const bf16_t*)(p.ws + WS_PROJ); bf16_t* MG = (bf16_t*)(p.ws + WS_MERGED);
  constexpr int nM = T / 128, nN = D / 128;
  for (int u = BID; u < nM * nN; u += NBLK) {
    const int pm = u / nN, pn = u % nN;
    f32x4 acc[4][2]; zero_acc(acc);
    RowPlain r1{YM + (size_t)pm * 128 * MW, (size_t)MW}; gemm_kloop(lds, r1, WM + (size_t)pn * 128 * MW, MW, MW, acc);
    float* park = (float*)(lds + 40960);
    { const int ptid = TID; UNR for (int mt = 0; mt < 4; ++mt) UNR for (int nt = 0; nt < 2; ++nt) UNR for (int i = 0; i < 4; ++i) park[((mt * 2 + nt) * 4 + i) * NTHREADS + ptid] = acc[mt][nt][i]; }
    zero_acc(acc);
    RowPlain r2{YA + (size_t)pm * 128 * AW, (size_t)AW}; gemm_kloop(lds, r2, WA + (size_t)pn * 128 * AW, AW, AW, acc);
    const int etid = TID, lane = etid & 63, w = etid >> 6, wm = w >> 2, wn = w & 3;
    UNR for (int nt = 0; nt < 2; ++nt) { const int col = pn * 128 + wn * 32 + nt * 16 + (lane & 15);
      UNR for (int mt = 0; mt < 4; ++mt) UNR for (int i = 0; i < 4; ++i) {
        const int row = pm * 128 + wm * 64 + mt * 16 + (lane >> 4) * 4 + i;
        const float gm = bf2f(PROJ[(size_t)row * NP + C_GM + col]), ga = bf2f(PROJ[(size_t)row * NP + C_GA + col]);
        MG[(size_t)row * D + col] = f2bf(sigmoidf_(gm) * park[((mt * 2 + nt) * 4 + i) * NTHREADS + etid] + sigmoidf_(ga) * acc[mt][nt][i]); } }
  }
}
DEV void phase_gemm_out(const Params& p, int l) {
  char* lds = LDS_PTR();
  const bf16_t* MG = (const bf16_t*)(p.ws + WS_MERGED); const bf16_t* W = (const bf16_t*)(p.ws + WS_WOUT);
  const float* mod = (const float*)(p.ws + WS_MOD);
  constexpr int nM = T / 128, nN = D / 128;
  for (int u = BID; u < nM * nN; u += NBLK) {
    const int pm = u / nN, pn = u % nN;
    f32x4 acc[4][2]; zero_acc(acc);
    RowPlain ra{MG + (size_t)pm * 128 * D, (size_t)D}; gemm_kloop(lds, ra, W + (size_t)pn * 128 * D, D, D, acc);
    const int etid = TID, lane = etid & 63, w = etid >> 6, wm = w >> 2, wn = w & 3;
    const int b = (pm * 128) / SEQ;
    UNR for (int nt = 0; nt < 2; ++nt) { const int col = pn * 128 + wn * 32 + nt * 16 + (lane & 15);
      const float g1 = mod[((size_t)l * BATCH + b) * 6 * D + 2 * D + col];
      UNR for (int mt = 0; mt < 4; ++mt) UNR for (int i = 0; i < 4; ++i) {
        const int row = pm * 128 + wm * 64 + mt * 16 + (lane >> 4) * 4 + i;
        p.out[(size_t)row * D + col] += g1 * acc[mt][nt][i]; } }
  }
}
DEV void phase_moe_up(const Params& p, int l) {
  char* lds = LDS_PTR(); int* s_pref = (int*)(lds + LDS_PHASE_BYTES + 64);
  moe_tiles(p, l, s_pref);
  const bf16_t* HS = (const bf16_t*)(p.ws + WS_HS); const bf16_t* W = (const bf16_t*)(p.ws + WS_WGU); bf16_t* ACT = (bf16_t*)(p.ws + WS_ACT);
  const int* slot_ent = (const int*)(p.ws + WS_SLOT_ENT); const float* slot_w = (const float*)(p.ws + WS_SLOT_W);
  const int ntile = s_pref[NE] * 2;
  for (int u = BID; u < ntile * 8; u += NBLK) {
    const int rt = u >> 3, ct = u & 7;
    int e = 0; while (s_pref[e + 1] <= (rt >> 1)) ++e;
    f32x4 acc[4][2]; zero_acc(acc);
    RowPlain ra{HS + (size_t)rt * 128 * D, (size_t)D};
    gemm_kloop(lds, ra, W + ((size_t)e * 2 * FF + ct * 128) * D, D, D, acc);
    const int etid = TID, lane = etid & 63, w = etid >> 6, wm = w >> 2, wn = w & 3;
    const int f = (ct * 4 + wn) * 16 + (lane & 15);
    UNR for (int mt = 0; mt < 4; ++mt) UNR for (int i = 0; i < 4; ++i) {
      const int slot = rt * 128 + wm * 64 + mt * 16 + (lane >> 4) * 4 + i;
      if (slot_ent[slot] >= 0) { const float wt = slot_w[slot]; const float a = acc[mt][0][i], uu = acc[mt][1][i];
        ACT[(size_t)slot * FF + f] = f2bf(siluf_(a) * uu * wt); } }
  }
}
DEV void phase_moe_down(const Params& p, int l) {
  char* lds = LDS_PTR(); int* s_pref = (int*)(lds + LDS_PHASE_BYTES + 64);
  moe_tiles(p, l, s_pref);
  const bf16_t* ACT = (const bf16_t*)(p.ws + WS_ACT); const bf16_t* W = (const bf16_t*)(p.ws + WS_WD); bf16_t* Y = (bf16_t*)(p.ws + WS_Y);
  const int* slot_ent = (const int*)(p.ws + WS_SLOT_ENT);
  const int ntile = s_pref[NE] * 2;
  for (int u = BID; u < ntile * 8; u += NBLK) {
    const int rt = u >> 3, ct = u & 7;
    int e = 0; while (s_pref[e + 1] <= (rt >> 1)) ++e;
    f32x4 acc[4][2]; zero_acc(acc);
    RowPlain ra{ACT + (size_t)rt * 128 * FF, (size_t)FF};
    gemm_kloop(lds, ra, W + ((size_t)e * D + ct * 128) * FF, FF, FF, acc);
    const int etid = TID, lane = etid & 63, w = etid >> 6, wm = w >> 2, wn = w & 3;
    UNR for (int nt = 0; nt < 2; ++nt) { const int col = ct * 128 + wn * 32 + nt * 16 + (lane & 15);
      UNR for (int mt = 0; mt < 4; ++mt) UNR for (int i = 0; i < 4; ++i) {
        const int slot = rt * 128 + wm * 64 + mt * 16 + (lane >> 4) * 4 + i; const int ent = slot_ent[slot];
        if (ent >= 0) Y[(size_t)ent * D + col] = f2bf(acc[mt][nt][i]); } }
  }
}
#else
namespace pg8 {
#define PG8_LAS __attribute__((address_space(3)))
typedef unsigned short bf16_t;
typedef short bf16x8 __attribute__((ext_vector_type(8)));
typedef float f32x4 __attribute__((ext_vector_type(4)));
typedef unsigned u32x4 __attribute__((ext_vector_type(4)));
constexpr int BM = 256, BK = 64, HALF = 128, HTB = HALF * BK * 2  , STAGE_BYTES = 8 * HTB, NXCD = 8, WGM = 8;

__host__ __device__ __forceinline__ int lds_byte(int r, int c) { const int st = (r >> 4) * 2 + (c >> 5), rr = r & 15, cc = c & 31, ob = rr * 64 + cc * 2; return st * 1024 + (ob ^ (((ob >> 9) & 1) << 5)); }
__host__ __device__ __forceinline__ void stage_rc(int b, int& R, int& C) { const int st = b / 1024, sb = b % 1024, swz = sb ^ (((sb >> 9) & 1) << 5); R = (st >> 1) * 16 + swz / 64; C = (st & 1) * 32 + (swz % 64) / 2; }
__host__ __device__ __forceinline__ int perm32(int rho) { const int n = rho >> 4, i = rho & 15; return 8 * (i >> 2) + 4 * n + (i & 3); }

struct Unit { int pm, pn; };
struct Gemm { const bf16_t* A; const bf16_t* Bt; int M, N, K; };

struct StaticOrder {
    int nM, nN, nwg, G, c;
    __host__ __device__ void init(int M, int N, int G_, int c_) { nM = M / BM; nN = N / BM; nwg = nM * nN; G = G_; c = c_; }
    __host__ __device__ bool next(int i, Unit& u) const {
        const long L = (long)i * G + c; if (L >= nwg) return false;
        int wgid = (int)L; { const int q = nwg / NXCD, r = nwg % NXCD, xcd = wgid % NXCD, off = wgid / NXCD; wgid = (xcd < r ? xcd * (q + 1) : r * (q + 1) + (xcd - r) * q) + off; }
        const int nig = WGM * nN, gid = wgid / nig, fm = gid * WGM, gsz = (nM - fm) < WGM ? (nM - fm) : WGM;
        u.pm = fm + ((wgid % nig) % gsz); u.pn = (wgid % nig) / gsz; return true;
    }
    __device__ __forceinline__ void a_ready(const Unit&) const {}
    __device__ __forceinline__ void done(const Unit&) const {}
};
__device__ __forceinline__ unsigned cvt_pk_bf16(float lo, float hi) { unsigned r; asm volatile("v_cvt_pk_bf16_f32 %0, %1, %2" : "=v"(r) : "v"(lo), "v"(hi)); return r; }
template <class Epi, class Sched, bool ALIGN_EPI = false, bool SP2 = false>
__device__ __forceinline__ void gemm_phase(PG8_LAS unsigned char* lds, const Gemm g, const Sched& S, const Epi& E) {
    const int tid = TID, wid = __builtin_amdgcn_readfirstlane(tid >> 6), lane = tid & 63, wr = wid >> 2, wc = wid & 3, fr = lane & 15, fq = lane >> 4;
    const int K = g.K, nt = K / BK;
    unsigned voffA[2], voffB[2];
#pragma unroll
    for (int i = 0; i < 2; ++i) { int R, C; stage_rc(tid * 16 + i * 8192, R, C); const int Rb = Epi::PERM ? ((R & ~31) + perm32(R & 31)) : R;
        voffA[i] = (unsigned)(R * K + C) * 2u; voffB[i] = (unsigned)(Rb * K + C) * 2u; }
    const size_t kstep = (size_t)(BK * 2);
    const size_t hstep = (size_t)HALF * K * 2;
    const size_t tstep = 2 * hstep;
    const unsigned ldsw = (unsigned)wid * 1024u;
    const int aoff = lds_byte(wr * 64 + fr, fq * 8), boff = lds_byte(wc * 32 + fr, fq * 8);
#define PG8_SA(b, h) (((b) * 2 + (h)) * HTB)
#define PG8_SB(b, h) ((4 + (b) * 2 + (h)) * HTB)
#define PG8_STAGE(bufoff, gbase, voff) do { _Pragma("unroll") for (int _i = 0; _i < 2; ++_i) \
        __builtin_amdgcn_global_load_lds((const unsigned*)((const char*)(gbase) + (voff)[_i]), (PG8_LAS unsigned*)(lds + (bufoff) + ldsw + _i * 8192), 16, 0, 0); } while (0)
#define PG8_LDA(dst, b, h) do { _Pragma("unroll") for (int m = 0; m < 4; ++m) _Pragma("unroll") for (int k = 0; k < 2; ++k) dst[m][k] = *(const PG8_LAS bf16x8*)(lds + PG8_SA(b, h) + aoff + m * 2048 + k * 1024); } while (0)
#define PG8_LDB(dst, b, h) do { _Pragma("unroll") for (int n = 0; n < 2; ++n) _Pragma("unroll") for (int k = 0; k < 2; ++k) dst[n][k] = *(const PG8_LAS bf16x8*)(lds + PG8_SB(b, h) + boff + n * 2048 + k * 1024); } while (0)
#define PG8_MMA(ai, bj, At, Bt) do { __builtin_amdgcn_s_setprio(1); _Pragma("unroll") for (int m = 0; m < 4; ++m) _Pragma("unroll") for (int n = 0; n < 2; ++n) _Pragma("unroll") for (int k = 0; k < 2; ++k) \
        acc[ai][bj][m][n] = __builtin_amdgcn_mfma_f32_16x16x32_bf16(Bt[n][k], At[m][k], acc[ai][bj][m][n], 0, 0, 0); __builtin_amdgcn_s_setprio(0); } while (0)
#define PG8_WAIT_V(n) asm volatile("s_waitcnt vmcnt(" #n ")" ::: "memory")
#define PG8_WAIT_L(n) asm volatile("s_waitcnt lgkmcnt(" #n ")" ::: "memory")
#define PG8_BAR __builtin_amdgcn_s_barrier()
#define PG8_SCHED __builtin_amdgcn_sched_barrier(0)
    Unit cur, nxt; int ui = 0;
    if (!S.next(0, cur)) return;
    f32x4 acc[2][2][4][2];
#pragma unroll
    for (int a = 0; a < 2; ++a)
#pragma unroll
        for (int b = 0; b < 2; ++b)
#pragma unroll
            for (int m = 0; m < 4; ++m)
#pragma unroll
                for (int n = 0; n < 2; ++n) acc[a][b][m][n] = (f32x4){0.f, 0.f, 0.f, 0.f};
    bf16x8 At[4][2], B0[2][2], B1[2][2];
    const char* cA = (const char*)g.A + (size_t)cur.pm * tstep; const char* cB = (const char*)g.Bt + (size_t)cur.pn * tstep;
    S.a_ready(cur);
    if constexpr (SP2) {
        PG8_STAGE(PG8_SB(0, 0), cB, voffB); PG8_STAGE(PG8_SB(0, 1), cB + hstep, voffB); PG8_STAGE(PG8_SA(0, 0), cA, voffA); PG8_STAGE(PG8_SA(0, 1), cA + hstep, voffA);
        if (wr == 1) PG8_BAR;
        PG8_WAIT_V(2); PG8_BAR;
        PG8_STAGE(PG8_SB(1, 0), cB + kstep, voffB); PG8_STAGE(PG8_SA(1, 0), cA + kstep, voffA); PG8_STAGE(PG8_SB(1, 1), cB + hstep + kstep, voffB);
        PG8_WAIT_V(6); PG8_BAR;
    } else {
        PG8_STAGE(PG8_SB(0, 0), cB, voffB); PG8_STAGE(PG8_SA(0, 0), cA, voffA); PG8_STAGE(PG8_SB(0, 1), cB + hstep, voffB); PG8_STAGE(PG8_SA(0, 1), cA + hstep, voffA);
        if (wr == 1) PG8_BAR;
        PG8_WAIT_V(4); PG8_BAR;
        PG8_STAGE(PG8_SB(1, 0), cB + kstep, voffB); PG8_STAGE(PG8_SA(1, 0), cA + kstep, voffA); PG8_STAGE(PG8_SB(1, 1), cB + hstep + kstep, voffB);
        PG8_WAIT_V(6); PG8_BAR;
    }
    for (;;) {
        const bool has_next = S.next(ui + 1, nxt);
        const char* nA = has_next ? (const char*)g.A + (size_t)nxt.pm * tstep : cA; const char* nB = has_next ? (const char*)g.Bt + (size_t)nxt.pn * tstep : cB;
        for (int t = 0; t < nt; t += 2) {
            const bool last = (t == nt - 2);
            const char* a1 = cA + (size_t)(t + 1) * kstep;
            const char* a2 = last ? nA : cA + (size_t)(t + 2) * kstep; const char* b2 = last ? nB : cB + (size_t)(t + 2) * kstep;
            const char* a3 = a2 + kstep; const char* b3 = b2 + kstep;
            if (last && has_next) S.a_ready(nxt);
            if constexpr (SP2) {
            PG8_LDB(B0, 0, 0); PG8_LDB(B1, 0, 1); PG8_SCHED; PG8_LDA(At, 0, 0); PG8_STAGE(PG8_SA(1, 1), a1 + hstep, voffA);
            PG8_WAIT_V(8); PG8_WAIT_L(0); PG8_BAR; PG8_MMA(0, 0, At, B0); PG8_MMA(0, 1, At, B1); PG8_BAR; PG8_SCHED;
            PG8_LDA(At, 0, 1); PG8_STAGE(PG8_SB(0, 0), b2, voffB); PG8_STAGE(PG8_SB(0, 1), b2 + hstep, voffB); PG8_STAGE(PG8_SA(0, 0), a2, voffA);
            PG8_WAIT_V(8); PG8_WAIT_L(0); PG8_BAR; PG8_MMA(1, 0, At, B0); PG8_MMA(1, 1, At, B1); PG8_BAR; PG8_SCHED;
            PG8_LDB(B0, 1, 0); PG8_LDB(B1, 1, 1); PG8_SCHED; PG8_LDA(At, 1, 0); PG8_STAGE(PG8_SA(0, 1), a2 + hstep, voffA);
            PG8_WAIT_V(8); PG8_WAIT_L(0); PG8_BAR; PG8_MMA(0, 0, At, B0); PG8_MMA(0, 1, At, B1); PG8_BAR; PG8_SCHED;
            PG8_LDA(At, 1, 1); PG8_STAGE(PG8_SB(1, 0), b3, voffB); PG8_STAGE(PG8_SB(1, 1), b3 + hstep, voffB); PG8_STAGE(PG8_SA(1, 0), a3, voffA);
            PG8_WAIT_V(8); PG8_WAIT_L(0); PG8_BAR; PG8_MMA(1, 0, At, B0); PG8_MMA(1, 1, At, B1); PG8_BAR; PG8_SCHED;
            } else {
            PG8_LDB(B0, 0, 0); PG8_SCHED; PG8_LDA(At, 0, 0); PG8_STAGE(PG8_SA(1, 1), a1 + hstep, voffA);
            PG8_WAIT_L(8); PG8_BAR; PG8_WAIT_L(0); PG8_MMA(0, 0, At, B0); PG8_BAR; PG8_SCHED;
            PG8_LDB(B1, 0, 1); PG8_STAGE(PG8_SB(0, 0), b2, voffB);
            PG8_BAR; PG8_WAIT_L(0); PG8_MMA(0, 1, At, B1); PG8_BAR;
            PG8_LDA(At, 0, 1); PG8_STAGE(PG8_SA(0, 0), a2, voffA);
            PG8_BAR; PG8_WAIT_L(0); PG8_MMA(1, 0, At, B0); PG8_BAR; PG8_SCHED;
            PG8_STAGE(PG8_SB(0, 1), b2 + hstep, voffB);
            PG8_WAIT_V(6); PG8_BAR; PG8_MMA(1, 1, At, B1); PG8_BAR;
            PG8_LDB(B0, 1, 0); PG8_SCHED; PG8_LDA(At, 1, 0); PG8_STAGE(PG8_SA(0, 1), a2 + hstep, voffA);
            PG8_WAIT_L(8); PG8_BAR; PG8_WAIT_L(0); PG8_MMA(0, 0, At, B0); PG8_BAR; PG8_SCHED;
            PG8_LDB(B1, 1, 1); PG8_STAGE(PG8_SB(1, 0), b3, voffB);
            PG8_BAR; PG8_WAIT_L(0); PG8_MMA(0, 1, At, B1); PG8_BAR;
            PG8_LDA(At, 1, 1); PG8_STAGE(PG8_SA(1, 0), a3, voffA);
            PG8_BAR; PG8_WAIT_L(0); PG8_MMA(1, 0, At, B0); PG8_BAR; PG8_SCHED;
            PG8_STAGE(PG8_SB(1, 1), b3 + hstep, voffB);
            PG8_WAIT_V(6); PG8_BAR; PG8_MMA(1, 1, At, B1); PG8_BAR;
            }
        }
        if constexpr (ALIGN_EPI) { if (wr == 0) PG8_BAR; }
        if constexpr (!Epi::AFTER_DRAIN) { E(acc, cur, wr, wc, fr, fq); S.done(cur); }
        if (!has_next) break;
#pragma unroll
        for (int a = 0; a < 2; ++a)
#pragma unroll
            for (int b = 0; b < 2; ++b)
#pragma unroll
                for (int m = 0; m < 4; ++m)
#pragma unroll
                    for (int n = 0; n < 2; ++n) acc[a][b][m][n] = (f32x4){0.f, 0.f, 0.f, 0.f};
        cur = nxt; cA = nA; cB = nB; ++ui;
        if constexpr (ALIGN_EPI) { if (wr == 1) PG8_BAR; }
    }
    PG8_WAIT_V(0);
    if constexpr (!ALIGN_EPI) { if (wr == 0) PG8_BAR; }
    PG8_BAR;
    if constexpr (Epi::AFTER_DRAIN) { E.fused(acc, cur, wr, wc, fr, fq, lds, wid, lane); S.done(cur); }
#undef PG8_SA
#undef PG8_SB
#undef PG8_STAGE
#undef PG8_LDA
#undef PG8_LDB
#undef PG8_MMA
#undef PG8_WAIT_V
#undef PG8_WAIT_L
#undef PG8_BAR
#undef PG8_SCHED
}
}

typedef pg8::Unit GUnit;
typedef f32x4 GAcc[2][2][4][2];
DEV u32x4 pack8(const f32x4& v0, const f32x4& v1) { u32x4 w; w.x = pg8::cvt_pk_bf16(v0[0], v0[1]); w.y = pg8::cvt_pk_bf16(v0[2], v0[3]); w.z = pg8::cvt_pk_bf16(v1[0], v1[1]); w.w = pg8::cvt_pk_bf16(v1[2], v1[3]); return w; }
DEV void unpack8(const u32x4& w, f32x4& v0, f32x4& v1) {
  v0[0] = __builtin_bit_cast(float, w.x << 16); v0[1] = __builtin_bit_cast(float, w.x & 0xffff0000u); v0[2] = __builtin_bit_cast(float, w.y << 16); v0[3] = __builtin_bit_cast(float, w.y & 0xffff0000u);
  v1[0] = __builtin_bit_cast(float, w.z << 16); v1[1] = __builtin_bit_cast(float, w.z & 0xffff0000u); v1[2] = __builtin_bit_cast(float, w.w << 16); v1[3] = __builtin_bit_cast(float, w.w & 0xffff0000u); }
DEV f32x4 sig4(const f32x4& x) { f32x4 r; UNR for (int i = 0; i < 4; ++i) r[i] = sigmoidf_(x[i]); return r; }
struct EpiIn { static constexpr bool PERM = true, AFTER_DRAIN = false; bf16_t* PROJ; float* GATES; const float* bias;
  DEVM void operator()(const GAcc& acc, const GUnit& u, int wr, int wc, int fr, int fq) const {
    const int row0 = u.pm * 256 + wr * 64 + fr;
    UNR for (int bj = 0; bj < 2; ++bj) { const int c = u.pn * 256 + bj * 128 + wc * 32 + 8 * fq;
      if (c < IN_W) { const f32x4 b0 = *(const f32x4*)(bias + c), b1 = *(const f32x4*)(bias + c + 4);
        UNR for (int ai = 0; ai < 2; ++ai) UNR for (int m = 0; m < 4; ++m) { const int row = row0 + ai * 128 + m * 16;
          const f32x4 v0 = acc[ai][bj][m][0] + b0, v1 = acc[ai][bj][m][1] + b1;
          *(u32x4*)(PROJ + (size_t)row * NP + c) = pack8(v0, v1);
          if (c >= C_GATES && c < C_GATES + 16) { float* gp = GATES + (size_t)row * 16 + (c - C_GATES); *(f32x4*)gp = v0; *(f32x4*)(gp + 4) = v1; } } } }
  } };
struct EpiMerge { static constexpr bool PERM = true, AFTER_DRAIN = false; const bf16_t* PROJ; float* TMP; bf16_t* MG;
  DEVM void operator()(const GAcc& acc, const GUnit& u, int wr, int wc, int fr, int fq) const {
    const bool second = u.pm >= T / 256; const int pm = second ? u.pm - T / 256 : u.pm, pn = second ? u.pn - 4 : u.pn;
    const int row0 = pm * 256 + wr * 64 + fr;
    UNR for (int bj = 0; bj < 2; ++bj) { const int c = pn * 256 + bj * 128 + wc * 32 + 8 * fq;
      UNR for (int ai = 0; ai < 2; ++ai) UNR for (int m = 0; m < 4; ++m) { const int row = row0 + ai * 128 + m * 16;
        f32x4 g0, g1; unpack8(*(const u32x4*)(PROJ + (size_t)row * NP + (second ? C_GA : C_GM) + c), g0, g1);
        float* tp = TMP + (size_t)row * D + c;
        const f32x4 v0 = sig4(g0) * acc[ai][bj][m][0], v1 = sig4(g1) * acc[ai][bj][m][1];
        if (!second) { *(f32x4*)tp = v0; *(f32x4*)(tp + 4) = v1; }
        else *(u32x4*)(MG + (size_t)row * D + c) = pack8(*(const f32x4*)tp + v0, *(const f32x4*)(tp + 4) + v1);
        asm volatile("" ::: "memory"); } }
  } };
struct MergeOrder { pg8::StaticOrder S;
  DEVM bool next(int i, GUnit& u) const { if (!S.next(i >> 1, u)) return false; if (i & 1) { u.pm += T / 256; u.pn += 4; } return true; }
  DEVM void a_ready(const GUnit&) const {}
  DEVM void done(const GUnit&) const {} };
struct EpiOut { static constexpr bool PERM = true, AFTER_DRAIN = false; float* X; const float* modl;
  DEVM void operator()(const GAcc& acc, const GUnit& u, int wr, int wc, int fr, int fq) const {
    const int row0 = u.pm * 256 + wr * 64 + fr; const float* g1p = modl + (size_t)((u.pm * 256) / SEQ) * 6 * D + 2 * D;
    UNR for (int bj = 0; bj < 2; ++bj) { const int c = u.pn * 256 + bj * 128 + wc * 32 + 8 * fq;
      const f32x4 ga = *(const f32x4*)(g1p + c), gb = *(const f32x4*)(g1p + c + 4);
      UNR for (int ai = 0; ai < 2; ++ai) UNR for (int m = 0; m < 4; ++m) { float* xp = X + (size_t)(row0 + ai * 128 + m * 16) * D + c;
        *(f32x4*)xp = *(const f32x4*)xp + ga * acc[ai][bj][m][0]; *(f32x4*)(xp + 4) = *(const f32x4*)(xp + 4) + gb * acc[ai][bj][m][1];
        asm volatile("" ::: "memory"); } }
  } };
struct EpiUp { static constexpr bool PERM = false, AFTER_DRAIN = false; bf16_t* ACT; const int* slot_ent; const float* slot_w;
  DEVM void operator()(const GAcc& acc, const GUnit& u, int wr, int wc, int fr, int fq) const {
    const int ct = u.pn & 3;
    UNR for (int ai = 0; ai < 2; ++ai) UNR for (int m = 0; m < 4; ++m) { const int slot = u.pm * 256 + ai * 128 + wr * 64 + m * 16 + fr;
      if (slot_ent[slot] >= 0) { const float wt = slot_w[slot];
        UNR for (int bj = 0; bj < 2; ++bj) { const int f = (8 * ct + 4 * bj + wc) * 16 + 4 * fq; const f32x4 a = acc[ai][bj][m][0], uu = acc[ai][bj][m][1];
          u32x2 o; o.x = pg8::cvt_pk_bf16(siluf_(a[0]) * uu[0] * wt, siluf_(a[1]) * uu[1] * wt); o.y = pg8::cvt_pk_bf16(siluf_(a[2]) * uu[2] * wt, siluf_(a[3]) * uu[3] * wt);
          *(u32x2*)(ACT + (size_t)slot * FF + f) = o; } } }
  } };
struct EpiDown { static constexpr bool PERM = true, AFTER_DRAIN = false; bf16_t* Y; const int* slot_ent;
  DEVM void operator()(const GAcc& acc, const GUnit& u, int wr, int wc, int fr, int fq) const {
    const int ct = u.pn & 3;
    UNR for (int ai = 0; ai < 2; ++ai) UNR for (int m = 0; m < 4; ++m) { const int ent = slot_ent[u.pm * 256 + ai * 128 + wr * 64 + m * 16 + fr];
      if (ent >= 0) { UNR for (int bj = 0; bj < 2; ++bj) { const int c = ct * 256 + bj * 128 + wc * 32 + 8 * fq;
          *(u32x4*)(Y + (size_t)ent * D + c) = pack8(acc[ai][bj][m][0], acc[ai][bj][m][1]); } } }
  } };
struct MoeOrder { const int* pref; int nunits, G, c;
  DEVM bool next(int i, GUnit& u) const { const long idx = (long)i * G + c; if (idx >= nunits) return false; const int rt = (int)(idx >> 2), ct = (int)(idx & 3);
    int e = 0; while (pref[e + 1] <= rt) ++e; u.pm = rt; u.pn = e * 4 + ct; return true; }
  DEVM void a_ready(const GUnit&) const {}
  DEVM void done(const GUnit&) const {} };
#define GEMM_LDS ((PG8_LAS unsigned char*)dyn_lds)
DEV void phase_gemm_in(const Params& p, int l) {
  pg8::Gemm g{(const bf16_t*)(p.ws + WS_H), (const bf16_t*)(p.ws + WS_WIN), T, NP, D}; pg8::StaticOrder S; S.init(T, NP, NBLK, BID);
  EpiIn E{(bf16_t*)(p.ws + WS_PROJ), (float*)(p.ws + WS_GATES), p.b_in + (size_t)l * IN_W};
  pg8::gemm_phase<EpiIn, pg8::StaticOrder, true, true>(GEMM_LDS, g, S, E);
}
DEV void phase_gemm_merge(const Params& p) {
  static_assert(WS_YA == WS_YM + (size_t)T * MW * 2 && WS_WBA == WS_WBM + (size_t)D * MW * 2 && MW == AW, "y_m|y_a and Wbm|Wba are stacked: one A, one Bt");
  pg8::Gemm g{(const bf16_t*)(p.ws + WS_YM), (const bf16_t*)(p.ws + WS_WBM), 2 * T, 2 * D, MW}; MergeOrder S; S.S.init(T, D, NBLK, BID);
  EpiMerge E{(const bf16_t*)(p.ws + WS_PROJ), (float*)(p.ws + WS_TMP), (bf16_t*)(p.ws + WS_MERGED)};
  pg8::gemm_phase<EpiMerge, MergeOrder, true, true>(GEMM_LDS, g, S, E);
}
DEV void phase_gemm_out(const Params& p, int l) {
  pg8::Gemm g{(const bf16_t*)(p.ws + WS_MERGED), (const bf16_t*)(p.ws + WS_WOUT), T, D, D}; pg8::StaticOrder S; S.init(T, D, NBLK, BID);
  EpiOut E{p.out, (const float*)(p.ws + WS_MOD) + (size_t)l * BATCH * 6 * D};
  pg8::gemm_phase<EpiOut, pg8::StaticOrder, true, true>(GEMM_LDS, g, S, E);
}
DEV void phase_moe_up(const Params& p, int l) {
  int* s_pref = (int*)(LDS_PTR() + LDS_PHASE_BYTES + 64);
  moe_tiles(p, l, s_pref);
  pg8::Gemm g{(const bf16_t*)(p.ws + WS_HS), (const bf16_t*)(p.ws + WS_WGU), SLOT_ROWS, NE * 2 * FF, D};
  MoeOrder S{s_pref, s_pref[NE] * 4, NBLK, BID};
  EpiUp E{(bf16_t*)(p.ws + WS_ACT), (const int*)(p.ws + WS_SLOT_ENT), (const float*)(p.ws + WS_SLOT_W)};
  pg8::gemm_phase<EpiUp, MoeOrder, true, true>(GEMM_LDS, g, S, E);
}
DEV void phase_moe_down(const Params& p, int l) {
  int* s_pref = (int*)(LDS_PTR() + LDS_PHASE_BYTES + 64);
  moe_tiles(p, l, s_pref);
  pg8::Gemm g{(const bf16_t*)(p.ws + WS_ACT), (const bf16_t*)(p.ws + WS_WD), SLOT_ROWS, NE * D, FF};
  MoeOrder S{s_pref, s_pref[NE] * 4, NBLK, BID};
  EpiDown E{(bf16_t*)(p.ws + WS_Y), (const int*)(p.ws + WS_SLOT_ENT)};
  pg8::gemm_phase<EpiDown, MoeOrder, true, true>(GEMM_LDS, g, S, E);
}
#endif
DEV void phase_prep(const Params& p, int l) {
  const bf16_t* PROJ = (const bf16_t*)(p.ws + WS_PROJ);
  bf16_t* QC = (bf16_t*)(p.ws + WS_QC); bf16_t* KC = (bf16_t*)(p.ws + WS_KC);
  const int gtid = BID * NTHREADS + TID, gstride = NBLK * NTHREADS;
  const float* cw = p.conv_w + (size_t)l * CONVW * 2 * MW; const float* cb = p.conv_b + (size_t)l * 2 * MW;
  for (int it = gtid; it < (T / 8) * 128; it += gstride) {
    const int c8 = (it & 127) * 8, tb = (it >> 7) * 8, s0 = tb % SEQ;
    float wt[CONVW][8], bias[8];
    UNR for (int wi = 0; wi < CONVW; ++wi) { const f32x4 a = *(const f32x4*)(cw + wi * 2 * MW + c8), b = *(const f32x4*)(cw + wi * 2 * MW + c8 + 4); UNR for (int j = 0; j < 4; ++j) { wt[wi][j] = a[j]; wt[wi][4 + j] = b[j]; } }
    { const f32x4 a = *(const f32x4*)(cb + c8), b = *(const f32x4*)(cb + c8 + 4); UNR for (int j = 0; j < 4; ++j) { bias[j] = a[j]; bias[4 + j] = b[j]; } }
    bf16x8 rows[12];
    UNR for (int r = 0; r < 12; ++r) { const int ss = s0 + r - 2; rows[r] = (ss >= 0 && ss < SEQ) ? ld8(PROJ + (size_t)(tb + r - 2) * NP + c8) : (bf16x8){0, 0, 0, 0, 0, 0, 0, 0}; }
    const float sc = (c8 < MW) ? 0.08838834764831845f : 1.f;
    UNR for (int q = 0; q < 8; ++q) {
      float a[8]; UNR for (int j = 0; j < 8; ++j) a[j] = bias[j];
      UNR for (int wi = 0; wi < CONVW; ++wi) UNR for (int j = 0; j < 8; ++j) a[j] += bf2f((bf16_t)rows[q + wi][j]) * wt[wi][j];
      u32x4 o; o.x = pk2(siluf_(a[0]) * sc, siluf_(a[1]) * sc); o.y = pk2(siluf_(a[2]) * sc, siluf_(a[3]) * sc); o.z = pk2(siluf_(a[4]) * sc, siluf_(a[5]) * sc); o.w = pk2(siluf_(a[6]) * sc, siluf_(a[7]) * sc);
      if (c8 < MW) *(u32x4*)(QC + (size_t)(tb + q) * MW + c8) = o; else *(u32x4*)(KC + (size_t)(tb + q) * MW + c8 - MW) = o; }
  }
  bf16_t* AQN = (bf16_t*)(p.ws + WS_AQN); bf16_t* AKN = (bf16_t*)(p.ws + WS_AKN); bf16_t* VT = (bf16_t*)(p.ws + WS_VT);
  const float* rope = (const float*)(p.ws + WS_ROPE); constexpr int NR = SEQ / GRID_W;
  for (int it0 = BID * NTHREADS; it0 < T * 10 * 8; it0 += gstride) {
    const int it = it0 + TID, j = it & 7, th = it >> 3, hh = th / T, t = th % T, s = t % SEQ;
    const bool isq = hh < AH;
    const bf16_t* src = PROJ + (size_t)t * NP + (isq ? C_AQ + hh * 64 : C_AK + (hh - AH) * 64) + j * 8;
    const float* g = (isq ? p.q_norm_g : p.k_norm_g) + (size_t)l * AHD + j * 8;
    const bf16x8 x8 = ld8(src);
    float v[8], pr[8]; float ss = 0.f;
#pragma unroll
    for (int k = 0; k < 8; ++k) { v[k] = bf2f((bf16_t)x8[k]); ss += v[k] * v[k]; }
    ss += shfl_xor_f(ss, 1); ss += shfl_xor_f(ss, 2); ss += shfl_xor_f(ss, 4);
    const float rs = 1.f / sqrtf(ss * (1.f / 64.f) + EPS);
#pragma unroll
    for (int k = 0; k < 8; ++k) v[k] = v[k] * rs * g[k];
#pragma unroll
    for (int k = 0; k < 8; ++k) pr[k] = shfl_xor_f(v[k], 2);
    const int pos = (j < 4) ? s / GRID_W : s % GRID_W;
    const float* ct = rope + (j < 4 ? 0 : 2 * NR * 16) + pos * 16 + (j & 1) * 8;
    const float* st = ct + (j < 4 ? NR * 16 : 64 * 16);
    const float sgn = (j & 2) ? 1.f : -1.f, qs = isq ? 0.125f * 1.4426950408889634f : 1.f;
    float o[8];
#pragma unroll
    for (int k = 0; k < 8; ++k) o[k] = (v[k] * ct[k] + sgn * pr[k] * st[k]) * qs;
    u32x4 w4; w4.x = pk2(o[0], o[1]); w4.y = pk2(o[2], o[3]); w4.z = pk2(o[4], o[5]); w4.w = pk2(o[6], o[7]);
    bf16_t* dst = isq ? AQN + (size_t)t * AW + hh * 64 + j * 8 : AKN + (size_t)t * KVW + (hh - AH) * 64 + j * 8;
    *(u32x4*)dst = w4;
  }
#ifdef EMU
  for (int it = gtid; it < T * KVH * 8; it += gstride) {
    const int s = it % SEQ, d8 = (it / SEQ) & 7, bk = it / (SEQ * 8), b = bk / KVH, kv = bk % KVH;
    const bf16x8 v8 = ld8(PROJ + (size_t)(b * SEQ + s) * NP + C_AV + kv * 64 + d8 * 8);
#pragma unroll
    for (int k = 0; k < 8; ++k) VT[((size_t)bk * 64 + d8 * 8 + k) * SEQ + s] = (bf16_t)v8[k];
  }
#else
  (void)VT;
#endif
}

#ifdef EMU
DEV void phase_attn(const Params& p) {
  char* lds = LDS_PTR();
  bf16_t* Ks = (bf16_t*)lds; bf16_t* Vs = Ks + 64 * GP; bf16_t* Ps = Vs + 64 * GP;
  const bf16_t* AQN = (const bf16_t*)(p.ws + WS_AQN); const bf16_t* AKN = (const bf16_t*)(p.ws + WS_AKN); const bf16_t* VT = (const bf16_t*)(p.ws + WS_VT);
  bf16_t* YA = (bf16_t*)(p.ws + WS_YA);
  const int tid = TID, lane = tid & 63, w = tid >> 6;
  constexpr int NQB = SEQ / 128, NU = BATCH * AH * NQB;
  bf16_t* Pw = Ps + w * 16 * GP;
  for (int u = BID; u < NU; u += NBLK) {
    const int qb = u % NQB, h = (u / NQB) % AH, b = u / (NQB * AH), kv = h / (AH / KVH);
    const int r0 = qb * 128 + w * 16;
    bf16x8 qa[2];
    UNR for (int ks = 0; ks < 2; ++ks) qa[ks] = ld8(AQN + (size_t)(b * SEQ + r0 + (lane & 15)) * AW + h * 64 + ks * 32 + (lane >> 4) * 8);
    f32x4 o[4]; UNR for (int i = 0; i < 4; ++i) o[i] = (f32x4){0.f, 0.f, 0.f, 0.f};
    float mrow[4], lrow[4]; UNR for (int i = 0; i < 4; ++i) { mrow[i] = -3.0e38f; lrow[i] = 0.f; }
    for (int kt = 0; kt < SEQ / 64; ++kt) {
      SYNC();
      { const int r = tid >> 3, pc = (tid & 7) * 8;
        *(u32x4*)(Ks + r * GP + pc) = *(const u32x4*)(AKN + (size_t)(b * SEQ + kt * 64 + r) * KVW + kv * 64 + pc);
        *(u32x4*)(Vs + r * GP + pc) = *(const u32x4*)(VT + ((size_t)(b * KVH + kv) * 64 + r) * SEQ + kt * 64 + pc); }
      SYNC();
      f32x4 s[4];
      UNR for (int nt = 0; nt < 4; ++nt) { s[nt] = (f32x4){0.f, 0.f, 0.f, 0.f};
        UNR for (int ks = 0; ks < 2; ++ks) s[nt] = mfma16(qa[ks], ld8(Ks + (nt * 16 + (lane & 15)) * GP + ks * 32 + (lane >> 4) * 8), s[nt]); }
      UNR for (int i = 0; i < 4; ++i) {
        float mx = fmaxf(fmaxf(s[0][i], s[1][i]), fmaxf(s[2][i], s[3][i])); mx = grp16_max(mx);
        const float mnew = fmaxf(mrow[i], mx), alpha = exp2f(mrow[i] - mnew); mrow[i] = mnew;
        float rsum = 0.f;
        UNR for (int nt = 0; nt < 4; ++nt) { const float pv = exp2f(s[nt][i] - mnew); rsum += pv; Pw[((lane >> 4) * 4 + i) * GP + nt * 16 + (lane & 15)] = f2bf(pv); }
        lrow[i] = lrow[i] * alpha + rsum;
        UNR for (int nd = 0; nd < 4; ++nd) o[nd][i] *= alpha;
      }
      SYNC();
      UNR for (int ks = 0; ks < 2; ++ks) { const bf16x8 pa = ld8(Pw + (lane & 15) * GP + ks * 32 + (lane >> 4) * 8);
        UNR for (int nd = 0; nd < 4; ++nd) o[nd] = mfma16(pa, ld8(Vs + (nd * 16 + (lane & 15)) * GP + ks * 32 + (lane >> 4) * 8), o[nd]); }
    }
    UNR for (int i = 0; i < 4; ++i) { const float lt = grp16_sum(lrow[i]), inv = 1.f / lt; const int row = b * SEQ + r0 + (lane >> 4) * 4 + i;
      UNR for (int nd = 0; nd < 4; ++nd) YA[(size_t)row * AW + h * 64 + nd * 16 + (lane & 15)] = f2bf(o[nd][i] * inv); }
  }
}

#else
namespace attn_body {
using bf16=unsigned short;
using bf16x8=__attribute__((ext_vector_type(8)))short;
using s16x4=__attribute__((ext_vector_type(4)))short;
using f32x16=__attribute__((ext_vector_type(16)))float;
using u32x4=__attribute__((ext_vector_type(4)))unsigned;
constexpr int SEQ=::SEQ,D=64;
constexpr int NW=8,QBLK=32,QB=QBLK*NW,KVBLK=64,NQB=SEQ/QB;
constexpr int ATTN_UNIT_ROWS=QB;
__device__ __forceinline__ int crow(int r,int hi){return (r&3)+8*(r>>2)+4*hi;}
#define SBAR() __builtin_amdgcn_sched_barrier(0)
constexpr int NSLOT=3, SLOTB=8192;
constexpr int LDS_K=0, LDS_V=NSLOT*SLOTB, LDS_WS=2*NSLOT*SLOTB, LDS_OST=LDS_WS+NW*64*4, LDS_BYTES=LDS_OST+NW*4096;
constexpr float C2=0.125f*1.4426950408889634f;
__device__ __forceinline__ void glds16(const void*gsrc,unsigned lds_dst){unsigned keep;
  asm volatile("s_mov_b32 %0, m0\n\ts_mov_b32 m0, %2\n\ts_nop 0\n\tglobal_load_lds_dwordx4 %1, off\n\ts_mov_b32 m0, %0":"=&s"(keep):"v"(gsrc),"s"(lds_dst):"memory");}
__device__ __forceinline__ float max3f(float a,float b,float c){float r;asm("v_max3_f32 %0, %1, %2, %3":"=v"(r):"v"(a),"v"(b),"v"(c));return r;}
__device__ __forceinline__ float max2f(float a,float b){float r;asm("v_max_f32_e32 %0, %1, %2":"=v"(r):"v"(a),"v"(b));return r;}
__device__ __forceinline__ float fadd_s(float a,float b){float r;asm("v_add_f32_e32 %0, %1, %2":"=v"(r):"v"(a),"v"(b));return r;}
__device__ __forceinline__ float fsub_s(float a,float b){float r;asm("v_sub_f32_e32 %0, %1, %2":"=v"(r):"v"(a),"v"(b));return r;}
typedef float f32x2_t __attribute__((ext_vector_type(2))); typedef __bf16 bf16x2_t __attribute__((ext_vector_type(2)));
__device__ __forceinline__ unsigned cvtpk_s(float lo,float hi){f32x2_t v={lo,hi};bf16x2_t b=__builtin_convertvector(v,bf16x2_t);return __builtin_bit_cast(unsigned,b);}
#define WAIT_BAR(N) asm volatile("s_waitcnt vmcnt(" #N ") lgkmcnt(0)\n\ts_barrier":::"memory")

__device__ __forceinline__ void qkt(f32x16&p0,f32x16&p1,const char*Kslot,const bf16x8*qr,const f32x16&negm,int r32,int hi){
  const char*kb=Kslot+hi*1024+r32*16;
  #pragma unroll
  for(int d0=0;d0<4;++d0){
    const bf16x8 b0=*reinterpret_cast<const bf16x8*>(kb+d0*2048);
    const bf16x8 b1=*reinterpret_cast<const bf16x8*>(kb+d0*2048+512);
    if(d0==0){p0=__builtin_amdgcn_mfma_f32_32x32x16_bf16(b0,qr[0],negm,0,0,0);p1=__builtin_amdgcn_mfma_f32_32x32x16_bf16(b1,qr[0],negm,0,0,0);}
    else{p0=__builtin_amdgcn_mfma_f32_32x32x16_bf16(b0,qr[d0],p0,0,0,0);p1=__builtin_amdgcn_mfma_f32_32x32x16_bf16(b1,qr[d0],p1,0,0,0);}}
}
typedef __attribute__((address_space(3))) const char* lds_cptr;
typedef short v4i16_t __attribute__((ext_vector_type(4)));
__device__ __forceinline__ void kload8(bf16x8*kf,lds_cptr kp){
  kf[0]=*(const __attribute__((address_space(3))) bf16x8*)(kp);      kf[1]=*(const __attribute__((address_space(3))) bf16x8*)(kp+512);
  kf[2]=*(const __attribute__((address_space(3))) bf16x8*)(kp+2048); kf[3]=*(const __attribute__((address_space(3))) bf16x8*)(kp+2560);
  kf[4]=*(const __attribute__((address_space(3))) bf16x8*)(kp+4096); kf[5]=*(const __attribute__((address_space(3))) bf16x8*)(kp+4608);
  kf[6]=*(const __attribute__((address_space(3))) bf16x8*)(kp+6144); kf[7]=*(const __attribute__((address_space(3))) bf16x8*)(kp+6656);
}
__device__ __forceinline__ void kload2(bf16x8*kf,lds_cptr kp,int j){ kf[2*j]=*(const __attribute__((address_space(3))) bf16x8*)(kp+j*2048); kf[2*j+1]=*(const __attribute__((address_space(3))) bf16x8*)(kp+j*2048+512); }
__device__ __forceinline__ s16x4 vtr(lds_cptr p){ return __builtin_bit_cast(s16x4,__builtin_amdgcn_ds_read_tr16_b64_v4i16((__attribute__((address_space(3))) v4i16_t*)p)); }
__device__ __forceinline__ float rowmax(const f32x16&p0,const f32x16&p1){
  float a=max3f(p0[0],p0[1],p1[0]),b=max3f(p0[2],p0[3],p1[1]);a=max3f(a,p1[2],p1[3]);
  #pragma unroll
  for(int r=4;r<16;r+=4){a=max3f(a,p0[r],p0[r+1]);b=max3f(b,p0[r+2],p0[r+3]);a=max3f(a,p1[r],p1[r+1]);b=max3f(b,p1[r+2],p1[r+3]);}
  const float m=max2f(a,b);
  auto rr=__builtin_amdgcn_permlane32_swap(__float_as_uint(m),__float_as_uint(m),false,false);
  return max2f(__uint_as_float(rr[0]),__uint_as_float(rr[1]));
}
__device__ __forceinline__ void pv(f32x16*o,int vb,bf16x8 pa0,bf16x8 pa1,bf16x8 pa2,bf16x8 pa3){
  #pragma unroll
  for(int d0=0;d0<2;++d0){s16x4 lo[4],hi[4];
    #pragma unroll
    for(int ks=0;ks<4;++ks){
      asm volatile("ds_read_b64_tr_b16 %0,%1 offset:%c2":"=&v"(lo[ks]):"v"(vb),"i"(d0*4096+ks*1024):"memory");
      asm volatile("ds_read_b64_tr_b16 %0,%1 offset:%c2":"=&v"(hi[ks]):"v"(vb),"i"(d0*4096+ks*1024+512):"memory");}
    asm volatile("s_waitcnt lgkmcnt(0)":::"memory");SBAR();
    #define PK(k) (bf16x8){lo[k][0],lo[k][1],lo[k][2],lo[k][3],hi[k][0],hi[k][1],hi[k][2],hi[k][3]}
    o[d0]=__builtin_amdgcn_mfma_f32_32x32x16_bf16(pa0,PK(0),o[d0],0,0,0);
    o[d0]=__builtin_amdgcn_mfma_f32_32x32x16_bf16(pa1,PK(1),o[d0],0,0,0);
    o[d0]=__builtin_amdgcn_mfma_f32_32x32x16_bf16(pa2,PK(2),o[d0],0,0,0);
    o[d0]=__builtin_amdgcn_mfma_f32_32x32x16_bf16(pa3,PK(3),o[d0],0,0,0);
    #undef PK
  }
}

#ifndef ATTN_STORE16
#define ATTN_STORE16(p,v) (*(u32x4*)(p)=(v))
#endif
template<int THRL,int QP,int KP,int VP> __device__ __forceinline__ void attn_unit(long rowbase,int qb,const bf16*Q,const bf16*__restrict__ K,const bf16*__restrict__ V,bf16*O,char*shm){
  const int tid=TID,lane=tid&63,r32=lane&31,hi=lane>>5; const int wid=__builtin_amdgcn_readfirstlane(tid>>6);
  const int q0=qb*QB;
  const bf16*Qw=Q+(rowbase+q0+wid*QBLK)*QP;
  const bf16*Kh=K+rowbase*KP,*Vh=V+rowbase*VP;
  const unsigned lds0=(unsigned)(uintptr_t)shm;
  float*wsf=(float*)(shm+LDS_WS)+wid*64;
  const bf16*ksrc=Kh+(long)lane*KP+wid*8;
  const bf16*vsrc=Vh+(long)(16*(wid&3)+(lane>>2))*VP+(wid>>2)*32+(lane&3)*8;
  const unsigned kdst=lds0+LDS_K+wid*1024, vdst=lds0+LDS_V+wid*1024;
  #define DMA_K(t,slot) glds16(ksrc+(long)(t)*KVBLK*KP,(unsigned)__builtin_amdgcn_readfirstlane(kdst+(slot)))
  #define DMA_V(t,slot) glds16(vsrc+(long)(t)*KVBLK*VP,(unsigned)__builtin_amdgcn_readfirstlane(vdst+(slot)))
  const int vb0=(int)(lds0+LDS_V)+((lane>>4)&1)*32+(lane&3)*8+(4*hi+((lane&15)>>2))*64;
  const char*Kbase=shm+LDS_K; bf16x8 kf[8];
  const lds_cptr shm3=(lds_cptr)shm; const lds_cptr kp0=shm3+LDS_K+hi*1024+r32*16; const lds_cptr vp0=shm3+LDS_V+((lane>>4)&1)*32+(lane&3)*8+(4*hi+((lane&15)>>2))*64;
  int NT=SEQ/KVBLK; asm volatile("":"+s"(NT));
  DMA_K(0,0);DMA_V(0,0);DMA_K(1,SLOTB);
  bf16x8 qr[4];
  #pragma unroll
  for(int d0=0;d0<4;++d0)qr[d0]=*reinterpret_cast<const bf16x8*>(&Qw[(long)r32*QP+d0*16+hi*8]);
  float mhat=0.f,l_reg=0.f;f32x16 o[2];o[0]=f32x16{};o[1]=f32x16{};f32x16 negm=f32x16{};asm volatile("":"+v"(negm));
  #define CMASK(P0,P1,t) do{}while(0)
  bool resc=false;
  #define START(P0,P1) do{ const float rm=rowmax(P0,P1); resc=false; \
    { const float dl=rm; mhat=fadd_s(mhat,dl); \
      _Pragma("unroll") for(int r=0;r<16;++r){P0[r]=fsub_s(P0[r],dl);P1[r]=fsub_s(P1[r],dl);} \
      _Pragma("unroll") for(int r=0;r<16;++r)negm[r]=-mhat; asm volatile("":"+v"(negm)); } \
    _Pragma("unroll") for(int r=0;r<16;++r)P0[r]=__builtin_amdgcn_exp2f(P0[r]); }while(0)
  #define RESC() do{ if(resc){ asm volatile("s_waitcnt lgkmcnt(0)":::"memory"); \
      _Pragma("unroll") for(int d_=0;d_<2;++d_) _Pragma("unroll") for(int r=0;r<16;++r)o[d_][r]*=wsf[crow(r,hi)]; } }while(0)
  f32x16 pA0,pA1,pB0,pB1;
  int sl_prev=0,sl_cur=0,sl_next=SLOTB;
  #define ROT() do{sl_prev=sl_cur;sl_cur=sl_next;sl_next=(sl_next==(NSLOT-1)*SLOTB)?0:sl_next+SLOTB;}while(0)
  DMA_K(2,2*SLOTB);
  WAIT_BAR(3);
  qkt(pA0,pA1,Kbase,qr,negm,r32,hi);asm volatile("s_nop 15\n\ts_nop 7":"+v"(pA0),"+v"(pA1));CMASK(pA0,pA1,0);
  START(pA0,pA1);
  _Pragma("unroll") for(int r=0;r<16;++r)pA1[r]=__builtin_amdgcn_exp2f(pA1[r]);
  WAIT_BAR(0);
  DMA_K(3,0);DMA_V(1,SLOTB);
  ROT();
  kload8(kf,kp0+sl_cur);
  WAIT_BAR(2);
  s16x4 vlo[8],vhi[8]; u32x4 pw0,pw1,pw2,pw3;
  #define PKW(P,B) cvtpk_s(P[B],P[B+1])
  #define PAF(k) __builtin_bit_cast(bf16x8,pw##k)
  #define VFR(i) (bf16x8){vlo[i][0],vlo[i][1],vlo[i][2],vlo[i][3],vhi[i][0],vhi[i][1],vhi[i][2],vhi[i][3]}
  #define PIN(x) asm volatile("":"+v"(x))
  #define MX3(a,b,c) __builtin_fmaxf(__builtin_fmaxf((a),(b)),(c))
  #define GAPA(MF,A0,A1,A2,A3,W0,W1,PW) do{ MF; sacc+=A0; sacc+=A1; sacc+=A2; sacc+=A3; PIN(sacc); W0; W1; PIN(PW); SBAR(); }while(0)
  #define EX(v) __builtin_amdgcn_exp2f(v)
  #define GAPB(MF,X,B) do{ MF; X[B]=EX(X[B]); X[B+1]=EX(X[B+1]); X[B+2]=EX(X[B+2]); X[B+3]=EX(X[B+3]); PIN(X); SBAR(); }while(0)
  #define VRD(i) do{ vlo[i]=vtr(vp_+(((i)>>2)*4096+((i)&3)*1024)); vhi[i]=vtr(vp_+(((i)>>2)*4096+((i)&3)*1024+512)); }while(0)
  #define KRD(G,j) do{ if(G){ kload2(kf,kp0+sl_next,j); SBAR(); } }while(0)
  #define STEP(C0,C1,P0,P1,t,GK,GV,GL) do{ SBAR(); \
    const lds_cptr vp_=vp0+sl_prev; \
    VRD(0); SBAR(); float sacc=(P0[0]+P0[1]); \
    GAPA(C0=__builtin_amdgcn_mfma_f32_32x32x16_bf16(kf[0],qr[0],negm,0,0,0), P0[2],P0[3],P0[4],P0[5],     pw0[0]=PKW(P0,0), pw0[1]=PKW(P0,2), pw0); \
    VRD(4); SBAR(); GAPA(C1=__builtin_amdgcn_mfma_f32_32x32x16_bf16(kf[1],qr[0],negm,0,0,0), P0[6],P0[7],P0[8],P0[9],     pw0[2]=PKW(P0,4), pw0[3]=PKW(P0,6), pw0); \
    VRD(1); SBAR(); GAPA(C0=__builtin_amdgcn_mfma_f32_32x32x16_bf16(kf[2],qr[1],C0,0,0,0),   P0[10],P0[11],P0[12],P0[13], pw1[0]=PKW(P0,8), pw1[1]=PKW(P0,10), pw1); \
    VRD(5); SBAR(); GAPA(C1=__builtin_amdgcn_mfma_f32_32x32x16_bf16(kf[3],qr[1],C1,0,0,0),   P0[14],P0[15],P1[0],P1[1],   pw1[2]=PKW(P0,12),pw1[3]=PKW(P0,14), pw1); \
    VRD(2); SBAR(); GAPA(C0=__builtin_amdgcn_mfma_f32_32x32x16_bf16(kf[4],qr[2],C0,0,0,0),   P1[2],P1[3],P1[4],P1[5],     pw2[0]=PKW(P1,0), pw2[1]=PKW(P1,2), pw2); \
    VRD(6); SBAR(); GAPA(C1=__builtin_amdgcn_mfma_f32_32x32x16_bf16(kf[5],qr[2],C1,0,0,0),   P1[6],P1[7],P1[8],P1[9],     pw2[2]=PKW(P1,4), pw2[3]=PKW(P1,6), pw2); \
    VRD(3); SBAR(); GAPA(C0=__builtin_amdgcn_mfma_f32_32x32x16_bf16(kf[6],qr[3],C0,0,0,0),   P1[10],P1[11],P1[12],P1[13], pw3[0]=PKW(P1,8), pw3[1]=PKW(P1,10), pw3); \
    VRD(7); SBAR(); GAPA(C1=__builtin_amdgcn_mfma_f32_32x32x16_bf16(kf[7],qr[3],C1,0,0,0),   P1[14],P1[15],0.f,0.f,       pw3[2]=PKW(P1,12),pw3[3]=PKW(P1,14), pw3); \
    l_reg+=sacc; \
    if(GK){DMA_K((t)+3,sl_cur);} if(GV){DMA_V((t)+1,sl_next);} \
    CMASK(C0,C1,t); \
    { float a=MX3(C0[0],C0[1],C1[0]),b=MX3(C0[2],C0[3],C1[1]); a=MX3(a,C1[2],C1[3]); \
      _Pragma("unroll") for(int r=4;r<16;r+=4){a=MX3(a,C0[r],C0[r+1]);b=MX3(b,C0[r+2],C0[r+3]);a=MX3(a,C1[r],C1[r+1]);b=MX3(b,C1[r+2],C1[r+3]);} \
      float rm=__builtin_fmaxf(a,b); { auto rr=__builtin_amdgcn_permlane32_swap(__float_as_uint(rm),__float_as_uint(rm),false,false); rm=__builtin_fmaxf(__uint_as_float(rr[0]),__uint_as_float(rr[1])); } \
      resc=false; \
      if(__builtin_expect(__any(rm>(float)THRL),0)){ const float dl=__builtin_fmaxf(rm,0.f); mhat+=dl; \
        _Pragma("unroll") for(int r=0;r<16;++r){C0[r]-=dl;C1[r]-=dl;} \
        _Pragma("unroll") for(int r=0;r<16;++r)negm[r]=-mhat; asm volatile("":"+v"(negm)); \
        const float f=__builtin_amdgcn_exp2f(-dl); l_reg*=f; if(hi==0)wsf[r32]=f; resc=true; } } \
    SBAR(); \
    GAPB(o[0]=__builtin_amdgcn_mfma_f32_32x32x16_bf16(PAF(0),VFR(0),o[0],0,0,0), C0,0); \
    GAPB(o[1]=__builtin_amdgcn_mfma_f32_32x32x16_bf16(PAF(0),VFR(4),o[1],0,0,0), C0,4); \
    KRD(GL,0); GAPB(o[0]=__builtin_amdgcn_mfma_f32_32x32x16_bf16(PAF(1),VFR(1),o[0],0,0,0), C0,8); \
    KRD(GL,1); GAPB(o[1]=__builtin_amdgcn_mfma_f32_32x32x16_bf16(PAF(1),VFR(5),o[1],0,0,0), C0,12); \
    KRD(GL,2); GAPB(o[0]=__builtin_amdgcn_mfma_f32_32x32x16_bf16(PAF(2),VFR(2),o[0],0,0,0), C1,0); \
    KRD(GL,3); GAPB(o[1]=__builtin_amdgcn_mfma_f32_32x32x16_bf16(PAF(2),VFR(6),o[1],0,0,0), C1,4); \
    GAPB(o[0]=__builtin_amdgcn_mfma_f32_32x32x16_bf16(PAF(3),VFR(3),o[0],0,0,0), C1,8); \
    GAPB(o[1]=__builtin_amdgcn_mfma_f32_32x32x16_bf16(PAF(3),VFR(7),o[1],0,0,0), C1,12); \
    }while(0)
  int t=1;
  for(;t+5<NT;t+=2){
    STEP(pB0,pB1,pA0,pA1,t,true,true,true);     WAIT_BAR(2); RESC(); ROT();
    STEP(pA0,pA1,pB0,pB1,t+1,true,true,true);   WAIT_BAR(2); RESC(); ROT();
  }
  #define ENDW(tt) do{ if((tt)+3<NT){WAIT_BAR(2);} else if((tt)+2<NT){WAIT_BAR(1);} else {WAIT_BAR(0);} }while(0)
  for(;t+1<NT;t+=2){
    STEP(pB0,pB1,pA0,pA1,t,(t+3<NT),(t+1<NT),(t+1<NT));       ENDW(t);   RESC(); ROT();
    STEP(pA0,pA1,pB0,pB1,t+1,(t+4<NT),(t+2<NT),(t+2<NT));     ENDW(t+1); RESC(); ROT();
  }
  STEP(pB0,pB1,pA0,pA1,NT-1,false,false,false); RESC();
  { float sacc=pB0[0]+pB0[1]; _Pragma("unroll") for(int r=2;r<16;++r)sacc+=pB0[r]; _Pragma("unroll") for(int r=0;r<16;++r)sacc+=pB1[r]; l_reg+=sacc;
    pw0=(u32x4){PKW(pB0,0),PKW(pB0,2),PKW(pB0,4),PKW(pB0,6)};pw1=(u32x4){PKW(pB0,8),PKW(pB0,10),PKW(pB0,12),PKW(pB0,14)};pw2=(u32x4){PKW(pB1,0),PKW(pB1,2),PKW(pB1,4),PKW(pB1,6)};pw3=(u32x4){PKW(pB1,8),PKW(pB1,10),PKW(pB1,12),PKW(pB1,14)};
    SBAR(); pv(o,vb0+sl_cur,PAF(0),PAF(1),PAF(2),PAF(3)); }
  #undef PKW
  #undef PAF
  #undef VFR
  #undef PIN
  #undef MX3
  #undef GAPA
  #undef GAPB
  #undef EX
  #undef VRD
  #undef KRD
  #undef STEP
  #undef ENDW
  {auto rr=__builtin_amdgcn_permlane32_swap(__float_as_uint(l_reg),__float_as_uint(l_reg),false,false);l_reg=__uint_as_float(rr[0])+__uint_as_float(rr[1]);}
  if(hi==0)wsf[32+r32]=l_reg;asm volatile("s_waitcnt lgkmcnt(0)":::"memory");
  float rli[16];
  #pragma unroll
  for(int r=0;r<16;++r)rli[r]=__builtin_amdgcn_rcpf(wsf[32+crow(r,hi)]);
  bf16*Ow=O+(rowbase+q0+wid*QBLK)*QP;
  { bf16*stg=(bf16*)(shm+LDS_OST)+wid*2048;
    #pragma unroll
    for(int r=0;r<16;++r){const int orow=crow(r,hi);
      #pragma unroll
      for(int d0=0;d0<2;++d0)stg[orow*64+d0*32+r32]=f2bf(o[d0][r]*rli[r]);}
    asm volatile("s_waitcnt lgkmcnt(0)":::"memory");
    #pragma unroll
    for(int i=0;i<4;++i){const int row=i*8+(lane>>3),ch=lane&7; const u32x4 v=*(const u32x4*)(stg+row*64+ch*8); ATTN_STORE16(Ow+(long)row*QP+ch*8,v);} }
  asm volatile("s_waitcnt lgkmcnt(0)\n\ts_barrier":::"memory");
  #undef DMA_K
  #undef DMA_V
  #undef CMASK
  #undef START
  #undef RESC
  #undef ROT
}
#undef SBAR
#undef WAIT_BAR
}

DEV void phase_attn(const Params& p) {
  char* lds = LDS_PTR();
  const bf16_t* AQN = (const bf16_t*)(p.ws + WS_AQN); const bf16_t* AKN = (const bf16_t*)(p.ws + WS_AKN); const bf16_t* PROJ = (const bf16_t*)(p.ws + WS_PROJ);
  bf16_t* YA = (bf16_t*)(p.ws + WS_YA);
  constexpr int NQB = SEQ / 256, NU = BATCH * AH * NQB;
  for (int u = BID; u < NU; u += NBLK) {
    const int qb = u % NQB, h = (u / NQB) % AH, b = u / (NQB * AH), kv = h / (AH / KVH);
    attn_body::attn_unit<8, AW, KVW, NP>((long)b * SEQ, qb, AQN + h * 64, AKN + kv * 64, PROJ + C_AV + kv * 64, YA + h * 64, lds);
  }
}
#endif
DEV void phase_mlstm_a(const Params& p) {
  char* lds = LDS_PTR();
  bf16_t* Ks = (bf16_t*)lds;
  bf16_t* VW = Ks + 64 * 136;
  float* s_lf = (float*)(VW + 2 * 64 * 136); float* s_a = s_lf + 128; float* s_w = s_a + 128;
  constexpr int QPA = 136;
  const bf16_t* PROJ = (const bf16_t*)(p.ws + WS_PROJ); const bf16_t* KC = (const bf16_t*)(p.ws + WS_KC); const float* GATES = (const float*)(p.ws + WS_GATES);
  bf16_t* CST = (bf16_t*)(p.ws + WS_CST); float* NST = (float*)(p.ws + WS_NST); float* AMAX = (float*)(p.ws + WS_AMAX); float* BLAST = (float*)(p.ws + WS_BLAST);
  const int tid = TID, lane = tid & 63, w = tid >> 6, g = lane >> 4, c16 = lane & 15;
  u32x4 pk[2], pv[2]; float pli = 0.f, plf = 0.f;
  auto request = [&](int u) {
    const int c = u % NC, h = (u / NC) % MH, b = u / (NC * MH); const int t0 = b * SEQ + c * ML;
    UNR for (int i = 0; i < 2; ++i) { const int it = tid + NTHREADS * i, r = it >> 4, d8 = (it & 15) * 8;
      pk[i] = *(const u32x4*)(KC + (size_t)(t0 + r) * MW + h * 128 + d8); pv[i] = *(const u32x4*)(PROJ + (size_t)(t0 + r) * NP + C_MV + h * 128 + d8); }
    if (tid < 128) { const int dir = tid >> 6, q = tid & 63; pli = GATES[(size_t)(t0 + q) * 16 + (dir ? 8 : 0) + h]; plf = GATES[(size_t)(t0 + q) * 16 + (dir ? 12 : 4) + h]; }
  };
  int u = BID;
  if (u < BHC) request(u);
  for (; u < BHC; u += NBLK) {
    SYNC();
    UNR for (int i = 0; i < 2; ++i) { const int it = tid + NTHREADS * i, r = it >> 4, d8 = (it & 15) * 8; *(u32x4*)(Ks + r * QPA + d8) = pk[i]; }
    const u32x4 v0 = pv[0], v1 = pv[1];
    if (tid < 128) {
      const int dir = tid >> 6; const float lf = logsigmoidf_(plf), pre = wave_prefix_incl(lf, lane), tot = shfl_f(pre, 63);
      const float a = pli + (dir == 0 ? tot - pre : pre - lf);
      const float mx = wave_max(a);
      s_w[tid] = expf(a - mx);
      if (lane == 0) { AMAX[dir * BHC + u] = mx; BLAST[dir * BHC + u] = tot; } }
    SYNC();
    UNR for (int i = 0; i < 2; ++i) { const int it = tid + NTHREADS * i, r = it >> 4, d8 = (it & 15) * 8; const u32x4 vv = i ? v1 : v0;
      const float wf = s_w[r], wb = s_w[64 + r];
      f32x4 a0, a1;
      a0[0] = __builtin_bit_cast(float, vv.x << 16); a0[1] = __builtin_bit_cast(float, vv.x & 0xffff0000u); a0[2] = __builtin_bit_cast(float, vv.y << 16); a0[3] = __builtin_bit_cast(float, vv.y & 0xffff0000u);
      a1[0] = __builtin_bit_cast(float, vv.z << 16); a1[1] = __builtin_bit_cast(float, vv.z & 0xffff0000u); a1[2] = __builtin_bit_cast(float, vv.w << 16); a1[3] = __builtin_bit_cast(float, vv.w & 0xffff0000u);
      u32x4 of, ob;
      of.x = pk2(a0[0] * wf, a0[1] * wf); of.y = pk2(a0[2] * wf, a0[3] * wf); of.z = pk2(a1[0] * wf, a1[1] * wf); of.w = pk2(a1[2] * wf, a1[3] * wf);
      ob.x = pk2(a0[0] * wb, a0[1] * wb); ob.y = pk2(a0[2] * wb, a0[3] * wb); ob.z = pk2(a1[0] * wb, a1[1] * wb); ob.w = pk2(a1[2] * wb, a1[3] * wb);
      *(u32x4*)(VW + r * QPA + d8) = of; *(u32x4*)(VW + (64 + r) * QPA + d8) = ob; }
    if (u + NBLK < BHC) request(u + NBLK);
    SYNC();
    { const int dir = w >> 2, m2 = w & 3;
      bf16x8 bfr[8][2];
      UNR for (int nt = 0; nt < 8; ++nt) UNR for (int ks = 0; ks < 2; ++ks) { const bf16_t* ba = VW + (dir * 64 + ks * 32 + 8 * g + (c16 >> 2)) * QPA + nt * 16 + 4 * (c16 & 3);
        bfr[nt][ks] = cat8(lds_tr16(ba), lds_tr16(ba + 4 * QPA)); }
      UNR for (int mi = 0; mi < 2; ++mi) { const int e0 = (m2 * 2 + mi) * 16;
        bf16x8 af[2];
        UNR for (int ks = 0; ks < 2; ++ks) { const bf16_t* aa = Ks + (ks * 32 + 8 * g + (c16 >> 2)) * QPA + e0 + 4 * (c16 & 3); af[ks] = cat8(lds_tr16(aa), lds_tr16(aa + 4 * QPA)); }
        UNR for (int nt = 0; nt < 8; ++nt) { f32x4 acc = (f32x4){0.f, 0.f, 0.f, 0.f};
          UNR for (int ks = 0; ks < 2; ++ks) acc = mfma16(af[ks], bfr[nt][ks], acc);
          u32x2 o; o.x = pk2(acc[0], acc[1]); o.y = pk2(acc[2], acc[3]);
          *(u32x2*)(CST + (size_t)(dir * BHC + u) * 16384 + (size_t)(nt * 16 + c16) * 128 + e0 + 4 * g) = o; } } }
    if (tid < 256) { const int dir = tid >> 7, e = tid & 127; float sacc = 0.f;
#pragma unroll 16
      for (int z = 0; z < 64; ++z) sacc += s_w[dir * 64 + z] * bf2f(Ks[z * QPA + e]);
      NST[(size_t)(dir * BHC + u) * 128 + e] = sacc; }
  }
}
DEV void phase_mlstm_scan(const Params& p) {
  bf16_t* CST = (bf16_t*)(p.ws + WS_CST); float* NST = (float*)(p.ws + WS_NST);
  const float* AMAX = (const float*)(p.ws + WS_AMAX); const float* BLAST = (const float*)(p.ws + WS_BLAST); float* MPREV = (float*)(p.ws + WS_MPREV);
  const int gtid = BID * NTHREADS + TID, gstride = NBLK * NTHREADS;
  constexpr int PER = 8192, SB = (NC % 8 == 0) ? 8 : 4;
  for (int it = gtid; it < 2 * BATCH * MH * PER; it += gstride) {
    const int pi = it % PER, dbh = it / PER, dir = dbh / (BATCH * MH), bh = dbh % (BATCH * MH);
    const bool hasn = pi < 64;
    float s0 = 0.f, s1 = 0.f, n0 = 0.f, n1 = 0.f, m = 0.f;
    for (int cc0 = 0; cc0 < NC; cc0 += SB) {
      unsigned in[SB]; float bl[SB], am[SB], i0[SB], i1[SB];
      UNR for (int j = 0; j < SB; ++j) { const int c = dir ? NC - 1 - (cc0 + j) : cc0 + j; const int u = dir * BHC + bh * NC + c;
        in[j] = *((const unsigned*)(CST + (size_t)u * 16384) + pi); bl[j] = BLAST[u]; am[j] = AMAX[u];
        if (hasn) { i0[j] = NST[(size_t)u * 128 + 2 * pi]; i1[j] = NST[(size_t)u * 128 + 2 * pi + 1]; } else { i0[j] = 0.f; i1[j] = 0.f; } }
      UNR for (int j = 0; j < SB; ++j) { const int c = dir ? NC - 1 - (cc0 + j) : cc0 + j; const int u = dir * BHC + bh * NC + c;
        const float mn = fmaxf(bl[j] + m, am[j]), dec = expf(bl[j] + m - mn), inj = expf(am[j] - mn);
        *((unsigned*)(CST + (size_t)u * 16384) + pi) = pk2(s0, s1);
        s0 = dec * s0 + inj * bf2f((bf16_t)(in[j] & 0xffff)); s1 = dec * s1 + inj * bf2f((bf16_t)(in[j] >> 16));
        if (hasn) { NST[(size_t)u * 128 + 2 * pi] = n0; NST[(size_t)u * 128 + 2 * pi + 1] = n1; n0 = dec * n0 + inj * i0[j]; n1 = dec * n1 + inj * i1[j]; }
        if (pi == 0) MPREV[u] = m;
        m = mn; }
    }
  }
}
constexpr int QP = 136;
constexpr int PP = 72;
DEV void phase_mlstm_c(const Params& p, int l) {
  char* lds = LDS_PTR();
  bf16_t* Qs = (bf16_t*)lds; bf16_t* Ks = Qs + 64 * QP; bf16_t* Vs = Ks + 64 * QP;
  bf16_t* Pd = Vs + 64 * QP;
  bf16_t* Qd = Pd + 2 * 64 * PP;
  float* s_lf = (float*)(Qd + 2 * 64 * QP);
  float* s_b = s_lf + 128;
  float* s_li = s_b + 128;
  float* s_n = s_li + 128;
  float* s_m = s_n + 256;
  float* s_ss = s_m + 4;
  const int tid = TID, lane = tid & 63, w = tid >> 6, g = lane >> 4, c16 = lane & 15;
  const bf16_t* PROJ = (const bf16_t*)(p.ws + WS_PROJ); const bf16_t* QC = (const bf16_t*)(p.ws + WS_QC); const bf16_t* KC = (const bf16_t*)(p.ws + WS_KC);
  const float* GATES = (const float*)(p.ws + WS_GATES); const bf16_t* CST = (const bf16_t*)(p.ws + WS_CST); const float* NST = (const float*)(p.ws + WS_NST);
  const float* MPREV = (const float*)(p.ws + WS_MPREV); bf16_t* YM = (bf16_t*)(p.ws + WS_YM);
  const float* ng = p.mlstm_norm_g + (size_t)l * MW;
  u32x4 pq[2], pk[2], pv[2]; float pli = 0.f, plf = 0.f;
  auto request = [&](int u) {
    const int c = u % NC, h = (u / NC) % MH, b = u / (NC * MH); const int t0 = b * SEQ + c * ML;
    UNR for (int i = 0; i < 2; ++i) { const int it = tid + NTHREADS * i, r = it >> 4, d8 = (it & 15) * 8;
      pq[i] = *(const u32x4*)(QC + (size_t)(t0 + r) * MW + h * 128 + d8); pk[i] = *(const u32x4*)(KC + (size_t)(t0 + r) * MW + h * 128 + d8);
      pv[i] = *(const u32x4*)(PROJ + (size_t)(t0 + r) * NP + C_MV + h * 128 + d8); }
    if (tid < 128) { const int dir = tid >> 6, q = tid & 63; pli = GATES[(size_t)(t0 + q) * 16 + (dir ? 8 : 0) + h]; plf = GATES[(size_t)(t0 + q) * 16 + (dir ? 12 : 4) + h]; }
  };
  int u = BID;
  if (u < BHC) request(u);
  for (; u < BHC; u += NBLK) {
    const int c = u % NC, h = (u / NC) % MH, b = u / (NC * MH);
    const int t0 = b * SEQ + c * ML;
    SYNC();
    UNR for (int i = 0; i < 2; ++i) { const int it = tid + NTHREADS * i, r = it >> 4, d8 = (it & 15) * 8;
      *(u32x4*)(Qs + r * QP + d8) = pq[i]; *(u32x4*)(Ks + r * QP + d8) = pk[i]; *(u32x4*)(Vs + r * QP + d8) = pv[i]; }
    if (tid < 128) { const int dir = tid >> 6; const float lf = logsigmoidf_(plf), pre = wave_prefix_incl(lf, lane), tot = shfl_f(pre, 63);
      s_li[tid] = pli; s_b[tid] = (dir == 0) ? pre : tot - pre + lf; }
    if (tid < 256) s_n[tid] = NST[(size_t)((tid >> 7) * BHC + u) * 128 + (tid & 127)];
    if (tid < 2) s_m[tid] = MPREV[tid * BHC + u];
    bf16x8 cfr[2][4];
    UNR for (int dir = 0; dir < 2; ++dir) UNR for (int ks = 0; ks < 4; ++ks) cfr[dir][ks] = ld8(CST + (size_t)(dir * BHC + u) * 16384 + (size_t)(16 * w + c16) * 128 + ks * 32 + g * 8);
    u32x2 ogv[4];
    UNR for (int nt = 0; nt < 4; ++nt) ogv[nt] = *(const u32x2*)(PROJ + (size_t)(t0 + nt * 16 + c16) * NP + C_MO + h * 128 + 16 * w + 4 * g);
    SYNC();
    if (u + NBLK < BHC) request(u + NBLK);
    {
      const int j0 = (w & 3) * 16, dir = w >> 2;
      bf16x8 qa[4]; UNR for (int ks = 0; ks < 4; ++ks) qa[ks] = ld8(Qs + (j0 + c16) * QP + ks * 32 + g * 8);
      f32x4 S[4];
      UNR for (int nt = 0; nt < 4; ++nt) { S[nt] = (f32x4){0.f, 0.f, 0.f, 0.f};
        UNR for (int ks = 0; ks < 4; ++ks) S[nt] = mfma16(qa[ks], ld8(Ks + (nt * 16 + c16) * QP + ks * 32 + g * 8), S[nt]); }
      float qn = 0.f; { const int e0 = g * 32;
        UNR for (int e8 = 0; e8 < 4; ++e8) { const bf16x8 q8 = ld8(Qs + (j0 + c16) * QP + e0 + e8 * 8); const f32x4 n0 = *(const f32x4*)(s_n + dir * 128 + e0 + e8 * 8), n1 = *(const f32x4*)(s_n + dir * 128 + e0 + e8 * 8 + 4);
          UNR for (int j = 0; j < 4; ++j) qn += bf2f((bf16_t)q8[j]) * n0[j] + bf2f((bf16_t)q8[4 + j]) * n1[j]; }
        qn += shfl_xor_f(qn, 16); qn += shfl_xor_f(qn, 32); }
      const float* bb = s_b + dir * 64; const float* li = s_li + dir * 64; const float mp = s_m[dir];
      bf16_t* Pw = Pd + dir * 64 * PP;
      float fsc[4];
      UNR for (int i = 0; i < 4; ++i) {
        const int j = j0 + g * 4 + i; const float bj = bb[j];
        float dv[4], sv[4], mx = -3.0e38f;
        UNR for (int nt = 0; nt < 4; ++nt) { const int lk = nt * 16 + c16; const bool ok = dir ? (lk >= j) : (lk <= j);
          dv[nt] = ok ? (bj - bb[lk] + li[lk]) : -3.0e38f; mx = fmaxf(mx, dv[nt]); }
        mx = grp16_max(mx);
        const float mi = bj + mp, mo = fmaxf(mi, mx);
        float rsum = 0.f;
        UNR for (int nt = 0; nt < 4; ++nt) { sv[nt] = (dv[nt] > -1.0e38f) ? S[nt][i] * expf(dv[nt] - mo) : 0.f; rsum += sv[nt]; }
        rsum = grp16_sum(rsum);
        const float iw = expf(mi - mo);
        const float qnj = shfl_f(qn, g * 4 + i);
        const float den = rsum + iw * qnj;
        const float dinv = 1.f / fmaxf(fabsf(den), expf(-mo));
        UNR for (int nt = 0; nt < 4; ++nt) Pw[j * PP + nt * 16 + c16] = f2bf(sv[nt] * dinv);
        fsc[i] = iw * dinv;
      }
      float fa = 0.f;
      UNR for (int i = 0; i < 4; ++i) { const float tv = shfl_f(fsc[i], (c16 >> 2) * 16); fa = ((lane & 3) == i) ? tv : fa; }
      UNR for (int ks = 0; ks < 4; ++ks) { u32x4 o;
        o.x = pk2(bf2f((bf16_t)qa[ks][0]) * fa, bf2f((bf16_t)qa[ks][1]) * fa); o.y = pk2(bf2f((bf16_t)qa[ks][2]) * fa, bf2f((bf16_t)qa[ks][3]) * fa);
        o.z = pk2(bf2f((bf16_t)qa[ks][4]) * fa, bf2f((bf16_t)qa[ks][5]) * fa); o.w = pk2(bf2f((bf16_t)qa[ks][6]) * fa, bf2f((bf16_t)qa[ks][7]) * fa);
        *(u32x4*)(Qd + (dir * 64 + j0 + c16) * QP + ks * 32 + g * 8) = o; }
    }
    SYNC();
    {
      f32x4 acc[4]; UNR for (int nt = 0; nt < 4; ++nt) acc[nt] = (f32x4){0.f, 0.f, 0.f, 0.f};
      bf16x8 vt[2];
      UNR for (int ks = 0; ks < 2; ++ks) { const bf16_t* va = Vs + (ks * 32 + 8 * g + (c16 >> 2)) * QP + 16 * w + 4 * (c16 & 3);
        vt[ks] = cat8(lds_tr16(va), lds_tr16(va + 4 * QP)); }
      UNR for (int dir = 0; dir < 2; ++dir) {
        UNR for (int ks = 0; ks < 2; ++ks) UNR for (int nt = 0; nt < 4; ++nt) acc[nt] = mfma16(vt[ks], ld8(Pd + (dir * 64 + nt * 16 + c16) * PP + ks * 32 + g * 8), acc[nt]);
        UNR for (int ks = 0; ks < 4; ++ks) UNR for (int nt = 0; nt < 4; ++nt) acc[nt] = mfma16(cfr[dir][ks], ld8(Qd + (dir * 64 + nt * 16 + c16) * QP + ks * 32 + g * 8), acc[nt]);
      }
      UNR for (int nt = 0; nt < 4; ++nt) { float ss = acc[nt][0] * acc[nt][0] + acc[nt][1] * acc[nt][1] + acc[nt][2] * acc[nt][2] + acc[nt][3] * acc[nt][3];
        ss += shfl_xor_f(ss, 16); ss += shfl_xor_f(ss, 32);
        if (g == 0) s_ss[w * 64 + nt * 16 + c16] = ss; }
      SYNC();
      const f32x4 gv = *(const f32x4*)(ng + h * 128 + 16 * w + 4 * g);
      UNR for (int nt = 0; nt < 4; ++nt) { const int j = nt * 16 + c16; float tot = 0.f; UNR for (int ww = 0; ww < 8; ++ww) tot += s_ss[ww * 64 + j];
        const float rs = 1.f / sqrtf(tot * (1.f / 128.f) + EPS);
        const float o0 = bf2f((bf16_t)(ogv[nt].x & 0xffff)), o1 = bf2f((bf16_t)(ogv[nt].x >> 16)), o2 = bf2f((bf16_t)(ogv[nt].y & 0xffff)), o3 = bf2f((bf16_t)(ogv[nt].y >> 16));
        u32x2 o; o.x = pk2(acc[nt][0] * rs * gv[0] * sigmoidf_(o0), acc[nt][1] * rs * gv[1] * sigmoidf_(o1)); o.y = pk2(acc[nt][2] * rs * gv[2] * sigmoidf_(o2), acc[nt][3] * rs * gv[3] * sigmoidf_(o3));
        *(u32x2*)(YM + (size_t)(t0 + j) * MW + h * 128 + 16 * w + 4 * g) = o; }
    }
  }
}

#ifndef EMU
#define XB_TMO      128
#define XB_XCNT(j)  (256  + 64 * (j))
#define XB_XSUB(j)  (1280 + 64 * (j))
#define XB_XGEN(j)  (2304 + 64 * (j))
#define XB_TOP      3328
#define XB_TOPGEN   3392
#define XCD_BAR_WORDS 3456
#define XB_SPIN_CAP (1u << 18)
#define LAS __attribute__((address_space(3)))
__device__ __forceinline__ unsigned xb_ld(unsigned* p)              { return __hip_atomic_load(p, __ATOMIC_RELAXED, __HIP_MEMORY_SCOPE_AGENT); }
__device__ __forceinline__ unsigned xb_add(unsigned* p, unsigned v) { return __hip_atomic_fetch_add(p, v, __ATOMIC_RELAXED, __HIP_MEMORY_SCOPE_AGENT); }
__device__ __forceinline__ unsigned xb_xcc_id() { return (unsigned)__builtin_amdgcn_s_getreg((3 << 11) | 20) & 0xFu; }
#define XB_SPIN(cond, bar) do { unsigned _sp = 0; while (cond) { __builtin_amdgcn_s_sleep(1); \
    if ((++_sp & 255u) == 0u) { if (xb_ld(&(bar)[XB_TMO])) break; if (_sp > XB_SPIN_CAP) { atomicAdd(&(bar)[XB_TMO], 1u); break; } } } } while (0)
struct XcdBarrier { unsigned* bar; unsigned x; volatile LAS unsigned* st; };
__device__ __forceinline__ XcdBarrier xcd_barrier_post(unsigned* bar, volatile LAS unsigned* st) {
    XcdBarrier b; b.bar = bar; b.x = xb_xcc_id(); b.st = st;
    if (threadIdx.x == 0) (void)xb_add(&bar[XB_XCNT(b.x)], 1u);
    return b;
}
__device__ __forceinline__ void xcd_barrier_complete(unsigned* bar, unsigned x, unsigned& nloc, unsigned& nx) {
    const unsigned G = gridDim.x * gridDim.y * gridDim.z;
    unsigned sum, cnt, mine, sp = 0u;
    for (;;) {
        sum = 0u; cnt = 0u; mine = 0u;
#pragma unroll
        for (unsigned j = 0; j < 16; ++j) { const unsigned c = xb_ld(&bar[XB_XCNT(j)]); sum += c; cnt += (c > 0u) ? 1u : 0u; mine = (j == x) ? c : mine; }
        if (sum == G) break;
        __builtin_amdgcn_s_sleep(1);
        if ((++sp & 255u) == 0u) { if (xb_ld(&bar[XB_TMO])) break; if (sp > XB_SPIN_CAP) { atomicAdd(&bar[XB_TMO], 1u); break; } }
    }
    nloc = mine > 0u ? mine : 1u; nx = cnt > 0u ? cnt : 1u;
}
__device__ __forceinline__ void xcd_barrier(const XcdBarrier& b) {
    asm volatile("s_waitcnt vmcnt(0)" ::: "memory");
    __syncthreads();
    if (threadIdx.x == 0) {
        unsigned* bar = b.bar;
        __builtin_amdgcn_s_waitcnt(0);
        unsigned nloc = b.st[0], nx = b.st[1];
        if (nloc == 0u) { xcd_barrier_complete(bar, b.x, nloc, nx); b.st[0] = nloc; b.st[1] = nx; }
        const unsigned old = xb_add(&bar[XB_XSUB(b.x)], 1u);
        const unsigned gen = old / nloc;
        if (old + 1u == (gen + 1u) * nloc) {
            __builtin_amdgcn_fence(__ATOMIC_RELEASE, "agent");
            asm volatile("s_waitcnt vmcnt(0)" ::: "memory");
            const unsigned og = xb_add(&bar[XB_TOP], 1u);
            const unsigned tg = og / nx;
            if (og + 1u == (tg + 1u) * nx) xb_add(&bar[XB_TOPGEN], 1u);
            else XB_SPIN(xb_ld(&bar[XB_TOPGEN]) == tg, bar);
            __builtin_amdgcn_fence(__ATOMIC_ACQUIRE, "agent");
            xb_add(&bar[XB_XGEN(b.x)], 1u);
            asm volatile("s_waitcnt vmcnt(0)" ::: "memory");
        } else {
            XB_SPIN(xb_ld(&bar[XB_XGEN(b.x)]) == gen, bar);
            __builtin_amdgcn_fence(__ATOMIC_ACQUIRE, "agent");
            asm volatile("s_waitcnt vmcnt(0)" ::: "memory");
        }
    }
    __syncthreads();
}
__device__ __forceinline__ Params fresh(const Params& p) { Params q = p; unsigned long long w = (unsigned long long)q.ws; asm volatile("" : "+s"(w)); q.ws = (unsigned char*)w; return q; }
#define GRID_BAR() do { XcdBarrier xb_ = xbar; unsigned long long bw_ = (unsigned long long)xb_.bar; asm volatile("" : "+s"(bw_)); xb_.bar = (unsigned*)bw_; xcd_barrier(xb_); } while (0)
__global__ void __launch_bounds__(NTHREADS, 2) k_fwd(Params p) {
  {
    volatile LAS unsigned* st = (volatile LAS unsigned*)(LAS char*)(dyn_lds + LDS_PHASE_BYTES);
    if (threadIdx.x == 0) { st[0] = 0u; st[1] = 0u; st[2] = 0u; st[3] = 0u; }
    __syncthreads();
  }
  const XcdBarrier xbar = xcd_barrier_post((unsigned*)(p.ws + WS_CTL) + CW_BAR, (volatile LAS unsigned*)(LAS char*)(dyn_lds + LDS_PHASE_BYTES));
#else
#define GRID_BAR() emu_gridsync()
static inline Params fresh(const Params& p) { return p; }
static void k_fwd(Params p) {
#endif
  if (PHMASK & (1u << 0)) { phase_mod_rope(fresh(p)); if (DUP_PHASE == 0) { GRID_BAR(); phase_mod_rope(fresh(p)); } }
  for (int l = 0; l < DEPTH; ++l) {
    if (PHMASK & (1u << 1)) { phase_convert(fresh(p), l); if (DUP_PHASE == 1) { GRID_BAR(); phase_convert(fresh(p), l); } }
    GRID_BAR();
    if (PHMASK & (1u << 2)) { if (l == 0) phase_norm(fresh(p), l, 0, 0); else phase_norm(fresh(p), l, 1, 0); if (DUP_PHASE == 2 && l == 0) { GRID_BAR(); phase_norm(fresh(p), l, 0, 0); } }
    GRID_BAR();
    if (PHMASK & (1u << 3)) { phase_gemm_in(fresh(p), l); if (DUP_PHASE == 3) { GRID_BAR(); phase_gemm_in(fresh(p), l); } }
    GRID_BAR();
    if (PHMASK & (1u << 4)) { phase_prep(fresh(p), l); if (DUP_PHASE == 4) { GRID_BAR(); phase_prep(fresh(p), l); } }
    GRID_BAR();
    if (PHMASK & (1u << 5)) { phase_mlstm_a(fresh(p)); if (DUP_PHASE == 5) { GRID_BAR(); phase_mlstm_a(fresh(p)); } }
    GRID_BAR();
    if (PHMASK & (1u << 6)) { phase_mlstm_scan(fresh(p)); if (DUP_PHASE == 6) { GRID_BAR(); phase_mlstm_scan(fresh(p)); } }
    if (PHMASK & (1u << 7)) { phase_attn(fresh(p)); if (DUP_PHASE == 7) { GRID_BAR(); phase_attn(fresh(p)); } }
    GRID_BAR();
    if (PHMASK & (1u << 8)) { phase_mlstm_c(fresh(p), l); if (DUP_PHASE == 8) { GRID_BAR(); phase_mlstm_c(fresh(p), l); } }
    GRID_BAR();
    if (PHMASK & (1u << 9)) { phase_gemm_merge(fresh(p)); if (DUP_PHASE == 9) { GRID_BAR(); phase_gemm_merge(fresh(p)); } }
    GRID_BAR();
    if (PHMASK & (1u << 10)) { phase_gemm_out(fresh(p), l); if (DUP_PHASE == 10) { GRID_BAR(); phase_gemm_out(fresh(p), l); } }
    GRID_BAR();
    if (PHMASK & (1u << 11)) { phase_norm2_router(fresh(p), l); if (DUP_PHASE == 11) { GRID_BAR(); phase_norm2_router(fresh(p), l, true); } }
    GRID_BAR();
    if (PHMASK & (1u << 15)) { phase_moe_gather(fresh(p), l); if (DUP_PHASE == 15) { GRID_BAR(); phase_moe_gather(fresh(p), l); } }
    GRID_BAR();
    if (PHMASK & (1u << 12)) { phase_moe_up(fresh(p), l); if (DUP_PHASE == 12) { GRID_BAR(); phase_moe_up(fresh(p), l); } }
    GRID_BAR();
    if (PHMASK & (1u << 13)) { phase_moe_down(fresh(p), l); if (DUP_PHASE == 13) { GRID_BAR(); phase_moe_down(fresh(p), l); } }
    GRID_BAR();
  }
  if (PHMASK & (1u << 14)) { phase_norm(fresh(p), DEPTH, 1, 2); if (DUP_PHASE == 14) { GRID_BAR(); phase_norm(fresh(p), DEPTH, 1, 2); } }
}

#ifdef EMU
static int emu_grid_size = 8;
static int emu_stop_after = 1000;
#endif
extern "C" void kernel_launch(void* const* d_in, const int* in_sizes, int n_in, void* d_out, int out_size, void* d_ws, size_t ws_size, hipStream_t stream) {
  (void)in_sizes; (void)n_in; (void)out_size;
  if (ws_size < WS_TOTAL) { fprintf(stderr, "workspace too small: %zu < %zu\n", ws_size, (size_t)WS_TOTAL); return; }
  Params prm{};
  const float** f = (const float**)&prm;
  for (int i = 0; i < 24; ++i) f[i] = (const float*)d_in[i];
  prm.out = (float*)d_out; prm.ws = (unsigned char*)d_ws;
#ifdef EMU
  memset(d_ws, 0, CTL_BYTES);
  emu_launch(emu_grid_size, NTHREADS, LDS_BYTES, [=]() { k_fwd(prm); }, true);
#else
  static int grid = 0;
  if (!grid) {
    int dev = 0, cus = 0, per_cu = 0;
    (void)hipGetDevice(&dev);
    (void)hipDeviceGetAttribute(&cus, hipDeviceAttributeMultiprocessorCount, dev);
    (void)hipFuncSetAttribute((const void*)k_fwd, hipFuncAttributeMaxDynamicSharedMemorySize, LDS_BYTES);
    (void)hipOccupancyMaxActiveBlocksPerMultiprocessor(&per_cu, k_fwd, NTHREADS, LDS_BYTES);
    grid = cus * (per_cu < 1 ? per_cu : 1);
    if (grid <= 0) { fprintf(stderr, "occupancy query says the kernel does not fit (cus %d per_cu %d)\n", cus, per_cu); grid = 0; return; }
  }
  (void)hipMemsetAsync(d_ws, 0, CTL_BYTES, stream);
  k_fwd<<<grid, NTHREADS, LDS_BYTES, stream>>>(prm);
#endif
}
```

```cpp
#ifdef EMU
#include "emu.h"
#define TID emu_tid()
#define BID emu_bid()
#define NBLK emu_nblk()
#define SYNC() emu_syncthreads()
#define DEV static inline
#define DEVM inline
#else
#include <hip/hip_runtime.h>
#include <cstdio>
#include <cstdint>
__device__ __forceinline__ int tid_opaque() { int t = (int)threadIdx.x; asm volatile("" : "+v"(t)); return t; }
#define TID tid_opaque()
#define BID ((int)blockIdx.x)
#define NBLK ((int)gridDim.x)
#define SYNC() __syncthreads()
#define DEV __device__ __forceinline__
#define DEVM __device__ __forceinline__
#endif

#ifndef CFG_SEQ
#define CFG_SEQ 8192
#endif
#ifndef CFG_BATCH
#define CFG_BATCH 2
#endif

#ifndef DUP_PHASE
#define DUP_PHASE (-1)
#endif
#ifndef PHMASK
#define PHMASK 0xFFFFFFFFu
#endif
#define UNR _Pragma("unroll")
typedef unsigned short bf16_t;
typedef short bf16x8 __attribute__((ext_vector_type(8)));
typedef float f32x4 __attribute__((ext_vector_type(4)));
typedef unsigned u32x4 __attribute__((ext_vector_type(4)));
typedef unsigned u32x2 __attribute__((ext_vector_type(2)));

constexpr int D = 1024, BATCH = CFG_BATCH, SEQ = CFG_SEQ, DEPTH = 2, T = BATCH * SEQ;
constexpr int GRID_W = 64;
constexpr int MH = 4, MHD = 128, MW = 512, ML = 64, NC = SEQ / ML, CONVW = 5;
constexpr int AH = 8, KVH = 2, AHD = 64, AW = 512, KVW = 128;
constexpr int NG = 4, EPG = 8, NE = 32, FF = 512;
constexpr float EPS = 1e-6f;
constexpr int IN_W = 4880, NP = 5120;
constexpr int C_MQ = 0, C_MK = 512, C_MV = 1024, C_MO = 1536, C_GATES = 2048, C_AQ = 2064, C_AK = 2576, C_AV = 2704, C_GM = 2832, C_GA = 3856;
constexpr int NTHREADS = 512;
constexpr int BHC = BATCH * MH * NC;
constexpr int ROWT_MAX = (2 * T) / 256 + NE;
constexpr int SLOT_ROWS = ROWT_MAX * 256;

constexpr size_t al256(size_t x) { return (x + 255) & ~(size_t)255; }
constexpr size_t WS_CTL = 0, CTL_BYTES = 1 << 20;
constexpr size_t WS_MOD = WS_CTL + CTL_BYTES;
constexpr size_t WS_ROPE = WS_MOD + al256((size_t)DEPTH * BATCH * 6 * D * 4);
constexpr size_t WS_WIN = WS_ROPE + al256((size_t)(2 * (SEQ / GRID_W) * 16 + 2 * 64 * 16) * 4);
constexpr size_t WS_WBM = WS_WIN + (size_t)NP * D * 2;
constexpr size_t WS_WBA = WS_WBM + (size_t)D * MW * 2;
constexpr size_t WS_WOUT = WS_WBA + (size_t)D * AW * 2;
constexpr size_t WS_WGU = WS_WOUT + (size_t)D * D * 2;
constexpr size_t WS_WD = WS_WGU + (size_t)NE * 2 * FF * D * 2;
constexpr size_t WS_PROJ = WS_WD + (size_t)NE * D * FF * 2;
constexpr size_t WS_ACT = WS_PROJ;
constexpr size_t WS_Y = WS_ACT + al256((size_t)SLOT_ROWS * FF * 2);
constexpr size_t PROJ_BYTES = (size_t)T * NP * 2;
constexpr size_t OVL_BYTES = (WS_Y + (size_t)2 * T * D * 2 - WS_PROJ) > PROJ_BYTES ? (WS_Y + (size_t)2 * T * D * 2 - WS_PROJ) : PROJ_BYTES;
constexpr size_t WS_GATES = WS_PROJ + al256(OVL_BYTES);
constexpr size_t WS_QC = WS_GATES + (size_t)T * 16 * 4;
constexpr size_t WS_KC = WS_QC + (size_t)T * MW * 2;
constexpr size_t WS_MERGED = WS_QC;
constexpr size_t WS_AQN = WS_KC + (size_t)T * MW * 2;
constexpr size_t WS_AKN = WS_AQN + (size_t)T * AW * 2;
constexpr size_t WS_VT = WS_AKN + (size_t)T * KVW * 2;
constexpr size_t WS_YM = WS_VT + (size_t)T * KVW * 2;
constexpr size_t WS_YA = WS_YM + (size_t)T * MW * 2;
constexpr size_t WS_CST = WS_YA + (size_t)T * AW * 2;
constexpr size_t WS_H = WS_CST;
constexpr size_t WS_TMP = WS_CST;
constexpr size_t CST_BYTES = (size_t)2 * BHC * 128 * 128 * 2;
static_assert((size_t)T * D * 4 <= CST_BYTES, "H and TMP fit in CST");
constexpr size_t WS_NST = WS_CST + CST_BYTES;
constexpr size_t WS_AMAX = WS_NST + (size_t)2 * BHC * 128 * 4;
constexpr size_t WS_BLAST = WS_AMAX + al256((size_t)2 * BHC * 4);
constexpr size_t WS_MPREV = WS_BLAST + al256((size_t)2 * BHC * 4);
constexpr size_t WS_LIST = WS_MPREV + al256((size_t)2 * BHC * 4);
constexpr size_t WS_WENT = WS_LIST + (size_t)NE * T * 4;
constexpr size_t WS_TOTAL = WS_WENT + (size_t)2 * T * 4;
constexpr int CW_CNT = 64;
constexpr int CW_BAR = 4096;

struct Params {
  const float *x, *c, *w_ada, *b_ada, *norm1_g, *w_in, *b_in, *conv_w, *conv_b, *mlstm_norm_g, *q_norm_g, *k_norm_g, *w_branch_m, *w_branch_a, *w_out, *norm2_g,
      *w_rg, *b_rg, *w_re, *b_re, *w_gate, *w_up, *w_down, *final_g;
  float* out; unsigned char* ws;
};

DEV float bf2f(bf16_t h) { return __builtin_bit_cast(float, (unsigned)h << 16); }
DEV bf16_t f2bf(float f) { unsigned u = __builtin_bit_cast(unsigned, f); return (bf16_t)((u + 0x7fffu + ((u >> 16) & 1u)) >> 16); }
DEV unsigned pk2(float lo, float hi) { return (unsigned)f2bf(lo) | ((unsigned)f2bf(hi) << 16); }
#ifdef EMU
DEV float sigmoidf_(float x) { return 1.f / (1.f + expf(-x)); }
DEV float siluf_(float x) { return x / (1.f + expf(-x)); }
#else
DEV float sigmoidf_(float x) { return __builtin_amdgcn_rcpf(1.f + __builtin_amdgcn_exp2f(-1.4426950408889634f * x)); }
DEV float siluf_(float x) { return x * __builtin_amdgcn_rcpf(1.f + __builtin_amdgcn_exp2f(-1.4426950408889634f * x)); }
#endif
#ifdef EMU
DEV float fexp(float x) { return expf(x); }
DEV float frcp(float x) { return 1.f / x; }
DEV float frsq(float x) { return 1.f / sqrtf(x); }
DEV float logsigmoidf_(float x) { return fminf(x, 0.f) - log1pf(expf(-fabsf(x))); }
#else
DEV float fexp(float x) { return __builtin_amdgcn_exp2f(1.4426950408889634f * x); }
DEV float frcp(float x) { return __builtin_amdgcn_rcpf(x); }
DEV float frsq(float x) { return __builtin_amdgcn_rsqf(x); }
DEV float logsigmoidf_(float x) { return fminf(x, 0.f) - 0.6931471805599453f * __builtin_amdgcn_logf(1.f + __builtin_amdgcn_exp2f(-1.4426950408889634f * fabsf(x))); }
#endif

#ifdef EMU
static inline f32x4 mfma16(bf16x8 a, bf16x8 b, f32x4 c) {
  struct In { bf16x8 a, b; f32x4 c; } in{a, b, c}; f32x4 out;
  emu_collective(&in, sizeof(In), &out, sizeof(out), [](char (*I)[64], char (*O)[32]) {
    float Dm[16][16];
    for (int r = 0; r < 16; ++r) for (int cc = 0; cc < 16; ++cc) { In* L = (In*)I[(r >> 2) * 16 + cc]; Dm[r][cc] = L->c[r & 3]; }
    for (int r = 0; r < 16; ++r) for (int cc = 0; cc < 16; ++cc) { float s = 0.f;
      for (int g = 0; g < 4; ++g) { In* LA = (In*)I[g * 16 + r]; In* LB = (In*)I[g * 16 + cc]; for (int j = 0; j < 8; ++j) s += bf2f((bf16_t)LA->a[j]) * bf2f((bf16_t)LB->b[j]); }
      Dm[r][cc] += s; }
    for (int l = 0; l < 64; ++l) { f32x4 o; for (int i = 0; i < 4; ++i) o[i] = Dm[(l >> 4) * 4 + i][l & 15]; memcpy(O[l], &o, 16); } });
  return out;
}
static inline f32x4 mfma4f32(float a, float b, f32x4 c) {
  struct In { float a, b; f32x4 c; } in{a, b, c}; f32x4 out;
  emu_collective(&in, sizeof(In), &out, sizeof(out), [](char (*I)[64], char (*O)[32]) {
    for (int l = 0; l < 64; ++l) { f32x4 o; UNR for (int i = 0; i < 4; ++i) { const int r = (l >> 4) * 4 + i, cc = l & 15; float s = ((In*)I[l])->c[i];
      for (int k = 0; k < 4; ++k) s = fmaf(((In*)I[k * 16 + r])->a, ((In*)I[k * 16 + cc])->b, s); o[i] = s; } memcpy(O[l], &o, 16); } });
  return out;
}
static inline float shfl_xor_f(float v, int m) { float out; emu_collective(&v, 4, &out, 4, [m](char (*I)[64], char (*O)[32]) { for (int l = 0; l < 64; ++l) memcpy(O[l], I[l ^ m], 4); }); return out; }
static inline float shfl_f(float v, int src) { struct In { float v; int s; } in{v, src}; float out;
  emu_collective(&in, 8, &out, 4, [](char (*I)[64], char (*O)[32]) { for (int l = 0; l < 64; ++l) { In* me = (In*)I[l]; memcpy(O[l], I[me->s & 63], 4); } }); return out; }
static inline int atomic_add_i(int* p, int v) { return __atomic_fetch_add(p, v, __ATOMIC_RELAXED); }
#define LDS_PTR() emu_lds()
#else
DEV f32x4 mfma16(bf16x8 a, bf16x8 b, f32x4 c) { return __builtin_amdgcn_mfma_f32_16x16x32_bf16(a, b, c, 0, 0, 0); }
DEV f32x4 mfma4f32(float a, float b, f32x4 c) { return __builtin_amdgcn_mfma_f32_16x16x4f32(a, b, c, 0, 0, 0); }
DEV float shfl_xor_f(float v, int m) {
  const int iv = __builtin_bit_cast(int, v);
  switch (m) {
    case 1: return __builtin_bit_cast(float, __builtin_amdgcn_ds_swizzle(iv, (1 << 10) | 0x1f));
    case 2: return __builtin_bit_cast(float, __builtin_amdgcn_ds_swizzle(iv, (2 << 10) | 0x1f));
    case 4: return __builtin_bit_cast(float, __builtin_amdgcn_ds_swizzle(iv, (4 << 10) | 0x1f));
    case 8: return __builtin_bit_cast(float, __builtin_amdgcn_ds_swizzle(iv, (8 << 10) | 0x1f));
    case 16: return __builtin_bit_cast(float, __builtin_amdgcn_ds_swizzle(iv, (16 << 10) | 0x1f));
    default: { const int lane = TID & 63; return __builtin_bit_cast(float, __builtin_amdgcn_ds_bpermute(((lane ^ m) & 63) << 2, iv)); }
  }
}
DEV float shfl_f(float v, int src) { return __builtin_bit_cast(float, __builtin_amdgcn_ds_bpermute((src & 63) << 2, __builtin_bit_cast(int, v))); }
DEV int atomic_add_i(int* p, int v) { return atomicAdd(p, v); }
extern __shared__ __attribute__((aligned(16))) char dyn_lds[];
#define LDS_PTR() (dyn_lds)
#endif
typedef short s16x4 __attribute__((ext_vector_type(4)));
#ifdef EMU
static inline s16x4 lds_tr16(const bf16_t* addr) { s16x4 out;
  emu_collective(&addr, sizeof(addr), &out, sizeof(out), [](char (*I)[64], char (*O)[32]) {
    for (int l = 0; l < 64; ++l) { const int g = l >> 4, i = l & 15; s16x4 o;
      for (int q = 0; q < 4; ++q) { const bf16_t* a; memcpy(&a, I[16 * g + 4 * q + (i >> 2)], sizeof(a)); o[q] = (short)a[i & 3]; }
      memcpy(O[l], &o, 8); } });
  return out; }
#else
DEV s16x4 lds_tr16(const bf16_t* addr) { return __builtin_bit_cast(s16x4, __builtin_amdgcn_ds_read_tr16_b64_v4i16((__attribute__((address_space(3))) s16x4*)addr)); }
#endif
DEV bf16x8 cat8(s16x4 a, s16x4 b) { return (bf16x8){a[0], a[1], a[2], a[3], b[0], b[1], b[2], b[3]}; }
DEV float grp16_sum(float v) { v += shfl_xor_f(v, 1); v += shfl_xor_f(v, 2); v += shfl_xor_f(v, 4); v += shfl_xor_f(v, 8); return v; }
DEV float grp16_max(float v) { v = fmaxf(v, shfl_xor_f(v, 1)); v = fmaxf(v, shfl_xor_f(v, 2)); v = fmaxf(v, shfl_xor_f(v, 4)); v = fmaxf(v, shfl_xor_f(v, 8)); return v; }
DEV float wave_prefix_incl(float v, int lane) { UNR for (int o = 0; o < 6; ++o) { const int off = 1 << o; const float t = shfl_f(v, lane - off); v += (lane >= off) ? t : 0.f; } return v; }
DEV float wave_max(float v) { v = grp16_max(v); v = fmaxf(v, shfl_xor_f(v, 16)); v = fmaxf(v, shfl_xor_f(v, 32)); return v; }
DEV float wave_sum(float v) { v = grp16_sum(v); v += shfl_xor_f(v, 16); v += shfl_xor_f(v, 32); return v; }
DEV bf16x8 ld8(const bf16_t* p) { return __builtin_bit_cast(bf16x8, *(const u32x4*)p); }

DEV void phase_mod_rope(const Params& p) {
  float* mod = (float*)(p.ws + WS_MOD);
  const int gtid = BID * NTHREADS + TID, gstride = NBLK * NTHREADS;
  {
    float* red = (float*)LDS_PTR();
    const int tid = TID, j = tid & 63, q = tid >> 6;
    for (int it = BID; it < DEPTH * (6 * D / 64); it += NBLK) {
      const int l = it / (6 * D / 64), n0 = (it % (6 * D / 64)) * 64;
      const float* w = p.w_ada + (size_t)l * D * 6 * D + (size_t)(128 * q) * 6 * D + n0 + j;
      float s[BATCH]; UNR for (int b = 0; b < BATCH; ++b) s[b] = 0.f;
#pragma unroll 16
      for (int k = 0; k < 128; ++k) { const float wv = w[(size_t)k * 6 * D];
        UNR for (int b = 0; b < BATCH; ++b) s[b] += siluf_(p.c[b * D + 128 * q + k]) * wv; }
      SYNC();
      UNR for (int b = 0; b < BATCH; ++b) red[(q * BATCH + b) * 64 + j] = s[b];
      SYNC();
      if (tid < BATCH * 64) { const int b = tid >> 6; float a = p.b_ada[l * 6 * D + n0 + j];
        UNR for (int qq = 0; qq < 8; ++qq) a += red[(qq * BATCH + b) * 64 + j];
        mod[((size_t)l * BATCH + b) * 6 * D + n0 + j] = a; }
    }
    SYNC();
  }
  float* rope = (float*)(p.ws + WS_ROPE);
  constexpr int NR = SEQ / GRID_W;
  for (int o = gtid; o < (NR + 64) * 16; o += gstride) {
    const int i = o & 15, pos = o >> 4;
    const float inv = powf(10000.f, -(float)(2 * i) / 32.f);
    if (pos < NR) { const float a = (float)pos * inv; rope[pos * 16 + i] = cosf(a); rope[NR * 16 + pos * 16 + i] = sinf(a); }
    else { const int cpos = pos - NR; const float a = (float)cpos * inv; rope[2 * NR * 16 + cpos * 16 + i] = cosf(a); rope[2 * NR * 16 + 64 * 16 + cpos * 16 + i] = sinf(a); }
  }
}
constexpr int TPP = 257;
DEV void transpose_item(char* lds, const float* src, int K, int N, bf16_t* dst, int mode, int item) {
  float* tile = (float*)lds;
  const int ntn = (N + 255) / 256, tk = item / ntn, tn = item % ntn, tid = TID;
  const int k0 = tk * 64, n0 = tn * 256;
  { const int c = (tid & 63) * 4; f32x4 v[8];
    UNR for (int i = 0; i < 8; ++i) { const int kk = (tid >> 6) + 8 * i; v[i] = (n0 + c < N) ? *(const f32x4*)(src + (size_t)(k0 + kk) * N + n0 + c) : (f32x4){0.f, 0.f, 0.f, 0.f}; }
    UNR for (int i = 0; i < 8; ++i) { const int kk = (tid >> 6) + 8 * i; UNR for (int j = 0; j < 4; ++j) tile[kk * TPP + c + j] = v[i][j]; } }
  SYNC();
  { const int k8 = (tid & 7) * 8;
    UNR for (int i = 0; i < 4; ++i) { const int nn = (tid >> 3) + 64 * i, n = n0 + nn;
      if (n < N) {
        int row = n; if (mode == 1) row = 32 * (n >> 4) + (n & 15); else if (mode == 2) row = 32 * (n >> 4) + 16 + (n & 15);
        u32x4 w; w.x = pk2(tile[(k8 + 0) * TPP + nn], tile[(k8 + 1) * TPP + nn]); w.y = pk2(tile[(k8 + 2) * TPP + nn], tile[(k8 + 3) * TPP + nn]);
        w.z = pk2(tile[(k8 + 4) * TPP + nn], tile[(k8 + 5) * TPP + nn]); w.w = pk2(tile[(k8 + 6) * TPP + nn], tile[(k8 + 7) * TPP + nn]);
        *(u32x4*)(dst + (size_t)row * K + k0 + k8) = w; } } }
  SYNC();
}
DEV void phase_convert(const Params& p, int l) {
  char* lds = LDS_PTR();
  constexpr int I_IN = (D / 64) * ((IN_W + 255) / 256), I_BM = (MW / 64) * (D / 256), I_BA = (AW / 64) * (D / 256), I_OUT = (D / 64) * (D / 256);
  constexpr int I_G = (D / 64) * (FF / 256), I_D = (FF / 64) * (D / 256);
  constexpr int B1 = I_IN, B2 = B1 + I_BM, B3 = B2 + I_BA, B4 = B3 + I_OUT, B5 = B4 + NE * I_G, B6 = B5 + NE * I_G, B7 = B6 + NE * I_D;
  for (int it = BID; it < B7; it += NBLK) {
    if (it < B1) transpose_item(lds, p.w_in + (size_t)l * D * IN_W, D, IN_W, (bf16_t*)(p.ws + WS_WIN), 0, it);
    else if (it < B2) transpose_item(lds, p.w_branch_m + (size_t)l * MW * D, MW, D, (bf16_t*)(p.ws + WS_WBM), 0, it - B1);
    else if (it < B3) transpose_item(lds, p.w_branch_a + (size_t)l * AW * D, AW, D, (bf16_t*)(p.ws + WS_WBA), 0, it - B2);
    else if (it < B4) transpose_item(lds, p.w_out + (size_t)l * D * D, D, D, (bf16_t*)(p.ws + WS_WOUT), 0, it - B3);
    else if (it < B5) { const int e = (it - B4) / I_G, r = (it - B4) % I_G; transpose_item(lds, p.w_gate + ((size_t)l * NE + e) * D * FF, D, FF, (bf16_t*)(p.ws + WS_WGU) + (size_t)e * 2 * FF * D, 1, r); }
    else if (it < B6) { const int e = (it - B5) / I_G, r = (it - B5) % I_G; transpose_item(lds, p.w_up + ((size_t)l * NE + e) * D * FF, D, FF, (bf16_t*)(p.ws + WS_WGU) + (size_t)e * 2 * FF * D, 2, r); }
    else { const int e = (it - B6) / I_D, r = (it - B6) % I_D; transpose_item(lds, p.w_down + ((size_t)l * NE + e) * FF * D, FF, D, (bf16_t*)(p.ws + WS_WD) + (size_t)e * D * FF, 0, r); }
  }
}

DEV void phase_norm(const Params& p, int l, int mode, int which) {
  const int lane = TID & 63, wv = TID >> 6, nwv = NTHREADS / 64;
  const float* mod = (const float*)(p.ws + WS_MOD);
  bf16_t* H = (bf16_t*)(p.ws + WS_H);
  const bf16_t* Y = (const bf16_t*)(p.ws + WS_Y);
  for (int t = BID * nwv + wv; t < T; t += NBLK * nwv) {
    const int b = t / SEQ;
    f32x4 v[4]; float ss = 0.f;
    UNR for (int i = 0; i < 4; ++i) {
      const int c4 = lane + 64 * i;
      if (mode == 0) v[i] = ((const f32x4*)(p.x + (size_t)t * D))[c4];
      else {
        v[i] = ((const f32x4*)(p.out + (size_t)t * D))[c4];
        if (mode == 1) {
          const f32x4 g2 = ((const f32x4*)(mod + ((size_t)(l - 1) * BATCH + b) * 6 * D + 5 * D))[c4];
          const u32x2 y0 = ((const u32x2*)(Y + (size_t)(2 * t) * D))[c4], y1 = ((const u32x2*)(Y + (size_t)(2 * t + 1) * D))[c4];
          v[i][0] += g2[0] * (bf2f((bf16_t)(y0.x & 0xffff)) + bf2f((bf16_t)(y1.x & 0xffff)));
          v[i][1] += g2[1] * (bf2f((bf16_t)(y0.x >> 16)) + bf2f((bf16_t)(y1.x >> 16)));
          v[i][2] += g2[2] * (bf2f((bf16_t)(y0.y & 0xffff)) + bf2f((bf16_t)(y1.y & 0xffff)));
          v[i][3] += g2[3] * (bf2f((bf16_t)(y0.y >> 16)) + bf2f((bf16_t)(y1.y >> 16)));
        }
      }
      ss += v[i][0] * v[i][0] + v[i][1] * v[i][1] + v[i][2] * v[i][2] + v[i][3] * v[i][3];
    }
    ss = wave_sum(ss);
    const float rs = frsq(ss * (1.f / D) + EPS);
    if (which == 2) {
      UNR for (int i = 0; i < 4; ++i) { const int c4 = lane + 64 * i; const f32x4 g = ((const f32x4*)p.final_g)[c4];
        f32x4 o; UNR for (int j = 0; j < 4; ++j) o[j] = v[i][j] * rs * g[j]; ((f32x4*)(p.out + (size_t)t * D))[c4] = o; }
      continue;
    }
    if (mode != 2) UNR for (int i = 0; i < 4; ++i) ((f32x4*)(p.out + (size_t)t * D))[lane + 64 * i] = v[i];
    const float* mb = mod + ((size_t)l * BATCH + b) * 6 * D + (which == 0 ? 0 : 3 * D);
    const float* gw = (which == 0 ? p.norm1_g : p.norm2_g) + (size_t)l * D;
    f32x4 hv[4];
    UNR for (int i = 0; i < 4; ++i) { const int c4 = lane + 64 * i;
      const f32x4 g = ((const f32x4*)gw)[c4], sh = ((const f32x4*)mb)[c4], sc = ((const f32x4*)(mb + D))[c4];
      UNR for (int j = 0; j < 4; ++j) hv[i][j] = (v[i][j] * rs * g[j]) * (1.f + sc[j]) + sh[j];
      u32x2 o; o.x = pk2(hv[i][0], hv[i][1]); o.y = pk2(hv[i][2], hv[i][3]); ((u32x2*)(H + (size_t)t * D))[c4] = o; }
  }
}
constexpr int HSP = 1028;
DEV void phase_norm2_router(const Params& p, int l, bool dry = false) {
  char* lds = LDS_PTR();
  float* HS = (float*)lds;
  float* PART = HS + 16 * HSP;
  float* SUM = PART + 8 * 16 * 48;
  const int tid = TID, lane = tid & 63, w = tid >> 6;
  const float* mod = (const float*)(p.ws + WS_MOD);
  bf16_t* H = (bf16_t*)(p.ws + WS_H);
  const float* wrg = p.w_rg + (size_t)l * D * NG; const float* wre = p.w_re + (size_t)l * D * NE;
  const float* gw = p.norm2_g + (size_t)l * D;
  float bq[32][3];
  { const int o0 = lane & 15;
    UNR for (int kk = 0; kk < 32; ++kk) { const int d = 128 * w + 4 * kk + (lane >> 4);
      bq[kk][0] = (o0 < NG) ? wrg[(size_t)d * NG + o0] : wre[(size_t)d * NE + o0 - NG];
      bq[kk][1] = wre[(size_t)d * NE + 16 + o0 - NG];
      bq[kk][2] = (o0 < NG) ? wre[(size_t)d * NE + 32 + o0 - NG] : 0.f; } }
  f32x4 v[2][4];
  int tb = BID * 16;
  if (tb < T) { UNR for (int q = 0; q < 2; ++q) UNR for (int i = 0; i < 4; ++i) v[q][i] = ((const f32x4*)(p.out + (size_t)(tb + 2 * w + q) * D))[lane + 64 * i]; }
  for (; tb < T; tb += NBLK * 16) {
    SYNC();
    UNR for (int q = 0; q < 2; ++q) {
      const int tl = 2 * w + q, t = tb + tl, b = t / SEQ;
      float ss = 0.f;
      UNR for (int i = 0; i < 4; ++i) ss += v[q][i][0] * v[q][i][0] + v[q][i][1] * v[q][i][1] + v[q][i][2] * v[q][i][2] + v[q][i][3] * v[q][i][3];
      ss = wave_sum(ss);
      const float rs = frsq(ss * (1.f / D) + EPS);
      const float* mb = mod + ((size_t)l * BATCH + b) * 6 * D + 3 * D;
      UNR for (int i = 0; i < 4; ++i) { const int c4 = lane + 64 * i;
        const f32x4 g = ((const f32x4*)gw)[c4], sh = ((const f32x4*)mb)[c4], sc = ((const f32x4*)(mb + D))[c4];
        f32x4 hv; UNR for (int j = 0; j < 4; ++j) hv[j] = (v[q][i][j] * rs * g[j]) * (1.f + sc[j]) + sh[j];
        u32x2 o; o.x = pk2(hv[0], hv[1]); o.y = pk2(hv[2], hv[3]); ((u32x2*)(H + (size_t)t * D))[c4] = o;
        *(f32x4*)(HS + tl * HSP + 4 * c4) = hv; }
    }
    { const int tn = tb + NBLK * 16;
      if (tn < T) { UNR for (int q = 0; q < 2; ++q) UNR for (int i = 0; i < 4; ++i) v[q][i] = ((const f32x4*)(p.out + (size_t)(tn + 2 * w + q) * D))[lane + 64 * i]; } }
    SYNC();
    f32x4 acc[3]; UNR for (int nt = 0; nt < 3; ++nt) acc[nt] = (f32x4){0.f, 0.f, 0.f, 0.f};
    UNR for (int kk = 0; kk < 32; ++kk) {
      const float a = HS[(lane & 15) * HSP + 128 * w + 4 * kk + (lane >> 4)];
      acc[0] = mfma4f32(a, bq[kk][0], acc[0]); acc[1] = mfma4f32(a, bq[kk][1], acc[1]); acc[2] = mfma4f32(a, bq[kk][2], acc[2]);
    }
    UNR for (int nt = 0; nt < 3; ++nt) UNR for (int i = 0; i < 4; ++i) PART[(w * 16 + (lane >> 4) * 4 + i) * 48 + nt * 16 + (lane & 15)] = acc[nt][i];
    SYNC();
    for (int o = tid; o < 16 * 48; o += NTHREADS) { float sacc = 0.f; UNR for (int ww = 0; ww < 8; ++ww) sacc += PART[ww * 16 * 48 + o]; SUM[o] = sacc; }
    SYNC();
    if (tid < 16) {
      const int t = tb + tid;
      float lg[NG];
      int g = 0; float gmx = -3.0e38f;
      UNR for (int o = 0; o < NG; ++o) { const float sv = p.b_rg[l * NG + o] + SUM[tid * 48 + o]; lg[o] = sv; if (sv > gmx) { gmx = sv; g = o; } }
      float gsum = 0.f; UNR for (int o = 0; o < NG; ++o) gsum += fexp(lg[o] - gmx);
      const float ptop = frcp(gsum);
      int e0 = 0, e1 = 0; float m0 = -3.0e38f, m1 = -3.0e38f;
#pragma unroll 1
      for (int j = 0; j < EPG; ++j) { const float sv = p.b_re[l * NE + g * EPG + j] + SUM[tid * 48 + NG + g * EPG + j];
        if (sv > m0) { m1 = m0; e1 = e0; m0 = sv; e0 = j; } else if (sv > m1) { m1 = sv; e1 = j; } }
      const float x1 = fexp(m1 - m0), ri = frcp(1.f + x1), w0 = ptop * ri, w1 = ptop * x1 * ri;
      int* cnt = (int*)(p.ws + WS_CTL) + CW_CNT + l * NE; int* list = (int*)(p.ws + WS_LIST); float* went = (float*)(p.ws + WS_WENT);
      const int ea = g * EPG + e0, eb = g * EPG + e1;
      if (!dry) { list[(size_t)ea * T + atomic_add_i(cnt + ea, 1)] = 2 * t; went[2 * t] = w0;
        list[(size_t)eb * T + atomic_add_i(cnt + eb, 1)] = 2 * t + 1; went[2 * t + 1] = w1; }
      else if (w0 + w1 < -1.f) went[2 * t] = w0;
    }
  }
}
constexpr int GP = 72;
constexpr int LDS_PHASE_BYTES = 131072;
constexpr int LDS_PARAMS_OFF = LDS_PHASE_BYTES + 512 + 16384;
constexpr int LDS_BYTES = LDS_PARAMS_OFF + 256;
DEV void moe_tiles(const Params& p, int l, int* s_pref) {
  SYNC();
  if (TID == 0) { const int* cnt = (const int*)(p.ws + WS_CTL) + CW_CNT + l * NE; int a = 0; for (int e = 0; e < NE; ++e) { const int ce = cnt[e]; s_pref[e] = a; s_pref[40 + e] = ce; a += (ce + 255) / 256; } s_pref[NE] = a; }
  SYNC();
}
#ifdef EMU
struct RowPlain { const bf16_t* base; size_t ld; DEVM const bf16_t* operator()(int r) const { return base + (size_t)r * ld; } };
template <class RowA>
DEV void gemm_kloop(char* lds, const RowA& rowA, const bf16_t* Bt, size_t ldb, int K, f32x4 (&acc)[4][2]) {
  bf16_t* As = (bf16_t*)lds; bf16_t* Bs = As + 128 * GP;
  const int tid = TID, lane = tid & 63, w = tid >> 6, wm = w >> 2, wn = w & 3;
  const int r0 = tid >> 3, pc = (tid & 7) * 8;
  const bf16_t* a0 = rowA(r0) + pc; const bf16_t* a1 = rowA(r0 + 64) + pc;
  const bf16_t* b0 = Bt + (size_t)r0 * ldb + pc; const bf16_t* b1 = Bt + (size_t)(r0 + 64) * ldb + pc;
  u32x4 ra0 = *(const u32x4*)a0, ra1 = *(const u32x4*)a1, rb0 = *(const u32x4*)b0, rb1 = *(const u32x4*)b1;
  const int nk = K / 64;
  for (int kt = 0; kt < nk; ++kt) {
    SYNC();
    *(u32x4*)(As + r0 * GP + pc) = ra0; *(u32x4*)(As + (r0 + 64) * GP + pc) = ra1;
    *(u32x4*)(Bs + r0 * GP + pc) = rb0; *(u32x4*)(Bs + (r0 + 64) * GP + pc) = rb1;
    SYNC();
    if (kt + 1 < nk) { const int ko = (kt + 1) * 64; ra0 = *(const u32x4*)(a0 + ko); ra1 = *(const u32x4*)(a1 + ko); rb0 = *(const u32x4*)(b0 + ko); rb1 = *(const u32x4*)(b1 + ko); }
#pragma unroll
    for (int ks = 0; ks < 2; ++ks) {
      const int kof = ks * 32 + (lane >> 4) * 8;
      bf16x8 af[4], bfr[2];
#pragma unroll
      for (int mt = 0; mt < 4; ++mt) af[mt] = ld8(As + (wm * 64 + mt * 16 + (lane & 15)) * GP + kof);
#pragma unroll
      for (int nt = 0; nt < 2; ++nt) bfr[nt] = ld8(Bs + (wn * 32 + nt * 16 + (lane & 15)) * GP + kof);
#pragma unroll
      for (int mt = 0; mt < 4; ++mt)
#pragma unroll
        for (int nt = 0; nt < 2; ++nt) acc[mt][nt] = mfma16(af[mt], bfr[nt], acc[mt][nt]);
    }
  }
}
DEV void zero_acc(f32x4 (&acc)[4][2]) { UNR for (int i = 0; i < 4; ++i) UNR for (int j = 0; j < 2; ++j) acc[i][j] = (f32x4){0.f, 0.f, 0.f, 0.f}; }

DEV void phase_gemm_in(const Params& p, int l) {
  char* lds = LDS_PTR();
  const bf16_t* H = (const bf16_t*)(p.ws + WS_H); const bf16_t* W = (const bf16_t*)(p.ws + WS_WIN);
  bf16_t* PROJ = (bf16_t*)(p.ws + WS_PROJ); float* GATES = (float*)(p.ws + WS_GATES);
  const float* bias = p.b_in + (size_t)l * IN_W;
  constexpr int nM = T / 128, nN = NP / 128;
  for (int u = BID; u < nM * nN; u += NBLK) {
    const int pm = u % nM, pn = u / nM;
    f32x4 acc[4][2]; zero_acc(acc);
    RowPlain ra{H + (size_t)pm * 128 * D, (size_t)D};
    gemm_kloop(lds, ra, W + (size_t)pn * 128 * D, D, D, acc);
    const int etid = TID, lane = etid & 63, w = etid >> 6, wm = w >> 2, wn = w & 3;
    UNR for (int nt = 0; nt < 2; ++nt) {
      const int col = pn * 128 + wn * 32 + nt * 16 + (lane & 15);
      if (col >= IN_W) continue;
      const float bv = bias[col];
      UNR for (int mt = 0; mt < 4; ++mt) UNR for (int i = 0; i < 4; ++i) {
        const int row = pm * 128 + wm * 64 + mt * 16 + (lane >> 4) * 4 + i; const float v = acc[mt][nt][i] + bv;
        PROJ[(size_t)row * NP + col] = f2bf(v);
        if (col >= C_GATES && col < C_GATES + 16) GATES[(size_t)row * 16 + (col - C_GATES)] = v;
      }
    }
  }
}
DEV void phase_gemm_merge(const Params& p) {
  char* lds = LDS_PTR();
  const bf16_t* YM = (const bf16_t*)(p.ws + WS_YM); const bf16_t* YA = (const bf16_t*)(p.ws + WS_YA);
  const bf16_t* WM = (const bf16_t*)(p.ws + WS_WBM); const bf16_t* WA = (const bf16_t*)(p.ws + WS_WBA);
  const bf16_t* PROJ = (const bf16_t*)(p.ws + WS_PROJ); bf16_t* MG = (bf16_t*)(p.ws + WS_MERGED);
  constexpr int nM = T / 128, nN = D / 128;
  for (int u = BID; u < nM * nN; u += NBLK) {
    const int pm = u / nN, pn = u % nN;
    f32x4 acc[4][2]; zero_acc(acc);
    RowPlain r1{YM + (size_t)pm * 128 * MW, (size_t)MW}; gemm_kloop(lds, r1, WM + (size_t)pn * 128 * MW, MW, MW, acc);
    float* park = (float*)(lds + 40960);
    { const int ptid = TID; UNR for (int mt = 0; mt < 4; ++mt) UNR for (int nt = 0; nt < 2; ++nt) UNR for (int i = 0; i < 4; ++i) park[((mt * 2 + nt) * 4 + i) * NTHREADS + ptid] = acc[mt][nt][i]; }
    zero_acc(acc);
    RowPlain r2{YA + (size_t)pm * 128 * AW, (size_t)AW}; gemm_kloop(lds, r2, WA + (size_t)pn * 128 * AW, AW, AW, acc);
    const int etid = TID, lane = etid & 63, w = etid >> 6, wm = w >> 2, wn = w & 3;
    UNR for (int nt = 0; nt < 2; ++nt) { const int col = pn * 128 + wn * 32 + nt * 16 + (lane & 15);
      UNR for (int mt = 0; mt < 4; ++mt) UNR for (int i = 0; i < 4; ++i) {
        const int row = pm * 128 + wm * 64 + mt * 16 + (lane >> 4) * 4 + i;
        const float gm = bf2f(PROJ[(size_t)row * NP + C_GM + col]), ga = bf2f(PROJ[(size_t)row * NP + C_GA + col]);
        MG[(size_t)row * D + col] = f2bf(sigmoidf_(gm) * park[((mt * 2 + nt) * 4 + i) * NTHREADS + etid] + sigmoidf_(ga) * acc[mt][nt][i]); } }
  }
}
DEV void phase_gemm_out(const Params& p, int l) {
  char* lds = LDS_PTR();
  const bf16_t* MG = (const bf16_t*)(p.ws + WS_MERGED); const bf16_t* W = (const bf16_t*)(p.ws + WS_WOUT);
  const float* mod = (const float*)(p.ws + WS_MOD);
  constexpr int nM = T / 128, nN = D / 128;
  for (int u = BID; u < nM * nN; u += NBLK) {
    const int pm = u / nN, pn = u % nN;
    f32x4 acc[4][2]; zero_acc(acc);
    RowPlain ra{MG + (size_t)pm * 128 * D, (size_t)D}; gemm_kloop(lds, ra, W + (size_t)pn * 128 * D, D, D, acc);
    const int etid = TID, lane = etid & 63, w = etid >> 6, wm = w >> 2, wn = w & 3;
    const int b = (pm * 128) / SEQ;
    UNR for (int nt = 0; nt < 2; ++nt) { const int col = pn * 128 + wn * 32 + nt * 16 + (lane & 15);
      const float g1 = mod[((size_t)l * BATCH + b) * 6 * D + 2 * D + col];
      UNR for (int mt = 0; mt < 4; ++mt) UNR for (int i = 0; i < 4; ++i) {
        const int row = pm * 128 + wm * 64 + mt * 16 + (lane >> 4) * 4 + i;
        p.out[(size_t)row * D + col] += g1 * acc[mt][nt][i]; } }
  }
}
struct RowGather { const bf16_t* base; const int* list; int nvalid; DEVM const bf16_t* operator()(int r) const { const int ent = (r < nvalid) ? list[r] : 0; return base + (size_t)(ent >> 1) * D; } };
DEV void phase_moe_up(const Params& p, int l) {
  char* lds = LDS_PTR(); int* s_pref = (int*)(lds + LDS_PHASE_BYTES + 64);
  moe_tiles(p, l, s_pref);
  const bf16_t* H = (const bf16_t*)(p.ws + WS_H); const bf16_t* W = (const bf16_t*)(p.ws + WS_WGU); bf16_t* ACT = (bf16_t*)(p.ws + WS_ACT);
  const int* list = (const int*)(p.ws + WS_LIST); const float* went = (const float*)(p.ws + WS_WENT);
  const int ntile = s_pref[NE] * 2;
  for (int u = BID; u < ntile * 8; u += NBLK) {
    const int rt = u >> 3, ct = u & 7;
    int e = 0; while (s_pref[e + 1] <= (rt >> 1)) ++e;
    const int r0 = (rt - 2 * s_pref[e]) * 128, nvalid = s_pref[40 + e] - r0; const int* elist = list + (size_t)e * T + r0;
    f32x4 acc[4][2]; zero_acc(acc);
    RowGather ra{H, elist, nvalid};
    gemm_kloop(lds, ra, W + ((size_t)e * 2 * FF + ct * 128) * D, D, D, acc);
    const int etid = TID, lane = etid & 63, w = etid >> 6, wm = w >> 2, wn = w & 3;
    const int f = (ct * 4 + wn) * 16 + (lane & 15);
    UNR for (int mt = 0; mt < 4; ++mt) UNR for (int i = 0; i < 4; ++i) {
      const int r = wm * 64 + mt * 16 + (lane >> 4) * 4 + i;
      if (r < nvalid) { const float wt = went[elist[r]]; const float a = acc[mt][0][i], uu = acc[mt][1][i];
        ACT[((size_t)rt * 128 + r) * FF + f] = f2bf(siluf_(a) * uu * wt); } }
  }
}
DEV void phase_moe_down(const Params& p, int l) {
  char* lds = LDS_PTR(); int* s_pref = (int*)(lds + LDS_PHASE_BYTES + 64);
  moe_tiles(p, l, s_pref);
  const bf16_t* ACT = (const bf16_t*)(p.ws + WS_ACT); const bf16_t* W = (const bf16_t*)(p.ws + WS_WD); bf16_t* Y = (bf16_t*)(p.ws + WS_Y);
  const int* list = (const int*)(p.ws + WS_LIST);
  const int ntile = s_pref[NE] * 2;
  for (int u = BID; u < ntile * 8; u += NBLK) {
    const int rt = u >> 3, ct = u & 7;
    int e = 0; while (s_pref[e + 1] <= (rt >> 1)) ++e;
    const int r0 = (rt - 2 * s_pref[e]) * 128, nvalid = s_pref[40 + e] - r0; const int* elist = list + (size_t)e * T + r0;
    f32x4 acc[4][2]; zero_acc(acc);
    RowPlain ra{ACT + (size_t)rt * 128 * FF, (size_t)FF};
    gemm_kloop(lds, ra, W + ((size_t)e * D + ct * 128) * FF, FF, FF, acc);
    const int etid = TID, lane = etid & 63, w = etid >> 6, wm = w >> 2, wn = w & 3;
    UNR for (int nt = 0; nt < 2; ++nt) { const int col = ct * 128 + wn * 32 + nt * 16 + (lane & 15);
      UNR for (int mt = 0; mt < 4; ++mt) UNR for (int i = 0; i < 4; ++i) {
        const int r = wm * 64 + mt * 16 + (lane >> 4) * 4 + i;
        if (r < nvalid) Y[(size_t)elist[r] * D + col] = f2bf(acc[mt][nt][i]); } }
  }
}
#else
namespace pg8 {
#define PG8_LAS __attribute__((address_space(3)))
typedef unsigned short bf16_t;
typedef short bf16x8 __attribute__((ext_vector_type(8)));
typedef float f32x4 __attribute__((ext_vector_type(4)));
typedef unsigned u32x4 __attribute__((ext_vector_type(4)));
constexpr int BM = 256, BK = 64, HALF = 128, HTB = HALF * BK * 2  , STAGE_BYTES = 8 * HTB, NXCD = 8, WGM = 8;

__host__ __device__ __forceinline__ int lds_byte(int r, int c) { const int st = (r >> 4) * 2 + (c >> 5), rr = r & 15, cc = c & 31, ob = rr * 64 + cc * 2; return st * 1024 + (ob ^ (((ob >> 9) & 1) << 5)); }
__host__ __device__ __forceinline__ void stage_rc(int b, int& R, int& C) { const int st = b / 1024, sb = b % 1024, swz = sb ^ (((sb >> 9) & 1) << 5); R = (st >> 1) * 16 + swz / 64; C = (st & 1) * 32 + (swz % 64) / 2; }
__host__ __device__ __forceinline__ int perm32(int rho) { const int n = rho >> 4, i = rho & 15; return 8 * (i >> 2) + 4 * n + (i & 3); }

struct Unit { int pm, pn; };
struct Gemm { const bf16_t* A; const bf16_t* Bt; int M, N, K; };

struct StaticOrder {
    int nM, nN, nwg, G, c;
    __host__ __device__ void init(int M, int N, int G_, int c_) { nM = M / BM; nN = N / BM; nwg = nM * nN; G = G_; c = c_; }
    __host__ __device__ bool next(int i, Unit& u) const {
        const long L = (long)i * G + c; if (L >= nwg) return false;
        int wgid = (int)L; { const int q = nwg / NXCD, r = nwg % NXCD, xcd = wgid % NXCD, off = wgid / NXCD; wgid = (xcd < r ? xcd * (q + 1) : r * (q + 1) + (xcd - r) * q) + off; }
        const int nig = WGM * nN, gid = wgid / nig, fm = gid * WGM, gsz = (nM - fm) < WGM ? (nM - fm) : WGM;
        u.pm = fm + ((wgid % nig) % gsz); u.pn = (wgid % nig) / gsz; return true;
    }
    __device__ __forceinline__ void a_ready(const Unit&) const {}
    __device__ __forceinline__ void done(const Unit&) const {}
};
__device__ __forceinline__ unsigned cvt_pk_bf16(float lo, float hi) { unsigned r; asm volatile("v_cvt_pk_bf16_f32 %0, %1, %2" : "=v"(r) : "v"(lo), "v"(hi)); return r; }
template <class Epi, class Sched, bool ALIGN_EPI = false, bool SP2 = false>
__device__ __forceinline__ void gemm_phase(PG8_LAS unsigned char* lds, const Gemm g, const Sched& S, const Epi& E) {
    const int tid = TID, wid = __builtin_amdgcn_readfirstlane(tid >> 6), lane = tid & 63, wr = wid >> 2, wc = wid & 3, fr = lane & 15, fq = lane >> 4;
    const int K = g.K, nt = K / BK;
    unsigned voffA[2], voffB[2];
#pragma unroll
    for (int i = 0; i < 2; ++i) { int R, C; stage_rc(tid * 16 + i * 8192, R, C); const int Rb = Epi::PERM ? ((R & ~31) + perm32(R & 31)) : R;
        voffA[i] = (unsigned)(R * K + C) * 2u; voffB[i] = (unsigned)(Rb * K + C) * 2u; }
    const size_t kstep = (size_t)(BK * 2);
    const size_t hstep = (size_t)HALF * K * 2;
    const size_t tstep = 2 * hstep;
    const unsigned ldsw = (unsigned)wid * 1024u;
    const int aoff = lds_byte(wr * 64 + fr, fq * 8), boff = lds_byte(wc * 32 + fr, fq * 8);
#define PG8_SA(b, h) (((b) * 2 + (h)) * HTB)
#define PG8_SB(b, h) ((4 + (b) * 2 + (h)) * HTB)
#define PG8_STAGE(bufoff, gbase, voff) do { _Pragma("unroll") for (int _i = 0; _i < 2; ++_i) \
        __builtin_amdgcn_global_load_lds((const unsigned*)((const char*)(gbase) + (voff)[_i]), (PG8_LAS unsigned*)(lds + (bufoff) + ldsw + _i * 8192), 16, 0, 0); } while (0)
#define PG8_LDA(dst, b, h) do { _Pragma("unroll") for (int m = 0; m < 4; ++m) _Pragma("unroll") for (int k = 0; k < 2; ++k) dst[m][k] = *(const PG8_LAS bf16x8*)(lds + PG8_SA(b, h) + aoff + m * 2048 + k * 1024); } while (0)
#define PG8_LDB(dst, b, h) do { _Pragma("unroll") for (int n = 0; n < 2; ++n) _Pragma("unroll") for (int k = 0; k < 2; ++k) dst[n][k] = *(const PG8_LAS bf16x8*)(lds + PG8_SB(b, h) + boff + n * 2048 + k * 1024); } while (0)
#define PG8_MMA(ai, bj, At, Bt) do { __builtin_amdgcn_s_setprio(1); _Pragma("unroll") for (int m = 0; m < 4; ++m) _Pragma("unroll") for (int n = 0; n < 2; ++n) _Pragma("unroll") for (int k = 0; k < 2; ++k) \
        acc[ai][bj][m][n] = __builtin_amdgcn_mfma_f32_16x16x32_bf16(Bt[n][k], At[m][k], acc[ai][bj][m][n], 0, 0, 0); __builtin_amdgcn_s_setprio(0); } while (0)
#define PG8_WAIT_V(n) asm volatile("s_waitcnt vmcnt(" #n ")" ::: "memory")
#define PG8_WAIT_L(n) asm volatile("s_waitcnt lgkmcnt(" #n ")" ::: "memory")
#define PG8_BAR __builtin_amdgcn_s_barrier()
#define PG8_SCHED __builtin_amdgcn_sched_barrier(0)
    Unit cur, nxt; int ui = 0;
    if (!S.next(0, cur)) return;
    f32x4 acc[2][2][4][2];
#pragma unroll
    for (int a = 0; a < 2; ++a)
#pragma unroll
        for (int b = 0; b < 2; ++b)
#pragma unroll
            for (int m = 0; m < 4; ++m)
#pragma unroll
                for (int n = 0; n < 2; ++n) acc[a][b][m][n] = (f32x4){0.f, 0.f, 0.f, 0.f};
    bf16x8 At[4][2], B0[2][2], B1[2][2];
    const char* cA = (const char*)g.A + (size_t)cur.pm * tstep; const char* cB = (const char*)g.Bt + (size_t)cur.pn * tstep;
    S.a_ready(cur);
    if constexpr (SP2) {
        PG8_STAGE(PG8_SB(0, 0), cB, voffB); PG8_STAGE(PG8_SB(0, 1), cB + hstep, voffB); PG8_STAGE(PG8_SA(0, 0), cA, voffA); PG8_STAGE(PG8_SA(0, 1), cA + hstep, voffA);
        if (wr == 1) PG8_BAR;
        PG8_WAIT_V(2); PG8_BAR;
        PG8_STAGE(PG8_SB(1, 0), cB + kstep, voffB); PG8_STAGE(PG8_SA(1, 0), cA + kstep, voffA); PG8_STAGE(PG8_SB(1, 1), cB + hstep + kstep, voffB);
        PG8_WAIT_V(6); PG8_BAR;
    } else {
        PG8_STAGE(PG8_SB(0, 0), cB, voffB); PG8_STAGE(PG8_SA(0, 0), cA, voffA); PG8_STAGE(PG8_SB(0, 1), cB + hstep, voffB); PG8_STAGE(PG8_SA(0, 1), cA + hstep, voffA);
        if (wr == 1) PG8_BAR;
        PG8_WAIT_V(4); PG8_BAR;
        PG8_STAGE(PG8_SB(1, 0), cB + kstep, voffB); PG8_STAGE(PG8_SA(1, 0), cA + kstep, voffA); PG8_STAGE(PG8_SB(1, 1), cB + hstep + kstep, voffB);
        PG8_WAIT_V(6); PG8_BAR;
    }
    for (;;) {
        const bool has_next = S.next(ui + 1, nxt);
        const char* nA = has_next ? (const char*)g.A + (size_t)nxt.pm * tstep : cA; const char* nB = has_next ? (const char*)g.Bt + (size_t)nxt.pn * tstep : cB;
        for (int t = 0; t < nt; t += 2) {
            const bool last = (t == nt - 2);
            const char* a1 = cA + (size_t)(t + 1) * kstep;
            const char* a2 = last ? nA : cA + (size_t)(t + 2) * kstep; const char* b2 = last ? nB : cB + (size_t)(t + 2) * kstep;
            const char* a3 = a2 + kstep; const char* b3 = b2 + kstep;
            if (last && has_next) S.a_ready(nxt);
            if constexpr (SP2) {
            PG8_LDB(B0, 0, 0); PG8_LDB(B1, 0, 1); PG8_SCHED; PG8_LDA(At, 0, 0); PG8_STAGE(PG8_SA(1, 1), a1 + hstep, voffA);
            PG8_WAIT_V(8); PG8_WAIT_L(0); PG8_BAR; PG8_MMA(0, 0, At, B0); PG8_MMA(0, 1, At, B1); PG8_BAR; PG8_SCHED;
            PG8_LDA(At, 0, 1); PG8_STAGE(PG8_SB(0, 0), b2, voffB); PG8_STAGE(PG8_SB(0, 1), b2 + hstep, voffB); PG8_STAGE(PG8_SA(0, 0), a2, voffA);
            PG8_WAIT_V(8); PG8_WAIT_L(0); PG8_BAR; PG8_MMA(1, 0, At, B0); PG8_MMA(1, 1, At, B1); PG8_BAR; PG8_SCHED;
            PG8_LDB(B0, 1, 0); PG8_LDB(B1, 1, 1); PG8_SCHED; PG8_LDA(At, 1, 0); PG8_STAGE(PG8_SA(0, 1), a2 + hstep, voffA);
            PG8_WAIT_V(8); PG8_WAIT_L(0); PG8_BAR; PG8_MMA(0, 0, At, B0); PG8_MMA(0, 1, At, B1); PG8_BAR; PG8_SCHED;
            PG8_LDA(At, 1, 1); PG8_STAGE(PG8_SB(1, 0), b3, voffB); PG8_STAGE(PG8_SB(1, 1), b3 + hstep, voffB); PG8_STAGE(PG8_SA(1, 0), a3, voffA);
            PG8_WAIT_V(8); PG8_WAIT_L(0); PG8_BAR; PG8_MMA(1, 0, At, B0); PG8_MMA(1, 1, At, B1); PG8_BAR; PG8_SCHED;
            } else {
            PG8_LDB(B0, 0, 0); PG8_SCHED; PG8_LDA(At, 0, 0); PG8_STAGE(PG8_SA(1, 1), a1 + hstep, voffA);
            PG8_WAIT_L(8); PG8_BAR; PG8_WAIT_L(0); PG8_MMA(0, 0, At, B0); PG8_BAR; PG8_SCHED;
            PG8_LDB(B1, 0, 1); PG8_STAGE(PG8_SB(0, 0), b2, voffB);
            PG8_BAR; PG8_WAIT_L(0); PG8_MMA(0, 1, At, B1); PG8_BAR;
            PG8_LDA(At, 0, 1); PG8_STAGE(PG8_SA(0, 0), a2, voffA);
            PG8_BAR; PG8_WAIT_L(0); PG8_MMA(1, 0, At, B0); PG8_BAR; PG8_SCHED;
            PG8_STAGE(PG8_SB(0, 1), b2 + hstep, voffB);
            PG8_WAIT_V(6); PG8_BAR; PG8_MMA(1, 1, At, B1); PG8_BAR;
            PG8_LDB(B0, 1, 0); PG8_SCHED; PG8_LDA(At, 1, 0); PG8_STAGE(PG8_SA(0, 1), a2 + hstep, voffA);
            PG8_WAIT_L(8); PG8_BAR; PG8_WAIT_L(0); PG8_MMA(0, 0, At, B0); PG8_BAR; PG8_SCHED;
            PG8_LDB(B1, 1, 1); PG8_STAGE(PG8_SB(1, 0), b3, voffB);
            PG8_BAR; PG8_WAIT_L(0); PG8_MMA(0, 1, At, B1); PG8_BAR;
            PG8_LDA(At, 1, 1); PG8_STAGE(PG8_SA(1, 0), a3, voffA);
            PG8_BAR; PG8_WAIT_L(0); PG8_MMA(1, 0, At, B0); PG8_BAR; PG8_SCHED;
            PG8_STAGE(PG8_SB(1, 1), b3 + hstep, voffB);
            PG8_WAIT_V(6); PG8_BAR; PG8_MMA(1, 1, At, B1); PG8_BAR;
            }
        }
        if constexpr (ALIGN_EPI) { if (wr == 0) PG8_BAR; }
        if constexpr (!Epi::AFTER_DRAIN) { E(acc, cur, wr, wc, fr, fq); S.done(cur); }
        if (!has_next) break;
#pragma unroll
        for (int a = 0; a < 2; ++a)
#pragma unroll
            for (int b = 0; b < 2; ++b)
#pragma unroll
                for (int m = 0; m < 4; ++m)
#pragma unroll
                    for (int n = 0; n < 2; ++n) acc[a][b][m][n] = (f32x4){0.f, 0.f, 0.f, 0.f};
        cur = nxt; cA = nA; cB = nB; ++ui;
        if constexpr (ALIGN_EPI) { if (wr == 1) PG8_BAR; }
    }
    PG8_WAIT_V(0);
    if constexpr (!ALIGN_EPI) { if (wr == 0) PG8_BAR; }
    PG8_BAR;
    if constexpr (Epi::AFTER_DRAIN) { E.fused(acc, cur, wr, wc, fr, fq, lds, wid, lane); S.done(cur); }
#undef PG8_SA
#undef PG8_SB
#undef PG8_STAGE
#undef PG8_LDA
#undef PG8_LDB
#undef PG8_MMA
#undef PG8_WAIT_V
#undef PG8_WAIT_L
#undef PG8_BAR
#undef PG8_SCHED
}
template <class Epi, class Sched, bool ALIGN_EPI = false, bool SP2 = false>
__device__ __forceinline__ void gemm_phase_gather(PG8_LAS unsigned char* lds, const Gemm g, const Sched& S, const Epi& E) {
    const int tid = threadIdx.x, wid = __builtin_amdgcn_readfirstlane(tid >> 6), lane = tid & 63, wr = wid >> 2, wc = wid & 3, fr = lane & 15, fq = lane >> 4;
    static_assert(SP2, "gather variant: SP2 loop only");
    const int K = g.K, nt = K / BK;
    unsigned voffB[2];
#pragma unroll
    for (int i = 0; i < 2; ++i) { int R, C; stage_rc(tid * 16 + i * 8192, R, C); const int Rb = Epi::PERM ? ((R & ~31) + perm32(R & 31)) : R;
        voffB[i] = (unsigned)(Rb * K + C) * 2u; }
    PG8_LAS u32x4* slot_cur = (PG8_LAS u32x4*)(lds + STAGE_BYTES + 512) + tid; PG8_LAS u32x4* slot_nxt = slot_cur + 512;
#define PG8_STAGE_A(bufoff, gbase, slotp, h) do { const u32x2 _o = ((const PG8_LAS u32x2*)(slotp))[h]; unsigned _v[2] = {_o.x, _o.y}; PG8_STAGE(bufoff, gbase, _v); } while (0)
#define PG8_ROWOFF(dst, unit) do { _Pragma("unroll") for (int _h = 0; _h < 2; ++_h) _Pragma("unroll") for (int _i = 0; _i < 2; ++_i) \
        { int _R, _C; stage_rc(tid * 16 + _i * 8192, _R, _C); dst[_h][_i] = (unsigned)(S.rowtok(unit, _h * HALF + _R) * K + _C) * 2u; } } while (0)
    const size_t kstep = (size_t)(BK * 2);
    const size_t hstep = (size_t)HALF * K * 2;
    const size_t tstep = 2 * hstep;
    const unsigned ldsw = (unsigned)wid * 1024u;
    const int aoff = lds_byte(wr * 64 + fr, fq * 8), boff = lds_byte(wc * 32 + fr, fq * 8);
#define PG8_SA(b, h) (((b) * 2 + (h)) * HTB)
#define PG8_SB(b, h) ((4 + (b) * 2 + (h)) * HTB)
#define PG8_STAGE(bufoff, gbase, voff) do { _Pragma("unroll") for (int _i = 0; _i < 2; ++_i) \
        __builtin_amdgcn_global_load_lds((const unsigned*)((const char*)(gbase) + (voff)[_i]), (PG8_LAS unsigned*)(lds + (bufoff) + ldsw + _i * 8192), 16, 0, 0); } while (0)
#define PG8_LDA(dst, b, h) do { _Pragma("unroll") for (int m = 0; m < 4; ++m) _Pragma("unroll") for (int k = 0; k < 2; ++k) dst[m][k] = *(const PG8_LAS bf16x8*)(lds + PG8_SA(b, h) + aoff + m * 2048 + k * 1024); } while (0)
#define PG8_LDB(dst, b, h) do { _Pragma("unroll") for (int n = 0; n < 2; ++n) _Pragma("unroll") for (int k = 0; k < 2; ++k) dst[n][k] = *(const PG8_LAS bf16x8*)(lds + PG8_SB(b, h) + boff + n * 2048 + k * 1024); } while (0)
#define PG8_MMA(ai, bj, At, Bt) do { __builtin_amdgcn_s_setprio(1); _Pragma("unroll") for (int m = 0; m < 4; ++m) _Pragma("unroll") for (int n = 0; n < 2; ++n) _Pragma("unroll") for (int k = 0; k < 2; ++k) \
        acc[ai][bj][m][n] = __builtin_amdgcn_mfma_f32_16x16x32_bf16(Bt[n][k], At[m][k], acc[ai][bj][m][n], 0, 0, 0); __builtin_amdgcn_s_setprio(0); } while (0)
#define PG8_WAIT_V(n) asm volatile("s_waitcnt vmcnt(" #n ")" ::: "memory")
#define PG8_WAIT_L(n) asm volatile("s_waitcnt lgkmcnt(" #n ")" ::: "memory")
#define PG8_BAR __builtin_amdgcn_s_barrier()
#define PG8_SCHED __builtin_amdgcn_sched_barrier(0)
    Unit cur, nxt; int ui = 0;
    if (!S.next(0, cur)) return;
    f32x4 acc[2][2][4][2];
#pragma unroll
    for (int a = 0; a < 2; ++a)
#pragma unroll
        for (int b = 0; b < 2; ++b)
#pragma unroll
            for (int m = 0; m < 4; ++m)
#pragma unroll
                for (int n = 0; n < 2; ++n) acc[a][b][m][n] = (f32x4){0.f, 0.f, 0.f, 0.f};
    bf16x8 At[4][2], B0[2][2], B1[2][2];
    const char* cA = (const char*)g.A; const char* cB = (const char*)g.Bt + (size_t)cur.pn * tstep;
    { unsigned va[2][2]; PG8_ROWOFF(va, cur); *slot_cur = (u32x4){va[0][0], va[0][1], va[1][0], va[1][1]}; }
    S.a_ready(cur);
    if constexpr (SP2) {
        PG8_STAGE(PG8_SB(0, 0), cB, voffB); PG8_STAGE(PG8_SB(0, 1), cB + hstep, voffB); PG8_STAGE_A(PG8_SA(0, 0), cA, slot_cur, 0); PG8_STAGE_A(PG8_SA(0, 1), cA, slot_cur, 1);
        if (wr == 1) PG8_BAR;
        PG8_WAIT_V(2); PG8_BAR;
        PG8_STAGE(PG8_SB(1, 0), cB + kstep, voffB); PG8_STAGE_A(PG8_SA(1, 0), cA + kstep, slot_cur, 0); PG8_STAGE(PG8_SB(1, 1), cB + hstep + kstep, voffB);
        PG8_WAIT_V(6); PG8_BAR;
    } else {
        unsigned va[2][2] = {{0u, 0u}, {0u, 0u}};
        PG8_STAGE(PG8_SB(0, 0), cB, voffB); PG8_STAGE(PG8_SA(0, 0), cA, va[0]); PG8_STAGE(PG8_SB(0, 1), cB + hstep, voffB); PG8_STAGE(PG8_SA(0, 1), cA + hstep, va[0]);
        if (wr == 1) PG8_BAR;
        PG8_WAIT_V(4); PG8_BAR;
        PG8_STAGE(PG8_SB(1, 0), cB + kstep, voffB); PG8_STAGE(PG8_SA(1, 0), cA + kstep, va[0]); PG8_STAGE(PG8_SB(1, 1), cB + hstep + kstep, voffB);
        PG8_WAIT_V(6); PG8_BAR;
    }
    for (;;) {
        const bool has_next = S.next(ui + 1, nxt);
        const char* nA = cA; const char* nB = has_next ? (const char*)g.Bt + (size_t)nxt.pn * tstep : cB;
        if (has_next) { unsigned vn[2][2]; PG8_ROWOFF(vn, nxt); *slot_nxt = (u32x4){vn[0][0], vn[0][1], vn[1][0], vn[1][1]}; } else *slot_nxt = *slot_cur;
        for (int t = 0; t < nt; t += 2) {
            const bool last = (t == nt - 2);
            const char* a1 = cA + (size_t)(t + 1) * kstep;
            const char* a2 = last ? nA : cA + (size_t)(t + 2) * kstep; const char* b2 = last ? nB : cB + (size_t)(t + 2) * kstep;
            const char* a3 = a2 + kstep; const char* b3 = b2 + kstep;
            if (last && has_next) S.a_ready(nxt);
            const PG8_LAS u32x4* slot_t2 = last ? slot_nxt : slot_cur;
            if constexpr (SP2) {
            PG8_LDB(B0, 0, 0); PG8_LDB(B1, 0, 1); PG8_SCHED; PG8_LDA(At, 0, 0); PG8_STAGE_A(PG8_SA(1, 1), a1, slot_cur, 1);
            PG8_WAIT_V(8); PG8_WAIT_L(0); PG8_BAR; PG8_MMA(0, 0, At, B0); PG8_MMA(0, 1, At, B1); PG8_BAR; PG8_SCHED;
            PG8_LDA(At, 0, 1); PG8_STAGE(PG8_SB(0, 0), b2, voffB); PG8_STAGE(PG8_SB(0, 1), b2 + hstep, voffB); PG8_STAGE_A(PG8_SA(0, 0), a2, slot_t2, 0);
            PG8_WAIT_V(8); PG8_WAIT_L(0); PG8_BAR; PG8_MMA(1, 0, At, B0); PG8_MMA(1, 1, At, B1); PG8_BAR; PG8_SCHED;
            PG8_LDB(B0, 1, 0); PG8_LDB(B1, 1, 1); PG8_SCHED; PG8_LDA(At, 1, 0); PG8_STAGE_A(PG8_SA(0, 1), a2, slot_t2, 1);
            PG8_WAIT_V(8); PG8_WAIT_L(0); PG8_BAR; PG8_MMA(0, 0, At, B0); PG8_MMA(0, 1, At, B1); PG8_BAR; PG8_SCHED;
            PG8_LDA(At, 1, 1); PG8_STAGE(PG8_SB(1, 0), b3, voffB); PG8_STAGE(PG8_SB(1, 1), b3 + hstep, voffB); PG8_STAGE_A(PG8_SA(1, 0), a3, slot_t2, 0);
            PG8_WAIT_V(8); PG8_WAIT_L(0); PG8_BAR; PG8_MMA(1, 0, At, B0); PG8_MMA(1, 1, At, B1); PG8_BAR; PG8_SCHED;
            } else {
            unsigned va[2][2] = {{0u, 0u}, {0u, 0u}};
            PG8_LDB(B0, 0, 0); PG8_SCHED; PG8_LDA(At, 0, 0); PG8_STAGE(PG8_SA(1, 1), a1 + hstep, va[0]);
            PG8_WAIT_L(8); PG8_BAR; PG8_WAIT_L(0); PG8_MMA(0, 0, At, B0); PG8_BAR; PG8_SCHED;
            PG8_LDB(B1, 0, 1); PG8_STAGE(PG8_SB(0, 0), b2, voffB);
            PG8_BAR; PG8_WAIT_L(0); PG8_MMA(0, 1, At, B1); PG8_BAR;
            PG8_LDA(At, 0, 1); PG8_STAGE_A(PG8_SA(0, 0), a2, slot_t2, 0);
            PG8_BAR; PG8_WAIT_L(0); PG8_MMA(1, 0, At, B0); PG8_BAR; PG8_SCHED;
            PG8_STAGE(PG8_SB(0, 1), b2 + hstep, voffB);
            PG8_WAIT_V(6); PG8_BAR; PG8_MMA(1, 1, At, B1); PG8_BAR;
            PG8_LDB(B0, 1, 0); PG8_SCHED; PG8_LDA(At, 1, 0); PG8_STAGE(PG8_SA(0, 1), a2 + hstep, va[0]);
            PG8_WAIT_L(8); PG8_BAR; PG8_WAIT_L(0); PG8_MMA(0, 0, At, B0); PG8_BAR; PG8_SCHED;
            PG8_LDB(B1, 1, 1); PG8_STAGE(PG8_SB(1, 0), b3, voffB);
            PG8_BAR; PG8_WAIT_L(0); PG8_MMA(0, 1, At, B1); PG8_BAR;
            PG8_LDA(At, 1, 1); PG8_STAGE_A(PG8_SA(1, 0), a3, slot_t2, 0);
            PG8_BAR; PG8_WAIT_L(0); PG8_MMA(1, 0, At, B0); PG8_BAR; PG8_SCHED;
            PG8_STAGE(PG8_SB(1, 1), b3 + hstep, voffB);
            PG8_WAIT_V(6); PG8_BAR; PG8_MMA(1, 1, At, B1); PG8_BAR;
            }
        }
        if constexpr (ALIGN_EPI) { if (wr == 0) PG8_BAR; }
        if constexpr (!Epi::AFTER_DRAIN) { E(acc, cur, wr, wc, fr, fq); S.done(cur); }
        if (!has_next) break;
#pragma unroll
        for (int a = 0; a < 2; ++a)
#pragma unroll
            for (int b = 0; b < 2; ++b)
#pragma unroll
                for (int m = 0; m < 4; ++m)
#pragma unroll
                    for (int n = 0; n < 2; ++n) acc[a][b][m][n] = (f32x4){0.f, 0.f, 0.f, 0.f};
        cur = nxt; cA = nA; cB = nB; ++ui; *slot_cur = *slot_nxt;
        if constexpr (ALIGN_EPI) { if (wr == 1) PG8_BAR; }
    }
    PG8_WAIT_V(0);
    if constexpr (!ALIGN_EPI) { if (wr == 0) PG8_BAR; }
    PG8_BAR;
    if constexpr (Epi::AFTER_DRAIN) { E.fused(acc, cur, wr, wc, fr, fq, lds, wid, lane); S.done(cur); }
#undef PG8_ROWOFF
#undef PG8_STAGE_A
#undef PG8_SA
#undef PG8_SB
#undef PG8_STAGE
#undef PG8_LDA
#undef PG8_LDB
#undef PG8_MMA
#undef PG8_WAIT_V
#undef PG8_WAIT_L
#undef PG8_BAR
#undef PG8_SCHED
}

}

typedef pg8::Unit GUnit;
typedef f32x4 GAcc[2][2][4][2];
DEV u32x4 pack8(const f32x4& v0, const f32x4& v1) { u32x4 w; w.x = pg8::cvt_pk_bf16(v0[0], v0[1]); w.y = pg8::cvt_pk_bf16(v0[2], v0[3]); w.z = pg8::cvt_pk_bf16(v1[0], v1[1]); w.w = pg8::cvt_pk_bf16(v1[2], v1[3]); return w; }
DEV void unpack8(const u32x4& w, f32x4& v0, f32x4& v1) {
  v0[0] = __builtin_bit_cast(float, w.x << 16); v0[1] = __builtin_bit_cast(float, w.x & 0xffff0000u); v0[2] = __builtin_bit_cast(float, w.y << 16); v0[3] = __builtin_bit_cast(float, w.y & 0xffff0000u);
  v1[0] = __builtin_bit_cast(float, w.z << 16); v1[1] = __builtin_bit_cast(float, w.z & 0xffff0000u); v1[2] = __builtin_bit_cast(float, w.w << 16); v1[3] = __builtin_bit_cast(float, w.w & 0xffff0000u); }
DEV f32x4 sig4(const f32x4& x) { f32x4 r; UNR for (int i = 0; i < 4; ++i) r[i] = sigmoidf_(x[i]); return r; }
struct EpiIn { static constexpr bool PERM = true, AFTER_DRAIN = false; bf16_t* PROJ; float* GATES; const float* bias;
  DEVM void operator()(const GAcc& acc, const GUnit& u, int wr, int wc, int fr, int fq) const {
    const int row0 = u.pm * 256 + wr * 64 + fr;
    UNR for (int bj = 0; bj < 2; ++bj) { const int c = u.pn * 256 + bj * 128 + wc * 32 + 8 * fq;
      if (c < IN_W) { const f32x4 b0 = *(const f32x4*)(bias + c), b1 = *(const f32x4*)(bias + c + 4);
        UNR for (int ai = 0; ai < 2; ++ai) UNR for (int m = 0; m < 4; ++m) { const int row = row0 + ai * 128 + m * 16;
          const f32x4 v0 = acc[ai][bj][m][0] + b0, v1 = acc[ai][bj][m][1] + b1;
          *(u32x4*)(PROJ + (size_t)row * NP + c) = pack8(v0, v1);
          if (c >= C_GATES && c < C_GATES + 16) { float* gp = GATES + (size_t)row * 16 + (c - C_GATES); *(f32x4*)gp = v0; *(f32x4*)(gp + 4) = v1; } } } }
  } };
struct EpiMerge { static constexpr bool PERM = true, AFTER_DRAIN = false; const bf16_t* PROJ; float* TMP; bf16_t* MG;
  DEVM void operator()(const GAcc& acc, const GUnit& u, int wr, int wc, int fr, int fq) const {
    const bool second = u.pm >= T / 256; const int pm = second ? u.pm - T / 256 : u.pm, pn = second ? u.pn - 4 : u.pn;
    const int row0 = pm * 256 + wr * 64 + fr;
    UNR for (int bj = 0; bj < 2; ++bj) { const int c = pn * 256 + bj * 128 + wc * 32 + 8 * fq;
      UNR for (int ai = 0; ai < 2; ++ai) {
        u32x4 gq[4]; f32x4 t0[4], t1[4];
        UNR for (int m = 0; m < 4; ++m) { const int row = row0 + ai * 128 + m * 16; gq[m] = *(const u32x4*)(PROJ + (size_t)row * NP + (second ? C_GA : C_GM) + c);
          if (second) { const float* tp = TMP + (size_t)row * D + c; t0[m] = *(const f32x4*)tp; t1[m] = *(const f32x4*)(tp + 4); } }
        UNR for (int m = 0; m < 4; ++m) { const int row = row0 + ai * 128 + m * 16;
          f32x4 g0, g1; unpack8(gq[m], g0, g1);
          const f32x4 v0 = sig4(g0) * acc[ai][bj][m][0], v1 = sig4(g1) * acc[ai][bj][m][1];
          if (!second) { float* tp = TMP + (size_t)row * D + c; *(f32x4*)tp = v0; *(f32x4*)(tp + 4) = v1; }
          else *(u32x4*)(MG + (size_t)row * D + c) = pack8(t0[m] + v0, t1[m] + v1); }
        asm volatile("" ::: "memory"); } }
  } };
struct MergeOrder { pg8::StaticOrder S;
  DEVM bool next(int i, GUnit& u) const { if (!S.next(i >> 1, u)) return false; if (i & 1) { u.pm += T / 256; u.pn += 4; } return true; }
  DEVM void a_ready(const GUnit&) const {}
  DEVM void done(const GUnit&) const {} };
struct EpiOut { static constexpr bool PERM = true, AFTER_DRAIN = false; float* X; const float* modl;
  DEVM void operator()(const GAcc& acc, const GUnit& u, int wr, int wc, int fr, int fq) const {
    const int row0 = u.pm * 256 + wr * 64 + fr; const float* g1p = modl + (size_t)((u.pm * 256) / SEQ) * 6 * D + 2 * D;
    UNR for (int bj = 0; bj < 2; ++bj) { const int c = u.pn * 256 + bj * 128 + wc * 32 + 8 * fq;
      const f32x4 ga = *(const f32x4*)(g1p + c), gb = *(const f32x4*)(g1p + c + 4);
      UNR for (int ai = 0; ai < 2; ++ai) {
        f32x4 x0[4], x1[4];
        UNR for (int m = 0; m < 4; ++m) { const float* xp = X + (size_t)(row0 + ai * 128 + m * 16) * D + c; x0[m] = *(const f32x4*)xp; x1[m] = *(const f32x4*)(xp + 4); }
        UNR for (int m = 0; m < 4; ++m) { float* xp = X + (size_t)(row0 + ai * 128 + m * 16) * D + c; *(f32x4*)xp = x0[m] + ga * acc[ai][bj][m][0]; *(f32x4*)(xp + 4) = x1[m] + gb * acc[ai][bj][m][1]; }
        asm volatile("" ::: "memory"); } }
  } };
struct MoeOrder { const int* pref; const int* list; int nunits, G, c;
  DEVM bool next(int i, GUnit& u) const { const long idx = (long)i * G + c; if (idx >= nunits) return false; const int rt = (int)(idx >> 2), ct = (int)(idx & 3);
    int e = 0; while (pref[e + 1] <= rt) ++e; u.pm = rt; u.pn = e * 4 + ct; return true; }
  DEVM int rowent(const GUnit& u, int r) const { const int e = u.pn >> 2, idx = (u.pm - pref[e]) * 256 + r; return (idx < pref[40 + e]) ? list[(size_t)e * T + idx] : -1; }
  DEVM int rowtok(const GUnit& u, int r) const { const int ent = rowent(u, r); return ent < 0 ? 0 : (ent >> 1); }
  DEVM void a_ready(const GUnit&) const {}
  DEVM void done(const GUnit&) const {} };
struct EpiUp { static constexpr bool PERM = false, AFTER_DRAIN = false; bf16_t* ACT; const float* went; MoeOrder S;
  DEVM void operator()(const GAcc& acc, const GUnit& u, int wr, int wc, int fr, int fq) const {
    const int ct = u.pn & 3;
    UNR for (int ai = 0; ai < 2; ++ai) {
      int ent[4]; float wt[4];
      UNR for (int m = 0; m < 4; ++m) ent[m] = S.rowent(u, ai * 128 + wr * 64 + m * 16 + fr);
      UNR for (int m = 0; m < 4; ++m) wt[m] = went[ent[m] < 0 ? 0 : ent[m]];
      UNR for (int m = 0; m < 4; ++m) { const int r = ai * 128 + wr * 64 + m * 16 + fr;
        if (ent[m] >= 0) {
          UNR for (int bj = 0; bj < 2; ++bj) { const int f = (8 * ct + 4 * bj + wc) * 16 + 4 * fq; const f32x4 a = acc[ai][bj][m][0], uu = acc[ai][bj][m][1]; const float w1 = wt[m];
            u32x2 o; o.x = pg8::cvt_pk_bf16(siluf_(a[0]) * uu[0] * w1, siluf_(a[1]) * uu[1] * w1); o.y = pg8::cvt_pk_bf16(siluf_(a[2]) * uu[2] * w1, siluf_(a[3]) * uu[3] * w1);
            *(u32x2*)(ACT + ((size_t)u.pm * 256 + r) * FF + f) = o; } } }
      asm volatile("" ::: "memory"); }
  } };
struct EpiDown { static constexpr bool PERM = true, AFTER_DRAIN = false; bf16_t* Y; MoeOrder S;
  DEVM void operator()(const GAcc& acc, const GUnit& u, int wr, int wc, int fr, int fq) const {
    const int ct = u.pn & 3;
    UNR for (int ai = 0; ai < 2; ++ai) UNR for (int m = 0; m < 4; ++m) { const int ent = S.rowent(u, ai * 128 + wr * 64 + m * 16 + fr);
      if (ent >= 0) { UNR for (int bj = 0; bj < 2; ++bj) { const int c = ct * 256 + bj * 128 + wc * 32 + 8 * fq;
          *(u32x4*)(Y + (size_t)ent * D + c) = pack8(acc[ai][bj][m][0], acc[ai][bj][m][1]); } } }
  } };
#define GEMM_LDS ((PG8_LAS unsigned char*)dyn_lds)
DEV void phase_gemm_in(const Params& p, int l) {
  pg8::Gemm g{(const bf16_t*)(p.ws + WS_H), (const bf16_t*)(p.ws + WS_WIN), T, NP, D}; pg8::StaticOrder S; S.init(T, NP, NBLK, BID);
  EpiIn E{(bf16_t*)(p.ws + WS_PROJ), (float*)(p.ws + WS_GATES), p.b_in + (size_t)l * IN_W};
  pg8::gemm_phase<EpiIn, pg8::StaticOrder, true, true>(GEMM_LDS, g, S, E);
}
DEV void phase_gemm_merge(const Params& p) {
  static_assert(WS_YA == WS_YM + (size_t)T * MW * 2 && WS_WBA == WS_WBM + (size_t)D * MW * 2 && MW == AW, "y_m|y_a and Wbm|Wba are stacked: one A, one Bt");
  pg8::Gemm g{(const bf16_t*)(p.ws + WS_YM), (const bf16_t*)(p.ws + WS_WBM), 2 * T, 2 * D, MW}; MergeOrder S; S.S.init(T, D, NBLK, BID);
  EpiMerge E{(const bf16_t*)(p.ws + WS_PROJ), (float*)(p.ws + WS_TMP), (bf16_t*)(p.ws + WS_MERGED)};
  pg8::gemm_phase<EpiMerge, MergeOrder, true, true>(GEMM_LDS, g, S, E);
}
DEV void phase_gemm_out(const Params& p, int l) {
  pg8::Gemm g{(const bf16_t*)(p.ws + WS_MERGED), (const bf16_t*)(p.ws + WS_WOUT), T, D, D}; pg8::StaticOrder S; S.init(T, D, NBLK, BID);
  EpiOut E{p.out, (const float*)(p.ws + WS_MOD) + (size_t)l * BATCH * 6 * D};
  pg8::gemm_phase<EpiOut, pg8::StaticOrder, true, true>(GEMM_LDS, g, S, E);
}
DEV void phase_moe_up(const Params& p, int l) {
  int* s_pref = (int*)(LDS_PTR() + LDS_PHASE_BYTES + 64);
  moe_tiles(p, l, s_pref);
  pg8::Gemm g{(const bf16_t*)(p.ws + WS_H), (const bf16_t*)(p.ws + WS_WGU), T, NE * 2 * FF, D};
  MoeOrder S{s_pref, (const int*)(p.ws + WS_LIST), s_pref[NE] * 4, NBLK, BID};
  EpiUp E{(bf16_t*)(p.ws + WS_ACT), (const float*)(p.ws + WS_WENT), S};
  pg8::gemm_phase_gather<EpiUp, MoeOrder, true, true>(GEMM_LDS, g, S, E);
}
DEV void phase_moe_down(const Params& p, int l) {
  int* s_pref = (int*)(LDS_PTR() + LDS_PHASE_BYTES + 64);
  moe_tiles(p, l, s_pref);
  pg8::Gemm g{(const bf16_t*)(p.ws + WS_ACT), (const bf16_t*)(p.ws + WS_WD), SLOT_ROWS, NE * D, FF};
  MoeOrder S{s_pref, (const int*)(p.ws + WS_LIST), s_pref[NE] * 4, NBLK, BID};
  EpiDown E{(bf16_t*)(p.ws + WS_Y), S};
  pg8::gemm_phase<EpiDown, MoeOrder, true, true>(GEMM_LDS, g, S, E);
}
#endif
DEV void phase_prep(const Params& p, int l) {
  const bf16_t* PROJ = (const bf16_t*)(p.ws + WS_PROJ);
  bf16_t* QC = (bf16_t*)(p.ws + WS_QC); bf16_t* KC = (bf16_t*)(p.ws + WS_KC);
  const int gtid = BID * NTHREADS + TID, gstride = NBLK * NTHREADS;
  const float* cw = p.conv_w + (size_t)l * CONVW * 2 * MW; const float* cb = p.conv_b + (size_t)l * 2 * MW;
  for (int it = gtid; it < (T / 8) * 128; it += gstride) {
    const int c8 = (it & 127) * 8, tb = (it >> 7) * 8, s0 = tb % SEQ;
    float wt[CONVW][8], bias[8];
    UNR for (int wi = 0; wi < CONVW; ++wi) { const f32x4 a = *(const f32x4*)(cw + wi * 2 * MW + c8), b = *(const f32x4*)(cw + wi * 2 * MW + c8 + 4); UNR for (int j = 0; j < 4; ++j) { wt[wi][j] = a[j]; wt[wi][4 + j] = b[j]; } }
    { const f32x4 a = *(const f32x4*)(cb + c8), b = *(const f32x4*)(cb + c8 + 4); UNR for (int j = 0; j < 4; ++j) { bias[j] = a[j]; bias[4 + j] = b[j]; } }
    bf16x8 rows[12];
    UNR for (int r = 0; r < 12; ++r) { const int ss = s0 + r - 2; rows[r] = (ss >= 0 && ss < SEQ) ? ld8(PROJ + (size_t)(tb + r - 2) * NP + c8) : (bf16x8){0, 0, 0, 0, 0, 0, 0, 0}; }
    const float sc = (c8 < MW) ? 0.08838834764831845f : 1.f;
    UNR for (int q = 0; q < 8; ++q) {
      float a[8]; UNR for (int j = 0; j < 8; ++j) a[j] = bias[j];
      UNR for (int wi = 0; wi < CONVW; ++wi) UNR for (int j = 0; j < 8; ++j) a[j] += bf2f((bf16_t)rows[q + wi][j]) * wt[wi][j];
      u32x4 o; o.x = pk2(siluf_(a[0]) * sc, siluf_(a[1]) * sc); o.y = pk2(siluf_(a[2]) * sc, siluf_(a[3]) * sc); o.z = pk2(siluf_(a[4]) * sc, siluf_(a[5]) * sc); o.w = pk2(siluf_(a[6]) * sc, siluf_(a[7]) * sc);
      if (c8 < MW) *(u32x4*)(QC + (size_t)(tb + q) * MW + c8) = o; else *(u32x4*)(KC + (size_t)(tb + q) * MW + c8 - MW) = o; }
  }
  bf16_t* AQN = (bf16_t*)(p.ws + WS_AQN); bf16_t* AKN = (bf16_t*)(p.ws + WS_AKN); bf16_t* VT = (bf16_t*)(p.ws + WS_VT);
  const float* rope = (const float*)(p.ws + WS_ROPE); constexpr int NR = SEQ / GRID_W;
  for (int it0 = BID * NTHREADS; it0 < T * 10 * 8; it0 += gstride) {
    const int it = it0 + TID, j = it & 7, th = it >> 3, hh = th / T, t = th % T, s = t % SEQ;
    const bool isq = hh < AH;
    const bf16_t* src = PROJ + (size_t)t * NP + (isq ? C_AQ + hh * 64 : C_AK + (hh - AH) * 64) + j * 8;
    const float* g = (isq ? p.q_norm_g : p.k_norm_g) + (size_t)l * AHD + j * 8;
    const bf16x8 x8 = ld8(src);
    float v[8], pr[8]; float ss = 0.f;
#pragma unroll
    for (int k = 0; k < 8; ++k) { v[k] = bf2f((bf16_t)x8[k]); ss += v[k] * v[k]; }
    ss += shfl_xor_f(ss, 1); ss += shfl_xor_f(ss, 2); ss += shfl_xor_f(ss, 4);
    const float rs = frsq(ss * (1.f / 64.f) + EPS);
#pragma unroll
    for (int k = 0; k < 8; ++k) v[k] = v[k] * rs * g[k];
#pragma unroll
    for (int k = 0; k < 8; ++k) pr[k] = shfl_xor_f(v[k], 2);
    const int pos = (j < 4) ? s / GRID_W : s % GRID_W;
    const float* ct = rope + (j < 4 ? 0 : 2 * NR * 16) + pos * 16 + (j & 1) * 8;
    const float* st = ct + (j < 4 ? NR * 16 : 64 * 16);
    const float sgn = (j & 2) ? 1.f : -1.f, qs = isq ? 0.125f * 1.4426950408889634f : 1.f;
    float o[8];
#pragma unroll
    for (int k = 0; k < 8; ++k) o[k] = (v[k] * ct[k] + sgn * pr[k] * st[k]) * qs;
    u32x4 w4; w4.x = pk2(o[0], o[1]); w4.y = pk2(o[2], o[3]); w4.z = pk2(o[4], o[5]); w4.w = pk2(o[6], o[7]);
    bf16_t* dst = isq ? AQN + (size_t)t * AW + hh * 64 + j * 8 : AKN + (size_t)t * KVW + (hh - AH) * 64 + j * 8;
    *(u32x4*)dst = w4;
  }
#ifdef EMU
  for (int it = gtid; it < T * KVH * 8; it += gstride) {
    const int s = it % SEQ, d8 = (it / SEQ) & 7, bk = it / (SEQ * 8), b = bk / KVH, kv = bk % KVH;
    const bf16x8 v8 = ld8(PROJ + (size_t)(b * SEQ + s) * NP + C_AV + kv * 64 + d8 * 8);
#pragma unroll
    for (int k = 0; k < 8; ++k) VT[((size_t)bk * 64 + d8 * 8 + k) * SEQ + s] = (bf16_t)v8[k];
  }
#else
  (void)VT;
#endif
}

#ifdef EMU
DEV void phase_attn(const Params& p) {
  char* lds = LDS_PTR();
  bf16_t* Ks = (bf16_t*)lds; bf16_t* Vs = Ks + 64 * GP; bf16_t* Ps = Vs + 64 * GP;
  const bf16_t* AQN = (const bf16_t*)(p.ws + WS_AQN); const bf16_t* AKN = (const bf16_t*)(p.ws + WS_AKN); const bf16_t* VT = (const bf16_t*)(p.ws + WS_VT);
  bf16_t* YA = (bf16_t*)(p.ws + WS_YA);
  const int tid = TID, lane = tid & 63, w = tid >> 6;
  constexpr int NQB = SEQ / 128, NU = BATCH * AH * NQB;
  bf16_t* Pw = Ps + w * 16 * GP;
  for (int u = BID; u < NU; u += NBLK) {
    const int qb = u % NQB, h = (u / NQB) % AH, b = u / (NQB * AH), kv = h / (AH / KVH);
    const int r0 = qb * 128 + w * 16;
    bf16x8 qa[2];
    UNR for (int ks = 0; ks < 2; ++ks) qa[ks] = ld8(AQN + (size_t)(b * SEQ + r0 + (lane & 15)) * AW + h * 64 + ks * 32 + (lane >> 4) * 8);
    f32x4 o[4]; UNR for (int i = 0; i < 4; ++i) o[i] = (f32x4){0.f, 0.f, 0.f, 0.f};
    float mrow[4], lrow[4]; UNR for (int i = 0; i < 4; ++i) { mrow[i] = -3.0e38f; lrow[i] = 0.f; }
    for (int kt = 0; kt < SEQ / 64; ++kt) {
      SYNC();
      { const int r = tid >> 3, pc = (tid & 7) * 8;
        *(u32x4*)(Ks + r * GP + pc) = *(const u32x4*)(AKN + (size_t)(b * SEQ + kt * 64 + r) * KVW + kv * 64 + pc);
        *(u32x4*)(Vs + r * GP + pc) = *(const u32x4*)(VT + ((size_t)(b * KVH + kv) * 64 + r) * SEQ + kt * 64 + pc); }
      SYNC();
      f32x4 s[4];
      UNR for (int nt = 0; nt < 4; ++nt) { s[nt] = (f32x4){0.f, 0.f, 0.f, 0.f};
        UNR for (int ks = 0; ks < 2; ++ks) s[nt] = mfma16(qa[ks], ld8(Ks + (nt * 16 + (lane & 15)) * GP + ks * 32 + (lane >> 4) * 8), s[nt]); }
      UNR for (int i = 0; i < 4; ++i) {
        float mx = fmaxf(fmaxf(s[0][i], s[1][i]), fmaxf(s[2][i], s[3][i])); mx = grp16_max(mx);
        const float mnew = fmaxf(mrow[i], mx), alpha = exp2f(mrow[i] - mnew); mrow[i] = mnew;
        float rsum = 0.f;
        UNR for (int nt = 0; nt < 4; ++nt) { const float pv = exp2f(s[nt][i] - mnew); rsum += pv; Pw[((lane >> 4) * 4 + i) * GP + nt * 16 + (lane & 15)] = f2bf(pv); }
        lrow[i] = lrow[i] * alpha + rsum;
        UNR for (int nd = 0; nd < 4; ++nd) o[nd][i] *= alpha;
      }
      SYNC();
      UNR for (int ks = 0; ks < 2; ++ks) { const bf16x8 pa = ld8(Pw + (lane & 15) * GP + ks * 32 + (lane >> 4) * 8);
        UNR for (int nd = 0; nd < 4; ++nd) o[nd] = mfma16(pa, ld8(Vs + (nd * 16 + (lane & 15)) * GP + ks * 32 + (lane >> 4) * 8), o[nd]); }
    }
    UNR for (int i = 0; i < 4; ++i) { const float lt = grp16_sum(lrow[i]), inv = frcp(lt); const int row = b * SEQ + r0 + (lane >> 4) * 4 + i;
      UNR for (int nd = 0; nd < 4; ++nd) YA[(size_t)row * AW + h * 64 + nd * 16 + (lane & 15)] = f2bf(o[nd][i] * inv); }
  }
}

#else
namespace attn_body {
using bf16=unsigned short;
using bf16x8=__attribute__((ext_vector_type(8)))short;
using s16x4=__attribute__((ext_vector_type(4)))short;
using f32x16=__attribute__((ext_vector_type(16)))float;
using u32x4=__attribute__((ext_vector_type(4)))unsigned;
constexpr int SEQ=::SEQ,D=64;
constexpr int NW=8,QBLK=32,QB=QBLK*NW,KVBLK=64,NQB=SEQ/QB;
constexpr int ATTN_UNIT_ROWS=QB;
__device__ __forceinline__ int crow(int r,int hi){return (r&3)+8*(r>>2)+4*hi;}
#define SBAR() __builtin_amdgcn_sched_barrier(0)
constexpr int NSLOT=3, SLOTB=8192;
constexpr int LDS_K=0, LDS_V=NSLOT*SLOTB, LDS_WS=2*NSLOT*SLOTB, LDS_OST=LDS_WS+NW*64*4, LDS_BYTES=LDS_OST+NW*4096;
constexpr float C2=0.125f*1.4426950408889634f;
__device__ __forceinline__ void glds16(const void*gsrc,unsigned lds_dst){unsigned keep;
  asm volatile("s_mov_b32 %0, m0\n\ts_mov_b32 m0, %2\n\ts_nop 0\n\tglobal_load_lds_dwordx4 %1, off\n\ts_mov_b32 m0, %0":"=&s"(keep):"v"(gsrc),"s"(lds_dst):"memory");}
__device__ __forceinline__ float max3f(float a,float b,float c){float r;asm("v_max3_f32 %0, %1, %2, %3":"=v"(r):"v"(a),"v"(b),"v"(c));return r;}
__device__ __forceinline__ float max2f(float a,float b){float r;asm("v_max_f32_e32 %0, %1, %2":"=v"(r):"v"(a),"v"(b));return r;}
__device__ __forceinline__ float fadd_s(float a,float b){float r;asm("v_add_f32_e32 %0, %1, %2":"=v"(r):"v"(a),"v"(b));return r;}
__device__ __forceinline__ float fsub_s(float a,float b){float r;asm("v_sub_f32_e32 %0, %1, %2":"=v"(r):"v"(a),"v"(b));return r;}
typedef float f32x2_t __attribute__((ext_vector_type(2))); typedef __bf16 bf16x2_t __attribute__((ext_vector_type(2)));
__device__ __forceinline__ unsigned cvtpk_s(float lo,float hi){f32x2_t v={lo,hi};bf16x2_t b=__builtin_convertvector(v,bf16x2_t);return __builtin_bit_cast(unsigned,b);}
#define WAIT_BAR(N) asm volatile("s_waitcnt vmcnt(" #N ") lgkmcnt(0)\n\ts_barrier":::"memory")

__device__ __forceinline__ void qkt(f32x16&p0,f32x16&p1,const char*Kslot,const bf16x8*qr,const f32x16&negm,int r32,int hi){
  const char*kb=Kslot+hi*1024+r32*16;
  #pragma unroll
  for(int d0=0;d0<4;++d0){
    const bf16x8 b0=*reinterpret_cast<const bf16x8*>(kb+d0*2048);
    const bf16x8 b1=*reinterpret_cast<const bf16x8*>(kb+d0*2048+512);
    if(d0==0){p0=__builtin_amdgcn_mfma_f32_32x32x16_bf16(b0,qr[0],negm,0,0,0);p1=__builtin_amdgcn_mfma_f32_32x32x16_bf16(b1,qr[0],negm,0,0,0);}
    else{p0=__builtin_amdgcn_mfma_f32_32x32x16_bf16(b0,qr[d0],p0,0,0,0);p1=__builtin_amdgcn_mfma_f32_32x32x16_bf16(b1,qr[d0],p1,0,0,0);}}
}
typedef __attribute__((address_space(3))) const char* lds_cptr;
typedef short v4i16_t __attribute__((ext_vector_type(4)));
__device__ __forceinline__ void kload8(bf16x8*kf,lds_cptr kp){
  kf[0]=*(const __attribute__((address_space(3))) bf16x8*)(kp);      kf[1]=*(const __attribute__((address_space(3))) bf16x8*)(kp+512);
  kf[2]=*(const __attribute__((address_space(3))) bf16x8*)(kp+2048); kf[3]=*(const __attribute__((address_space(3))) bf16x8*)(kp+2560);
  kf[4]=*(const __attribute__((address_space(3))) bf16x8*)(kp+4096); kf[5]=*(const __attribute__((address_space(3))) bf16x8*)(kp+4608);
  kf[6]=*(const __attribute__((address_space(3))) bf16x8*)(kp+6144); kf[7]=*(const __attribute__((address_space(3))) bf16x8*)(kp+6656);
}
__device__ __forceinline__ void kload2(bf16x8*kf,lds_cptr kp,int j){ kf[2*j]=*(const __attribute__((address_space(3))) bf16x8*)(kp+j*2048); kf[2*j+1]=*(const __attribute__((address_space(3))) bf16x8*)(kp+j*2048+512); }
__device__ __forceinline__ s16x4 vtr(lds_cptr p){ return __builtin_bit_cast(s16x4,__builtin_amdgcn_ds_read_tr16_b64_v4i16((__attribute__((address_space(3))) v4i16_t*)p)); }
__device__ __forceinline__ float rowmax(const f32x16&p0,const f32x16&p1){
  float a=max3f(p0[0],p0[1],p1[0]),b=max3f(p0[2],p0[3],p1[1]);a=max3f(a,p1[2],p1[3]);
  #pragma unroll
  for(int r=4;r<16;r+=4){a=max3f(a,p0[r],p0[r+1]);b=max3f(b,p0[r+2],p0[r+3]);a=max3f(a,p1[r],p1[r+1]);b=max3f(b,p1[r+2],p1[r+3]);}
  const float m=max2f(a,b);
  auto rr=__builtin_amdgcn_permlane32_swap(__float_as_uint(m),__float_as_uint(m),false,false);
  return max2f(__uint_as_float(rr[0]),__uint_as_float(rr[1]));
}
__device__ __forceinline__ void pv(f32x16*o,int vb,bf16x8 pa0,bf16x8 pa1,bf16x8 pa2,bf16x8 pa3){
  #pragma unroll
  for(int d0=0;d0<2;++d0){s16x4 lo[4],hi[4];
    #pragma unroll
    for(int ks=0;ks<4;++ks){
      asm volatile("ds_read_b64_tr_b16 %0,%1 offset:%c2":"=&v"(lo[ks]):"v"(vb),"i"(d0*4096+ks*1024):"memory");
      asm volatile("ds_read_b64_tr_b16 %0,%1 offset:%c2":"=&v"(hi[ks]):"v"(vb),"i"(d0*4096+ks*1024+512):"memory");}
    asm volatile("s_waitcnt lgkmcnt(0)":::"memory");SBAR();
    #define PK(k) (bf16x8){lo[k][0],lo[k][1],lo[k][2],lo[k][3],hi[k][0],hi[k][1],hi[k][2],hi[k][3]}
    o[d0]=__builtin_amdgcn_mfma_f32_32x32x16_bf16(pa0,PK(0),o[d0],0,0,0);
    o[d0]=__builtin_amdgcn_mfma_f32_32x32x16_bf16(pa1,PK(1),o[d0],0,0,0);
    o[d0]=__builtin_amdgcn_mfma_f32_32x32x16_bf16(pa2,PK(2),o[d0],0,0,0);
    o[d0]=__builtin_amdgcn_mfma_f32_32x32x16_bf16(pa3,PK(3),o[d0],0,0,0);
    #undef PK
  }
}

#ifndef ATTN_STORE16
#define ATTN_STORE16(p,v) (*(u32x4*)(p)=(v))
#endif
template<int THRL,int QP,int KP,int VP> __device__ __forceinline__ void attn_unit(long rowbase,int qb,const bf16*Q,const bf16*__restrict__ K,const bf16*__restrict__ V,bf16*O,char*shm){
  const int tid=TID,lane=tid&63,r32=lane&31,hi=lane>>5; const int wid=__builtin_amdgcn_readfirstlane(tid>>6);
  const int q0=qb*QB;
  const bf16*Qw=Q+(rowbase+q0+wid*QBLK)*QP;
  const bf16*Kh=K+rowbase*KP,*Vh=V+rowbase*VP;
  const unsigned lds0=(unsigned)(uintptr_t)shm;
  float*wsf=(float*)(shm+LDS_WS)+wid*64;
  const bf16*ksrc=Kh+(long)lane*KP+wid*8;
  const bf16*vsrc=Vh+(long)(16*(wid&3)+(lane>>2))*VP+(wid>>2)*32+(lane&3)*8;
  const unsigned kdst=lds0+LDS_K+wid*1024, vdst=lds0+LDS_V+wid*1024;
  #define DMA_K(t,slot) glds16(ksrc+(long)(t)*KVBLK*KP,(unsigned)__builtin_amdgcn_readfirstlane(kdst+(slot)))
  #define DMA_V(t,slot) glds16(vsrc+(long)(t)*KVBLK*VP,(unsigned)__builtin_amdgcn_readfirstlane(vdst+(slot)))
  const int vb0=(int)(lds0+LDS_V)+((lane>>4)&1)*32+(lane&3)*8+(4*hi+((lane&15)>>2))*64;
  const char*Kbase=shm+LDS_K; bf16x8 kf[8];
  const lds_cptr shm3=(lds_cptr)shm; const lds_cptr kp0=shm3+LDS_K+hi*1024+r32*16; const lds_cptr vp0=shm3+LDS_V+((lane>>4)&1)*32+(lane&3)*8+(4*hi+((lane&15)>>2))*64;
  int NT=SEQ/KVBLK; asm volatile("":"+s"(NT));
  DMA_K(0,0);DMA_V(0,0);DMA_K(1,SLOTB);
  bf16x8 qr[4];
  #pragma unroll
  for(int d0=0;d0<4;++d0)qr[d0]=*reinterpret_cast<const bf16x8*>(&Qw[(long)r32*QP+d0*16+hi*8]);
  float mhat=0.f,l_reg=0.f;f32x16 o[2];o[0]=f32x16{};o[1]=f32x16{};f32x16 negm=f32x16{};asm volatile("":"+v"(negm));
  #define CMASK(P0,P1,t) do{}while(0)
  bool resc=false;
  #define START(P0,P1) do{ const float rm=rowmax(P0,P1); resc=false; \
    { const float dl=rm; mhat=fadd_s(mhat,dl); \
      _Pragma("unroll") for(int r=0;r<16;++r){P0[r]=fsub_s(P0[r],dl);P1[r]=fsub_s(P1[r],dl);} \
      _Pragma("unroll") for(int r=0;r<16;++r)negm[r]=-mhat; asm volatile("":"+v"(negm)); } \
    _Pragma("unroll") for(int r=0;r<16;++r)P0[r]=__builtin_amdgcn_exp2f(P0[r]); }while(0)
  #define RESC() do{ if(resc){ asm volatile("s_waitcnt lgkmcnt(0)":::"memory"); \
      _Pragma("unroll") for(int d_=0;d_<2;++d_) _Pragma("unroll") for(int r=0;r<16;++r)o[d_][r]*=wsf[crow(r,hi)]; } }while(0)
  f32x16 pA0,pA1,pB0,pB1;
  int sl_prev=0,sl_cur=0,sl_next=SLOTB;
  #define ROT() do{sl_prev=sl_cur;sl_cur=sl_next;sl_next=(sl_next==(NSLOT-1)*SLOTB)?0:sl_next+SLOTB;}while(0)
  DMA_K(2,2*SLOTB);
  WAIT_BAR(3);
  qkt(pA0,pA1,Kbase,qr,negm,r32,hi);asm volatile("s_nop 15\n\ts_nop 7":"+v"(pA0),"+v"(pA1));CMASK(pA0,pA1,0);
  START(pA0,pA1);
  _Pragma("unroll") for(int r=0;r<16;++r)pA1[r]=__builtin_amdgcn_exp2f(pA1[r]);
  WAIT_BAR(0);
  DMA_K(3,0);DMA_V(1,SLOTB);
  ROT();
  kload8(kf,kp0+sl_cur);
  WAIT_BAR(2);
  s16x4 vlo[8],vhi[8]; u32x4 pw0,pw1,pw2,pw3;
  #define PKW(P,B) cvtpk_s(P[B],P[B+1])
  #define PAF(k) __builtin_bit_cast(bf16x8,pw##k)
  #define VFR(i) (bf16x8){vlo[i][0],vlo[i][1],vlo[i][2],vlo[i][3],vhi[i][0],vhi[i][1],vhi[i][2],vhi[i][3]}
  #define PIN(x) asm volatile("":"+v"(x))
  #define MX3(a,b,c) __builtin_fmaxf(__builtin_fmaxf((a),(b)),(c))
  #define GAPA(MF,A0,A1,A2,A3,W0,W1,PW) do{ MF; sacc+=A0; sacc+=A1; sacc+=A2; sacc+=A3; PIN(sacc); W0; W1; PIN(PW); SBAR(); }while(0)
  #define EX(v) __builtin_amdgcn_exp2f(v)
  #define GAPB(MF,X,B) do{ MF; X[B]=EX(X[B]); X[B+1]=EX(X[B+1]); X[B+2]=EX(X[B+2]); X[B+3]=EX(X[B+3]); PIN(X); SBAR(); }while(0)
  #define VRD(i) do{ vlo[i]=vtr(vp_+(((i)>>2)*4096+((i)&3)*1024)); vhi[i]=vtr(vp_+(((i)>>2)*4096+((i)&3)*1024+512)); }while(0)
  #define KRD(G,j) do{ if(G){ kload2(kf,kp0+sl_next,j); SBAR(); } }while(0)
  #define STEP(C0,C1,P0,P1,t,GK,GV,GL) do{ SBAR(); \
    const lds_cptr vp_=vp0+sl_prev; \
    VRD(0); SBAR(); float sacc=(P0[0]+P0[1]); \
    GAPA(C0=__builtin_amdgcn_mfma_f32_32x32x16_bf16(kf[0],qr[0],negm,0,0,0), P0[2],P0[3],P0[4],P0[5],     pw0[0]=PKW(P0,0), pw0[1]=PKW(P0,2), pw0); \
    VRD(4); SBAR(); GAPA(C1=__builtin_amdgcn_mfma_f32_32x32x16_bf16(kf[1],qr[0],negm,0,0,0), P0[6],P0[7],P0[8],P0[9],     pw0[2]=PKW(P0,4), pw0[3]=PKW(P0,6), pw0); \
    VRD(1); SBAR(); GAPA(C0=__builtin_amdgcn_mfma_f32_32x32x16_bf16(kf[2],qr[1],C0,0,0,0),   P0[10],P0[11],P0[12],P0[13], pw1[0]=PKW(P0,8), pw1[1]=PKW(P0,10), pw1); \
    VRD(5); SBAR(); GAPA(C1=__builtin_amdgcn_mfma_f32_32x32x16_bf16(kf[3],qr[1],C1,0,0,0),   P0[14],P0[15],P1[0],P1[1],   pw1[2]=PKW(P0,12),pw1[3]=PKW(P0,14), pw1); \
    VRD(2); SBAR(); GAPA(C0=__builtin_amdgcn_mfma_f32_32x32x16_bf16(kf[4],qr[2],C0,0,0,0),   P1[2],P1[3],P1[4],P1[5],     pw2[0]=PKW(P1,0), pw2[1]=PKW(P1,2), pw2); \
    VRD(6); SBAR(); GAPA(C1=__builtin_amdgcn_mfma_f32_32x32x16_bf16(kf[5],qr[2],C1,0,0,0),   P1[6],P1[7],P1[8],P1[9],     pw2[2]=PKW(P1,4), pw2[3]=PKW(P1,6), pw2); \
    VRD(3); SBAR(); GAPA(C0=__builtin_amdgcn_mfma_f32_32x32x16_bf16(kf[6],qr[3],C0,0,0,0),   P1[10],P1[11],P1[12],P1[13], pw3[0]=PKW(P1,8), pw3[1]=PKW(P1,10), pw3); \
    VRD(7); SBAR(); GAPA(C1=__builtin_amdgcn_mfma_f32_32x32x16_bf16(kf[7],qr[3],C1,0,0,0),   P1[14],P1[15],0.f,0.f,       pw3[2]=PKW(P1,12),pw3[3]=PKW(P1,14), pw3); \
    l_reg+=sacc; \
    if(GK){DMA_K((t)+3,sl_cur);} if(GV){DMA_V((t)+1,sl_next);} \
    CMASK(C0,C1,t); \
    { float a=MX3(C0[0],C0[1],C1[0]),b=MX3(C0[2],C0[3],C1[1]); a=MX3(a,C1[2],C1[3]); \
      _Pragma("unroll") for(int r=4;r<16;r+=4){a=MX3(a,C0[r],C0[r+1]);b=MX3(b,C0[r+2],C0[r+3]);a=MX3(a,C1[r],C1[r+1]);b=MX3(b,C1[r+2],C1[r+3]);} \
      float rm=__builtin_fmaxf(a,b); { auto rr=__builtin_amdgcn_permlane32_swap(__float_as_uint(rm),__float_as_uint(rm),false,false); rm=__builtin_fmaxf(__uint_as_float(rr[0]),__uint_as_float(rr[1])); } \
      resc=false; \
      if(__builtin_expect(__any(rm>(float)THRL),0)){ const float dl=__builtin_fmaxf(rm,0.f); mhat+=dl; \
        _Pragma("unroll") for(int r=0;r<16;++r){C0[r]-=dl;C1[r]-=dl;} \
        _Pragma("unroll") for(int r=0;r<16;++r)negm[r]=-mhat; asm volatile("":"+v"(negm)); \
        const float f=__builtin_amdgcn_exp2f(-dl); l_reg*=f; if(hi==0)wsf[r32]=f; resc=true; } } \
    SBAR(); \
    GAPB(o[0]=__builtin_amdgcn_mfma_f32_32x32x16_bf16(PAF(0),VFR(0),o[0],0,0,0), C0,0); \
    GAPB(o[1]=__builtin_amdgcn_mfma_f32_32x32x16_bf16(PAF(0),VFR(4),o[1],0,0,0), C0,4); \
    KRD(GL,0); GAPB(o[0]=__builtin_amdgcn_mfma_f32_32x32x16_bf16(PAF(1),VFR(1),o[0],0,0,0), C0,8); \
    KRD(GL,1); GAPB(o[1]=__builtin_amdgcn_mfma_f32_32x32x16_bf16(PAF(1),VFR(5),o[1],0,0,0), C0,12); \
    KRD(GL,2); GAPB(o[0]=__builtin_amdgcn_mfma_f32_32x32x16_bf16(PAF(2),VFR(2),o[0],0,0,0), C1,0); \
    KRD(GL,3); GAPB(o[1]=__builtin_amdgcn_mfma_f32_32x32x16_bf16(PAF(2),VFR(6),o[1],0,0,0), C1,4); \
    GAPB(o[0]=__builtin_amdgcn_mfma_f32_32x32x16_bf16(PAF(3),VFR(3),o[0],0,0,0), C1,8); \
    GAPB(o[1]=__builtin_amdgcn_mfma_f32_32x32x16_bf16(PAF(3),VFR(7),o[1],0,0,0), C1,12); \
    }while(0)
  int t=1;
  for(;t+5<NT;t+=2){
    STEP(pB0,pB1,pA0,pA1,t,true,true,true);     WAIT_BAR(2); RESC(); ROT();
    STEP(pA0,pA1,pB0,pB1,t+1,true,true,true);   WAIT_BAR(2); RESC(); ROT();
  }
  #define ENDW(tt) do{ if((tt)+3<NT){WAIT_BAR(2);} else if((tt)+2<NT){WAIT_BAR(1);} else {WAIT_BAR(0);} }while(0)
  for(;t+1<NT;t+=2){
    STEP(pB0,pB1,pA0,pA1,t,(t+3<NT),(t+1<NT),(t+1<NT));       ENDW(t);   RESC(); ROT();
    STEP(pA0,pA1,pB0,pB1,t+1,(t+4<NT),(t+2<NT),(t+2<NT));     ENDW(t+1); RESC(); ROT();
  }
  STEP(pB0,pB1,pA0,pA1,NT-1,false,false,false); RESC();
  { float sacc=pB0[0]+pB0[1]; _Pragma("unroll") for(int r=2;r<16;++r)sacc+=pB0[r]; _Pragma("unroll") for(int r=0;r<16;++r)sacc+=pB1[r]; l_reg+=sacc;
    pw0=(u32x4){PKW(pB0,0),PKW(pB0,2),PKW(pB0,4),PKW(pB0,6)};pw1=(u32x4){PKW(pB0,8),PKW(pB0,10),PKW(pB0,12),PKW(pB0,14)};pw2=(u32x4){PKW(pB1,0),PKW(pB1,2),PKW(pB1,4),PKW(pB1,6)};pw3=(u32x4){PKW(pB1,8),PKW(pB1,10),PKW(pB1,12),PKW(pB1,14)};
    SBAR(); pv(o,vb0+sl_cur,PAF(0),PAF(1),PAF(2),PAF(3)); }
  #undef PKW
  #undef PAF
  #undef VFR
  #undef PIN
  #undef MX3
  #undef GAPA
  #undef GAPB
  #undef EX
  #undef VRD
  #undef KRD
  #undef STEP
  #undef ENDW
  {auto rr=__builtin_amdgcn_permlane32_swap(__float_as_uint(l_reg),__float_as_uint(l_reg),false,false);l_reg=__uint_as_float(rr[0])+__uint_as_float(rr[1]);}
  if(hi==0)wsf[32+r32]=l_reg;asm volatile("s_waitcnt lgkmcnt(0)":::"memory");
  float rli[16];
  #pragma unroll
  for(int r=0;r<16;++r)rli[r]=__builtin_amdgcn_rcpf(wsf[32+crow(r,hi)]);
  bf16*Ow=O+(rowbase+q0+wid*QBLK)*QP;
  { bf16*stg=(bf16*)(shm+LDS_OST)+wid*2048;
    #pragma unroll
    for(int r=0;r<16;++r){const int orow=crow(r,hi);
      #pragma unroll
      for(int d0=0;d0<2;++d0)stg[orow*64+d0*32+r32]=f2bf(o[d0][r]*rli[r]);}
    asm volatile("s_waitcnt lgkmcnt(0)":::"memory");
    #pragma unroll
    for(int i=0;i<4;++i){const int row=i*8+(lane>>3),ch=lane&7; const u32x4 v=*(const u32x4*)(stg+row*64+ch*8); ATTN_STORE16(Ow+(long)row*QP+ch*8,v);} }
  asm volatile("s_waitcnt lgkmcnt(0)\n\ts_barrier":::"memory");
  #undef DMA_K
  #undef DMA_V
  #undef CMASK
  #undef START
  #undef RESC
  #undef ROT
}
#undef SBAR
#undef WAIT_BAR
}

DEV void phase_attn(const Params& p) {
  char* lds = LDS_PTR();
  const bf16_t* AQN = (const bf16_t*)(p.ws + WS_AQN); const bf16_t* AKN = (const bf16_t*)(p.ws + WS_AKN); const bf16_t* PROJ = (const bf16_t*)(p.ws + WS_PROJ);
  bf16_t* YA = (bf16_t*)(p.ws + WS_YA);
  constexpr int NQB = SEQ / 256, NU = BATCH * AH * NQB;
  for (int u = BID; u < NU; u += NBLK) {
    const int qb = u % NQB, h = (u / NQB) % AH, b = u / (NQB * AH), kv = h / (AH / KVH);
    attn_body::attn_unit<8, AW, KVW, NP>((long)b * SEQ, qb, AQN + h * 64, AKN + kv * 64, PROJ + C_AV + kv * 64, YA + h * 64, lds);
  }
}
#endif
DEV void phase_mlstm_a(const Params& p) {
  char* lds = LDS_PTR();
  bf16_t* Ks = (bf16_t*)lds;
  bf16_t* VW = Ks + 64 * 136;
  float* s_lf = (float*)(VW + 2 * 64 * 136); float* s_a = s_lf + 128; float* s_w = s_a + 128;
  constexpr int QPA = 136;
  const bf16_t* PROJ = (const bf16_t*)(p.ws + WS_PROJ); const bf16_t* KC = (const bf16_t*)(p.ws + WS_KC); const float* GATES = (const float*)(p.ws + WS_GATES);
  bf16_t* CST = (bf16_t*)(p.ws + WS_CST); float* NST = (float*)(p.ws + WS_NST); float* AMAX = (float*)(p.ws + WS_AMAX); float* BLAST = (float*)(p.ws + WS_BLAST);
  const int tid = TID, lane = tid & 63, w = tid >> 6, g = lane >> 4, c16 = lane & 15;
  u32x4 pk[2], pv[2]; float pli = 0.f, plf = 0.f;
  auto request = [&](int u) {
    const int c = u % NC, h = (u / NC) % MH, b = u / (NC * MH); const int t0 = b * SEQ + c * ML;
    UNR for (int i = 0; i < 2; ++i) { const int it = tid + NTHREADS * i, r = it >> 4, d8 = (it & 15) * 8;
      pk[i] = *(const u32x4*)(KC + (size_t)(t0 + r) * MW + h * 128 + d8); pv[i] = *(const u32x4*)(PROJ + (size_t)(t0 + r) * NP + C_MV + h * 128 + d8); }
    if (tid < 128) { const int dir = tid >> 6, q = tid & 63; pli = GATES[(size_t)(t0 + q) * 16 + (dir ? 8 : 0) + h]; plf = GATES[(size_t)(t0 + q) * 16 + (dir ? 12 : 4) + h]; }
  };
  int u = BID;
  if (u < BHC) request(u);
  for (; u < BHC; u += NBLK) {
    SYNC();
    UNR for (int i = 0; i < 2; ++i) { const int it = tid + NTHREADS * i, r = it >> 4, d8 = (it & 15) * 8; *(u32x4*)(Ks + r * QPA + d8) = pk[i]; }
    const u32x4 v0 = pv[0], v1 = pv[1];
    if (tid < 128) {
      const int dir = tid >> 6; const float lf = logsigmoidf_(plf), pre = wave_prefix_incl(lf, lane), tot = shfl_f(pre, 63);
      const float a = pli + (dir == 0 ? tot - pre : pre - lf);
      const float mx = wave_max(a);
      s_w[tid] = fexp(a - mx);
      if (lane == 0) { AMAX[dir * BHC + u] = mx; BLAST[dir * BHC + u] = tot; } }
    SYNC();
    UNR for (int i = 0; i < 2; ++i) { const int it = tid + NTHREADS * i, r = it >> 4, d8 = (it & 15) * 8; const u32x4 vv = i ? v1 : v0;
      const float wf = s_w[r], wb = s_w[64 + r];
      f32x4 a0, a1;
      a0[0] = __builtin_bit_cast(float, vv.x << 16); a0[1] = __builtin_bit_cast(float, vv.x & 0xffff0000u); a0[2] = __builtin_bit_cast(float, vv.y << 16); a0[3] = __builtin_bit_cast(float, vv.y & 0xffff0000u);
      a1[0] = __builtin_bit_cast(float, vv.z << 16); a1[1] = __builtin_bit_cast(float, vv.z & 0xffff0000u); a1[2] = __builtin_bit_cast(float, vv.w << 16); a1[3] = __builtin_bit_cast(float, vv.w & 0xffff0000u);
      u32x4 of, ob;
      of.x = pk2(a0[0] * wf, a0[1] * wf); of.y = pk2(a0[2] * wf, a0[3] * wf); of.z = pk2(a1[0] * wf, a1[1] * wf); of.w = pk2(a1[2] * wf, a1[3] * wf);
      ob.x = pk2(a0[0] * wb, a0[1] * wb); ob.y = pk2(a0[2] * wb, a0[3] * wb); ob.z = pk2(a1[0] * wb, a1[1] * wb); ob.w = pk2(a1[2] * wb, a1[3] * wb);
      *(u32x4*)(VW + r * QPA + d8) = of; *(u32x4*)(VW + (64 + r) * QPA + d8) = ob; }
    if (u + NBLK < BHC) request(u + NBLK);
    SYNC();
    { const int dir = w >> 2, m2 = w & 3;
      bf16x8 bfr[8][2];
      UNR for (int nt = 0; nt < 8; ++nt) UNR for (int ks = 0; ks < 2; ++ks) { const bf16_t* ba = VW + (dir * 64 + ks * 32 + 8 * g + (c16 >> 2)) * QPA + nt * 16 + 4 * (c16 & 3);
        bfr[nt][ks] = cat8(lds_tr16(ba), lds_tr16(ba + 4 * QPA)); }
      UNR for (int mi = 0; mi < 2; ++mi) { const int e0 = (m2 * 2 + mi) * 16;
        bf16x8 af[2];
        UNR for (int ks = 0; ks < 2; ++ks) { const bf16_t* aa = Ks + (ks * 32 + 8 * g + (c16 >> 2)) * QPA + e0 + 4 * (c16 & 3); af[ks] = cat8(lds_tr16(aa), lds_tr16(aa + 4 * QPA)); }
        UNR for (int nt = 0; nt < 8; ++nt) { f32x4 acc = (f32x4){0.f, 0.f, 0.f, 0.f};
          UNR for (int ks = 0; ks < 2; ++ks) acc = mfma16(af[ks], bfr[nt][ks], acc);
          u32x2 o; o.x = pk2(acc[0], acc[1]); o.y = pk2(acc[2], acc[3]);
          *(u32x2*)(CST + (size_t)(dir * BHC + u) * 16384 + (size_t)(nt * 16 + c16) * 128 + e0 + 4 * g) = o; } } }
    if (tid < 256) { const int dir = tid >> 7, e = tid & 127; float sacc = 0.f;
#pragma unroll 16
      for (int z = 0; z < 64; ++z) sacc += s_w[dir * 64 + z] * bf2f(Ks[z * QPA + e]);
      NST[(size_t)(dir * BHC + u) * 128 + e] = sacc; }
  }
}
DEV void phase_mlstm_scan(const Params& p) {
  bf16_t* CST = (bf16_t*)(p.ws + WS_CST); float* NST = (float*)(p.ws + WS_NST);
  const float* AMAX = (const float*)(p.ws + WS_AMAX); const float* BLAST = (const float*)(p.ws + WS_BLAST); float* MPREV = (float*)(p.ws + WS_MPREV);
  const int gtid = BID * NTHREADS + TID, gstride = NBLK * NTHREADS;
  constexpr int PER = 8192, SB = (NC % 8 == 0) ? 8 : 4;
  for (int it = gtid; it < 2 * BATCH * MH * PER; it += gstride) {
    const int pi = it % PER, dbh = it / PER, dir = dbh / (BATCH * MH), bh = dbh % (BATCH * MH);
    const bool hasn = pi < 64;
    float s0 = 0.f, s1 = 0.f, n0 = 0.f, n1 = 0.f, m = 0.f;
    for (int cc0 = 0; cc0 < NC; cc0 += SB) {
      unsigned in[SB]; float bl[SB], am[SB], i0[SB], i1[SB];
      UNR for (int j = 0; j < SB; ++j) { const int c = dir ? NC - 1 - (cc0 + j) : cc0 + j; const int u = dir * BHC + bh * NC + c;
        in[j] = *((const unsigned*)(CST + (size_t)u * 16384) + pi); bl[j] = BLAST[u]; am[j] = AMAX[u];
        if (hasn) { i0[j] = NST[(size_t)u * 128 + 2 * pi]; i1[j] = NST[(size_t)u * 128 + 2 * pi + 1]; } else { i0[j] = 0.f; i1[j] = 0.f; } }
      UNR for (int j = 0; j < SB; ++j) { const int c = dir ? NC - 1 - (cc0 + j) : cc0 + j; const int u = dir * BHC + bh * NC + c;
        const float mn = fmaxf(bl[j] + m, am[j]), dec = fexp(bl[j] + m - mn), inj = fexp(am[j] - mn);
        *((unsigned*)(CST + (size_t)u * 16384) + pi) = pk2(s0, s1);
        s0 = dec * s0 + inj * bf2f((bf16_t)(in[j] & 0xffff)); s1 = dec * s1 + inj * bf2f((bf16_t)(in[j] >> 16));
        if (hasn) { NST[(size_t)u * 128 + 2 * pi] = n0; NST[(size_t)u * 128 + 2 * pi + 1] = n1; n0 = dec * n0 + inj * i0[j]; n1 = dec * n1 + inj * i1[j]; }
        if (pi == 0) MPREV[u] = m;
        m = mn; }
    }
  }
}
constexpr int QP = 136;
constexpr int PP = 72;
DEV void phase_mlstm_c(const Params& p, int l) {
  char* lds = LDS_PTR();
  bf16_t* Qs = (bf16_t*)lds; bf16_t* Ks = Qs + 64 * QP; bf16_t* Vs = Ks + 64 * QP;
  bf16_t* Pd = Vs + 64 * QP;
  bf16_t* Qd = Pd + 2 * 64 * PP;
  float* s_lf = (float*)(Qd + 2 * 64 * QP);
  float* s_b = s_lf + 128;
  float* s_li = s_b + 128;
  float* s_n = s_li + 128;
  float* s_m = s_n + 256;
  float* s_ss = s_m + 4;
  const int tid = TID, lane = tid & 63, w = tid >> 6, g = lane >> 4, c16 = lane & 15;
  const bf16_t* PROJ = (const bf16_t*)(p.ws + WS_PROJ); const bf16_t* QC = (const bf16_t*)(p.ws + WS_QC); const bf16_t* KC = (const bf16_t*)(p.ws + WS_KC);
  const float* GATES = (const float*)(p.ws + WS_GATES); const bf16_t* CST = (const bf16_t*)(p.ws + WS_CST); const float* NST = (const float*)(p.ws + WS_NST);
  const float* MPREV = (const float*)(p.ws + WS_MPREV); bf16_t* YM = (bf16_t*)(p.ws + WS_YM);
  const float* ng = p.mlstm_norm_g + (size_t)l * MW;
  u32x4 pq[2], pk[2], pv[2]; float pli = 0.f, plf = 0.f;
  auto request = [&](int u) {
    const int c = u % NC, h = (u / NC) % MH, b = u / (NC * MH); const int t0 = b * SEQ + c * ML;
    UNR for (int i = 0; i < 2; ++i) { const int it = tid + NTHREADS * i, r = it >> 4, d8 = (it & 15) * 8;
      pq[i] = *(const u32x4*)(QC + (size_t)(t0 + r) * MW + h * 128 + d8); pk[i] = *(const u32x4*)(KC + (size_t)(t0 + r) * MW + h * 128 + d8);
      pv[i] = *(const u32x4*)(PROJ + (size_t)(t0 + r) * NP + C_MV + h * 128 + d8); }
    if (tid < 128) { const int dir = tid >> 6, q = tid & 63; pli = GATES[(size_t)(t0 + q) * 16 + (dir ? 8 : 0) + h]; plf = GATES[(size_t)(t0 + q) * 16 + (dir ? 12 : 4) + h]; }
  };
  int u = BID;
  if (u < BHC) request(u);
  for (; u < BHC; u += NBLK) {
    const int c = u % NC, h = (u / NC) % MH, b = u / (NC * MH);
    const int t0 = b * SEQ + c * ML;
    SYNC();
    UNR for (int i = 0; i < 2; ++i) { const int it = tid + NTHREADS * i, r = it >> 4, d8 = (it & 15) * 8;
      *(u32x4*)(Qs + r * QP + d8) = pq[i]; *(u32x4*)(Ks + r * QP + d8) = pk[i]; *(u32x4*)(Vs + r * QP + d8) = pv[i]; }
    if (tid < 128) { const int dir = tid >> 6; const float lf = logsigmoidf_(plf), pre = wave_prefix_incl(lf, lane), tot = shfl_f(pre, 63);
      s_li[tid] = pli; s_b[tid] = (dir == 0) ? pre : tot - pre + lf; }
    if (tid < 256) s_n[tid] = NST[(size_t)((tid >> 7) * BHC + u) * 128 + (tid & 127)];
    if (tid < 2) s_m[tid] = MPREV[tid * BHC + u];
    bf16x8 cfr[2][4];
    UNR for (int dir = 0; dir < 2; ++dir) UNR for (int ks = 0; ks < 4; ++ks) cfr[dir][ks] = ld8(CST + (size_t)(dir * BHC + u) * 16384 + (size_t)(16 * w + c16) * 128 + ks * 32 + g * 8);
    u32x2 ogv[4];
    UNR for (int nt = 0; nt < 4; ++nt) ogv[nt] = *(const u32x2*)(PROJ + (size_t)(t0 + nt * 16 + c16) * NP + C_MO + h * 128 + 16 * w + 4 * g);
    SYNC();
    if (u + NBLK < BHC) request(u + NBLK);
    {
      const int j0 = (w & 3) * 16, dir = w >> 2;
      bf16x8 qa[4]; UNR for (int ks = 0; ks < 4; ++ks) qa[ks] = ld8(Qs + (j0 + c16) * QP + ks * 32 + g * 8);
      f32x4 S[4];
      UNR for (int nt = 0; nt < 4; ++nt) { S[nt] = (f32x4){0.f, 0.f, 0.f, 0.f};
        UNR for (int ks = 0; ks < 4; ++ks) S[nt] = mfma16(qa[ks], ld8(Ks + (nt * 16 + c16) * QP + ks * 32 + g * 8), S[nt]); }
      float qn = 0.f; { const int e0 = g * 32;
        UNR for (int e8 = 0; e8 < 4; ++e8) { const bf16x8 q8 = ld8(Qs + (j0 + c16) * QP + e0 + e8 * 8); const f32x4 n0 = *(const f32x4*)(s_n + dir * 128 + e0 + e8 * 8), n1 = *(const f32x4*)(s_n + dir * 128 + e0 + e8 * 8 + 4);
          UNR for (int j = 0; j < 4; ++j) qn += bf2f((bf16_t)q8[j]) * n0[j] + bf2f((bf16_t)q8[4 + j]) * n1[j]; }
        qn += shfl_xor_f(qn, 16); qn += shfl_xor_f(qn, 32); }
      const float* bb = s_b + dir * 64; const float* li = s_li + dir * 64; const float mp = s_m[dir];
      bf16_t* Pw = Pd + dir * 64 * PP;
      float fsc[4];
      UNR for (int i = 0; i < 4; ++i) {
        const int j = j0 + g * 4 + i; const float bj = bb[j];
        float dv[4], sv[4], mx = -3.0e38f;
        UNR for (int nt = 0; nt < 4; ++nt) { const int lk = nt * 16 + c16; const bool ok = dir ? (lk >= j) : (lk <= j);
          dv[nt] = ok ? (bj - bb[lk] + li[lk]) : -3.0e38f; mx = fmaxf(mx, dv[nt]); }
        mx = grp16_max(mx);
        const float mi = bj + mp, mo = fmaxf(mi, mx);
        float rsum = 0.f;
        UNR for (int nt = 0; nt < 4; ++nt) { sv[nt] = (dv[nt] > -1.0e38f) ? S[nt][i] * fexp(dv[nt] - mo) : 0.f; rsum += sv[nt]; }
        rsum = grp16_sum(rsum);
        const float iw = fexp(mi - mo);
        const float qnj = shfl_f(qn, g * 4 + i);
        const float den = rsum + iw * qnj;
        const float dinv = frcp(fmaxf(fabsf(den), fexp(-mo)));
        UNR for (int nt = 0; nt < 4; ++nt) Pw[j * PP + nt * 16 + c16] = f2bf(sv[nt] * dinv);
        fsc[i] = iw * dinv;
      }
      float fa = 0.f;
      UNR for (int i = 0; i < 4; ++i) { const float tv = shfl_f(fsc[i], (c16 >> 2) * 16); fa = ((lane & 3) == i) ? tv : fa; }
      UNR for (int ks = 0; ks < 4; ++ks) { u32x4 o;
        o.x = pk2(bf2f((bf16_t)qa[ks][0]) * fa, bf2f((bf16_t)qa[ks][1]) * fa); o.y = pk2(bf2f((bf16_t)qa[ks][2]) * fa, bf2f((bf16_t)qa[ks][3]) * fa);
        o.z = pk2(bf2f((bf16_t)qa[ks][4]) * fa, bf2f((bf16_t)qa[ks][5]) * fa); o.w = pk2(bf2f((bf16_t)qa[ks][6]) * fa, bf2f((bf16_t)qa[ks][7]) * fa);
        *(u32x4*)(Qd + (dir * 64 + j0 + c16) * QP + ks * 32 + g * 8) = o; }
    }
    SYNC();
    {
      f32x4 acc[4]; UNR for (int nt = 0; nt < 4; ++nt) acc[nt] = (f32x4){0.f, 0.f, 0.f, 0.f};
      bf16x8 vt[2];
      UNR for (int ks = 0; ks < 2; ++ks) { const bf16_t* va = Vs + (ks * 32 + 8 * g + (c16 >> 2)) * QP + 16 * w + 4 * (c16 & 3);
        vt[ks] = cat8(lds_tr16(va), lds_tr16(va + 4 * QP)); }
      UNR for (int dir = 0; dir < 2; ++dir) {
        UNR for (int ks = 0; ks < 2; ++ks) UNR for (int nt = 0; nt < 4; ++nt) acc[nt] = mfma16(vt[ks], ld8(Pd + (dir * 64 + nt * 16 + c16) * PP + ks * 32 + g * 8), acc[nt]);
        UNR for (int ks = 0; ks < 4; ++ks) UNR for (int nt = 0; nt < 4; ++nt) acc[nt] = mfma16(cfr[dir][ks], ld8(Qd + (dir * 64 + nt * 16 + c16) * QP + ks * 32 + g * 8), acc[nt]);
      }
      UNR for (int nt = 0; nt < 4; ++nt) { float ss = acc[nt][0] * acc[nt][0] + acc[nt][1] * acc[nt][1] + acc[nt][2] * acc[nt][2] + acc[nt][3] * acc[nt][3];
        ss += shfl_xor_f(ss, 16); ss += shfl_xor_f(ss, 32);
        if (g == 0) s_ss[w * 64 + nt * 16 + c16] = ss; }
      SYNC();
      const f32x4 gv = *(const f32x4*)(ng + h * 128 + 16 * w + 4 * g);
      UNR for (int nt = 0; nt < 4; ++nt) { const int j = nt * 16 + c16; float tot = 0.f; UNR for (int ww = 0; ww < 8; ++ww) tot += s_ss[ww * 64 + j];
        const float rs = frsq(tot * (1.f / 128.f) + EPS);
        const float o0 = bf2f((bf16_t)(ogv[nt].x & 0xffff)), o1 = bf2f((bf16_t)(ogv[nt].x >> 16)), o2 = bf2f((bf16_t)(ogv[nt].y & 0xffff)), o3 = bf2f((bf16_t)(ogv[nt].y >> 16));
        u32x2 o; o.x = pk2(acc[nt][0] * rs * gv[0] * sigmoidf_(o0), acc[nt][1] * rs * gv[1] * sigmoidf_(o1)); o.y = pk2(acc[nt][2] * rs * gv[2] * sigmoidf_(o2), acc[nt][3] * rs * gv[3] * sigmoidf_(o3));
        *(u32x2*)(YM + (size_t)(t0 + j) * MW + h * 128 + 16 * w + 4 * g) = o; }
    }
  }
}

#ifndef EMU
#define XB_TMO      128
#define XB_XCNT(j)  (256  + 64 * (j))
#define XB_XSUB(j)  (1280 + 64 * (j))
#define XB_XGEN(j)  (2304 + 64 * (j))
#define XB_TOP      3328
#define XB_TOPGEN   3392
#define XCD_BAR_WORDS 3456
#define XB_SPIN_CAP (1u << 18)
#define LAS __attribute__((address_space(3)))
__device__ __forceinline__ unsigned xb_ld(unsigned* p)              { return __hip_atomic_load(p, __ATOMIC_RELAXED, __HIP_MEMORY_SCOPE_AGENT); }
__device__ __forceinline__ unsigned xb_add(unsigned* p, unsigned v) { return __hip_atomic_fetch_add(p, v, __ATOMIC_RELAXED, __HIP_MEMORY_SCOPE_AGENT); }
__device__ __forceinline__ unsigned xb_xcc_id() { return (unsigned)__builtin_amdgcn_s_getreg((3 << 11) | 20) & 0xFu; }
#define XB_SPIN(cond, bar) do { unsigned _sp = 0; while (cond) { __builtin_amdgcn_s_sleep(1); \
    if ((++_sp & 255u) == 0u) { if (xb_ld(&(bar)[XB_TMO])) break; if (_sp > XB_SPIN_CAP) { atomicAdd(&(bar)[XB_TMO], 1u); break; } } } } while (0)
struct XcdBarrier { unsigned* bar; unsigned x; volatile LAS unsigned* st; };
__device__ __forceinline__ XcdBarrier xcd_barrier_post(unsigned* bar, volatile LAS unsigned* st) {
    XcdBarrier b; b.bar = bar; b.x = xb_xcc_id(); b.st = st;
    if (threadIdx.x == 0) (void)xb_add(&bar[XB_XCNT(b.x)], 1u);
    return b;
}
__device__ __forceinline__ void xcd_barrier_complete(unsigned* bar, unsigned x, unsigned& nloc, unsigned& nx) {
    const unsigned G = gridDim.x * gridDim.y * gridDim.z;
    unsigned sum, cnt, mine, sp = 0u;
    for (;;) {
        sum = 0u; cnt = 0u; mine = 0u;
#pragma unroll
        for (unsigned j = 0; j < 16; ++j) { const unsigned c = xb_ld(&bar[XB_XCNT(j)]); sum += c; cnt += (c > 0u) ? 1u : 0u; mine = (j == x) ? c : mine; }
        if (sum == G) break;
        __builtin_amdgcn_s_sleep(1);
        if ((++sp & 255u) == 0u) { if (xb_ld(&bar[XB_TMO])) break; if (sp > XB_SPIN_CAP) { atomicAdd(&bar[XB_TMO], 1u); break; } }
    }
    nloc = mine > 0u ? mine : 1u; nx = cnt > 0u ? cnt : 1u;
}
__device__ __forceinline__ void xcd_barrier(const XcdBarrier& b) {
    asm volatile("s_waitcnt vmcnt(0)" ::: "memory");
    __syncthreads();
    if (threadIdx.x == 0) {
        unsigned* bar = b.bar;
        __builtin_amdgcn_s_waitcnt(0);
        unsigned nloc = b.st[0], nx = b.st[1];
        if (nloc == 0u) { xcd_barrier_complete(bar, b.x, nloc, nx); b.st[0] = nloc; b.st[1] = nx; }
        const unsigned old = xb_add(&bar[XB_XSUB(b.x)], 1u);
        const unsigned gen = old / nloc;
        if (old + 1u == (gen + 1u) * nloc) {
            __builtin_amdgcn_fence(__ATOMIC_RELEASE, "agent");
            asm volatile("s_waitcnt vmcnt(0)" ::: "memory");
            const unsigned og = xb_add(&bar[XB_TOP], 1u);
            const unsigned tg = og / nx;
            if (og + 1u == (tg + 1u) * nx) xb_add(&bar[XB_TOPGEN], 1u);
            else XB_SPIN(xb_ld(&bar[XB_TOPGEN]) == tg, bar);
            __builtin_amdgcn_fence(__ATOMIC_ACQUIRE, "agent");
            xb_add(&bar[XB_XGEN(b.x)], 1u);
            asm volatile("s_waitcnt vmcnt(0)" ::: "memory");
        } else {
            XB_SPIN(xb_ld(&bar[XB_XGEN(b.x)]) == gen, bar);
            __builtin_amdgcn_fence(__ATOMIC_ACQUIRE, "agent");
            asm volatile("s_waitcnt vmcnt(0)" ::: "memory");
        }
    }
    __syncthreads();
}
__device__ __forceinline__ Params fresh(const Params& p) { Params q = p; unsigned long long w = (unsigned long long)q.ws; asm volatile("" : "+s"(w)); q.ws = (unsigned char*)w; return q; }
#define GRID_BAR() do { XcdBarrier xb_ = xbar; unsigned long long bw_ = (unsigned long long)xb_.bar; asm volatile("" : "+s"(bw_)); xb_.bar = (unsigned*)bw_; xcd_barrier(xb_); } while (0)
__global__ void __launch_bounds__(NTHREADS, 2) k_fwd(Params p) {
  {
    volatile LAS unsigned* st = (volatile LAS unsigned*)(LAS char*)(dyn_lds + LDS_PHASE_BYTES);
    if (threadIdx.x == 0) { st[0] = 0u; st[1] = 0u; st[2] = 0u; st[3] = 0u;
    }
    __syncthreads();
  }
  const XcdBarrier xbar = xcd_barrier_post((unsigned*)(p.ws + WS_CTL) + CW_BAR, (volatile LAS unsigned*)(LAS char*)(dyn_lds + LDS_PHASE_BYTES));
#else
#define GRID_BAR() emu_gridsync()
static inline Params fresh(const Params& p) { return p; }
static void k_fwd(Params p) {
#endif
  if (PHMASK & (1u << 0)) { phase_mod_rope(fresh(p)); if (DUP_PHASE == 0) { GRID_BAR(); phase_mod_rope(fresh(p)); } }
  for (int l = 0; l < DEPTH; ++l) {
    if (PHMASK & (1u << 1)) { phase_convert(fresh(p), l); if (DUP_PHASE == 1) { GRID_BAR(); phase_convert(fresh(p), l); } }
    GRID_BAR();
    if (PHMASK & (1u << 2)) { if (l == 0) phase_norm(fresh(p), l, 0, 0); else phase_norm(fresh(p), l, 1, 0); if (DUP_PHASE == 2 && l == 0) { GRID_BAR(); phase_norm(fresh(p), l, 0, 0); } }
    GRID_BAR();
    if (PHMASK & (1u << 3)) { phase_gemm_in(fresh(p), l); if (DUP_PHASE == 3) { GRID_BAR(); phase_gemm_in(fresh(p), l); } }
    GRID_BAR();
    if (PHMASK & (1u << 4)) { phase_prep(fresh(p), l); if (DUP_PHASE == 4) { GRID_BAR(); phase_prep(fresh(p), l); } }
    GRID_BAR();
    if (PHMASK & (1u << 5)) { phase_mlstm_a(fresh(p)); if (DUP_PHASE == 5) { GRID_BAR(); phase_mlstm_a(fresh(p)); } }
    GRID_BAR();
    if (PHMASK & (1u << 6)) { phase_mlstm_scan(fresh(p)); if (DUP_PHASE == 6) { GRID_BAR(); phase_mlstm_scan(fresh(p)); } }
    if (PHMASK & (1u << 7)) { phase_attn(fresh(p)); if (DUP_PHASE == 7) { GRID_BAR(); phase_attn(fresh(p)); } }
    GRID_BAR();
    if (PHMASK & (1u << 8)) { phase_mlstm_c(fresh(p), l); if (DUP_PHASE == 8) { GRID_BAR(); phase_mlstm_c(fresh(p), l); } }
    GRID_BAR();
    if (PHMASK & (1u << 9)) { phase_gemm_merge(fresh(p)); if (DUP_PHASE == 9) { GRID_BAR(); phase_gemm_merge(fresh(p)); } }
    GRID_BAR();
    if (PHMASK & (1u << 10)) { phase_gemm_out(fresh(p), l); if (DUP_PHASE == 10) { GRID_BAR(); phase_gemm_out(fresh(p), l); } }
    GRID_BAR();
    if (PHMASK & (1u << 11)) { phase_norm2_router(fresh(p), l); if (DUP_PHASE == 11) { GRID_BAR(); phase_norm2_router(fresh(p), l, true); } }
    GRID_BAR();
    if (PHMASK & (1u << 12)) { phase_moe_up(fresh(p), l); if (DUP_PHASE == 12) { GRID_BAR(); phase_moe_up(fresh(p), l); } }
    GRID_BAR();
    if (PHMASK & (1u << 13)) { phase_moe_down(fresh(p), l); if (DUP_PHASE == 13) { GRID_BAR(); phase_moe_down(fresh(p), l); } }
    GRID_BAR();
  }
  if (PHMASK & (1u << 14)) { phase_norm(fresh(p), DEPTH, 1, 2); if (DUP_PHASE == 14) { GRID_BAR(); phase_norm(fresh(p), DEPTH, 1, 2); } }
}

#ifdef EMU
static int emu_grid_size = 8;
static int emu_stop_after = 1000;
#endif
extern "C" void kernel_launch(void* const* d_in, const int* in_sizes, int n_in, void* d_out, int out_size, void* d_ws, size_t ws_size, hipStream_t stream) {
  (void)in_sizes; (void)n_in; (void)out_size;
  if (ws_size < WS_TOTAL) { fprintf(stderr, "workspace too small: %zu < %zu\n", ws_size, (size_t)WS_TOTAL); return; }
  Params prm{};
  const float** f = (const float**)&prm;
  for (int i = 0; i < 24; ++i) f[i] = (const float*)d_in[i];
  prm.out = (float*)d_out; prm.ws = (unsigned char*)d_ws;
#ifdef EMU
  memset(d_ws, 0, CTL_BYTES);
  emu_launch(emu_grid_size, NTHREADS, LDS_BYTES, [=]() { k_fwd(prm); }, true);
#else
  static int grid = 0;
  if (!grid) {
    int dev = 0, cus = 0, per_cu = 0;
    (void)hipGetDevice(&dev);
    (void)hipDeviceGetAttribute(&cus, hipDeviceAttributeMultiprocessorCount, dev);
    (void)hipFuncSetAttribute((const void*)k_fwd, hipFuncAttributeMaxDynamicSharedMemorySize, LDS_BYTES);
    (void)hipOccupancyMaxActiveBlocksPerMultiprocessor(&per_cu, k_fwd, NTHREADS, LDS_BYTES);
    grid = cus * (per_cu < 1 ? per_cu : 1);
    if (grid <= 0) { fprintf(stderr, "occupancy query says the kernel does not fit (cus %d per_cu %d)\n", cus, per_cu); grid = 0; return; }
  }
  (void)hipMemsetAsync(d_ws, 0, CTL_BYTES, stream);
  k_fwd<<<grid, NTHREADS, LDS_BYTES, stream>>>(prm);
#endif
}
```
